# Optimizing an MI355X kernel written in HIP

```python
import jax, jax.numpy as jnp
from jax import lax
import numpy as np

D_MODEL = 1024
BATCH = 4
SEQ = 4096
DEPTH = 1

CONV_DIM = 512
CONV_WIDTH = 3
N_HEADS = 16
N_KV_HEADS = 4
HEAD_DIM = 64
GROUP = N_HEADS // N_KV_HEADS
CMP_LEN = 32
CMP_STRIDE = 16
CMP_HIDDEN = 256
SEL_LEN = 64
SEL_TOP = 16
WINDOW = 512
Q_BLOCK = 64
N_NSA_BRANCHES = 3
D_FF = -(-8 * D_MODEL // (3 * 256)) * 256
EPS = 1e-6

Q_COLS = N_HEADS * HEAD_DIM
KV_COLS = N_KV_HEADS * HEAD_DIM
IN_SIZES = (CONV_DIM, CONV_DIM, CONV_DIM, Q_COLS,
            KV_COLS, KV_COLS, KV_COLS, KV_COLS, KV_COLS, KV_COLS,
            N_NSA_BRANCHES * N_HEADS, D_MODEL, D_MODEL)
IN_COLS = sum(IN_SIZES)

kernel_name = "hybrid_shortconv_nsa_gated_merge"


def _split_points():
    pts, acc = [], 0
    for s in IN_SIZES[:-1]:
        acc += s
        pts.append(acc)
    return pts


def rmsnorm(x, g):
    xf = x.astype(jnp.float32)
    y = xf * lax.rsqrt(jnp.mean(xf * xf, axis=-1, keepdims=True) + EPS)
    return (y * g.astype(jnp.float32)).astype(x.dtype)


def masked_softmax(s, mask):
    s = jnp.where(mask, s.astype(jnp.float32), -jnp.inf)
    m = jnp.max(s, axis=-1, keepdims=True)
    m = jnp.where(jnp.isfinite(m), m, 0.0)
    e = jnp.exp(s - m)
    return e / jnp.maximum(jnp.sum(e, axis=-1, keepdims=True), 1e-30)


def short_conv_mixer(b_gate, c_gate, h_in, conv_w, w_out):
    S = h_in.shape[1]
    u = c_gate * h_in
    up = jnp.pad(u, ((0, 0), (CONV_WIDTH - 1, 0), (0, 0)))
    conv = sum(up[:, k:k + S, :] * conv_w[k] for k in range(CONV_WIDTH))
    return (b_gate * conv) @ w_out


def compress(kv, pos, w1, w2, n_cmp):
    B = kv.shape[0]
    idx = jnp.arange(n_cmp)[:, None] * CMP_STRIDE + jnp.arange(CMP_LEN)[None, :]
    blk = kv[:, idx] + pos[None, None, :, None, :]
    blk = blk.transpose(0, 3, 1, 2, 4).reshape(B, N_KV_HEADS, n_cmp, CMP_LEN * HEAD_DIM)
    return jax.nn.gelu(blk @ w1) @ w2


def overlap_matrix(n_cmp, n_sel):
    cs = np.arange(n_cmp)[:, None] * CMP_STRIDE
    ss = np.arange(n_sel)[None, :] * SEL_LEN
    ov = np.maximum(0, np.minimum(cs + CMP_LEN, ss + SEL_LEN) - np.maximum(cs, ss))
    return jnp.asarray(ov / CMP_LEN, dtype=jnp.float32)


def nsa_attention(q, k_cmp, v_cmp, k_sel, v_sel, k_win, v_win, overlap, n_top):
    B, _, _, S, _ = q.shape
    n_cmp = k_cmp.shape[2]
    n_sel = k_sel.shape[2]
    scale = HEAD_DIM ** -0.5
    cmp_end = jnp.arange(n_cmp) * CMP_STRIDE + CMP_LEN - 1
    blk_ids = jnp.arange(n_sel)
    bi = jnp.arange(B)[:, None, None]
    hi = jnp.arange(N_KV_HEADS)[None, :, None]

    def block(b):
        q0 = b * Q_BLOCK
        qb = lax.dynamic_slice_in_dim(q, q0, Q_BLOCK, axis=3)
        t = q0 + jnp.arange(Q_BLOCK)
        s = jnp.einsum('bhgqd,bhnd->bhgqn', qb, k_cmp) * scale
        p_cmp = masked_softmax(s, cmp_end[None, :] <= t[:, None])
        o_cmp = jnp.einsum('bhgqn,bhnd->bhgqd', p_cmp.astype(v_cmp.dtype), v_cmp)
        imp = jnp.einsum('bhgqn,nm->bhqm', p_cmp, overlap)
        cur = t // SEL_LEN
        forced = (blk_ids[None, :] == 0) | (blk_ids[None, :] == cur[:, None]) | (blk_ids[None, :] == cur[:, None] - 1)
        imp = jnp.where(forced, jnp.inf, imp)
        imp = jnp.where(blk_ids[None, :] * SEL_LEN <= t[:, None], imp, -jnp.inf)
        top_val, top_idx = lax.top_k(imp, n_top)
        blk_ok = top_val > -jnp.inf
        flat = top_idx.reshape(B, N_KV_HEADS, Q_BLOCK * n_top)
        ks = k_sel[bi, hi, flat].reshape(B, N_KV_HEADS, Q_BLOCK, n_top * SEL_LEN, HEAD_DIM)
        vs = v_sel[bi, hi, flat].reshape(B, N_KV_HEADS, Q_BLOCK, n_top * SEL_LEN, HEAD_DIM)
        kpos = top_idx[..., None] * SEL_LEN + jnp.arange(SEL_LEN)
        smask = (kpos <= t[None, None, :, None, None]) & blk_ok[..., None]
        smask = smask.reshape(B, N_KV_HEADS, Q_BLOCK, n_top * SEL_LEN)
        s = jnp.einsum('bhgqd,bhqkd->bhgqk', qb, ks) * scale
        p = masked_softmax(s, smask[:, :, None])
        o_sel = jnp.einsum('bhgqk,bhqkd->bhgqd', p.astype(vs.dtype), vs)
        kw = lax.dynamic_slice_in_dim(k_win, q0, Q_BLOCK + WINDOW, axis=2)
        vw = lax.dynamic_slice_in_dim(v_win, q0, Q_BLOCK + WINDOW, axis=2)
        wpos = q0 - WINDOW + jnp.arange(Q_BLOCK + WINDOW)
        diff = t[:, None] - wpos[None, :]
        wmask = (diff >= 0) & (diff < WINDOW) & (wpos[None, :] >= 0)
        s = jnp.einsum('bhgqd,bhkd->bhgqk', qb, kw) * scale
        p = masked_softmax(s, wmask)
        o_win = jnp.einsum('bhgqk,bhkd->bhgqd', p.astype(vw.dtype), vw)
        return jnp.stack([o_cmp, o_sel, o_win], axis=0)

    out = lax.map(block, jnp.arange(S // Q_BLOCK))
    out = out.transpose(1, 2, 0, 5, 3, 4, 6)
    return out.reshape(N_NSA_BRANCHES, B, S, N_HEADS, HEAD_DIM)


def setup_inputs(seed: int = 0) -> dict:
    key = jax.random.key(seed)
    ks = jax.random.split(key, 20)
    L = DEPTH
    nrm = lambda k, shape, fan_in: jax.random.normal(k, shape, jnp.float32) * (fan_in ** -0.5)
    gain = lambda k, shape: 1.0 + 0.05 * jax.random.normal(k, shape, jnp.float32)
    return {
        "x": jax.random.normal(ks[0], (BATCH, SEQ, D_MODEL), jnp.float32),
        "w_in": nrm(ks[1], (L, D_MODEL, IN_COLS), D_MODEL),
        "conv_w": nrm(ks[2], (L, CONV_WIDTH, CONV_DIM), CONV_WIDTH),
        "w_conv_out": nrm(ks[3], (L, CONV_DIM, D_MODEL), CONV_DIM),
        "cmp_pos_k": 0.1 * jax.random.normal(ks[4], (L, CMP_LEN, HEAD_DIM), jnp.float32),
        "cmp_w1_k": nrm(ks[5], (L, CMP_LEN * HEAD_DIM, CMP_HIDDEN), CMP_LEN * HEAD_DIM),
        "cmp_w2_k": nrm(ks[6], (L, CMP_HIDDEN, HEAD_DIM), CMP_HIDDEN),
        "cmp_pos_v": 0.1 * jax.random.normal(ks[7], (L, CMP_LEN, HEAD_DIM), jnp.float32),
        "cmp_w1_v": nrm(ks[8], (L, CMP_LEN * HEAD_DIM, CMP_HIDDEN), CMP_LEN * HEAD_DIM),
        "cmp_w2_v": nrm(ks[9], (L, CMP_HIDDEN, HEAD_DIM), CMP_HIDDEN),
        "w_attn_out": nrm(ks[10], (L, Q_COLS, D_MODEL), Q_COLS),
        "w_o": nrm(ks[11], (L, D_MODEL, D_MODEL), D_MODEL),
        "g_mix": gain(ks[12], (L, D_MODEL)),
        "g_ffn": gain(ks[13], (L, D_MODEL)),
        "w_gate": nrm(ks[14], (L, D_MODEL, D_FF), D_MODEL),
        "w_up": nrm(ks[15], (L, D_MODEL, D_FF), D_MODEL),
        "w_down": nrm(ks[16], (L, D_FF, D_MODEL), D_FF),
        "g_final": gain(ks[17], (D_MODEL,)),
    }


def reference(x, w_in, conv_w, w_conv_out, cmp_pos_k, cmp_w1_k, cmp_w2_k, cmp_pos_v, cmp_w1_v, cmp_w2_v,
              w_attn_out, w_o, g_mix, g_ffn, w_gate, w_up, w_down, g_final):
    B, S, _ = x.shape
    n_cmp = (S - CMP_LEN) // CMP_STRIDE + 1
    n_sel = S // SEL_LEN
    n_top = min(SEL_TOP, n_sel)
    overlap = overlap_matrix(n_cmp, n_sel)
    split_pts = _split_points()
    h = x
    for l in range(DEPTH):
        n = rmsnorm(h, g_mix[l])
        proj = n @ w_in[l]
        (b_gate, c_gate, h_conv, q, k_c, v_c, k_s, v_s, k_w, v_w,
         g_br, g_conv, g_attn) = jnp.split(proj, split_pts, axis=-1)
        y_conv = short_conv_mixer(b_gate, c_gate, h_conv, conv_w[l], w_conv_out[l])
        q = q.reshape(B, S, N_KV_HEADS, GROUP, HEAD_DIM).transpose(0, 2, 3, 1, 4)
        kvh = lambda t: t.reshape(B, S, N_KV_HEADS, HEAD_DIM)
        k_cmp = compress(kvh(k_c), cmp_pos_k[l], cmp_w1_k[l], cmp_w2_k[l], n_cmp)
        v_cmp = compress(kvh(v_c), cmp_pos_v[l], cmp_w1_v[l], cmp_w2_v[l], n_cmp)
        selb = lambda t: kvh(t).reshape(B, n_sel, SEL_LEN, N_KV_HEADS, HEAD_DIM).transpose(0, 3, 1, 2, 4)
        winp = lambda t: jnp.pad(kvh(t).transpose(0, 2, 1, 3), ((0, 0), (0, 0), (WINDOW, 0), (0, 0)))
        o_all = nsa_attention(q, k_cmp, v_cmp, selb(k_s), selb(v_s), winp(k_w), winp(v_w), overlap, n_top)
        br_gates = jax.nn.sigmoid(g_br).reshape(B, S, N_NSA_BRANCHES, N_HEADS)
        o = jnp.einsum('bsch,cbshd->bshd', br_gates, o_all).reshape(B, S, Q_COLS)
        y_attn = o @ w_attn_out[l]
        mix = jax.nn.sigmoid(g_conv) * y_conv + jax.nn.sigmoid(g_attn) * y_attn
        h = h + mix @ w_o[l]
        n = rmsnorm(h, g_ffn[l])
        h = h + (jax.nn.silu(n @ w_gate[l]) * (n @ w_up[l])) @ w_down[l]
    return rmsnorm(h, g_final)
```

```cpp
#include <hip/hip_runtime.h>
#include <hip/hip_cooperative_groups.h>
#include <cstdio>
#include <cstdint>
namespace cg = cooperative_groups;

#define LAS __attribute__((address_space(3)))
typedef unsigned short bf16_t;
typedef short bf16x8 __attribute__((ext_vector_type(8)));
typedef short s16x4 __attribute__((ext_vector_type(4)));
typedef float f32x4 __attribute__((ext_vector_type(4)));
typedef float f32x16 __attribute__((ext_vector_type(16)));
typedef unsigned u32x4 __attribute__((ext_vector_type(4)));
typedef unsigned u32x2 __attribute__((ext_vector_type(2)));
typedef float f32x2_t __attribute__((ext_vector_type(2)));
typedef __bf16 bf16x2_t __attribute__((ext_vector_type(2)));

constexpr int MTOK = 16384, DM = 1024, SEQ = 4096, NB = 4;
constexpr int PP = 6400;
constexpr int INCOLS = 6192;
constexpr int C_B = 0, C_C = 512, C_H = 1024, C_Q = 1536, C_KC = 2560, C_VC = 2816, C_KS = 3072, C_VS = 3328, C_KW = 3584, C_VW = 3840,
              C_GBR = 4096, C_GCONV = 4144, C_GATTN = 5168;
constexpr int DFF = 2816;
constexpr float EPS = 1e-6f;
constexpr float LOG2E = 1.4426950408889634f;
constexpr float QSCALE = 0.125f * LOG2E;

constexpr size_t MiB = 1u << 20;
constexpr size_t WS_PART1 = 0;
constexpr size_t WS_PART2 = 1 * MiB;
constexpr size_t WS_BIAS = 2 * MiB;
constexpr size_t WS_BAR = 2 * MiB + 65536;
constexpr size_t WS_WIN = 3 * MiB;
constexpr size_t WS_WCONV = 16 * MiB;
constexpr size_t WS_WATTN = 17 * MiB;
constexpr size_t WS_WO = 19 * MiB;
constexpr size_t WS_WUP = 21 * MiB;
constexpr size_t WS_WDOWN = 32 * MiB;
constexpr size_t WS_W1 = 38 * MiB;
constexpr size_t WS_W2 = 40 * MiB;
constexpr size_t WS_HID = 41 * MiB;
constexpr size_t WS_KCMP = 45 * MiB;
constexpr size_t WS_PROJ = 46 * MiB;
constexpr size_t WS_H1F = 46 * MiB;
constexpr size_t WS_H1B = 110 * MiB;
constexpr size_t WS_ACT = 142 * MiB;
constexpr size_t WS_NEED = 246 * MiB;
constexpr size_t OUT_BC = 32 * MiB;

constexpr int LDS_BYTES = 147456;

__device__ __forceinline__ float bf2f(unsigned short v) { return __uint_as_float(((unsigned)v) << 16); }
__device__ __forceinline__ unsigned pk2(float lo, float hi) { f32x2_t v = {lo, hi}; bf16x2_t b = __builtin_convertvector(v, bf16x2_t); return __builtin_bit_cast(unsigned, b); }
__device__ __forceinline__ float ex2(float x) { return __builtin_amdgcn_exp2f(x); }
__device__ __forceinline__ float sigmoidf_(float x) { return __builtin_amdgcn_rcpf(1.0f + ex2(-x * LOG2E)); }
__device__ __forceinline__ float lo_bf(unsigned w) { return __uint_as_float(w << 16); }
__device__ __forceinline__ float hi_bf(unsigned w) { return __uint_as_float(w & 0xffff0000u); }

namespace pg8 {
constexpr int BM = 256, BK = 64, HALF = 128, HTB = HALF * BK * 2, STAGE_BYTES = 8 * HTB, NXCD = 8, WGM = 8;
__host__ __device__ __forceinline__ int lds_byte(int r, int c) { const int st = (r >> 4) * 2 + (c >> 5), rr = r & 15, cc = c & 31, ob = rr * 64 + cc * 2; return st * 1024 + (ob ^ (((ob >> 9) & 1) << 5)); }
__host__ __device__ __forceinline__ void stage_rc(int b, int& R, int& C) { const int st = b / 1024, sb = b % 1024, swz = sb ^ (((sb >> 9) & 1) << 5); R = (st >> 1) * 16 + swz / 64; C = (st & 1) * 32 + (swz % 64) / 2; }
__host__ __device__ __forceinline__ int perm32(int rho) { const int n = rho >> 4, i = rho & 15; return 8 * (i >> 2) + 4 * n + (i & 3); }

struct Unit { int pm, pn; };
struct Gemm { const bf16_t* A; const bf16_t* Bt; int M, N, K; int lda; int a_kstep; int amode; };

struct StaticOrder {
    int nM, nN, nwg, G, c;
    __host__ __device__ void init(int M, int N, int G_, int c_) { nM = M / BM; nN = N / BM; nwg = nM * nN; G = G_; c = c_; }
    __host__ __device__ bool next(int i, Unit& u) const {
        const long L = (long)i * G + c; if (L >= nwg) return false;
        int wgid = (int)L; { const int q = nwg / NXCD, r = nwg % NXCD, xcd = wgid % NXCD, off = wgid / NXCD; wgid = (xcd < r ? xcd * (q + 1) : r * (q + 1) + (xcd - r) * q) + off; }
        const int nig = WGM * nN, gid = wgid / nig, fm = gid * WGM, gsz = (nM - fm) < WGM ? (nM - fm) : WGM;
        u.pm = fm + ((wgid % nig) % gsz); u.pn = (wgid % nig) / gsz; return true;
    }
};

__device__ __forceinline__ const char* a_tile(const Gemm& g, const Unit& u) {
    if (g.amode == 1) return (const char*)g.A + ((size_t)(u.pm >> 2) * SEQ * PP + (size_t)u.pn * 256 + (size_t)(u.pm & 3) * 64) * 2;
    if (g.amode == 2) return (const char*)g.A + ((size_t)u.pn * 4096 * 256 + (size_t)u.pm * 256 * 256) * 2;
    return (const char*)g.A + (size_t)u.pm * 256 * (size_t)g.lda * 2;
}

template <class Epi>
__device__ __forceinline__ void gemm_phase(LAS unsigned char* lds, const Gemm g, const StaticOrder& S, const Epi& E) {
#ifdef NO_GEMM
    return;
#endif
    int tid_ = threadIdx.x; asm volatile("" : "+v"(tid_));
    const int tid = tid_, wid = __builtin_amdgcn_readfirstlane(tid >> 6), lane = tid & 63, wr = wid >> 2, wc = wid & 3, fr = lane & 15, fq = lane >> 4;
    const int K = g.K, nt = K / BK;
    unsigned voffA[2], voffB[2];
#pragma unroll
    for (int i = 0; i < 2; ++i) { int R, C; stage_rc(tid * 16 + i * 8192, R, C); const int Rb = (R & ~31) + perm32(R & 31);
        voffA[i] = (unsigned)(R * g.lda + C) * 2u; voffB[i] = (unsigned)(Rb * K + C) * 2u; }
    const size_t kstepA = (size_t)g.a_kstep, kstepB = (size_t)(BK * 2);
    const size_t hstepA = (size_t)HALF * g.lda * 2, hstepB = (size_t)HALF * K * 2;
    const size_t tstepB = 2 * hstepB;
    const unsigned ldsw = (unsigned)wid * 1024u;
    const int aoff = lds_byte(wr * 64 + fr, fq * 8), boff = lds_byte(wc * 32 + fr, fq * 8);
#define PG8_SA(b, h) (((b) * 2 + (h)) * HTB)
#define PG8_SB(b, h) ((4 + (b) * 2 + (h)) * HTB)
#define PG8_STAGE(bufoff, gbase, voff) do { _Pragma("unroll") for (int _i = 0; _i < 2; ++_i) \
        __builtin_amdgcn_global_load_lds((const unsigned*)((const char*)(gbase) + (voff)[_i]), (LAS unsigned*)(lds + (bufoff) + ldsw + _i * 8192), 16, 0, 0); } while (0)
#define PG8_LDA(dst, b, h) do { _Pragma("unroll") for (int m = 0; m < 4; ++m) _Pragma("unroll") for (int k = 0; k < 2; ++k) dst[m][k] = *(const LAS bf16x8*)(lds + PG8_SA(b, h) + aoff + m * 2048 + k * 1024); } while (0)
#define PG8_LDB(dst, b, h) do { _Pragma("unroll") for (int n = 0; n < 2; ++n) _Pragma("unroll") for (int k = 0; k < 2; ++k) dst[n][k] = *(const LAS bf16x8*)(lds + PG8_SB(b, h) + boff + n * 2048 + k * 1024); } while (0)
#define PG8_MMA(ai, bj, At, Bt) do { __builtin_amdgcn_s_setprio(1); _Pragma("unroll") for (int m = 0; m < 4; ++m) _Pragma("unroll") for (int n = 0; n < 2; ++n) _Pragma("unroll") for (int k = 0; k < 2; ++k) \
        acc[ai][bj][m][n] = __builtin_amdgcn_mfma_f32_16x16x32_bf16(Bt[n][k], At[m][k], acc[ai][bj][m][n], 0, 0, 0); __builtin_amdgcn_s_setprio(0); } while (0)
#define PG8_WAIT_V(n) asm volatile("s_waitcnt vmcnt(" #n ")" ::: "memory")
#define PG8_WAIT_L(n) asm volatile("s_waitcnt lgkmcnt(" #n ")" ::: "memory")
#define PG8_BAR __builtin_amdgcn_s_barrier()
#define PG8_SCHED __builtin_amdgcn_sched_barrier(0)
    Unit cur, nxt; int ui = 0;
    if (!S.next(0, cur)) return;
    f32x4 acc[2][2][4][2];
#pragma unroll
    for (int a = 0; a < 2; ++a)
#pragma unroll
        for (int b = 0; b < 2; ++b)
#pragma unroll
            for (int m = 0; m < 4; ++m)
#pragma unroll
                for (int n = 0; n < 2; ++n) acc[a][b][m][n] = (f32x4){0.f, 0.f, 0.f, 0.f};
    bf16x8 At[4][2], B0[2][2], B1[2][2];
    const char* cA = a_tile(g, cur); const char* cB = (const char*)g.Bt + (size_t)cur.pn * tstepB;
    PG8_STAGE(PG8_SB(0, 0), cB, voffB); PG8_STAGE(PG8_SB(0, 1), cB + hstepB, voffB); PG8_STAGE(PG8_SA(0, 0), cA, voffA); PG8_STAGE(PG8_SA(0, 1), cA + hstepA, voffA);
    if (wr == 1) PG8_BAR;
    PG8_WAIT_V(2); PG8_BAR;
    PG8_STAGE(PG8_SB(1, 0), cB + kstepB, voffB); PG8_STAGE(PG8_SA(1, 0), cA + kstepA, voffA); PG8_STAGE(PG8_SB(1, 1), cB + hstepB + kstepB, voffB);
    PG8_WAIT_V(6); PG8_BAR;
    for (;;) {
        const bool has_next = S.next(ui + 1, nxt);
        const char* nA = has_next ? a_tile(g, nxt) : cA; const char* nB = has_next ? (const char*)g.Bt + (size_t)nxt.pn * tstepB : cB;
        for (int t = 0; t < nt; t += 2) {
            const bool last = (t == nt - 2);
            const char* a1 = cA + (size_t)(t + 1) * kstepA;
            const char* a2 = last ? nA : cA + (size_t)(t + 2) * kstepA; const char* b2 = last ? nB : cB + (size_t)(t + 2) * kstepB;
            const char* a3 = a2 + kstepA; const char* b3 = b2 + kstepB;
            PG8_LDB(B0, 0, 0); PG8_LDB(B1, 0, 1); PG8_SCHED; PG8_LDA(At, 0, 0); PG8_STAGE(PG8_SA(1, 1), a1 + hstepA, voffA);
            PG8_WAIT_V(8); PG8_WAIT_L(0); PG8_BAR; PG8_MMA(0, 0, At, B0); PG8_MMA(0, 1, At, B1); PG8_BAR; PG8_SCHED;
            PG8_LDA(At, 0, 1); PG8_STAGE(PG8_SB(0, 0), b2, voffB); PG8_STAGE(PG8_SB(0, 1), b2 + hstepB, voffB); PG8_STAGE(PG8_SA(0, 0), a2, voffA);
            PG8_WAIT_V(8); PG8_WAIT_L(0); PG8_BAR; PG8_MMA(1, 0, At, B0); PG8_MMA(1, 1, At, B1); PG8_BAR; PG8_SCHED;
            PG8_LDB(B0, 1, 0); PG8_LDB(B1, 1, 1); PG8_SCHED; PG8_LDA(At, 1, 0); PG8_STAGE(PG8_SA(0, 1), a2 + hstepA, voffA);
            PG8_WAIT_V(8); PG8_WAIT_L(0); PG8_BAR; PG8_MMA(0, 0, At, B0); PG8_MMA(0, 1, At, B1); PG8_BAR; PG8_SCHED;
            PG8_LDA(At, 1, 1); PG8_STAGE(PG8_SB(1, 0), b3, voffB); PG8_STAGE(PG8_SB(1, 1), b3 + hstepB, voffB); PG8_STAGE(PG8_SA(1, 0), a3, voffA);
            PG8_WAIT_V(8); PG8_WAIT_L(0); PG8_BAR; PG8_MMA(1, 0, At, B0); PG8_MMA(1, 1, At, B1); PG8_BAR; PG8_SCHED;
        }
        if (wr == 0) PG8_BAR;
        E(acc, cur, wr, wc, fr, fq);
        if (!has_next) break;
#pragma unroll
        for (int a = 0; a < 2; ++a)
#pragma unroll
            for (int b = 0; b < 2; ++b)
#pragma unroll
                for (int m = 0; m < 4; ++m)
#pragma unroll
                    for (int n = 0; n < 2; ++n) acc[a][b][m][n] = (f32x4){0.f, 0.f, 0.f, 0.f};
        cur = nxt; cA = nA; cB = nB; ++ui;
        if (wr == 1) PG8_BAR;
    }
    PG8_WAIT_V(0);
    PG8_BAR;
#undef PG8_SA
#undef PG8_SB
#undef PG8_STAGE
#undef PG8_LDA
#undef PG8_LDB
#undef PG8_MMA
#undef PG8_WAIT_V
#undef PG8_WAIT_L
#undef PG8_BAR
#undef PG8_SCHED
}

typedef f32x4 Acc[2][2][4][2];
#define EPI_LOOP_BEGIN \
    _Pragma("unroll") for (int ai = 0; ai < 2; ++ai) _Pragma("unroll") for (int m = 0; m < 4; ++m) { const int row = u.pm * BM + wr * 64 + fr + ai * HALF + m * 16; \
    _Pragma("unroll") for (int bj = 0; bj < 2; ++bj) { const f32x4 v0 = acc[ai][bj][m][0], v1 = acc[ai][bj][m][1]; const int col = u.pn * BM + bj * HALF + wc * 32 + 8 * fq;
#define EPI_LOOP_END } }
__device__ __forceinline__ u32x4 pack8(const f32x4 a, const f32x4 b) { u32x4 w; w.x = pk2(a[0], a[1]); w.y = pk2(a[2], a[3]); w.z = pk2(b[0], b[1]); w.w = pk2(b[2], b[3]); return w; }

struct EpiProj { bf16_t* O; int ldc;
    __device__ __forceinline__ void operator()(const Acc& acc, const Unit& u, int wr, int wc, int fr, int fq) const {
        EPI_LOOP_BEGIN
            *(u32x4*)(O + (size_t)row * ldc + col) = pack8(v0, v1);
        EPI_LOOP_END
    } };
__device__ __forceinline__ float gelu_tanh(float x) {
    const float z = x * (1.0f + 0.044715f * x * x) * (2.0f * 0.7978845608028654f * LOG2E);
    return x * __builtin_amdgcn_rcpf(1.0f + ex2(-z));
}
struct EpiHid { bf16_t* O; const float* bias;
    __device__ __forceinline__ void operator()(const Acc& acc, const Unit& u, int wr, int wc, int fr, int fq) const {
        EPI_LOOP_BEGIN
            const int c = col - u.pn * BM; const float* bp = bias + u.pn * 256 + c;
            const f32x4 b0 = *(const f32x4*)bp, b1 = *(const f32x4*)(bp + 4);
            f32x4 a = v0 + b0, b = v1 + b1;
#pragma unroll
            for (int j = 0; j < 4; ++j) { a[j] = gelu_tanh(a[j]); b[j] = gelu_tanh(b[j]); }
            *(u32x4*)(O + (size_t)u.pn * 4096 * 256 + (size_t)row * 256 + c) = pack8(a, b);
        EPI_LOOP_END
    } };
struct EpiCmp { bf16_t* O;
    __device__ __forceinline__ void operator()(const Acc& acc, const Unit& u, int wr, int wc, int fr, int fq) const {
        EPI_LOOP_BEGIN
            const int c = col - u.pn * BM;
            if (c < 64) { u32x4 w = pack8(v0, v1); if ((row & 255) == 255) w = (u32x4){0u, 0u, 0u, 0u};
                *(u32x4*)(O + (size_t)u.pn * 4096 * 64 + (size_t)row * 64 + c) = w; }
        EPI_LOOP_END
    } };
template <int ADD> struct EpiMix { bf16_t* mix; const bf16_t* proj; int gcol;
    __device__ __forceinline__ void operator()(const Acc& acc, const Unit& u, int wr, int wc, int fr, int fq) const {
        EPI_LOOP_BEGIN
            const u32x4 gv = *(const u32x4*)(proj + (size_t)row * PP + gcol + col);
            f32x4 a, b;
            a[0] = sigmoidf_(lo_bf(gv.x)) * v0[0]; a[1] = sigmoidf_(hi_bf(gv.x)) * v0[1]; a[2] = sigmoidf_(lo_bf(gv.y)) * v0[2]; a[3] = sigmoidf_(hi_bf(gv.y)) * v0[3];
            b[0] = sigmoidf_(lo_bf(gv.z)) * v1[0]; b[1] = sigmoidf_(hi_bf(gv.z)) * v1[1]; b[2] = sigmoidf_(lo_bf(gv.w)) * v1[2]; b[3] = sigmoidf_(hi_bf(gv.w)) * v1[3];
            bf16_t* mp = mix + (size_t)row * DM + col;
            if (ADD) { const u32x4 pv = *(const u32x4*)mp;
                a[0] += lo_bf(pv.x); a[1] += hi_bf(pv.x); a[2] += lo_bf(pv.y); a[3] += hi_bf(pv.y); b[0] += lo_bf(pv.z); b[1] += hi_bf(pv.z); b[2] += lo_bf(pv.w); b[3] += hi_bf(pv.w); }
            *(u32x4*)mp = pack8(a, b);
        EPI_LOOP_END
    } };
template <int WB> struct EpiRes { const float* base; float* hf; bf16_t* hb; float* part;
    __device__ __forceinline__ void operator()(const Acc& acc, const Unit& u, int wr, int wc, int fr, int fq) const {
#pragma unroll
        for (int ai = 0; ai < 2; ++ai)
#pragma unroll
            for (int m = 0; m < 4; ++m) { const int row = u.pm * BM + wr * 64 + fr + ai * HALF + m * 16; float ss = 0.f;
#pragma unroll
                for (int bj = 0; bj < 2; ++bj) { const int col = u.pn * BM + bj * HALF + wc * 32 + 8 * fq; const size_t off = (size_t)row * DM + col;
                    const f32x4 x0 = *(const f32x4*)(base + off), x1 = *(const f32x4*)(base + off + 4);
                    const f32x4 a = x0 + acc[ai][bj][m][0], b = x1 + acc[ai][bj][m][1];
                    *(f32x4*)(hf + off) = a; *(f32x4*)(hf + off + 4) = b;
                    if (WB) *(u32x4*)(hb + off) = pack8(a, b);
                    ss += (a[0] * a[0] + a[1] * a[1]) + (a[2] * a[2] + a[3] * a[3]) + (b[0] * b[0] + b[1] * b[1]) + (b[2] * b[2] + b[3] * b[3]); }
                ss += __shfl_xor(ss, 16); ss += __shfl_xor(ss, 32);
                if (fq == 0) part[(size_t)row * 16 + u.pn * 4 + wc] = ss; }
    } };
struct EpiUp { bf16_t* act; const float* part;
    __device__ __forceinline__ void operator()(const Acc& acc, const Unit& u, int wr, int wc, int fr, int fq) const {
#pragma unroll
        for (int ai = 0; ai < 2; ++ai)
#pragma unroll
            for (int m = 0; m < 4; ++m) { const int row = u.pm * BM + wr * 64 + fr + ai * HALF + m * 16;
                const f32x4 pp = *(const f32x4*)(part + (size_t)row * 16 + 4 * fq); float ss = (pp[0] + pp[1]) + (pp[2] + pp[3]);
                ss += __shfl_xor(ss, 16); ss += __shfl_xor(ss, 32);
                const float r = __builtin_amdgcn_rsqf(ss * (1.0f / DM) + EPS);
                f32x4 a, b;
#pragma unroll
                for (int j = 0; j < 4; ++j) { const float g0 = acc[ai][0][m][0][j] * r, u0 = acc[ai][1][m][0][j] * r, g1 = acc[ai][0][m][1][j] * r, u1 = acc[ai][1][m][1][j] * r;
                    a[j] = g0 * sigmoidf_(g0) * u0; b[j] = g1 * sigmoidf_(g1) * u1; }
                *(u32x4*)(act + (size_t)row * DFF + u.pn * 128 + wc * 32 + 8 * fq) = pack8(a, b); }
    } };
}

namespace att {
constexpr int KB0 = 0, VB0 = 16384, IMP = 32768, IMPW = 65, SELM = IMP + 4 * 64 * IMPW * 4, WMASK = SELM + 512, WSF = WMASK + 64, STEPS = WSF + 8 * 32 * 4, QFR = STEPS + 8 * 128, ATT_LDS = QFR + 8 * 4096;
static_assert(ATT_LDS <= 143360, "attention LDS");
#define MFMA32(a, b, c) __builtin_amdgcn_mfma_f32_32x32x16_bf16((a), (b), (c), 0, 0, 0)
__device__ __forceinline__ int crow(int r, int hi) { return (r & 3) + 8 * (r >> 2) + 4 * hi; }
typedef short v4i16_t __attribute__((ext_vector_type(4)));
__device__ __forceinline__ s16x4 vtr(LAS const unsigned char* p) { return __builtin_bit_cast(s16x4, __builtin_amdgcn_ds_read_tr16_b64_v4i16((LAS v4i16_t*)p)); }

struct St { float m, l; f32x16 o0, o1; };

__device__ __forceinline__ void qk_tile(f32x16& p0, f32x16& p1, LAS const unsigned char* kb, LAS const unsigned char* qf, int r, int h) {
    bf16x8 k0[4], k1[4], qv[4];
#pragma unroll
    for (int d0 = 0; d0 < 4; ++d0) { k0[d0] = *(const LAS bf16x8*)(kb + (2 * d0 + h) * 1024 + r * 16); k1[d0] = *(const LAS bf16x8*)(kb + (2 * d0 + h) * 1024 + 512 + r * 16);
        qv[d0] = *(const LAS bf16x8*)(qf + d0 * 1024); }
#pragma unroll
    for (int i = 0; i < 16; ++i) { p0[i] = 0.f; p1[i] = 0.f; }
    __builtin_amdgcn_sched_barrier(0);
#pragma unroll
    for (int d0 = 0; d0 < 4; ++d0) { p0 = MFMA32(k0[d0], qv[d0], p0); p1 = MFMA32(k1[d0], qv[d0], p1); }
}
__device__ __forceinline__ void apply_mask(f32x16& p0, f32x16& p1, unsigned long long allow, int h) {
    if (__all(allow == ~0ull)) return;
    const unsigned long long a = allow >> (4 * h); const unsigned lo = (unsigned)a, hi = (unsigned)(a >> 32);
#pragma unroll
    for (int i = 0; i < 16; ++i) { const int cb = (i & 3) + 8 * (i >> 2);
        p0[i] = ((lo >> cb) & 1u) ? p0[i] : -INFINITY; p1[i] = ((hi >> cb) & 1u) ? p1[i] : -INFINITY; }
}
__device__ __forceinline__ float rowmax32(const f32x16& p0, const f32x16& p1) {
    float a = fmaxf(p0[0], p1[0]);
#pragma unroll
    for (int i = 1; i < 16; ++i) a = fmaxf(a, fmaxf(p0[i], p1[i]));
    return fmaxf(a, __shfl_xor(a, 32));
}
__device__ __forceinline__ void pv_tile(f32x16& o0, f32x16& o1, LAS const unsigned char* vb, const f32x16& p0, const f32x16& p1, int lane, int h) {
    bf16x8 pa[4];
#pragma unroll
    for (int s = 0; s < 4; ++s) { u32x4 w;
#pragma unroll
        for (int j = 0; j < 4; ++j) { const int i0 = 8 * (s & 1) + 2 * j; w[j] = (s < 2) ? pk2(p0[i0], p0[i0 + 1]) : pk2(p1[i0], p1[i0 + 1]); }
        pa[s] = __builtin_bit_cast(bf16x8, w); }
    LAS const unsigned char* vp = vb + ((lane >> 4) & 1) * 32 + (lane & 3) * 8 + (4 * h + ((lane & 15) >> 2)) * 64;
    s16x4 l0[4], h0[4], l1[4], h1[4];
#pragma unroll
    for (int s = 0; s < 4; ++s) { l0[s] = vtr(vp + s * 1024); h0[s] = vtr(vp + s * 1024 + 512); l1[s] = vtr(vp + 4096 + s * 1024); h1[s] = vtr(vp + 4096 + s * 1024 + 512); }
    __builtin_amdgcn_sched_barrier(0);
#pragma unroll
    for (int s = 0; s < 4; ++s) {
        const bf16x8 v0 = (bf16x8){l0[s][0], l0[s][1], l0[s][2], l0[s][3], h0[s][0], h0[s][1], h0[s][2], h0[s][3]};
        const bf16x8 v1 = (bf16x8){l1[s][0], l1[s][1], l1[s][2], l1[s][3], h1[s][0], h1[s][1], h1[s][2], h1[s][3]};
        o0 = MFMA32(pa[s], v0, o0); o1 = MFMA32(pa[s], v1, o1);
    }
}
__device__ __forceinline__ void tile_online(St& st, LAS const unsigned char* kb, LAS const unsigned char* vb, LAS const unsigned char* qr, unsigned long long allow,
                                            LAS float* wsf, int lane, int r, int h) {
    f32x16 p0, p1; qk_tile(p0, p1, kb, qr, r, h); __builtin_amdgcn_sched_barrier(0); apply_mask(p0, p1, allow, h);
    const float rm = rowmax32(p0, p1), mnew = fmaxf(st.m, rm), f = ex2(st.m - mnew); st.m = mnew;
    float ls = 0.f;
#pragma unroll
    for (int i = 0; i < 16; ++i) { p0[i] = ex2(p0[i] - mnew); p1[i] = ex2(p1[i] - mnew); ls += p0[i] + p1[i]; }
    st.l = st.l * f + ls;
    if (__any(f != 1.0f)) {
        if (h == 0) wsf[r] = f;
#pragma unroll
        for (int i = 0; i < 16; ++i) { const float fi = wsf[crow(i, h)]; st.o0[i] *= fi; st.o1[i] *= fi; }
    }
    pv_tile(st.o0, st.o1, vb, p0, p1, lane, h);
}
__device__ __forceinline__ void tile_stats(float& m, float& l, LAS const unsigned char* kb, LAS const unsigned char* qr, unsigned long long allow, int r, int h) {
    f32x16 p0, p1; qk_tile(p0, p1, kb, qr, r, h); __builtin_amdgcn_sched_barrier(0); apply_mask(p0, p1, allow, h);
    const float rm = rowmax32(p0, p1), mnew = fmaxf(m, rm), f = ex2(m - mnew); m = mnew;
    float ls = 0.f;
#pragma unroll
    for (int i = 0; i < 16; ++i) ls += ex2(p0[i] - mnew) + ex2(p1[i] - mnew);
    l = l * f + ls;
}
__device__ __forceinline__ void tile_exact(f32x16& o0, f32x16& o1, float m, float invl, LAS const unsigned char* kb, LAS const unsigned char* vb, LAS const unsigned char* qr,
                                           unsigned long long allow, LAS float* impw  , float& carry, int j, int lane, int r, int h) {
    f32x16 p0, p1; qk_tile(p0, p1, kb, qr, r, h); __builtin_amdgcn_sched_barrier(0); apply_mask(p0, p1, allow, h);
#pragma unroll
    for (int i = 0; i < 16; ++i) { p0[i] = ex2(p0[i] - m) * invl; p1[i] = ex2(p1[i] - m) * invl; }
#pragma unroll
    for (int pos = 0; pos < 8; ++pos) {
        const int half = pos >> 2, r4 = pos & 3;
        const float P0 = half ? p1[4 * r4] : p0[4 * r4], P1 = half ? p1[4 * r4 + 1] : p0[4 * r4 + 1], P2 = half ? p1[4 * r4 + 2] : p0[4 * r4 + 2], P3 = half ? p1[4 * r4 + 3] : p0[4 * r4 + 3];
        const float a = (P0 + P1) + (P2 + 0.5f * P3), b = 0.5f * P3;
        const float bx = __shfl_xor(b, 32);
        const float add = h ? bx : carry;
        impw[16 * j + 2 * pos + h] = a + add;
        carry = bx;
    }
    pv_tile(o0, o1, vb, p0, p1, lane, h);
}

__device__ __forceinline__ void qk_tile_c(f32x16& p0, f32x16& p1, LAS const unsigned char* kb, LAS const unsigned char* qf, const f32x16& c, int r, int h) {
    bf16x8 k0[4], k1[4], qv[4];
#pragma unroll
    for (int d0 = 0; d0 < 4; ++d0) { k0[d0] = *(const LAS bf16x8*)(kb + (2 * d0 + h) * 1024 + r * 16); k1[d0] = *(const LAS bf16x8*)(kb + (2 * d0 + h) * 1024 + 512 + r * 16);
        qv[d0] = *(const LAS bf16x8*)(qf + d0 * 1024); }
    __builtin_amdgcn_sched_barrier(0);
    p0 = MFMA32(k0[0], qv[0], c); p1 = MFMA32(k1[0], qv[0], c);
#pragma unroll
    for (int d0 = 1; d0 < 4; ++d0) { p0 = MFMA32(k0[d0], qv[d0], p0); p1 = MFMA32(k1[d0], qv[d0], p1); }
}
__device__ __forceinline__ unsigned long long lowmask(int n);
__device__ __forceinline__ void soft_pv(St& st, f32x16& x0, f32x16& x1, float cx, LAS const unsigned char* vb, bool first, int kind, int tq,
                                        LAS float* wsf, int lane, int r, int h) {
    if (first) st.m = cx;
    else { const float d = st.m - cx;
        if (__any(d != 0.f)) {
#pragma unroll
            for (int i = 0; i < 16; ++i) { x0[i] -= d; x1[i] -= d; } } }
    if (kind) apply_mask(x0, x1, kind == 1 ? lowmask(tq + 1) : ~lowmask(tq + 1), h);
    const float rm = rowmax32(x0, x1);
    if (first) {
        const float dl = (rm > -INFINITY) ? rm : 0.f; st.m += dl;
#pragma unroll
        for (int i = 0; i < 16; ++i) { x0[i] -= dl; x1[i] -= dl; }
    } else if (__any(rm > 8.0f)) {
        const float dl = fmaxf(rm, 0.f), f = ex2(-dl); st.m += dl; st.l *= f;
        if (h == 0) wsf[r] = f;
#pragma unroll
        for (int i = 0; i < 16; ++i) { x0[i] -= dl; x1[i] -= dl; }
#pragma unroll
        for (int i = 0; i < 16; ++i) { const float fi = wsf[crow(i, h)]; st.o0[i] *= fi; st.o1[i] *= fi; }
    }
    float ls = 0.f;
#pragma unroll
    for (int i = 0; i < 16; ++i) { x0[i] = ex2(x0[i]); x1[i] = ex2(x1[i]); ls += x0[i] + x1[i]; }
    st.l += ls;
    pv_tile(st.o0, st.o1, vb, x0, x1, lane, h);
}
__device__ __forceinline__ unsigned long long lowmask(int n) { return n >= 64 ? ~0ull : ((1ull << n) - 1ull); }

__device__ __forceinline__ void attn_unit(LAS unsigned char* lds, bf16_t* proj, const bf16_t* kcmp, const bf16_t* vcmp, int bh, int qb, int skipw) {
    int tid_ = threadIdx.x; asm volatile("" : "+v"(tid_));
    const int tid = tid_, lane = tid & 63, r = lane & 31, h = lane >> 5, wid = __builtin_amdgcn_readfirstlane(tid >> 6);
    const int b = bh >> 2, hk = bh & 3, g = wid >> 1, tq = (wid & 1) * 32 + r;
    const size_t row = (size_t)b * SEQ + (size_t)qb * 64 + tq;
    const int t = qb * 64 + tq;
    bf16_t* qp = proj + row * PP + C_Q + (hk * 4 + g) * 64;
    LAS unsigned char* qr = lds + QFR + wid * 4096 + lane * 16;
#pragma unroll
    for (int d0 = 0; d0 < 4; ++d0) *(LAS bf16x8*)(qr + d0 * 1024) = *(const bf16x8*)(qp + d0 * 16 + h * 8);
    float gate[3];
#pragma unroll
    for (int c = 0; c < 3; ++c) gate[c] = sigmoidf_(bf2f(proj[row * PP + C_GBR + c * 16 + hk * 4 + g]));
#ifdef GATE2X
    if (GATE2X & 1) gate[0] *= 2.f; if (GATE2X & 2) gate[1] *= 2.f; if (GATE2X & 4) gate[2] *= 2.f;
#endif
#ifdef GATEZ
    if (GATEZ & 1) gate[0] = 0.f; if (GATEZ & 2) gate[1] = 0.f; if (GATEZ & 4) gate[2] = 0.f;
#endif
    LAS float* wsf = (LAS float*)(lds + WSF) + wid * 32;
    LAS float* impw = (LAS float*)(lds + IMP) + (g * 64 + tq) * IMPW;
    const size_t krow = lane, kcol = wid * 8;
    const size_t vrow = 16 * (wid & 3) + (lane >> 2), vcol = 32 * (wid >> 2) + 8 * (lane & 3);
    LAS unsigned char* kst = lds + KB0 + wid * 1024 + lane * 16;
    LAS unsigned char* vst = lds + VB0 + wid * 1024 + lane * 16;
    u32x4 kreg, vreg;
    LAS float* osl = (LAS float*)(lds + IMP + wid * (32 * IMPW * 4)) + lane;
#define LDK(base, pitch) kreg = *(const u32x4*)((base) + krow * (size_t)(pitch) + kcol)
#define LDV(base, pitch) vreg = *(const u32x4*)((base) + vrow * (size_t)(pitch) + vcol)
#define STK(buf) *(LAS u32x4*)(kst + (buf) * 8192) = kreg
#define STV(buf) *(LAS u32x4*)(vst + (buf) * 8192) = vreg
#define KBUF(buf) (lds + KB0 + (buf) * 8192)
#define VBUF(buf) (lds + VB0 + (buf) * 8192)
#define ACCUM_OUT(scale_expr, FIRST) do { if (h == 0) wsf[r] = (scale_expr); \
        _Pragma("unroll") for (int i = 0; i < 16; ++i) { const float sc = wsf[crow(i, h)]; \
            if (FIRST) { osl[(i * 2) * 64] = st.o0[i] * sc; osl[(i * 2 + 1) * 64] = st.o1[i] * sc; } \
            else { osl[(i * 2) * 64] += st.o0[i] * sc; osl[(i * 2 + 1) * 64] += st.o1[i] * sc; } } } while (0)

    St st;
    const bf16_t* kc = kcmp + (size_t)bh * 256 * 64; const bf16_t* vc = vcmp + (size_t)bh * 256 * 64;
    const int nmax = (t >= 31) ? ((t - 31) >> 4) : -1;
    float carry = 0.f;
    float m1 = -1e30f, l1 = 0.f;
    LDK(kc, 64); STK(0); __syncthreads();
#pragma unroll 1
    for (int j = 0; j < 4; ++j) {
        if (j + 1 < 4) LDK(kc + (size_t)(j + 1) * 64 * 64, 64);
        { const int cnt = nmax - 64 * j + 1; const unsigned long long allow = cnt <= 0 ? 0ull : lowmask(cnt);
          tile_stats(m1, l1, KBUF(j & 1), qr, allow, r, h); }
        if (j + 1 < 4) STK((j + 1) & 1);
        __syncthreads();
    }
    l1 += __shfl_xor(l1, 32);
    const float invl = __builtin_amdgcn_rcpf(fmaxf(l1, 1e-30f));
#pragma unroll
    for (int i = 0; i < 16; ++i) { st.o0[i] = 0.f; st.o1[i] = 0.f; }
    LDK(kc, 64); LDV(vc, 64); STK(0); STV(0); __syncthreads();
#pragma unroll 1
    for (int j = 0; j < 4; ++j) {
        if (j + 1 < 4) { LDK(kc + (size_t)(j + 1) * 64 * 64, 64); LDV(vc + (size_t)(j + 1) * 64 * 64, 64); }
        { const int cnt = nmax - 64 * j + 1; const unsigned long long allow = cnt <= 0 ? 0ull : lowmask(cnt);
          tile_exact(st.o0, st.o1, m1, invl, KBUF(j & 1), VBUF(j & 1), qr, allow, impw, carry, j, lane, r, h); }
        if (j + 1 < 4) { STK((j + 1) & 1); STV((j + 1) & 1); }
        __syncthreads();
    }
    {
        unsigned long long wor = 0ull;
        const unsigned long long valid = lowmask(qb + 1);
        LAS const float* ib = (LAS const float*)(lds + IMP);
        unsigned key[8], T[8];
#pragma unroll
        for (int i = 0; i < 8; ++i) { const int q = wid * 8 + i;
            float v = ((ib[(0 * 64 + q) * IMPW + lane] + ib[(1 * 64 + q) * IMPW + lane]) + ib[(2 * 64 + q) * IMPW + lane]) + ib[(3 * 64 + q) * IMPW + lane];
            if (lane == 0 || lane == qb || lane == qb - 1) v = INFINITY;
            key[i] = (lane <= qb) ? __float_as_uint(fmaxf(v, 0.f)) : 0u; T[i] = 0u; }
#pragma unroll 1
        for (int bb = 30; bb >= 0; --bb) {
#pragma unroll
            for (int i = 0; i < 8; ++i) { const unsigned cand = T[i] | (1u << bb);
                const int c = __popcll(__ballot(key[i] >= cand) & valid); T[i] = (c >= 16) ? cand : T[i]; }
        }
#pragma unroll
        for (int i = 0; i < 8; ++i) { const int q = wid * 8 + i;
            const unsigned long long gt = __ballot(key[i] > T[i]) & valid, eq = __ballot(key[i] == T[i]) & valid;
            const int need = 16 - __popcll(gt);
            const bool pick = ((eq >> lane) & 1ull) && (__popcll(eq & lowmask(lane)) < need);
            const unsigned long long msk = gt | __ballot(pick);
            if (lane == 0) *(LAS unsigned long long*)(lds + SELM + q * 8) = msk;
            wor |= msk; }
        if (lane == 0) *(LAS unsigned long long*)(lds + WMASK + wid * 8) = wor;
    }
    __syncthreads();
    unsigned long long un = 0ull;
#pragma unroll
    for (int w = 0; w < 8; ++w) un |= *(LAS const unsigned long long*)(lds + WMASK + w * 8);
    { const unsigned ulo = __builtin_amdgcn_readfirstlane((unsigned)un), uhi = __builtin_amdgcn_readfirstlane((unsigned)(un >> 32)); un = ((unsigned long long)uhi << 32) | ulo; }
    const unsigned long long mysel = *(LAS const unsigned long long*)(lds + SELM + tq * 8);
    ACCUM_OUT(gate[0], true);
#ifdef PROBE_NOLD
    const bool NOLD = skipw != 0;
#else
    const bool NOLD = false;
#endif
    LAS unsigned char* steps = lds + STEPS + wid * 128;
    const int nsel = __popcll(un), j0w = qb >= 8 ? qb - 8 : 0, nwin = qb - j0w + 1, NS = nsel + nwin;
    if ((un >> lane) & 1ull) steps[__popcll(un & lowmask(lane))] = (unsigned char)lane;
    if (lane < nwin) steps[nsel + lane] = (unsigned char)(0x80 | (j0w + lane));
    {
        const bf16_t* ksb = proj + (size_t)b * SEQ * PP + C_KS + hk * 64;
#define STEP_CODE(s_) ((int)__builtin_amdgcn_readfirstlane((int)steps[(s_)]))
#define KSRC(code) (ksb + (size_t)((code) >> 7) * (C_KW - C_KS) + (size_t)((code) & 127) * 64 * PP)
#define VSRC(code) (ksb + (C_VS - C_KS) + (size_t)((code) >> 7) * (C_VW - C_VS) + (size_t)((code) & 127) * 64 * PP)
        st.m = 0.f; st.l = 0.f;
#pragma unroll
        for (int i = 0; i < 16; ++i) { st.o0[i] = 0.f; st.o1[i] = 0.f; }
        f32x16 pa0, pa1, pb0, pb1; float ca = 0.f, cb = 0.f;
        int code0 = STEP_CODE(0), code1 = NS > 1 ? STEP_CODE(1) : 0;
        LDK(KSRC(code0), PP); LDV(VSRC(code0), PP); STK(0); STV(0);
        if (NS > 1) LDK(KSRC(code1), PP);
        __syncthreads();
        {
          f32x16 cc;
#pragma unroll
          for (int i = 0; i < 16; ++i) cc[i] = 0.f;
          qk_tile_c(pa0, pa1, KBUF(0), qr, cc, r, h); ca = 0.f; }
        if (NS > 1) STK(1);
        __syncthreads();
#define SW_STEP(X0, X1, CX, Y0, Y1, CY, s_) do { \
            const int s = (s_); const int code = STEP_CODE(s); const bool hasn = s + 1 < NS, hasn2 = s + 2 < NS; \
            const int coden = hasn ? STEP_CODE(s + 1) : 0, coden2 = hasn2 ? STEP_CODE(s + 2) : 0; \
            if (hasn2 && !NOLD) LDK(KSRC(coden2), PP); \
            if (hasn && !NOLD) LDV(VSRC(coden), PP); \
            if (hasn) { CY = st.m; \
                const bool en = (coden & 0x80) ? true : (((mysel >> (coden & 127)) & 1ull) != 0ull); const float cv = en ? -st.m : -INFINITY; f32x16 cc; \
                _Pragma("unroll") for (int i = 0; i < 16; ++i) cc[i] = cv; \
                qk_tile_c(Y0, Y1, KBUF((s + 1) & 1), qr, cc, r, h); __builtin_amdgcn_sched_barrier(0); } \
            { const int jj = code & 127; const bool isw = (code & 0x80) != 0; const bool first = (s == 0) || (s == nsel); \
              if (s == nsel) {   \
                  const float lt = st.l + __shfl_xor(st.l, 32); ACCUM_OUT(gate[1] * __builtin_amdgcn_rcpf(fmaxf(lt, 1e-30f)), false); \
                  st.l = 0.f; _Pragma("unroll") for (int i = 0; i < 16; ++i) { st.o0[i] = 0.f; st.o1[i] = 0.f; } } \
              int kind = 0; if (jj == qb) kind = 1; else if (isw && jj == qb - 8) kind = 2; \
              soft_pv(st, X0, X1, CX, VBUF(s & 1), first, kind, tq, wsf, lane, r, h); } \
            if (hasn2 && !NOLD) STK(s & 1); \
            if (hasn && !NOLD) STV((s + 1) & 1); \
            __syncthreads(); } while (0)
#pragma unroll 1
        for (int s2 = 0; s2 < NS; s2 += 2) {
            SW_STEP(pa0, pa1, ca, pb0, pb1, cb, s2);
            if (s2 + 1 < NS) SW_STEP(pb0, pb1, cb, pa0, pa1, ca, s2 + 1);
        }
        const float lt = st.l + __shfl_xor(st.l, 32);
        if (h == 0) wsf[r] = gate[2] * __builtin_amdgcn_rcpf(fmaxf(lt, 1e-30f));
#undef SW_STEP
#undef STEP_CODE
#undef KSRC
#undef VSRC
    }
    {
        bf16_t* ob = proj + ((size_t)b * SEQ + (size_t)qb * 64 + (wid & 1) * 32) * PP + C_Q + (hk * 4 + g) * 64;
        if (!skipw)
#pragma unroll
        for (int i = 0; i < 16; ++i) { const int q = crow(i, h); const float sc = wsf[q];
            const float f0 = osl[(i * 2) * 64] + st.o0[i] * sc, f1 = osl[(i * 2 + 1) * 64] + st.o1[i] * sc;
            ob[(size_t)q * PP + r] = (bf16_t)(pk2(f0, 0.f) & 0xffffu); ob[(size_t)q * PP + 32 + r] = (bf16_t)(pk2(f1, 0.f) & 0xffffu); }
    }
#undef LDK
#undef LDV
#undef STK
#undef STV
#undef KBUF
#undef VBUF
#undef ACCUM_OUT
}
}

__device__ __forceinline__ float wave_sum(float v) {
#pragma unroll
    for (int o = 1; o < 64; o <<= 1) v += __shfl_xor(v, o);
    return v;
}
__device__ __forceinline__ void transpose_item(const float* W, int K, int N, bf16_t* WT, int ldt, int k0, int n0, int drow0, const float* kscale, float cscale, LAS float* scr, int lane) {
#pragma unroll 8
    for (int i = 0; i < 32; ++i) { const int kk = 2 * i + (lane >> 5); const int n = n0 + (lane & 31);
        float v = (n < N) ? W[(size_t)(k0 + kk) * N + n] : 0.f;
        if (kscale) v *= kscale[k0 + kk];
        scr[kk * 33 + (lane & 31)] = v * cscale; }
    asm volatile("s_waitcnt lgkmcnt(0)" ::: "memory");
    const int c = lane & 7;
#pragma unroll
    for (int j = 0; j < 4; ++j) { const int n = (lane >> 3) + 8 * j; const LAS float* s = scr + (8 * c) * 33 + n;
        u32x4 o; o.x = pk2(s[0 * 33], s[1 * 33]); o.y = pk2(s[2 * 33], s[3 * 33]); o.z = pk2(s[4 * 33], s[5 * 33]); o.w = pk2(s[6 * 33], s[7 * 33]);
        *(u32x4*)(WT + (size_t)(drow0 + n) * ldt + k0 + 8 * c) = o; }
    asm volatile("s_waitcnt lgkmcnt(0)" ::: "memory");
}

#define XB_TMO      128
#define XB_XCNT(j)  (256  + 64 * (j))
#define XB_XSUB(j)  (1280 + 64 * (j))
#define XB_XGEN(j)  (2304 + 64 * (j))
#define XB_TOP      3328
#define XB_TOPGEN   3392
#define XCD_BAR_WORDS 3456
#define XB_SPIN_CAP (1u << 18)
__device__ __forceinline__ unsigned xb_ld(unsigned* p)              { return __hip_atomic_load(p, __ATOMIC_RELAXED, __HIP_MEMORY_SCOPE_AGENT); }
__device__ __forceinline__ unsigned xb_add(unsigned* p, unsigned v) { return __hip_atomic_fetch_add(p, v, __ATOMIC_RELAXED, __HIP_MEMORY_SCOPE_AGENT); }
__device__ __forceinline__ unsigned xb_xcc_id() { return (unsigned)__builtin_amdgcn_s_getreg((3 << 11) | 20) & 0xFu; }
#define XB_SPIN(cond, bar) do { unsigned _sp = 0; while (cond) { __builtin_amdgcn_s_sleep(1); \
    if ((++_sp & 255u) == 0u) { if (xb_ld(&(bar)[XB_TMO])) break; if (_sp > XB_SPIN_CAP) { atomicAdd(&(bar)[XB_TMO], 1u); break; } } } } while (0)
struct XcdBarrier { unsigned* bar; unsigned x; volatile LAS unsigned* st; };
__device__ __forceinline__ XcdBarrier xcd_barrier_post(unsigned* bar, volatile LAS unsigned* st) {
    XcdBarrier b; b.bar = bar; b.x = xb_xcc_id(); b.st = st;
    if (threadIdx.x == 0) (void)xb_add(&bar[XB_XCNT(b.x)], 1u);
    return b;
}
__device__ __forceinline__ void xcd_barrier_complete(unsigned* bar, unsigned x, unsigned& nloc, unsigned& nx) {
    const unsigned G = gridDim.x * gridDim.y * gridDim.z;
    unsigned sum, cnt, mine, sp = 0u;
    for (;;) {
        sum = 0u; cnt = 0u; mine = 0u;
#pragma unroll
        for (unsigned j = 0; j < 16; ++j) { const unsigned c = xb_ld(&bar[XB_XCNT(j)]); sum += c; cnt += (c > 0u) ? 1u : 0u; mine = (j == x) ? c : mine; }
        if (sum == G) break;
        __builtin_amdgcn_s_sleep(1);
        if ((++sp & 255u) == 0u) { if (xb_ld(&bar[XB_TMO])) break; if (sp > XB_SPIN_CAP) { atomicAdd(&bar[XB_TMO], 1u); break; } }
    }
    nloc = mine > 0u ? mine : 1u; nx = cnt > 0u ? cnt : 1u;
}
__device__ __forceinline__ void xcd_barrier(const XcdBarrier& b) {
    asm volatile("s_waitcnt vmcnt(0)" ::: "memory");
    __syncthreads();
    if (threadIdx.x == 0) {
        unsigned* bar = b.bar;
        __builtin_amdgcn_s_waitcnt(0);
        unsigned nloc = b.st[0], nx = b.st[1];
        if (nloc == 0u) { xcd_barrier_complete(bar, b.x, nloc, nx); b.st[0] = nloc; b.st[1] = nx; }
        const unsigned old = xb_add(&bar[XB_XSUB(b.x)], 1u);
        const unsigned gen = old / nloc;
        if (old + 1u == (gen + 1u) * nloc) {
            __builtin_amdgcn_fence(__ATOMIC_RELEASE, "agent");
            asm volatile("s_waitcnt vmcnt(0)" ::: "memory");
            const unsigned og = xb_add(&bar[XB_TOP], 1u);
            const unsigned tg = og / nx;
            if (og + 1u == (tg + 1u) * nx) xb_add(&bar[XB_TOPGEN], 1u);
            else XB_SPIN(xb_ld(&bar[XB_TOPGEN]) == tg, bar);
            __builtin_amdgcn_fence(__ATOMIC_ACQUIRE, "agent");
            xb_add(&bar[XB_XGEN(b.x)], 1u);
            asm volatile("s_waitcnt vmcnt(0)" ::: "memory");
        } else {
            XB_SPIN(xb_ld(&bar[XB_XGEN(b.x)]) == gen, bar);
            __builtin_amdgcn_fence(__ATOMIC_ACQUIRE, "agent");
            asm volatile("s_waitcnt vmcnt(0)" ::: "memory");
        }
    }
    __syncthreads();
}

struct Args {
    const float *x, *w_in, *conv_w, *w_conv_out, *pos_k, *w1_k, *w2_k, *pos_v, *w1_v, *w2_v, *w_attn_out, *w_o, *g_mix, *g_ffn, *w_gate, *w_up, *w_down, *g_final;
    float* out; unsigned char* ws; int probe; int pad;
};

__global__ void __launch_bounds__(512, 2) nsa_fwd(Args a) {
    extern __shared__ __attribute__((aligned(16))) unsigned char lds_raw[];
    LAS unsigned char* lds = (LAS unsigned char*)lds_raw;
    cg::grid_group grid = cg::this_grid();
    const int tid = threadIdx.x, lane = tid & 63, wave = __builtin_amdgcn_readfirstlane(tid >> 6);
    const int G = gridDim.x, bx = blockIdx.x;
    const int vcu = (G % 8 == 0) ? (bx % 8) * (G / 8) + bx / 8 : bx;
    unsigned char* ws = a.ws;
    volatile LAS unsigned* bst = (volatile LAS unsigned*)(lds + 143360);
    if (tid < 2) bst[tid] = 0u;
    __syncthreads();
    const XcdBarrier gbar = xcd_barrier_post((unsigned*)(ws + WS_BAR), bst);
#define SEAM() xcd_barrier(gbar)
    float* part1 = (float*)(ws + WS_PART1); float* part2 = (float*)(ws + WS_PART2); float* cbias = (float*)(ws + WS_BIAS);
    bf16_t* Win = (bf16_t*)(ws + WS_WIN); bf16_t* Wconv = (bf16_t*)(ws + WS_WCONV); bf16_t* Wattn = (bf16_t*)(ws + WS_WATTN); bf16_t* Wo = (bf16_t*)(ws + WS_WO);
    bf16_t* Wup = (bf16_t*)(ws + WS_WUP); bf16_t* Wdown = (bf16_t*)(ws + WS_WDOWN); bf16_t* W1 = (bf16_t*)(ws + WS_W1); bf16_t* W2 = (bf16_t*)(ws + WS_W2);
    bf16_t* hid = (bf16_t*)(ws + WS_HID); bf16_t* kcmp = (bf16_t*)(ws + WS_KCMP); bf16_t* proj = (bf16_t*)(ws + WS_PROJ);
    float* h1f = (float*)(ws + WS_H1F); bf16_t* h1b = (bf16_t*)(ws + WS_H1B); bf16_t* act = (bf16_t*)(ws + WS_ACT);
    bf16_t* nb = (bf16_t*)a.out; bf16_t* mix = (bf16_t*)a.out; bf16_t* bc = (bf16_t*)((unsigned char*)a.out + OUT_BC);

    {
        LAS float* scr = (LAS float*)(lds + wave * 16384);
        const int gw = vcu * 8 + wave, NGW = G * 8;
        constexpr int I_IN = 16 * 194, I_CONV = 8 * 32, I_ATT = 16 * 32, I_O = 16 * 32, I_G = 16 * 88, I_U = 16 * 88, I_D = 44 * 32, I_1 = 32 * 8, I_2 = 4 * 2;
        constexpr int NITEMS = I_IN + I_CONV + I_ATT + I_O + 2 * I_1 + 2 * I_2;
        for (int it = gw; it < NITEMS; it += NGW) {
            int q = it;
            if (q < I_IN) { const int kb = q / 194, nbk = q % 194, n0 = 32 * nbk; const float cs = (n0 >= C_Q && n0 < C_KC) ? QSCALE : 1.0f;
                transpose_item(a.w_in, 1024, INCOLS, Win, 1024, 64 * kb, n0, n0, a.g_mix, cs, scr, lane); continue; } q -= I_IN;
            if (q < I_CONV) { const int kb = q / 32, nbk = q % 32; transpose_item(a.w_conv_out, 512, 1024, Wconv, 512, 64 * kb, 32 * nbk, 32 * nbk, nullptr, 1.f, scr, lane); continue; } q -= I_CONV;
            if (q < I_ATT) { const int kb = q / 32, nbk = q % 32; transpose_item(a.w_attn_out, 1024, 1024, Wattn, 1024, 64 * kb, 32 * nbk, 32 * nbk, nullptr, 1.f, scr, lane); continue; } q -= I_ATT;
            if (q < I_O) { const int kb = q / 32, nbk = q % 32; transpose_item(a.w_o, 1024, 1024, Wo, 1024, 64 * kb, 32 * nbk, 32 * nbk, nullptr, 1.f, scr, lane); continue; } q -= I_O;
            if (q < I_1) { const int kb = q / 8, nbk = q % 8; transpose_item(a.w1_k, 2048, 256, W1, 2048, 64 * kb, 32 * nbk, 32 * nbk, nullptr, 1.f, scr, lane); continue; } q -= I_1;
            if (q < I_1) { const int kb = q / 8, nbk = q % 8; transpose_item(a.w1_v, 2048, 256, W1, 2048, 64 * kb, 32 * nbk, 256 + 32 * nbk, nullptr, 1.f, scr, lane); continue; } q -= I_1;
            if (q < I_2) { const int kb = q / 2, nbk = q % 2; transpose_item(a.w2_k, 256, 64, W2, 256, 64 * kb, 32 * nbk, 32 * nbk, nullptr, 1.f, scr, lane); continue; } q -= I_2;
            { const int kb = q / 2, nbk = q % 2; transpose_item(a.w2_v, 256, 64, W2, 256, 64 * kb, 32 * nbk, 256 + 32 * nbk, nullptr, 1.f, scr, lane); }
        }
        const int gt = vcu * 512 + tid, NGT = G * 512;
        for (int i = gt; i < 192 * 1024 / 8; i += NGT) *(u32x4*)(Win + (size_t)6208 * 1024 + (size_t)i * 8) = (u32x4){0u, 0u, 0u, 0u};
        for (int i = gt; i < 2 * 192 * 256 / 8; i += NGT) { const int half = i / (192 * 256 / 8), o = i % (192 * 256 / 8);
            *(u32x4*)(W2 + (size_t)(half * 256 + 64) * 256 + (size_t)o * 8) = (u32x4){0u, 0u, 0u, 0u}; }
        for (int m = gw; m < MTOK; m += NGW) {
            const f32x4* xr = (const f32x4*)(a.x + (size_t)m * DM) + lane; f32x4 v[4]; float s = 0.f;
#pragma unroll
            for (int j = 0; j < 4; ++j) { v[j] = xr[64 * j]; s += (v[j][0] * v[j][0] + v[j][1] * v[j][1]) + (v[j][2] * v[j][2] + v[j][3] * v[j][3]); }
            const float rstd = __builtin_amdgcn_rsqf(wave_sum(s) * (1.0f / DM) + EPS);
            u32x2* o8 = (u32x2*)(nb + (size_t)m * DM) + lane;
#pragma unroll
            for (int j = 0; j < 4; ++j) { u32x2 w; w.x = pk2(v[j][0] * rstd, v[j][1] * rstd); w.y = pk2(v[j][2] * rstd, v[j][3] * rstd); o8[64 * j] = w; }
        }
        if (bx < 2) {
            const float* pos = bx ? a.pos_v : a.pos_k; const float* w1 = bx ? a.w1_v : a.w1_k;
            const int j = tid & 255, part = tid >> 8; float s = 0.f;
            for (int k = part * 1024; k < part * 1024 + 1024; ++k) s += pos[k] * w1[(size_t)k * 256 + j];
            LAS float* red = (LAS float*)(lds + 8 * 16384);
            if (part == 1) red[j] = s;
            __syncthreads();
            if (part == 0) cbias[bx * 256 + j] = s + red[j];
        }
    }
    if (a.probe == 0x7fffffff) grid.sync();
    SEAM();
    {
        const int ncols1 = (G > 64) ? 6144 : PP;
        pg8::Gemm g{nb, Win, MTOK, ncols1, DM, DM, 128, 0}; pg8::StaticOrder S; S.init(MTOK, ncols1, G, bx);
        pg8::EpiProj E{proj, PP};
        pg8::gemm_phase(lds, g, S, E);
    }
    SEAM();
    {
        {
            pg8::Gemm g{proj + C_KC, W1, 4096, 512, 2048, 16 * PP, PP * 2, 1}; pg8::StaticOrder S; S.init(4096, 512, G, bx);
            pg8::EpiHid E{hid, cbias};
            pg8::gemm_phase(lds, g, S, E);
        }
        int wb = bx, wn = G; if (G > 64) { wb = bx - 32; wn = G - 32; }
        if (wb >= 0) {
            for (int it = wb * 512 + tid; it < MTOK * 64; it += wn * 512) {
                const int row = it >> 6, ch = (it & 63) * 8, t = row & (SEQ - 1);
                const bf16_t* pr = proj + (size_t)row * PP;
                float accv[8];
#pragma unroll
                for (int j = 0; j < 8; ++j) accv[j] = 0.f;
#pragma unroll
                for (int k = 0; k < 3; ++k) { const int dt = 2 - k;
                    if (t - dt >= 0) { const u32x4 cv = *(const u32x4*)(pr - (size_t)dt * PP + C_C + ch), hv = *(const u32x4*)(pr - (size_t)dt * PP + C_H + ch);
                        const f32x4 w0 = *(const f32x4*)(a.conv_w + k * 512 + ch), w1 = *(const f32x4*)(a.conv_w + k * 512 + ch + 4);
                        accv[0] += w0[0] * lo_bf(cv.x) * lo_bf(hv.x); accv[1] += w0[1] * hi_bf(cv.x) * hi_bf(hv.x); accv[2] += w0[2] * lo_bf(cv.y) * lo_bf(hv.y); accv[3] += w0[3] * hi_bf(cv.y) * hi_bf(hv.y);
                        accv[4] += w1[0] * lo_bf(cv.z) * lo_bf(hv.z); accv[5] += w1[1] * hi_bf(cv.z) * hi_bf(hv.z); accv[6] += w1[2] * lo_bf(cv.w) * lo_bf(hv.w); accv[7] += w1[3] * hi_bf(cv.w) * hi_bf(hv.w); } }
                const u32x4 bv = *(const u32x4*)(pr + C_B + ch);
                u32x4 o; o.x = pk2(accv[0] * lo_bf(bv.x), accv[1] * hi_bf(bv.x)); o.y = pk2(accv[2] * lo_bf(bv.y), accv[3] * hi_bf(bv.y));
                o.z = pk2(accv[4] * lo_bf(bv.z), accv[5] * hi_bf(bv.z)); o.w = pk2(accv[6] * lo_bf(bv.w), accv[7] * hi_bf(bv.w));
                *(u32x4*)(bc + (size_t)row * 512 + ch) = o;
            }
        }
        if (G > 64 && wb >= 0) {
            { pg8::Gemm g{nb, Win + (size_t)6144 * 1024, MTOK, 256, DM, DM, 128, 0}; pg8::StaticOrder S; S.init(MTOK, 256, wn, wb);
              pg8::EpiProj E{proj + 6144, PP}; pg8::gemm_phase(lds, g, S, E); }
            __syncthreads();
            LAS float* scr = (LAS float*)(lds + wave * 16384);
            constexpr int I_G = 16 * 88, I_U = 16 * 88, I_D = 44 * 32;
            for (int it = wb * 8 + wave; it < I_G + I_U + I_D; it += wn * 8) {
                int q = it;
                if (q < I_G) { const int kb = q / 88, nbk = q % 88, n0 = 32 * nbk; transpose_item(a.w_gate, 1024, DFF, Wup, 1024, 64 * kb, n0, (n0 / 128) * 256 + (n0 % 128), a.g_ffn, 1.f, scr, lane); continue; } q -= I_G;
                if (q < I_U) { const int kb = q / 88, nbk = q % 88, n0 = 32 * nbk; transpose_item(a.w_up, 1024, DFF, Wup, 1024, 64 * kb, n0, (n0 / 128) * 256 + 128 + (n0 % 128), a.g_ffn, 1.f, scr, lane); continue; } q -= I_U;
                { const int kb = q / 32, nbk = q % 32; transpose_item(a.w_down, DFF, 1024, Wdown, DFF, 64 * kb, 32 * nbk, 32 * nbk, nullptr, 1.f, scr, lane); }
            }
        }
    }
    {
        pg8::Gemm g{hid, W2, 4096, 512, 256, 256, 128, 2}; pg8::StaticOrder S; S.init(4096, 512, G, bx);
        pg8::EpiCmp E{kcmp};
        pg8::gemm_phase(lds, g, S, E);
    }
    SEAM();
    {
        for (int v = vcu; v < 256; v += G) {
            const int bh = v >> 4, s = v & 15;
#pragma unroll 1
            for (int i = 0; i < 4; ++i) { const int qb = (i == 0) ? 63 - s : (i == 1) ? 32 + s : (i == 2) ? 31 - s : s;
#if defined(PROBE_ATT2) || defined(PROBE_NOLD)
                att::attn_unit(lds, proj, kcmp, kcmp + 4096 * 64, bh, qb, a.probe);
#endif
                att::attn_unit(lds, proj, kcmp, kcmp + 4096 * 64, bh, qb, 0);
            }
        }
    }
    SEAM();
    {
        { pg8::Gemm g{bc, Wconv, MTOK, DM, 512, 512, 128, 0}; pg8::StaticOrder S; S.init(MTOK, DM, G, bx);
          pg8::EpiMix<0> E{mix, proj, C_GCONV}; pg8::gemm_phase(lds, g, S, E); }
        { pg8::Gemm g{proj + C_Q, Wattn, MTOK, DM, DM, PP, 128, 0}; pg8::StaticOrder S; S.init(MTOK, DM, G, bx);
          pg8::EpiMix<1> E{mix, proj, C_GATTN}; pg8::gemm_phase(lds, g, S, E); }
    }
    SEAM();
    {
        pg8::Gemm g{mix, Wo, MTOK, DM, DM, DM, 128, 0}; pg8::StaticOrder S; S.init(MTOK, DM, G, bx);
        pg8::EpiRes<1> E{a.x, h1f, h1b, part1}; pg8::gemm_phase(lds, g, S, E);
    }
    SEAM();
    {
        pg8::Gemm g{h1b, Wup, MTOK, 2 * DFF, DM, DM, 128, 0}; pg8::StaticOrder S; S.init(MTOK, 2 * DFF, G, bx);
        pg8::EpiUp E{act, part1}; pg8::gemm_phase(lds, g, S, E);
    }
    SEAM();
    {
        pg8::Gemm g{act, Wdown, MTOK, DM, DFF, DFF, 128, 0}; pg8::StaticOrder S; S.init(MTOK, DM, G, bx);
        pg8::EpiRes<0> E{h1f, a.out, nullptr, part2}; pg8::gemm_phase(lds, g, S, E);
    }
    SEAM();
#ifdef PROBE_SYNC
    for (int i = 0; i < 8 * a.probe; ++i) grid.sync();
#endif
    {
        for (int it = bx * 512 + tid; it < MTOK * 256; it += G * 512) {
            const int row = it >> 8, c4 = (it & 255) * 4;
            const f32x4* pp = (const f32x4*)(part2 + (size_t)row * 16); float ss = 0.f;
#pragma unroll
            for (int j = 0; j < 4; ++j) { const f32x4 p = pp[j]; ss += (p[0] + p[1]) + (p[2] + p[3]); }
            const float r = __builtin_amdgcn_rsqf(ss * (1.0f / DM) + EPS);
            f32x4 v = *(f32x4*)(a.out + (size_t)row * DM + c4); const f32x4 gf = *(const f32x4*)(a.g_final + c4);
            v = v * r * gf; *(f32x4*)(a.out + (size_t)row * DM + c4) = v;
        }
    }
}

extern "C" void kernel_launch(void* const* d_in, const int* in_sizes, int n_in, void* d_out, int out_size, void* d_ws, size_t ws_size, hipStream_t stream) {
    static int grid = 0;
    if (grid == 0) {
        if (n_in != 18 || out_size != MTOK * DM || ws_size < WS_NEED) { fprintf(stderr, "kernel_launch: unexpected shapes (n_in %d out %d ws %zu)\n", n_in, out_size, ws_size); grid = -1; return; }
        int dev = 0, cus = 0, per_cu = 0;
        (void)hipGetDevice(&dev);
        (void)hipDeviceGetAttribute(&cus, hipDeviceAttributeMultiprocessorCount, dev);
        (void)hipFuncSetAttribute((const void*)nsa_fwd, hipFuncAttributeMaxDynamicSharedMemorySize, LDS_BYTES);
        (void)hipOccupancyMaxActiveBlocksPerMultiprocessor(&per_cu, (const void*)nsa_fwd, 512, LDS_BYTES);
        if (per_cu < 1) { fprintf(stderr, "kernel_launch: occupancy query says %d blocks/CU\n", per_cu); grid = -1; return; }
        grid = cus;
    }
    if (grid < 0) return;
    (void)hipMemsetAsync((unsigned char*)d_ws + WS_BAR, 0, 16384, stream);
    Args a{};
    a.x = (const float*)d_in[0]; a.w_in = (const float*)d_in[1]; a.conv_w = (const float*)d_in[2]; a.w_conv_out = (const float*)d_in[3];
    a.pos_k = (const float*)d_in[4]; a.w1_k = (const float*)d_in[5]; a.w2_k = (const float*)d_in[6];
    a.pos_v = (const float*)d_in[7]; a.w1_v = (const float*)d_in[8]; a.w2_v = (const float*)d_in[9];
    a.w_attn_out = (const float*)d_in[10]; a.w_o = (const float*)d_in[11]; a.g_mix = (const float*)d_in[12]; a.g_ffn = (const float*)d_in[13];
    a.w_gate = (const float*)d_in[14]; a.w_up = (const float*)d_in[15]; a.w_down = (const float*)d_in[16]; a.g_final = (const float*)d_in[17];
    a.out = (float*)d_out; a.ws = (unsigned char*)d_ws; a.probe = 1; a.pad = 0;
    void* args[] = {&a};
    hipError_t e = hipLaunchCooperativeKernel((void*)nsa_fwd, dim3(grid), dim3(512), args, LDS_BYTES, stream);
    if (e != hipSuccess) fprintf(stderr, "kernel_launch: cooperative launch failed: %s (grid %d)\n", hipGetErrorString(e), grid);
}
```

```cpp
#include <hip/hip_runtime.h>
#include <hip/hip_cooperative_groups.h>
#include <cstdio>
#include <cstdint>
namespace cg = cooperative_groups;

#define LAS __attribute__((address_space(3)))
typedef unsigned short bf16_t;
typedef short bf16x8 __attribute__((ext_vector_type(8)));
typedef short s16x4 __attribute__((ext_vector_type(4)));
typedef float f32x4 __attribute__((ext_vector_type(4)));
typedef float f32x16 __attribute__((ext_vector_type(16)));
typedef unsigned u32x4 __attribute__((ext_vector_type(4)));
typedef unsigned u32x2 __attribute__((ext_vector_type(2)));
typedef float f32x2_t __attribute__((ext_vector_type(2)));
typedef __bf16 bf16x2_t __attribute__((ext_vector_type(2)));

constexpr int MTOK = 16384, DM = 1024, SEQ = 4096, NB = 4;
constexpr int PP = 6400;
constexpr int INCOLS = 6192;
constexpr int C_B = 0, C_C = 512, C_H = 1024, C_Q = 1536, C_KC = 2560, C_VC = 2816, C_KS = 3072, C_VS = 3328, C_KW = 3584, C_VW = 3840,
              C_GBR = 4096, C_GCONV = 4144, C_GATTN = 5168;
constexpr int DFF = 2816;
constexpr float EPS = 1e-6f;
constexpr float LOG2E = 1.4426950408889634f;
constexpr float QSCALE = 0.125f * LOG2E;

constexpr size_t MiB = 1u << 20;
constexpr size_t WS_PART1 = 0;
constexpr size_t WS_PART2 = 1 * MiB;
constexpr size_t WS_BIAS = 2 * MiB;
constexpr size_t WS_BAR = 2 * MiB + 65536;
constexpr size_t WS_WIN = 3 * MiB;
constexpr size_t WS_WCONV = 16 * MiB;
constexpr size_t WS_WATTN = 17 * MiB;
constexpr size_t WS_WO = 19 * MiB;
constexpr size_t WS_WUP = 21 * MiB;
constexpr size_t WS_WDOWN = 32 * MiB;
constexpr size_t WS_W1 = 38 * MiB;
constexpr size_t WS_W2 = 40 * MiB;
constexpr size_t WS_HID = 41 * MiB;
constexpr size_t WS_KCMP = 45 * MiB;
constexpr size_t WS_PROJ = 46 * MiB;
constexpr size_t WS_H1F = 46 * MiB;
constexpr size_t WS_H1B = 110 * MiB;
constexpr size_t WS_ACT = 142 * MiB;
constexpr size_t WS_NEED = 246 * MiB;
constexpr size_t OUT_BC = 32 * MiB;

constexpr int LDS_BYTES = 147456;

__device__ __forceinline__ float bf2f(unsigned short v) { return __uint_as_float(((unsigned)v) << 16); }
__device__ __forceinline__ unsigned pk2(float lo, float hi) { f32x2_t v = {lo, hi}; bf16x2_t b = __builtin_convertvector(v, bf16x2_t); return __builtin_bit_cast(unsigned, b); }
__device__ __forceinline__ float ex2(float x) { return __builtin_amdgcn_exp2f(x); }
__device__ __forceinline__ float sigmoidf_(float x) { return __builtin_amdgcn_rcpf(1.0f + ex2(-x * LOG2E)); }
__device__ __forceinline__ float lo_bf(unsigned w) { return __uint_as_float(w << 16); }
__device__ __forceinline__ float hi_bf(unsigned w) { return __uint_as_float(w & 0xffff0000u); }

namespace pg8 {
constexpr int BM = 256, BK = 64, HALF = 128, HTB = HALF * BK * 2, STAGE_BYTES = 8 * HTB, NXCD = 8, WGM = 8;
__host__ __device__ __forceinline__ int lds_byte(int r, int c) { const int st = (r >> 4) * 2 + (c >> 5), rr = r & 15, cc = c & 31, ob = rr * 64 + cc * 2; return st * 1024 + (ob ^ (((ob >> 9) & 1) << 5)); }
__host__ __device__ __forceinline__ void stage_rc(int b, int& R, int& C) { const int st = b / 1024, sb = b % 1024, swz = sb ^ (((sb >> 9) & 1) << 5); R = (st >> 1) * 16 + swz / 64; C = (st & 1) * 32 + (swz % 64) / 2; }
__host__ __device__ __forceinline__ int perm32(int rho) { const int n = rho >> 4, i = rho & 15; return 8 * (i >> 2) + 4 * n + (i & 3); }

struct Unit { int pm, pn; };
struct Gemm { const bf16_t* A; const bf16_t* Bt; int M, N, K; int lda; int a_kstep; int amode; };

struct StaticOrder {
    int nM, nN, nwg, G, c;
    __host__ __device__ void init(int M, int N, int G_, int c_) { nM = M / BM; nN = N / BM; nwg = nM * nN; G = G_; c = c_; }
    __host__ __device__ bool next(int i, Unit& u) const {
        const long L = (long)i * G + c; if (L >= nwg) return false;
        int wgid = (int)L; { const int q = nwg / NXCD, r = nwg % NXCD, xcd = wgid % NXCD, off = wgid / NXCD; wgid = (xcd < r ? xcd * (q + 1) : r * (q + 1) + (xcd - r) * q) + off; }
        const int nig = WGM * nN, gid = wgid / nig, fm = gid * WGM, gsz = (nM - fm) < WGM ? (nM - fm) : WGM;
        u.pm = fm + ((wgid % nig) % gsz); u.pn = (wgid % nig) / gsz; return true;
    }
};

__device__ __forceinline__ const char* a_tile(const Gemm& g, const Unit& u) {
    if (g.amode == 1) return (const char*)g.A + ((size_t)(u.pm >> 2) * SEQ * PP + (size_t)u.pn * 256 + (size_t)(u.pm & 3) * 64) * 2;
    if (g.amode == 2) return (const char*)g.A + ((size_t)u.pn * 4096 * 256 + (size_t)u.pm * 256 * 256) * 2;
    return (const char*)g.A + (size_t)u.pm * 256 * (size_t)g.lda * 2;
}

template <class T, class = void> struct is_fused { static constexpr bool value = false; };
template <class T> struct is_fused<T, decltype((void)T::FUSED)> { static constexpr bool value = true; };
template <class Epi>
__device__ __forceinline__ void gemm_phase(LAS unsigned char* lds, const Gemm g, const StaticOrder& S, const Epi& E) {
#ifdef NO_GEMM
    return;
#endif
    int tid_ = threadIdx.x; asm volatile("" : "+v"(tid_));
    const int tid = tid_, wid = __builtin_amdgcn_readfirstlane(tid >> 6), lane = tid & 63, wr = wid >> 2, wc = wid & 3, fr = lane & 15, fq = lane >> 4;
    const int K = g.K, nt = K / BK;
    unsigned voffA[2], voffB[2];
#pragma unroll
    for (int i = 0; i < 2; ++i) { int R, C; stage_rc(tid * 16 + i * 8192, R, C); const int Rb = (R & ~31) + perm32(R & 31);
        voffA[i] = (unsigned)(R * g.lda + C) * 2u; voffB[i] = (unsigned)(Rb * K + C) * 2u; }
    const size_t kstepA = (size_t)g.a_kstep, kstepB = (size_t)(BK * 2);
    const size_t hstepA = (size_t)HALF * g.lda * 2, hstepB = (size_t)HALF * K * 2;
    const size_t tstepB = 2 * hstepB;
    const unsigned ldsw = (unsigned)wid * 1024u;
    const int aoff = lds_byte(wr * 64 + fr, fq * 8), boff = lds_byte(wc * 32 + fr, fq * 8);
#define PG8_SA(b, h) (((b) * 2 + (h)) * HTB)
#define PG8_SB(b, h) ((4 + (b) * 2 + (h)) * HTB)
#define PG8_STAGE(bufoff, gbase, voff) do { _Pragma("unroll") for (int _i = 0; _i < 2; ++_i) \
        __builtin_amdgcn_global_load_lds((const unsigned*)((const char*)(gbase) + (voff)[_i]), (LAS unsigned*)(lds + (bufoff) + ldsw + _i * 8192), 16, 0, 0); } while (0)
#define PG8_LDA(dst, b, h) do { _Pragma("unroll") for (int m = 0; m < 4; ++m) _Pragma("unroll") for (int k = 0; k < 2; ++k) dst[m][k] = *(const LAS bf16x8*)(lds + PG8_SA(b, h) + aoff + m * 2048 + k * 1024); } while (0)
#define PG8_LDB(dst, b, h) do { _Pragma("unroll") for (int n = 0; n < 2; ++n) _Pragma("unroll") for (int k = 0; k < 2; ++k) dst[n][k] = *(const LAS bf16x8*)(lds + PG8_SB(b, h) + boff + n * 2048 + k * 1024); } while (0)
#define PG8_MMA(ai, bj, At, Bt) do { __builtin_amdgcn_s_setprio(1); _Pragma("unroll") for (int m = 0; m < 4; ++m) _Pragma("unroll") for (int n = 0; n < 2; ++n) _Pragma("unroll") for (int k = 0; k < 2; ++k) \
        acc[ai][bj][m][n] = __builtin_amdgcn_mfma_f32_16x16x32_bf16(Bt[n][k], At[m][k], acc[ai][bj][m][n], 0, 0, 0); __builtin_amdgcn_s_setprio(0); } while (0)
#define PG8_WAIT_V(n) asm volatile("s_waitcnt vmcnt(" #n ")" ::: "memory")
#define PG8_WAIT_L(n) asm volatile("s_waitcnt lgkmcnt(" #n ")" ::: "memory")
#define PG8_BAR __builtin_amdgcn_s_barrier()
#define PG8_SCHED __builtin_amdgcn_sched_barrier(0)
    Unit cur, nxt; int ui = 0;
    if (!S.next(0, cur)) return;
    f32x4 acc[2][2][4][2];
#pragma unroll
    for (int a = 0; a < 2; ++a)
#pragma unroll
        for (int b = 0; b < 2; ++b)
#pragma unroll
            for (int m = 0; m < 4; ++m)
#pragma unroll
                for (int n = 0; n < 2; ++n) acc[a][b][m][n] = (f32x4){0.f, 0.f, 0.f, 0.f};
    bf16x8 At[4][2], B0[2][2], B1[2][2];
    const char* cA = a_tile(g, cur); const char* cB = (const char*)g.Bt + (size_t)cur.pn * tstepB;
    PG8_STAGE(PG8_SB(0, 0), cB, voffB); PG8_STAGE(PG8_SB(0, 1), cB + hstepB, voffB); PG8_STAGE(PG8_SA(0, 0), cA, voffA); PG8_STAGE(PG8_SA(0, 1), cA + hstepA, voffA);
    if (wr == 1) PG8_BAR;
    PG8_WAIT_V(2); PG8_BAR;
    PG8_STAGE(PG8_SB(1, 0), cB + kstepB, voffB); PG8_STAGE(PG8_SA(1, 0), cA + kstepA, voffA); PG8_STAGE(PG8_SB(1, 1), cB + hstepB + kstepB, voffB);
    PG8_WAIT_V(6); PG8_BAR;
    for (;;) {
        const bool has_next = S.next(ui + 1, nxt);
        const char* nA = has_next ? a_tile(g, nxt) : cA; const char* nB = has_next ? (const char*)g.Bt + (size_t)nxt.pn * tstepB : cB;
        for (int t = 0; t < nt; t += 2) {
            const bool last = (t == nt - 2);
            const char* a1 = cA + (size_t)(t + 1) * kstepA;
            const char* a2 = last ? nA : cA + (size_t)(t + 2) * kstepA; const char* b2 = last ? nB : cB + (size_t)(t + 2) * kstepB;
            const char* a3 = a2 + kstepA; const char* b3 = b2 + kstepB;
            PG8_LDB(B0, 0, 0); PG8_LDB(B1, 0, 1); PG8_SCHED; PG8_LDA(At, 0, 0); PG8_STAGE(PG8_SA(1, 1), a1 + hstepA, voffA);
            PG8_WAIT_V(8); PG8_WAIT_L(0); PG8_BAR; PG8_MMA(0, 0, At, B0); PG8_MMA(0, 1, At, B1); PG8_BAR; PG8_SCHED;
            PG8_LDA(At, 0, 1); PG8_STAGE(PG8_SB(0, 0), b2, voffB); PG8_STAGE(PG8_SB(0, 1), b2 + hstepB, voffB); PG8_STAGE(PG8_SA(0, 0), a2, voffA);
            PG8_WAIT_V(8); PG8_WAIT_L(0); PG8_BAR; PG8_MMA(1, 0, At, B0); PG8_MMA(1, 1, At, B1); PG8_BAR; PG8_SCHED;
            PG8_LDB(B0, 1, 0); PG8_LDB(B1, 1, 1); PG8_SCHED; PG8_LDA(At, 1, 0); PG8_STAGE(PG8_SA(0, 1), a2 + hstepA, voffA);
            PG8_WAIT_V(8); PG8_WAIT_L(0); PG8_BAR; PG8_MMA(0, 0, At, B0); PG8_MMA(0, 1, At, B1); PG8_BAR; PG8_SCHED;
            PG8_LDA(At, 1, 1); PG8_STAGE(PG8_SB(1, 0), b3, voffB); PG8_STAGE(PG8_SB(1, 1), b3 + hstepB, voffB); PG8_STAGE(PG8_SA(1, 0), a3, voffA);
            PG8_WAIT_V(8); PG8_WAIT_L(0); PG8_BAR; PG8_MMA(1, 0, At, B0); PG8_MMA(1, 1, At, B1); PG8_BAR; PG8_SCHED;
        }
        if (wr == 0) PG8_BAR;
        if constexpr (!is_fused<Epi>::value) E(acc, cur, wr, wc, fr, fq);
        if (!has_next) break;
#pragma unroll
        for (int a = 0; a < 2; ++a)
#pragma unroll
            for (int b = 0; b < 2; ++b)
#pragma unroll
                for (int m = 0; m < 4; ++m)
#pragma unroll
                    for (int n = 0; n < 2; ++n) acc[a][b][m][n] = (f32x4){0.f, 0.f, 0.f, 0.f};
        cur = nxt; cA = nA; cB = nB; ++ui;
        if (wr == 1) PG8_BAR;
    }
    PG8_WAIT_V(0);
    PG8_BAR;
    if constexpr (is_fused<Epi>::value) E.fused(acc, cur, wr, wc, fr, fq, lds, wid, lane);
#undef PG8_SA
#undef PG8_SB
#undef PG8_STAGE
#undef PG8_LDA
#undef PG8_LDB
#undef PG8_MMA
#undef PG8_WAIT_V
#undef PG8_WAIT_L
#undef PG8_BAR
#undef PG8_SCHED
}

typedef f32x4 Acc[2][2][4][2];
#define EPI_LOOP_BEGIN \
    _Pragma("unroll") for (int ai = 0; ai < 2; ++ai) _Pragma("unroll") for (int m = 0; m < 4; ++m) { const int row = u.pm * BM + wr * 64 + fr + ai * HALF + m * 16; \
    _Pragma("unroll") for (int bj = 0; bj < 2; ++bj) { const f32x4 v0 = acc[ai][bj][m][0], v1 = acc[ai][bj][m][1]; const int col = u.pn * BM + bj * HALF + wc * 32 + 8 * fq;
#define EPI_LOOP_END } }
__device__ __forceinline__ u32x4 pack8(const f32x4 a, const f32x4 b) { u32x4 w; w.x = pk2(a[0], a[1]); w.y = pk2(a[2], a[3]); w.z = pk2(b[0], b[1]); w.w = pk2(b[2], b[3]); return w; }

struct EpiProj { bf16_t* O; int ldc;
    __device__ __forceinline__ void operator()(const Acc& acc, const Unit& u, int wr, int wc, int fr, int fq) const {
        EPI_LOOP_BEGIN
            *(u32x4*)(O + (size_t)row * ldc + col) = pack8(v0, v1);
        EPI_LOOP_END
    } };
__device__ __forceinline__ float gelu_tanh(float x) {
    const float z = x * (1.0f + 0.044715f * x * x) * (2.0f * 0.7978845608028654f * LOG2E);
    return x * __builtin_amdgcn_rcpf(1.0f + ex2(-z));
}
struct EpiHid { bf16_t* O; const float* bias;
    __device__ __forceinline__ void operator()(const Acc& acc, const Unit& u, int wr, int wc, int fr, int fq) const {
        EPI_LOOP_BEGIN
            const int c = col - u.pn * BM; const float* bp = bias + u.pn * 256 + c;
            const f32x4 b0 = *(const f32x4*)bp, b1 = *(const f32x4*)(bp + 4);
            f32x4 a = v0 + b0, b = v1 + b1;
#pragma unroll
            for (int j = 0; j < 4; ++j) { a[j] = gelu_tanh(a[j]); b[j] = gelu_tanh(b[j]); }
            *(u32x4*)(O + (size_t)u.pn * 4096 * 256 + (size_t)row * 256 + c) = pack8(a, b);
        EPI_LOOP_END
    } };
struct EpiCmp { bf16_t* O;
    __device__ __forceinline__ void operator()(const Acc& acc, const Unit& u, int wr, int wc, int fr, int fq) const {
        EPI_LOOP_BEGIN
            const int c = col - u.pn * BM;
            if (c < 64) { u32x4 w = pack8(v0, v1); if ((row & 255) == 255) w = (u32x4){0u, 0u, 0u, 0u};
                *(u32x4*)(O + (size_t)u.pn * 4096 * 64 + (size_t)row * 64 + c) = w; }
        EPI_LOOP_END
    } };
template <int ADD> struct EpiMix { bf16_t* mix; const bf16_t* proj; int gcol;
    __device__ __forceinline__ void operator()(const Acc& acc, const Unit& u, int wr, int wc, int fr, int fq) const {
        EPI_LOOP_BEGIN
            const u32x4 gv = *(const u32x4*)(proj + (size_t)row * PP + gcol + col);
            f32x4 a, b;
            a[0] = sigmoidf_(lo_bf(gv.x)) * v0[0]; a[1] = sigmoidf_(hi_bf(gv.x)) * v0[1]; a[2] = sigmoidf_(lo_bf(gv.y)) * v0[2]; a[3] = sigmoidf_(hi_bf(gv.y)) * v0[3];
            b[0] = sigmoidf_(lo_bf(gv.z)) * v1[0]; b[1] = sigmoidf_(hi_bf(gv.z)) * v1[1]; b[2] = sigmoidf_(lo_bf(gv.w)) * v1[2]; b[3] = sigmoidf_(hi_bf(gv.w)) * v1[3];
            bf16_t* mp = mix + (size_t)row * DM + col;
            if (ADD) { const u32x4 pv = *(const u32x4*)mp;
                a[0] += lo_bf(pv.x); a[1] += hi_bf(pv.x); a[2] += lo_bf(pv.y); a[3] += hi_bf(pv.y); b[0] += lo_bf(pv.z); b[1] += hi_bf(pv.z); b[2] += lo_bf(pv.w); b[3] += hi_bf(pv.w); }
            *(u32x4*)mp = pack8(a, b);
        EPI_LOOP_END
    } };
template <int WB> struct EpiRes { const float* base; float* hf; bf16_t* hb; float* part;
    __device__ __forceinline__ void operator()(const Acc& acc, const Unit& u, int wr, int wc, int fr, int fq) const {
#pragma unroll
        for (int ai = 0; ai < 2; ++ai)
#pragma unroll
            for (int m = 0; m < 4; ++m) { const int row = u.pm * BM + wr * 64 + fr + ai * HALF + m * 16; float ss = 0.f;
#pragma unroll
                for (int bj = 0; bj < 2; ++bj) { const int col = u.pn * BM + bj * HALF + wc * 32 + 8 * fq; const size_t off = (size_t)row * DM + col;
                    const f32x4 x0 = *(const f32x4*)(base + off), x1 = *(const f32x4*)(base + off + 4);
                    const f32x4 a = x0 + acc[ai][bj][m][0], b = x1 + acc[ai][bj][m][1];
                    *(f32x4*)(hf + off) = a; *(f32x4*)(hf + off + 4) = b;
                    if (WB) *(u32x4*)(hb + off) = pack8(a, b);
                    ss += (a[0] * a[0] + a[1] * a[1]) + (a[2] * a[2] + a[3] * a[3]) + (b[0] * b[0] + b[1] * b[1]) + (b[2] * b[2] + b[3] * b[3]); }
                ss += __shfl_xor(ss, 16); ss += __shfl_xor(ss, 32);
                if (fq == 0) part[(size_t)row * 16 + u.pn * 4 + wc] = ss; }
    } };
struct EpiUp { bf16_t* act; const float* part;
    __device__ __forceinline__ void operator()(const Acc& acc, const Unit& u, int wr, int wc, int fr, int fq) const {
#pragma unroll
        for (int ai = 0; ai < 2; ++ai)
#pragma unroll
            for (int m = 0; m < 4; ++m) { const int row = u.pm * BM + wr * 64 + fr + ai * HALF + m * 16;
                const f32x4 pp = *(const f32x4*)(part + (size_t)row * 16 + 4 * fq); float ss = (pp[0] + pp[1]) + (pp[2] + pp[3]);
                ss += __shfl_xor(ss, 16); ss += __shfl_xor(ss, 32);
                const float r = __builtin_amdgcn_rsqf(ss * (1.0f / DM) + EPS);
                f32x4 a, b;
#pragma unroll
                for (int j = 0; j < 4; ++j) { const float g0 = acc[ai][0][m][0][j] * r, u0 = acc[ai][1][m][0][j] * r, g1 = acc[ai][0][m][1][j] * r, u1 = acc[ai][1][m][1][j] * r;
                    a[j] = g0 * sigmoidf_(g0) * u0; b[j] = g1 * sigmoidf_(g1) * u1; }
                *(u32x4*)(act + (size_t)row * DFF + u.pn * 128 + wc * 32 + 8 * fq) = pack8(a, b); }
    } };
struct EpiFinal { static constexpr bool FUSED = true;
    const float* base; float* out; const float* gfin; unsigned* xbuf; unsigned* cnt; unsigned* tmo;
    __device__ __forceinline__ void operator()(const Acc&, const Unit&, int, int, int, int) const {}
    __device__ __forceinline__ void fused(f32x4 (&acc)[2][2][4][2], const Unit& u, int wr, int wc, int fr, int fq, LAS unsigned char* lds, int wid, int lane) const {
        LAS float* P = (LAS float*)lds;
        LAS float* S = (LAS float*)(lds + 8192);
        LAS unsigned* flag = (LAS unsigned*)(lds + 8192 + 2048);
#pragma unroll
        for (int ai = 0; ai < 2; ++ai)
#pragma unroll
            for (int m = 0; m < 4; ++m) { const int rl = ai * HALF + wr * 64 + m * 16 + fr; const int row = u.pm * BM + rl; float ss = 0.f;
#pragma unroll
                for (int bj = 0; bj < 2; ++bj) { const int col = u.pn * BM + bj * HALF + wc * 32 + 8 * fq; const size_t off = (size_t)row * DM + col;
                    const f32x4 x0 = *(const f32x4*)(base + off), x1 = *(const f32x4*)(base + off + 4);
                    const f32x4 a = x0 + acc[ai][bj][m][0], b = x1 + acc[ai][bj][m][1]; acc[ai][bj][m][0] = a; acc[ai][bj][m][1] = b;
                    ss += (a[0] * a[0] + a[1] * a[1]) + (a[2] * a[2] + a[3] * a[3]) + (b[0] * b[0] + b[1] * b[1]) + (b[2] * b[2] + b[3] * b[3]); }
                ss += __shfl_xor(ss, 16); ss += __shfl_xor(ss, 32);
                if (fq == 0) P[rl * 4 + wc] = ss; }
        asm volatile("s_waitcnt lgkmcnt(0)" ::: "memory"); __builtin_amdgcn_s_barrier(); asm volatile("" ::: "memory");
        const int rl = wid * 32 + (lane & 31);
        if (lane < 32) { const float tot = (P[rl * 4 + 0] + P[rl * 4 + 1]) + (P[rl * 4 + 2] + P[rl * 4 + 3]);
            __hip_atomic_store(xbuf + ((size_t)(u.pm * BM + rl) * 4 + u.pn), __float_as_uint(tot), __ATOMIC_RELAXED, __HIP_MEMORY_SCOPE_AGENT); }
        asm volatile("s_waitcnt vmcnt(0)" ::: "memory");
        if (lane == 0) __hip_atomic_fetch_add(cnt + 64 * u.pm, 1u, __ATOMIC_RELAXED, __HIP_MEMORY_SCOPE_AGENT);
        if (wid == 0) {
            unsigned sp = 0u;
            for (;;) {
                if ((unsigned)__builtin_amdgcn_readfirstlane(__hip_atomic_load(cnt + 64 * u.pm, __ATOMIC_RELAXED, __HIP_MEMORY_SCOPE_AGENT)) >= 32u) break;
                __builtin_amdgcn_s_sleep(2);
                if (++sp > (1u << 20)) { if (lane == 0) __hip_atomic_store(tmo, 1u, __ATOMIC_RELAXED, __HIP_MEMORY_SCOPE_AGENT); break; }
            }
            __builtin_amdgcn_fence(__ATOMIC_ACQUIRE, "agent");
            if (lane == 0) flag[0] = 1u;
        }
        asm volatile("s_waitcnt vmcnt(0) lgkmcnt(0)" ::: "memory"); __builtin_amdgcn_s_barrier(); asm volatile("" ::: "memory");
        if (lane < 32) { const unsigned* sl = xbuf + (size_t)(u.pm * BM + rl) * 4; float tot = 0.f;
#pragma unroll
            for (int t = 0; t < 4; ++t) tot += __uint_as_float(__hip_atomic_load(sl + t, __ATOMIC_RELAXED, __HIP_MEMORY_SCOPE_AGENT));
            S[rl] = __builtin_amdgcn_rsqf(tot * (1.0f / DM) + EPS); }
        asm volatile("s_waitcnt lgkmcnt(0)" ::: "memory"); __builtin_amdgcn_s_barrier(); asm volatile("" ::: "memory");
#pragma unroll
        for (int bj = 0; bj < 2; ++bj) { const int col = u.pn * BM + bj * HALF + wc * 32 + 8 * fq;
            const f32x4 g0 = *(const f32x4*)(gfin + col), g1 = *(const f32x4*)(gfin + col + 4);
#pragma unroll
            for (int ai = 0; ai < 2; ++ai)
#pragma unroll
                for (int m = 0; m < 4; ++m) { const int rl2 = ai * HALF + wr * 64 + m * 16 + fr; const float rs = S[rl2]; const size_t off = (size_t)(u.pm * BM + rl2) * DM + col;
                    *(f32x4*)(out + off) = acc[ai][bj][m][0] * rs * g0; *(f32x4*)(out + off + 4) = acc[ai][bj][m][1] * rs * g1; } }
    } };
}

namespace att {
constexpr int KB0 = 0, VB0 = 16384, IMP = 32768, IMPW = 65, SELM = IMP + 4 * 64 * IMPW * 4, WMASK = SELM + 512, WSF = WMASK + 64, STEPS = WSF + 8 * 32 * 4, QFR = STEPS + 8 * 128, ATT_LDS = QFR + 8 * 4096;
static_assert(ATT_LDS <= 143360, "attention LDS");
#define MFMA32(a, b, c) __builtin_amdgcn_mfma_f32_32x32x16_bf16((a), (b), (c), 0, 0, 0)
__device__ __forceinline__ int crow(int r, int hi) { return (r & 3) + 8 * (r >> 2) + 4 * hi; }
typedef short v4i16_t __attribute__((ext_vector_type(4)));
__device__ __forceinline__ s16x4 vtr(LAS const unsigned char* p) { return __builtin_bit_cast(s16x4, __builtin_amdgcn_ds_read_tr16_b64_v4i16((LAS v4i16_t*)p)); }

struct St { float m, l; f32x16 o0, o1; };

__device__ __forceinline__ void qk_tile(f32x16& p0, f32x16& p1, LAS const unsigned char* kb, LAS const unsigned char* qf, int r, int h) {
    bf16x8 k0[4], k1[4], qv[4];
#pragma unroll
    for (int d0 = 0; d0 < 4; ++d0) { k0[d0] = *(const LAS bf16x8*)(kb + (2 * d0 + h) * 1024 + r * 16); k1[d0] = *(const LAS bf16x8*)(kb + (2 * d0 + h) * 1024 + 512 + r * 16);
        qv[d0] = *(const LAS bf16x8*)(qf + d0 * 1024); }
#pragma unroll
    for (int i = 0; i < 16; ++i) { p0[i] = 0.f; p1[i] = 0.f; }
    __builtin_amdgcn_sched_barrier(0);
#pragma unroll
    for (int d0 = 0; d0 < 4; ++d0) { p0 = MFMA32(k0[d0], qv[d0], p0); p1 = MFMA32(k1[d0], qv[d0], p1); }
}
__device__ __forceinline__ void apply_mask(f32x16& p0, f32x16& p1, unsigned long long allow, int h) {
    if (__all(allow == ~0ull)) return;
    const unsigned long long a = allow >> (4 * h); const unsigned lo = (unsigned)a, hi = (unsigned)(a >> 32);
#pragma unroll
    for (int i = 0; i < 16; ++i) { const int cb = (i & 3) + 8 * (i >> 2);
        p0[i] = ((lo >> cb) & 1u) ? p0[i] : -INFINITY; p1[i] = ((hi >> cb) & 1u) ? p1[i] : -INFINITY; }
}
__device__ __forceinline__ float rowmax32(const f32x16& p0, const f32x16& p1) {
    float a = fmaxf(p0[0], p1[0]);
#pragma unroll
    for (int i = 1; i < 16; ++i) a = fmaxf(a, fmaxf(p0[i], p1[i]));
    return fmaxf(a, __shfl_xor(a, 32));
}
__device__ __forceinline__ void pv_tile(f32x16& o0, f32x16& o1, LAS const unsigned char* vb, const f32x16& p0, const f32x16& p1, int lane, int h) {
    bf16x8 pa[4];
#pragma unroll
    for (int s = 0; s < 4; ++s) { u32x4 w;
#pragma unroll
        for (int j = 0; j < 4; ++j) { const int i0 = 8 * (s & 1) + 2 * j; w[j] = (s < 2) ? pk2(p0[i0], p0[i0 + 1]) : pk2(p1[i0], p1[i0 + 1]); }
        pa[s] = __builtin_bit_cast(bf16x8, w); }
    LAS const unsigned char* vp = vb + ((lane >> 4) & 1) * 32 + (lane & 3) * 8 + (4 * h + ((lane & 15) >> 2)) * 64;
    s16x4 l0[4], h0[4], l1[4], h1[4];
#pragma unroll
    for (int s = 0; s < 4; ++s) { l0[s] = vtr(vp + s * 1024); h0[s] = vtr(vp + s * 1024 + 512); l1[s] = vtr(vp + 4096 + s * 1024); h1[s] = vtr(vp + 4096 + s * 1024 + 512); }
    __builtin_amdgcn_sched_barrier(0);
#pragma unroll
    for (int s = 0; s < 4; ++s) {
        const bf16x8 v0 = (bf16x8){l0[s][0], l0[s][1], l0[s][2], l0[s][3], h0[s][0], h0[s][1], h0[s][2], h0[s][3]};
        const bf16x8 v1 = (bf16x8){l1[s][0], l1[s][1], l1[s][2], l1[s][3], h1[s][0], h1[s][1], h1[s][2], h1[s][3]};
        o0 = MFMA32(pa[s], v0, o0); o1 = MFMA32(pa[s], v1, o1);
    }
}
__device__ __forceinline__ void tile_online(St& st, LAS const unsigned char* kb, LAS const unsigned char* vb, LAS const unsigned char* qr, unsigned long long allow,
                                            LAS float* wsf, int lane, int r, int h) {
    f32x16 p0, p1; qk_tile(p0, p1, kb, qr, r, h); __builtin_amdgcn_sched_barrier(0); apply_mask(p0, p1, allow, h);
    const float rm = rowmax32(p0, p1), mnew = fmaxf(st.m, rm), f = ex2(st.m - mnew); st.m = mnew;
    float ls = 0.f;
#pragma unroll
    for (int i = 0; i < 16; ++i) { p0[i] = ex2(p0[i] - mnew); p1[i] = ex2(p1[i] - mnew); ls += p0[i] + p1[i]; }
    st.l = st.l * f + ls;
    if (__any(f != 1.0f)) {
        if (h == 0) wsf[r] = f;
#pragma unroll
        for (int i = 0; i < 16; ++i) { const float fi = wsf[crow(i, h)]; st.o0[i] *= fi; st.o1[i] *= fi; }
    }
    pv_tile(st.o0, st.o1, vb, p0, p1, lane, h);
}
__device__ __forceinline__ void tile_stats(float& m, float& l, LAS const unsigned char* kb, LAS const unsigned char* qr, unsigned long long allow, int r, int h) {
    f32x16 p0, p1; qk_tile(p0, p1, kb, qr, r, h); __builtin_amdgcn_sched_barrier(0); apply_mask(p0, p1, allow, h);
    const float rm = rowmax32(p0, p1), mnew = fmaxf(m, rm), f = ex2(m - mnew); m = mnew;
    float ls = 0.f;
#pragma unroll
    for (int i = 0; i < 16; ++i) ls += ex2(p0[i] - mnew) + ex2(p1[i] - mnew);
    l = l * f + ls;
}
__device__ __forceinline__ void tile_exact(f32x16& o0, f32x16& o1, float m, float invl, LAS const unsigned char* kb, LAS const unsigned char* vb, LAS const unsigned char* qr,
                                           unsigned long long allow, LAS float* impw  , float& carry, int j, int lane, int r, int h) {
    f32x16 p0, p1; qk_tile(p0, p1, kb, qr, r, h); __builtin_amdgcn_sched_barrier(0); apply_mask(p0, p1, allow, h);
#pragma unroll
    for (int i = 0; i < 16; ++i) { p0[i] = ex2(p0[i] - m) * invl; p1[i] = ex2(p1[i] - m) * invl; }
#pragma unroll
    for (int pos = 0; pos < 8; ++pos) {
        const int half = pos >> 2, r4 = pos & 3;
        const float P0 = half ? p1[4 * r4] : p0[4 * r4], P1 = half ? p1[4 * r4 + 1] : p0[4 * r4 + 1], P2 = half ? p1[4 * r4 + 2] : p0[4 * r4 + 2], P3 = half ? p1[4 * r4 + 3] : p0[4 * r4 + 3];
        const float a = (P0 + P1) + (P2 + 0.5f * P3), b = 0.5f * P3;
        const float bx = __shfl_xor(b, 32);
        const float add = h ? bx : carry;
        impw[16 * j + 2 * pos + h] = a + add;
        carry = bx;
    }
    pv_tile(o0, o1, vb, p0, p1, lane, h);
}

__device__ __forceinline__ void qk_tile_c(f32x16& p0, f32x16& p1, LAS const unsigned char* kb, LAS const unsigned char* qf, const f32x16& c, int r, int h) {
    bf16x8 k0[4], k1[4], qv[4];
#pragma unroll
    for (int d0 = 0; d0 < 4; ++d0) { k0[d0] = *(const LAS bf16x8*)(kb + (2 * d0 + h) * 1024 + r * 16); k1[d0] = *(const LAS bf16x8*)(kb + (2 * d0 + h) * 1024 + 512 + r * 16);
        qv[d0] = *(const LAS bf16x8*)(qf + d0 * 1024); }
    __builtin_amdgcn_sched_barrier(0);
    p0 = MFMA32(k0[0], qv[0], c); p1 = MFMA32(k1[0], qv[0], c);
#pragma unroll
    for (int d0 = 1; d0 < 4; ++d0) { p0 = MFMA32(k0[d0], qv[d0], p0); p1 = MFMA32(k1[d0], qv[d0], p1); }
}
__device__ __forceinline__ unsigned long long lowmask(int n);
__device__ __forceinline__ void soft_pv(St& st, f32x16& x0, f32x16& x1, float cx, LAS const unsigned char* vb, bool first, int kind, int tq,
                                        LAS float* wsf, int lane, int r, int h) {
    if (first) st.m = cx;
    else { const float d = st.m - cx;
        if (__any(d != 0.f)) {
#pragma unroll
            for (int i = 0; i < 16; ++i) { x0[i] -= d; x1[i] -= d; } } }
    if (kind) apply_mask(x0, x1, kind == 1 ? lowmask(tq + 1) : ~lowmask(tq + 1), h);
    const float rm = rowmax32(x0, x1);
    if (first) {
        const float dl = (rm > -INFINITY) ? rm : 0.f; st.m += dl;
#pragma unroll
        for (int i = 0; i < 16; ++i) { x0[i] -= dl; x1[i] -= dl; }
    } else if (__any(rm > 8.0f)) {
        const float dl = fmaxf(rm, 0.f), f = ex2(-dl); st.m += dl; st.l *= f;
        if (h == 0) wsf[r] = f;
#pragma unroll
        for (int i = 0; i < 16; ++i) { x0[i] -= dl; x1[i] -= dl; }
#pragma unroll
        for (int i = 0; i < 16; ++i) { const float fi = wsf[crow(i, h)]; st.o0[i] *= fi; st.o1[i] *= fi; }
    }
    float ls = 0.f;
#pragma unroll
    for (int i = 0; i < 16; ++i) { x0[i] = ex2(x0[i]); x1[i] = ex2(x1[i]); ls += x0[i] + x1[i]; }
    st.l += ls;
    pv_tile(st.o0, st.o1, vb, x0, x1, lane, h);
}
__device__ __forceinline__ unsigned long long lowmask(int n) { return n >= 64 ? ~0ull : ((1ull << n) - 1ull); }

__device__ __forceinline__ void attn_unit(LAS unsigned char* lds, bf16_t* proj, const bf16_t* kcmp, const bf16_t* vcmp, int bh, int qb, int skipw) {
    int tid_ = threadIdx.x; asm volatile("" : "+v"(tid_));
    const int tid = tid_, lane = tid & 63, r = lane & 31, h = lane >> 5, wid = __builtin_amdgcn_readfirstlane(tid >> 6);
    const int b = bh >> 2, hk = bh & 3, g = wid >> 1, tq = (wid & 1) * 32 + r;
    const size_t row = (size_t)b * SEQ + (size_t)qb * 64 + tq;
    const int t = qb * 64 + tq;
    bf16_t* qp = proj + row * PP + C_Q + (hk * 4 + g) * 64;
    LAS unsigned char* qr = lds + QFR + wid * 4096 + lane * 16;
#pragma unroll
    for (int d0 = 0; d0 < 4; ++d0) *(LAS bf16x8*)(qr + d0 * 1024) = *(const bf16x8*)(qp + d0 * 16 + h * 8);
    float gate[3];
#pragma unroll
    for (int c = 0; c < 3; ++c) gate[c] = sigmoidf_(bf2f(proj[row * PP + C_GBR + c * 16 + hk * 4 + g]));
#ifdef GATE2X
    if (GATE2X & 1) gate[0] *= 2.f; if (GATE2X & 2) gate[1] *= 2.f; if (GATE2X & 4) gate[2] *= 2.f;
#endif
#ifdef GATEZ
    if (GATEZ & 1) gate[0] = 0.f; if (GATEZ & 2) gate[1] = 0.f; if (GATEZ & 4) gate[2] = 0.f;
#endif
    LAS float* wsf = (LAS float*)(lds + WSF) + wid * 32;
    LAS float* impw = (LAS float*)(lds + IMP) + (g * 64 + tq) * IMPW;
    const size_t krow = lane, kcol = wid * 8;
    const size_t vrow = 16 * (wid & 3) + (lane >> 2), vcol = 32 * (wid >> 2) + 8 * (lane & 3);
    LAS unsigned char* kst = lds + KB0 + wid * 1024 + lane * 16;
    LAS unsigned char* vst = lds + VB0 + wid * 1024 + lane * 16;
    u32x4 kreg, vreg;
    LAS float* osl = (LAS float*)(lds + IMP + wid * (32 * IMPW * 4)) + lane;
#define LDK(base, pitch) kreg = *(const u32x4*)((base) + krow * (size_t)(pitch) + kcol)
#define LDV(base, pitch) vreg = *(const u32x4*)((base) + vrow * (size_t)(pitch) + vcol)
#define STK(buf) *(LAS u32x4*)(kst + (buf) * 8192) = kreg
#define STV(buf) *(LAS u32x4*)(vst + (buf) * 8192) = vreg
#define KBUF(buf) (lds + KB0 + (buf) * 8192)
#define VBUF(buf) (lds + VB0 + (buf) * 8192)
#define ACCUM_OUT(scale_expr, FIRST) do { if (h == 0) wsf[r] = (scale_expr); \
        _Pragma("unroll") for (int i = 0; i < 16; ++i) { const float sc = wsf[crow(i, h)]; \
            if (FIRST) { osl[(i * 2) * 64] = st.o0[i] * sc; osl[(i * 2 + 1) * 64] = st.o1[i] * sc; } \
            else { osl[(i * 2) * 64] += st.o0[i] * sc; osl[(i * 2 + 1) * 64] += st.o1[i] * sc; } } } while (0)

    St st;
    const bf16_t* kc = kcmp + (size_t)bh * 256 * 64; const bf16_t* vc = vcmp + (size_t)bh * 256 * 64;
    const int nmax = (t >= 31) ? ((t - 31) >> 4) : -1;
    float carry = 0.f;
    float m1 = -1e30f, l1 = 0.f;
    LDK(kc, 64); STK(0); __syncthreads();
#pragma unroll 1
    for (int j = 0; j < 4; ++j) {
        if (j + 1 < 4) LDK(kc + (size_t)(j + 1) * 64 * 64, 64);
        { const int cnt = nmax - 64 * j + 1; const unsigned long long allow = cnt <= 0 ? 0ull : lowmask(cnt);
          tile_stats(m1, l1, KBUF(j & 1), qr, allow, r, h); }
        if (j + 1 < 4) STK((j + 1) & 1);
        __syncthreads();
    }
    l1 += __shfl_xor(l1, 32);
    const float invl = __builtin_amdgcn_rcpf(fmaxf(l1, 1e-30f));
#pragma unroll
    for (int i = 0; i < 16; ++i) { st.o0[i] = 0.f; st.o1[i] = 0.f; }
    LDK(kc, 64); LDV(vc, 64); STK(0); STV(0); __syncthreads();
#pragma unroll 1
    for (int j = 0; j < 4; ++j) {
        if (j + 1 < 4) { LDK(kc + (size_t)(j + 1) * 64 * 64, 64); LDV(vc + (size_t)(j + 1) * 64 * 64, 64); }
        { const int cnt = nmax - 64 * j + 1; const unsigned long long allow = cnt <= 0 ? 0ull : lowmask(cnt);
          tile_exact(st.o0, st.o1, m1, invl, KBUF(j & 1), VBUF(j & 1), qr, allow, impw, carry, j, lane, r, h); }
        if (j + 1 < 4) { STK((j + 1) & 1); STV((j + 1) & 1); }
        __syncthreads();
    }
    {
        unsigned long long wor = 0ull;
        const unsigned long long valid = lowmask(qb + 1);
        LAS const float* ib = (LAS const float*)(lds + IMP);
        unsigned key[8], T[8];
#pragma unroll
        for (int i = 0; i < 8; ++i) { const int q = wid * 8 + i;
            float v = ((ib[(0 * 64 + q) * IMPW + lane] + ib[(1 * 64 + q) * IMPW + lane]) + ib[(2 * 64 + q) * IMPW + lane]) + ib[(3 * 64 + q) * IMPW + lane];
            if (lane == 0 || lane == qb || lane == qb - 1) v = INFINITY;
            key[i] = (lane <= qb) ? __float_as_uint(fmaxf(v, 0.f)) : 0u; T[i] = 0u; }
#pragma unroll 1
        for (int bb = 30; bb >= 0; --bb) {
#pragma unroll
            for (int i = 0; i < 8; ++i) { const unsigned cand = T[i] | (1u << bb);
                const int c = __popcll(__ballot(key[i] >= cand) & valid); T[i] = (c >= 16) ? cand : T[i]; }
        }
#pragma unroll
        for (int i = 0; i < 8; ++i) { const int q = wid * 8 + i;
            const unsigned long long gt = __ballot(key[i] > T[i]) & valid, eq = __ballot(key[i] == T[i]) & valid;
            const int need = 16 - __popcll(gt);
            const bool pick = ((eq >> lane) & 1ull) && (__popcll(eq & lowmask(lane)) < need);
            const unsigned long long msk = gt | __ballot(pick);
            if (lane == 0) *(LAS unsigned long long*)(lds + SELM + q * 8) = msk;
            wor |= msk; }
        if (lane == 0) *(LAS unsigned long long*)(lds + WMASK + wid * 8) = wor;
    }
    __syncthreads();
    unsigned long long un = 0ull;
#pragma unroll
    for (int w = 0; w < 8; ++w) un |= *(LAS const unsigned long long*)(lds + WMASK + w * 8);
    { const unsigned ulo = __builtin_amdgcn_readfirstlane((unsigned)un), uhi = __builtin_amdgcn_readfirstlane((unsigned)(un >> 32)); un = ((unsigned long long)uhi << 32) | ulo; }
    const unsigned long long mysel = *(LAS const unsigned long long*)(lds + SELM + tq * 8);
    ACCUM_OUT(gate[0], true);
#ifdef PROBE_NOLD
    const bool NOLD = skipw != 0;
#else
    const bool NOLD = false;
#endif
    LAS unsigned char* steps = lds + STEPS + wid * 128;
    const int nsel = __popcll(un), j0w = qb >= 8 ? qb - 8 : 0, nwin = qb - j0w + 1, NS = nsel + nwin;
    if ((un >> lane) & 1ull) steps[__popcll(un & lowmask(lane))] = (unsigned char)lane;
    if (lane < nwin) steps[nsel + lane] = (unsigned char)(0x80 | (j0w + lane));
    {
        const bf16_t* ksb = proj + (size_t)b * SEQ * PP + C_KS + hk * 64;
#define STEP_CODE(s_) ((int)__builtin_amdgcn_readfirstlane((int)steps[(s_)]))
#define KSRC(code) (ksb + (size_t)((code) >> 7) * (C_KW - C_KS) + (size_t)((code) & 127) * 64 * PP)
#define VSRC(code) (ksb + (C_VS - C_KS) + (size_t)((code) >> 7) * (C_VW - C_VS) + (size_t)((code) & 127) * 64 * PP)
        st.m = 0.f; st.l = 0.f;
#pragma unroll
        for (int i = 0; i < 16; ++i) { st.o0[i] = 0.f; st.o1[i] = 0.f; }
        f32x16 pa0, pa1, pb0, pb1; float ca = 0.f, cb = 0.f;
        int code0 = STEP_CODE(0), code1 = NS > 1 ? STEP_CODE(1) : 0;
        LDK(KSRC(code0), PP); LDV(VSRC(code0), PP); STK(0); STV(0);
        if (NS > 1) LDK(KSRC(code1), PP);
        __syncthreads();
        {
          f32x16 cc;
#pragma unroll
          for (int i = 0; i < 16; ++i) cc[i] = 0.f;
          qk_tile_c(pa0, pa1, KBUF(0), qr, cc, r, h); ca = 0.f; }
        if (NS > 1) STK(1);
        __syncthreads();
#define SW_STEP(X0, X1, CX, Y0, Y1, CY, s_) do { \
            const int s = (s_); const int code = STEP_CODE(s); const bool hasn = s + 1 < NS, hasn2 = s + 2 < NS; \
            const int coden = hasn ? STEP_CODE(s + 1) : 0, coden2 = hasn2 ? STEP_CODE(s + 2) : 0; \
            if (hasn2 && !NOLD) LDK(KSRC(coden2), PP); \
            if (hasn && !NOLD) LDV(VSRC(coden), PP); \
            if (hasn) { CY = st.m; \
                const bool en = (coden & 0x80) ? true : (((mysel >> (coden & 127)) & 1ull) != 0ull); const float cv = en ? -st.m : -INFINITY; f32x16 cc; \
                _Pragma("unroll") for (int i = 0; i < 16; ++i) cc[i] = cv; \
                qk_tile_c(Y0, Y1, KBUF((s + 1) & 1), qr, cc, r, h); __builtin_amdgcn_sched_barrier(0); } \
            { const int jj = code & 127; const bool isw = (code & 0x80) != 0; const bool first = (s == 0) || (s == nsel); \
              if (s == nsel) {   \
                  const float lt = st.l + __shfl_xor(st.l, 32); ACCUM_OUT(gate[1] * __builtin_amdgcn_rcpf(fmaxf(lt, 1e-30f)), false); \
                  st.l = 0.f; _Pragma("unroll") for (int i = 0; i < 16; ++i) { st.o0[i] = 0.f; st.o1[i] = 0.f; } } \
              int kind = 0; if (jj == qb) kind = 1; else if (isw && jj == qb - 8) kind = 2; \
              soft_pv(st, X0, X1, CX, VBUF(s & 1), first, kind, tq, wsf, lane, r, h); } \
            if (hasn2 && !NOLD) STK(s & 1); \
            if (hasn && !NOLD) STV((s + 1) & 1); \
            __syncthreads(); } while (0)
#pragma unroll 1
        for (int s2 = 0; s2 < NS; s2 += 2) {
            SW_STEP(pa0, pa1, ca, pb0, pb1, cb, s2);
            if (s2 + 1 < NS) SW_STEP(pb0, pb1, cb, pa0, pa1, ca, s2 + 1);
        }
        const float lt = st.l + __shfl_xor(st.l, 32);
        if (h == 0) wsf[r] = gate[2] * __builtin_amdgcn_rcpf(fmaxf(lt, 1e-30f));
#undef SW_STEP
#undef STEP_CODE
#undef KSRC
#undef VSRC
    }
    {
        bf16_t* ob = proj + ((size_t)b * SEQ + (size_t)qb * 64 + (wid & 1) * 32) * PP + C_Q + (hk * 4 + g) * 64;
        if (!skipw)
#pragma unroll
        for (int i = 0; i < 16; ++i) { const int q = crow(i, h); const float sc = wsf[q];
            const float f0 = osl[(i * 2) * 64] + st.o0[i] * sc, f1 = osl[(i * 2 + 1) * 64] + st.o1[i] * sc;
            ob[(size_t)q * PP + r] = (bf16_t)(pk2(f0, 0.f) & 0xffffu); ob[(size_t)q * PP + 32 + r] = (bf16_t)(pk2(f1, 0.f) & 0xffffu); }
    }
#undef LDK
#undef LDV
#undef STK
#undef STV
#undef KBUF
#undef VBUF
#undef ACCUM_OUT
}
}

__device__ __forceinline__ float wave_sum(float v) {
#pragma unroll
    for (int o = 1; o < 64; o <<= 1) v += __shfl_xor(v, o);
    return v;
}
__device__ __forceinline__ void transpose_item(const float* W, int K, int N, bf16_t* WT, int ldt, int k0, int n0, int drow0, const float* kscale, float cscale, LAS float* scr, int lane) {
#pragma unroll 8
    for (int i = 0; i < 32; ++i) { const int kk = 2 * i + (lane >> 5); const int n = n0 + (lane & 31);
        float v = (n < N) ? W[(size_t)(k0 + kk) * N + n] : 0.f;
        if (kscale) v *= kscale[k0 + kk];
        scr[kk * 33 + (lane & 31)] = v * cscale; }
    asm volatile("s_waitcnt lgkmcnt(0)" ::: "memory");
    const int c = lane & 7;
#pragma unroll
    for (int j = 0; j < 4; ++j) { const int n = (lane >> 3) + 8 * j; const LAS float* s = scr + (8 * c) * 33 + n;
        u32x4 o; o.x = pk2(s[0 * 33], s[1 * 33]); o.y = pk2(s[2 * 33], s[3 * 33]); o.z = pk2(s[4 * 33], s[5 * 33]); o.w = pk2(s[6 * 33], s[7 * 33]);
        *(u32x4*)(WT + (size_t)(drow0 + n) * ldt + k0 + 8 * c) = o; }
    asm volatile("s_waitcnt lgkmcnt(0)" ::: "memory");
}

#define XB_TMO      128
#define XB_XCNT(j)  (256  + 64 * (j))
#define XB_XSUB(j)  (1280 + 64 * (j))
#define XB_XGEN(j)  (2304 + 64 * (j))
#define XB_TOP      3328
#define XB_TOPGEN   3392
#define XCD_BAR_WORDS 3456
#define XB_SPIN_CAP (1u << 18)
__device__ __forceinline__ unsigned xb_ld(unsigned* p)              { return __hip_atomic_load(p, __ATOMIC_RELAXED, __HIP_MEMORY_SCOPE_AGENT); }
__device__ __forceinline__ unsigned xb_add(unsigned* p, unsigned v) { return __hip_atomic_fetch_add(p, v, __ATOMIC_RELAXED, __HIP_MEMORY_SCOPE_AGENT); }
__device__ __forceinline__ unsigned xb_xcc_id() { return (unsigned)__builtin_amdgcn_s_getreg((3 << 11) | 20) & 0xFu; }
#define XB_SPIN(cond, bar) do { unsigned _sp = 0; while (cond) { __builtin_amdgcn_s_sleep(1); \
    if ((++_sp & 255u) == 0u) { if (xb_ld(&(bar)[XB_TMO])) break; if (_sp > XB_SPIN_CAP) { atomicAdd(&(bar)[XB_TMO], 1u); break; } } } } while (0)
struct XcdBarrier { unsigned* bar; unsigned x; volatile LAS unsigned* st; };
__device__ __forceinline__ XcdBarrier xcd_barrier_post(unsigned* bar, volatile LAS unsigned* st) {
    XcdBarrier b; b.bar = bar; b.x = xb_xcc_id(); b.st = st;
    if (threadIdx.x == 0) (void)xb_add(&bar[XB_XCNT(b.x)], 1u);
    return b;
}
__device__ __forceinline__ void xcd_barrier_complete(unsigned* bar, unsigned x, unsigned& nloc, unsigned& nx) {
    const unsigned G = gridDim.x * gridDim.y * gridDim.z;
    unsigned sum, cnt, mine, sp = 0u;
    for (;;) {
        sum = 0u; cnt = 0u; mine = 0u;
#pragma unroll
        for (unsigned j = 0; j < 16; ++j) { const unsigned c = xb_ld(&bar[XB_XCNT(j)]); sum += c; cnt += (c > 0u) ? 1u : 0u; mine = (j == x) ? c : mine; }
        if (sum == G) break;
        __builtin_amdgcn_s_sleep(1);
        if ((++sp & 255u) == 0u) { if (xb_ld(&bar[XB_TMO])) break; if (sp > XB_SPIN_CAP) { atomicAdd(&bar[XB_TMO], 1u); break; } }
    }
    nloc = mine > 0u ? mine : 1u; nx = cnt > 0u ? cnt : 1u;
}
__device__ __forceinline__ void xcd_barrier(const XcdBarrier& b) {
    asm volatile("s_waitcnt vmcnt(0)" ::: "memory");
    __syncthreads();
    if (threadIdx.x == 0) {
        unsigned* bar = b.bar;
        __builtin_amdgcn_s_waitcnt(0);
        unsigned nloc = b.st[0], nx = b.st[1];
        if (nloc == 0u) { xcd_barrier_complete(bar, b.x, nloc, nx); b.st[0] = nloc; b.st[1] = nx; }
        const unsigned old = xb_add(&bar[XB_XSUB(b.x)], 1u);
        const unsigned gen = old / nloc;
        if (old + 1u == (gen + 1u) * nloc) {
            __builtin_amdgcn_fence(__ATOMIC_RELEASE, "agent");
            asm volatile("s_waitcnt vmcnt(0)" ::: "memory");
            const unsigned og = xb_add(&bar[XB_TOP], 1u);
            const unsigned tg = og / nx;
            if (og + 1u == (tg + 1u) * nx) xb_add(&bar[XB_TOPGEN], 1u);
            else XB_SPIN(xb_ld(&bar[XB_TOPGEN]) == tg, bar);
            __builtin_amdgcn_fence(__ATOMIC_ACQUIRE, "agent");
            xb_add(&bar[XB_XGEN(b.x)], 1u);
            asm volatile("s_waitcnt vmcnt(0)" ::: "memory");
        } else {
            XB_SPIN(xb_ld(&bar[XB_XGEN(b.x)]) == gen, bar);
            __builtin_amdgcn_fence(__ATOMIC_ACQUIRE, "agent");
            asm volatile("s_waitcnt vmcnt(0)" ::: "memory");
        }
    }
    __syncthreads();
}

struct Args {
    const float *x, *w_in, *conv_w, *w_conv_out, *pos_k, *w1_k, *w2_k, *pos_v, *w1_v, *w2_v, *w_attn_out, *w_o, *g_mix, *g_ffn, *w_gate, *w_up, *w_down, *g_final;
    float* out; unsigned char* ws; int probe; int pad;
};

__global__ void __launch_bounds__(512, 2) nsa_fwd(Args a) {
    extern __shared__ __attribute__((aligned(16))) unsigned char lds_raw[];
    LAS unsigned char* lds = (LAS unsigned char*)lds_raw;
    cg::grid_group grid = cg::this_grid();
    const int tid = threadIdx.x, lane = tid & 63, wave = __builtin_amdgcn_readfirstlane(tid >> 6);
    const int G = gridDim.x, bx = blockIdx.x;
    const int vcu = (G % 8 == 0) ? (bx % 8) * (G / 8) + bx / 8 : bx;
    unsigned char* ws = a.ws;
    volatile LAS unsigned* bst = (volatile LAS unsigned*)(lds + 143360);
    if (tid < 2) bst[tid] = 0u;
    __syncthreads();
    const XcdBarrier gbar = xcd_barrier_post((unsigned*)(ws + WS_BAR), bst);
#define SEAM() xcd_barrier(gbar)
    float* part1 = (float*)(ws + WS_PART1); float* part2 = (float*)(ws + WS_PART2); float* cbias = (float*)(ws + WS_BIAS);
    bf16_t* Win = (bf16_t*)(ws + WS_WIN); bf16_t* Wconv = (bf16_t*)(ws + WS_WCONV); bf16_t* Wattn = (bf16_t*)(ws + WS_WATTN); bf16_t* Wo = (bf16_t*)(ws + WS_WO);
    bf16_t* Wup = (bf16_t*)(ws + WS_WUP); bf16_t* Wdown = (bf16_t*)(ws + WS_WDOWN); bf16_t* W1 = (bf16_t*)(ws + WS_W1); bf16_t* W2 = (bf16_t*)(ws + WS_W2);
    bf16_t* hid = (bf16_t*)(ws + WS_HID); bf16_t* kcmp = (bf16_t*)(ws + WS_KCMP); bf16_t* proj = (bf16_t*)(ws + WS_PROJ);
    float* h1f = (float*)(ws + WS_H1F); bf16_t* h1b = (bf16_t*)(ws + WS_H1B); bf16_t* act = (bf16_t*)(ws + WS_ACT);
    bf16_t* nb = (bf16_t*)a.out; bf16_t* mix = (bf16_t*)a.out; bf16_t* bc = (bf16_t*)((unsigned char*)a.out + OUT_BC);

    {
        LAS float* scr = (LAS float*)(lds + wave * 16384);
        const int gw = vcu * 8 + wave, NGW = G * 8;
        constexpr int I_IN = 16 * 194, I_CONV = 8 * 32, I_ATT = 16 * 32, I_O = 16 * 32, I_G = 16 * 88, I_U = 16 * 88, I_D = 44 * 32, I_1 = 32 * 8, I_2 = 4 * 2;
        constexpr int NITEMS = I_IN + I_CONV + I_ATT + I_O + 2 * I_1 + 2 * I_2;
        for (int it = gw; it < NITEMS; it += NGW) {
            int q = it;
            if (q < I_IN) { const int kb = q / 194, nbk = q % 194, n0 = 32 * nbk; const float cs = (n0 >= C_Q && n0 < C_KC) ? QSCALE : 1.0f;
                transpose_item(a.w_in, 1024, INCOLS, Win, 1024, 64 * kb, n0, n0, a.g_mix, cs, scr, lane); continue; } q -= I_IN;
            if (q < I_CONV) { const int kb = q / 32, nbk = q % 32; transpose_item(a.w_conv_out, 512, 1024, Wconv, 512, 64 * kb, 32 * nbk, 32 * nbk, nullptr, 1.f, scr, lane); continue; } q -= I_CONV;
            if (q < I_ATT) { const int kb = q / 32, nbk = q % 32; transpose_item(a.w_attn_out, 1024, 1024, Wattn, 1024, 64 * kb, 32 * nbk, 32 * nbk, nullptr, 1.f, scr, lane); continue; } q -= I_ATT;
            if (q < I_O) { const int kb = q / 32, nbk = q % 32; transpose_item(a.w_o, 1024, 1024, Wo, 1024, 64 * kb, 32 * nbk, 32 * nbk, nullptr, 1.f, scr, lane); continue; } q -= I_O;
            if (q < I_1) { const int kb = q / 8, nbk = q % 8; transpose_item(a.w1_k, 2048, 256, W1, 2048, 64 * kb, 32 * nbk, 32 * nbk, nullptr, 1.f, scr, lane); continue; } q -= I_1;
            if (q < I_1) { const int kb = q / 8, nbk = q % 8; transpose_item(a.w1_v, 2048, 256, W1, 2048, 64 * kb, 32 * nbk, 256 + 32 * nbk, nullptr, 1.f, scr, lane); continue; } q -= I_1;
            if (q < I_2) { const int kb = q / 2, nbk = q % 2; transpose_item(a.w2_k, 256, 64, W2, 256, 64 * kb, 32 * nbk, 32 * nbk, nullptr, 1.f, scr, lane); continue; } q -= I_2;
            { const int kb = q / 2, nbk = q % 2; transpose_item(a.w2_v, 256, 64, W2, 256, 64 * kb, 32 * nbk, 256 + 32 * nbk, nullptr, 1.f, scr, lane); }
        }
        const int gt = vcu * 512 + tid, NGT = G * 512;
        for (int i = gt; i < 192 * 1024 / 8; i += NGT) *(u32x4*)(Win + (size_t)6208 * 1024 + (size_t)i * 8) = (u32x4){0u, 0u, 0u, 0u};
        for (int i = gt; i < 2 * 192 * 256 / 8; i += NGT) { const int half = i / (192 * 256 / 8), o = i % (192 * 256 / 8);
            *(u32x4*)(W2 + (size_t)(half * 256 + 64) * 256 + (size_t)o * 8) = (u32x4){0u, 0u, 0u, 0u}; }
        for (int m = gw; m < MTOK; m += NGW) {
            const f32x4* xr = (const f32x4*)(a.x + (size_t)m * DM) + lane; f32x4 v[4]; float s = 0.f;
#pragma unroll
            for (int j = 0; j < 4; ++j) { v[j] = xr[64 * j]; s += (v[j][0] * v[j][0] + v[j][1] * v[j][1]) + (v[j][2] * v[j][2] + v[j][3] * v[j][3]); }
            const float rstd = __builtin_amdgcn_rsqf(wave_sum(s) * (1.0f / DM) + EPS);
            u32x2* o8 = (u32x2*)(nb + (size_t)m * DM) + lane;
#pragma unroll
            for (int j = 0; j < 4; ++j) { u32x2 w; w.x = pk2(v[j][0] * rstd, v[j][1] * rstd); w.y = pk2(v[j][2] * rstd, v[j][3] * rstd); o8[64 * j] = w; }
        }
        if (bx < 2) {
            const float* pos = bx ? a.pos_v : a.pos_k; const float* w1 = bx ? a.w1_v : a.w1_k;
            const int j = tid & 255, part = tid >> 8; float s = 0.f;
            for (int k = part * 1024; k < part * 1024 + 1024; ++k) s += pos[k] * w1[(size_t)k * 256 + j];
            LAS float* red = (LAS float*)(lds + 8 * 16384);
            if (part == 1) red[j] = s;
            __syncthreads();
            if (part == 0) cbias[bx * 256 + j] = s + red[j];
        }
    }
    if (a.probe == 0x7fffffff) grid.sync();
    SEAM();
    {
        const int ncols1 = (G > 64) ? 6144 : PP;
        pg8::Gemm g{nb, Win, MTOK, ncols1, DM, DM, 128, 0}; pg8::StaticOrder S; S.init(MTOK, ncols1, G, bx);
        pg8::EpiProj E{proj, PP};
        pg8::gemm_phase(lds, g, S, E);
    }
    SEAM();
    {
        {
            pg8::Gemm g{proj + C_KC, W1, 4096, 512, 2048, 16 * PP, PP * 2, 1}; pg8::StaticOrder S; S.init(4096, 512, G, bx);
            pg8::EpiHid E{hid, cbias};
            pg8::gemm_phase(lds, g, S, E);
        }
        int wb = bx, wn = G; if (G > 64) { wb = bx - 32; wn = G - 32; }
        if (wb >= 0) {
            for (int it = wb * 512 + tid; it < MTOK * 64; it += wn * 512) {
                const int row = it >> 6, ch = (it & 63) * 8, t = row & (SEQ - 1);
                const bf16_t* pr = proj + (size_t)row * PP;
                float accv[8];
#pragma unroll
                for (int j = 0; j < 8; ++j) accv[j] = 0.f;
#pragma unroll
                for (int k = 0; k < 3; ++k) { const int dt = 2 - k;
                    if (t - dt >= 0) { const u32x4 cv = *(const u32x4*)(pr - (size_t)dt * PP + C_C + ch), hv = *(const u32x4*)(pr - (size_t)dt * PP + C_H + ch);
                        const f32x4 w0 = *(const f32x4*)(a.conv_w + k * 512 + ch), w1 = *(const f32x4*)(a.conv_w + k * 512 + ch + 4);
                        accv[0] += w0[0] * lo_bf(cv.x) * lo_bf(hv.x); accv[1] += w0[1] * hi_bf(cv.x) * hi_bf(hv.x); accv[2] += w0[2] * lo_bf(cv.y) * lo_bf(hv.y); accv[3] += w0[3] * hi_bf(cv.y) * hi_bf(hv.y);
                        accv[4] += w1[0] * lo_bf(cv.z) * lo_bf(hv.z); accv[5] += w1[1] * hi_bf(cv.z) * hi_bf(hv.z); accv[6] += w1[2] * lo_bf(cv.w) * lo_bf(hv.w); accv[7] += w1[3] * hi_bf(cv.w) * hi_bf(hv.w); } }
                const u32x4 bv = *(const u32x4*)(pr + C_B + ch);
                u32x4 o; o.x = pk2(accv[0] * lo_bf(bv.x), accv[1] * hi_bf(bv.x)); o.y = pk2(accv[2] * lo_bf(bv.y), accv[3] * hi_bf(bv.y));
                o.z = pk2(accv[4] * lo_bf(bv.z), accv[5] * hi_bf(bv.z)); o.w = pk2(accv[6] * lo_bf(bv.w), accv[7] * hi_bf(bv.w));
                *(u32x4*)(bc + (size_t)row * 512 + ch) = o;
            }
        }
        if (G > 64 && wb >= 0) {
            { pg8::Gemm g{nb, Win + (size_t)6144 * 1024, MTOK, 256, DM, DM, 128, 0}; pg8::StaticOrder S; S.init(MTOK, 256, wn, wb);
              pg8::EpiProj E{proj + 6144, PP}; pg8::gemm_phase(lds, g, S, E); }
            __syncthreads();
            LAS float* scr = (LAS float*)(lds + wave * 16384);
            constexpr int I_G = 16 * 88, I_U = 16 * 88, I_D = 44 * 32;
            for (int it = wb * 8 + wave; it < I_G + I_U + I_D; it += wn * 8) {
                int q = it;
                if (q < I_G) { const int kb = q / 88, nbk = q % 88, n0 = 32 * nbk; transpose_item(a.w_gate, 1024, DFF, Wup, 1024, 64 * kb, n0, (n0 / 128) * 256 + (n0 % 128), a.g_ffn, 1.f, scr, lane); continue; } q -= I_G;
                if (q < I_U) { const int kb = q / 88, nbk = q % 88, n0 = 32 * nbk; transpose_item(a.w_up, 1024, DFF, Wup, 1024, 64 * kb, n0, (n0 / 128) * 256 + 128 + (n0 % 128), a.g_ffn, 1.f, scr, lane); continue; } q -= I_U;
                { const int kb = q / 32, nbk = q % 32; transpose_item(a.w_down, DFF, 1024, Wdown, DFF, 64 * kb, 32 * nbk, 32 * nbk, nullptr, 1.f, scr, lane); }
            }
        }
    }
    {
        pg8::Gemm g{hid, W2, 4096, 512, 256, 256, 128, 2}; pg8::StaticOrder S; S.init(4096, 512, G, bx);
        pg8::EpiCmp E{kcmp};
        pg8::gemm_phase(lds, g, S, E);
    }
    SEAM();
    {
        for (int v = vcu; v < 256; v += G) {
            const int bh = v >> 4, s = v & 15;
#pragma unroll 1
            for (int i = 0; i < 4; ++i) { const int qb = (i == 0) ? 63 - s : (i == 1) ? 32 + s : (i == 2) ? 31 - s : s;
#if defined(PROBE_ATT2) || defined(PROBE_NOLD)
                att::attn_unit(lds, proj, kcmp, kcmp + 4096 * 64, bh, qb, a.probe);
#endif
                att::attn_unit(lds, proj, kcmp, kcmp + 4096 * 64, bh, qb, 0);
            }
        }
    }
    SEAM();
    {
        { pg8::Gemm g{bc, Wconv, MTOK, DM, 512, 512, 128, 0}; pg8::StaticOrder S; S.init(MTOK, DM, G, bx);
          pg8::EpiMix<0> E{mix, proj, C_GCONV}; pg8::gemm_phase(lds, g, S, E); }
        { pg8::Gemm g{proj + C_Q, Wattn, MTOK, DM, DM, PP, 128, 0}; pg8::StaticOrder S; S.init(MTOK, DM, G, bx);
          pg8::EpiMix<1> E{mix, proj, C_GATTN}; pg8::gemm_phase(lds, g, S, E); }
    }
    SEAM();
    {
        pg8::Gemm g{mix, Wo, MTOK, DM, DM, DM, 128, 0}; pg8::StaticOrder S; S.init(MTOK, DM, G, bx);
        pg8::EpiRes<1> E{a.x, h1f, h1b, part1}; pg8::gemm_phase(lds, g, S, E);
    }
    SEAM();
    {
        pg8::Gemm g{h1b, Wup, MTOK, 2 * DFF, DM, DM, 128, 0}; pg8::StaticOrder S; S.init(MTOK, 2 * DFF, G, bx);
        pg8::EpiUp E{act, part1}; pg8::gemm_phase(lds, g, S, E);
    }
    SEAM();
    if (G == 256) {
        pg8::Gemm g{act, Wdown, MTOK, DM, DFF, DFF, 128, 0}; pg8::StaticOrder S; S.init(MTOK, DM, G, bx);
        pg8::EpiFinal E{h1f, a.out, a.g_final, (unsigned*)part2, (unsigned*)(ws + WS_BAR) + 4096, (unsigned*)(ws + WS_BAR) + XB_TMO};
        pg8::gemm_phase(lds, g, S, E);
        return;
    }
    {
        pg8::Gemm g{act, Wdown, MTOK, DM, DFF, DFF, 128, 0}; pg8::StaticOrder S; S.init(MTOK, DM, G, bx);
        pg8::EpiRes<0> E{h1f, a.out, nullptr, part2}; pg8::gemm_phase(lds, g, S, E);
    }
    SEAM();
    {
        for (int it = bx * 512 + tid; it < MTOK * 256; it += G * 512) {
            const int row = it >> 8, c4 = (it & 255) * 4;
            const f32x4* pp = (const f32x4*)(part2 + (size_t)row * 16); float ss = 0.f;
#pragma unroll
            for (int j = 0; j < 4; ++j) { const f32x4 p = pp[j]; ss += (p[0] + p[1]) + (p[2] + p[3]); }
            const float r = __builtin_amdgcn_rsqf(ss * (1.0f / DM) + EPS);
            f32x4 v = *(f32x4*)(a.out + (size_t)row * DM + c4); const f32x4 gf = *(const f32x4*)(a.g_final + c4);
            v = v * r * gf; *(f32x4*)(a.out + (size_t)row * DM + c4) = v;
        }
    }
}

extern "C" void kernel_launch(void* const* d_in, const int* in_sizes, int n_in, void* d_out, int out_size, void* d_ws, size_t ws_size, hipStream_t stream) {
    static int grid = 0;
    if (grid == 0) {
        if (n_in != 18 || out_size != MTOK * DM || ws_size < WS_NEED) { fprintf(stderr, "kernel_launch: unexpected shapes (n_in %d out %d ws %zu)\n", n_in, out_size, ws_size); grid = -1; return; }
        int dev = 0, cus = 0, per_cu = 0;
        (void)hipGetDevice(&dev);
        (void)hipDeviceGetAttribute(&cus, hipDeviceAttributeMultiprocessorCount, dev);
        (void)hipFuncSetAttribute((const void*)nsa_fwd, hipFuncAttributeMaxDynamicSharedMemorySize, LDS_BYTES);
        (void)hipOccupancyMaxActiveBlocksPerMultiprocessor(&per_cu, (const void*)nsa_fwd, 512, LDS_BYTES);
        if (per_cu < 1) { fprintf(stderr, "kernel_launch: occupancy query says %d blocks/CU\n", per_cu); grid = -1; return; }
        grid = cus;
    }
    if (grid < 0) return;
    (void)hipMemsetAsync((unsigned char*)d_ws + WS_BAR, 0, 32768, stream);
    Args a{};
    a.x = (const float*)d_in[0]; a.w_in = (const float*)d_in[1]; a.conv_w = (const float*)d_in[2]; a.w_conv_out = (const float*)d_in[3];
    a.pos_k = (const float*)d_in[4]; a.w1_k = (const float*)d_in[5]; a.w2_k = (const float*)d_in[6];
    a.pos_v = (const float*)d_in[7]; a.w1_v = (const float*)d_in[8]; a.w2_v = (const float*)d_in[9];
    a.w_attn_out = (const float*)d_in[10]; a.w_o = (const float*)d_in[11]; a.g_mix = (const float*)d_in[12]; a.g_ffn = (const float*)d_in[13];
    a.w_gate = (const float*)d_in[14]; a.w_up = (const float*)d_in[15]; a.w_down = (const float*)d_in[16]; a.g_final = (const float*)d_in[17];
    a.out = (float*)d_out; a.ws = (unsigned char*)d_ws; a.probe = 1; a.pad = 0;
    void* args[] = {&a};
    hipError_t e = hipLaunchCooperativeKernel((void*)nsa_fwd, dim3(grid), dim3(512), args, LDS_BYTES, stream);
    if (e != hipSuccess) fprintf(stderr, "kernel_launch: cooperative launch failed: %s (grid %d)\n", hipGetErrorString(e), grid);
}
```

```cpp
#include <hip/hip_runtime.h>
#include <hip/hip_cooperative_groups.h>
#include <cstdio>
#include <cstdint>
namespace cg = cooperative_groups;

#define LAS __attribute__((address_space(3)))
typedef unsigned short bf16_t;
typedef short bf16x8 __attribute__((ext_vector_type(8)));
typedef short s16x4 __attribute__((ext_vector_type(4)));
typedef float f32x4 __attribute__((ext_vector_type(4)));
typedef float f32x16 __attribute__((ext_vector_type(16)));
typedef unsigned u32x4 __attribute__((ext_vector_type(4)));
typedef unsigned u32x2 __attribute__((ext_vector_type(2)));
typedef float f32x2_t __attribute__((ext_vector_type(2)));
typedef __bf16 bf16x2_t __attribute__((ext_vector_type(2)));

constexpr int MTOK = 16384, DM = 1024, SEQ = 4096, NB = 4;
constexpr int PP = 6400;
constexpr int INCOLS = 6192;
constexpr int C_B = 0, C_C = 512, C_H = 1024, C_Q = 1536, C_KC = 2560, C_VC = 2816, C_KS = 3072, C_VS = 3328, C_KW = 3584, C_VW = 3840,
              C_GBR = 4096, C_GCONV = 4144, C_GATTN = 5168;
constexpr int DFF = 2816;
constexpr float EPS = 1e-6f;
constexpr float LOG2E = 1.4426950408889634f;
constexpr float QSCALE = 0.125f * LOG2E;

constexpr size_t MiB = 1u << 20;
constexpr size_t WS_PART1 = 0;
constexpr size_t WS_PART2 = 1 * MiB;
constexpr size_t WS_BIAS = 2 * MiB;
constexpr size_t WS_BAR = 2 * MiB + 65536;
constexpr size_t WS_WIN = 3 * MiB;
constexpr size_t WS_WCONV = 16 * MiB;
constexpr size_t WS_WATTN = 17 * MiB;
constexpr size_t WS_WO = 19 * MiB;
constexpr size_t WS_WUP = 21 * MiB;
constexpr size_t WS_WDOWN = 32 * MiB;
constexpr size_t WS_W1 = 38 * MiB;
constexpr size_t WS_W2 = 40 * MiB;
constexpr size_t WS_HID = 41 * MiB;
constexpr size_t WS_KCMP = 45 * MiB;
constexpr size_t WS_PROJ = 46 * MiB;
constexpr size_t WS_H1F = 46 * MiB;
constexpr size_t WS_H1B = 110 * MiB;
constexpr size_t WS_ACT = 142 * MiB;
constexpr size_t WS_NEED = 246 * MiB;
constexpr size_t OUT_BC = 32 * MiB;

constexpr int LDS_BYTES = 147456;

__device__ __forceinline__ float bf2f(unsigned short v) { return __uint_as_float(((unsigned)v) << 16); }
__device__ __forceinline__ unsigned pk2(float lo, float hi) { f32x2_t v = {lo, hi}; bf16x2_t b = __builtin_convertvector(v, bf16x2_t); return __builtin_bit_cast(unsigned, b); }
__device__ __forceinline__ float ex2(float x) { return __builtin_amdgcn_exp2f(x); }
__device__ __forceinline__ float sigmoidf_(float x) { return __builtin_amdgcn_rcpf(1.0f + ex2(-x * LOG2E)); }
__device__ __forceinline__ float lo_bf(unsigned w) { return __uint_as_float(w << 16); }
__device__ __forceinline__ float hi_bf(unsigned w) { return __uint_as_float(w & 0xffff0000u); }

namespace pg8 {
constexpr int BM = 256, BK = 64, HALF = 128, HTB = HALF * BK * 2, STAGE_BYTES = 8 * HTB, NXCD = 8, WGM = 8;
__host__ __device__ __forceinline__ int lds_byte(int r, int c) { const int st = (r >> 4) * 2 + (c >> 5), rr = r & 15, cc = c & 31, ob = rr * 64 + cc * 2; return st * 1024 + (ob ^ (((ob >> 9) & 1) << 5)); }
__host__ __device__ __forceinline__ void stage_rc(int b, int& R, int& C) { const int st = b / 1024, sb = b % 1024, swz = sb ^ (((sb >> 9) & 1) << 5); R = (st >> 1) * 16 + swz / 64; C = (st & 1) * 32 + (swz % 64) / 2; }
__host__ __device__ __forceinline__ int perm32(int rho) { const int n = rho >> 4, i = rho & 15; return 8 * (i >> 2) + 4 * n + (i & 3); }

struct Unit { int pm, pn; };
struct Gemm { const bf16_t* A; const bf16_t* Bt; int M, N, K; int lda; int a_kstep; int amode; };

struct StaticOrder {
    int nM, nN, nwg, G, c;
    __host__ __device__ void init(int M, int N, int G_, int c_) { nM = M / BM; nN = N / BM; nwg = nM * nN; G = G_; c = c_; }
    __host__ __device__ bool next(int i, Unit& u) const {
        const long L = (long)i * G + c; if (L >= nwg) return false;
        int wgid = (int)L; { const int q = nwg / NXCD, r = nwg % NXCD, xcd = wgid % NXCD, off = wgid / NXCD; wgid = (xcd < r ? xcd * (q + 1) : r * (q + 1) + (xcd - r) * q) + off; }
        const int nig = WGM * nN, gid = wgid / nig, fm = gid * WGM, gsz = (nM - fm) < WGM ? (nM - fm) : WGM;
        u.pm = fm + ((wgid % nig) % gsz); u.pn = (wgid % nig) / gsz; return true;
    }
};

__device__ __forceinline__ const char* a_tile(const Gemm& g, const Unit& u) {
    if (g.amode == 1) return (const char*)g.A + ((size_t)(u.pm >> 2) * SEQ * PP + (size_t)u.pn * 256 + (size_t)(u.pm & 3) * 64) * 2;
    if (g.amode == 2) return (const char*)g.A + ((size_t)u.pn * 4096 * 256 + (size_t)u.pm * 256 * 256) * 2;
    return (const char*)g.A + (size_t)u.pm * 256 * (size_t)g.lda * 2;
}

template <class T, class = void> struct is_fused { static constexpr bool value = false; };
template <class T> struct is_fused<T, decltype((void)T::FUSED)> { static constexpr bool value = true; };
template <class Epi>
__device__ __forceinline__ void gemm_phase(LAS unsigned char* lds, const Gemm g, const StaticOrder& S, const Epi& E) {
#ifdef NO_GEMM
    return;
#endif
    int tid_ = threadIdx.x; asm volatile("" : "+v"(tid_));
    const int tid = tid_, wid = __builtin_amdgcn_readfirstlane(tid >> 6), lane = tid & 63, wr = wid >> 2, wc = wid & 3, fr = lane & 15, fq = lane >> 4;
    const int K = g.K, nt = K / BK;
    unsigned voffA[2], voffB[2];
#pragma unroll
    for (int i = 0; i < 2; ++i) { int R, C; stage_rc(tid * 16 + i * 8192, R, C); const int Rb = (R & ~31) + perm32(R & 31);
        voffA[i] = (unsigned)(R * g.lda + C) * 2u; voffB[i] = (unsigned)(Rb * K + C) * 2u; }
    const size_t kstepA = (size_t)g.a_kstep, kstepB = (size_t)(BK * 2);
    const size_t hstepA = (size_t)HALF * g.lda * 2, hstepB = (size_t)HALF * K * 2;
    const size_t tstepB = 2 * hstepB;
    const unsigned ldsw = (unsigned)wid * 1024u;
    const int aoff = lds_byte(wr * 64 + fr, fq * 8), boff = lds_byte(wc * 32 + fr, fq * 8);
#define PG8_SA(b, h) (((b) * 2 + (h)) * HTB)
#define PG8_SB(b, h) ((4 + (b) * 2 + (h)) * HTB)
#define PG8_STAGE(bufoff, gbase, voff) do { _Pragma("unroll") for (int _i = 0; _i < 2; ++_i) \
        __builtin_amdgcn_global_load_lds((const unsigned*)((const char*)(gbase) + (voff)[_i]), (LAS unsigned*)(lds + (bufoff) + ldsw + _i * 8192), 16, 0, 0); } while (0)
#define PG8_LDA(dst, b, h) do { _Pragma("unroll") for (int m = 0; m < 4; ++m) _Pragma("unroll") for (int k = 0; k < 2; ++k) dst[m][k] = *(const LAS bf16x8*)(lds + PG8_SA(b, h) + aoff + m * 2048 + k * 1024); } while (0)
#define PG8_LDB(dst, b, h) do { _Pragma("unroll") for (int n = 0; n < 2; ++n) _Pragma("unroll") for (int k = 0; k < 2; ++k) dst[n][k] = *(const LAS bf16x8*)(lds + PG8_SB(b, h) + boff + n * 2048 + k * 1024); } while (0)
#define PG8_MMA(ai, bj, At, Bt) do { __builtin_amdgcn_s_setprio(1); _Pragma("unroll") for (int m = 0; m < 4; ++m) _Pragma("unroll") for (int n = 0; n < 2; ++n) _Pragma("unroll") for (int k = 0; k < 2; ++k) \
        acc[ai][bj][m][n] = __builtin_amdgcn_mfma_f32_16x16x32_bf16(Bt[n][k], At[m][k], acc[ai][bj][m][n], 0, 0, 0); __builtin_amdgcn_s_setprio(0); } while (0)
#define PG8_WAIT_V(n) asm volatile("s_waitcnt vmcnt(" #n ")" ::: "memory")
#define PG8_WAIT_L(n) asm volatile("s_waitcnt lgkmcnt(" #n ")" ::: "memory")
#define PG8_BAR __builtin_amdgcn_s_barrier()
#define PG8_SCHED __builtin_amdgcn_sched_barrier(0)
    Unit cur, nxt; int ui = 0;
    if (!S.next(0, cur)) return;
    f32x4 acc[2][2][4][2];
#pragma unroll
    for (int a = 0; a < 2; ++a)
#pragma unroll
        for (int b = 0; b < 2; ++b)
#pragma unroll
            for (int m = 0; m < 4; ++m)
#pragma unroll
                for (int n = 0; n < 2; ++n) acc[a][b][m][n] = (f32x4){0.f, 0.f, 0.f, 0.f};
    bf16x8 At[4][2], B0[2][2], B1[2][2];
    const char* cA = a_tile(g, cur); const char* cB = (const char*)g.Bt + (size_t)cur.pn * tstepB;
    PG8_STAGE(PG8_SB(0, 0), cB, voffB); PG8_STAGE(PG8_SB(0, 1), cB + hstepB, voffB); PG8_STAGE(PG8_SA(0, 0), cA, voffA); PG8_STAGE(PG8_SA(0, 1), cA + hstepA, voffA);
    if (wr == 1) PG8_BAR;
    PG8_WAIT_V(2); PG8_BAR;
    PG8_STAGE(PG8_SB(1, 0), cB + kstepB, voffB); PG8_STAGE(PG8_SA(1, 0), cA + kstepA, voffA); PG8_STAGE(PG8_SB(1, 1), cB + hstepB + kstepB, voffB);
    PG8_WAIT_V(6); PG8_BAR;
    for (;;) {
        const bool has_next = S.next(ui + 1, nxt);
        const char* nA = has_next ? a_tile(g, nxt) : cA; const char* nB = has_next ? (const char*)g.Bt + (size_t)nxt.pn * tstepB : cB;
        for (int t = 0; t < nt; t += 2) {
            const bool last = (t == nt - 2);
            const char* a1 = cA + (size_t)(t + 1) * kstepA;
            const char* a2 = last ? nA : cA + (size_t)(t + 2) * kstepA; const char* b2 = last ? nB : cB + (size_t)(t + 2) * kstepB;
            const char* a3 = a2 + kstepA; const char* b3 = b2 + kstepB;
            PG8_LDB(B0, 0, 0); PG8_LDB(B1, 0, 1); PG8_SCHED; PG8_LDA(At, 0, 0); PG8_STAGE(PG8_SA(1, 1), a1 + hstepA, voffA);
            PG8_WAIT_V(8); PG8_WAIT_L(0); PG8_BAR; PG8_MMA(0, 0, At, B0); PG8_MMA(0, 1, At, B1); PG8_BAR; PG8_SCHED;
            PG8_LDA(At, 0, 1); PG8_STAGE(PG8_SB(0, 0), b2, voffB); PG8_STAGE(PG8_SB(0, 1), b2 + hstepB, voffB); PG8_STAGE(PG8_SA(0, 0), a2, voffA);
            PG8_WAIT_V(8); PG8_WAIT_L(0); PG8_BAR; PG8_MMA(1, 0, At, B0); PG8_MMA(1, 1, At, B1); PG8_BAR; PG8_SCHED;
            PG8_LDB(B0, 1, 0); PG8_LDB(B1, 1, 1); PG8_SCHED; PG8_LDA(At, 1, 0); PG8_STAGE(PG8_SA(0, 1), a2 + hstepA, voffA);
            PG8_WAIT_V(8); PG8_WAIT_L(0); PG8_BAR; PG8_MMA(0, 0, At, B0); PG8_MMA(0, 1, At, B1); PG8_BAR; PG8_SCHED;
            PG8_LDA(At, 1, 1); PG8_STAGE(PG8_SB(1, 0), b3, voffB); PG8_STAGE(PG8_SB(1, 1), b3 + hstepB, voffB); PG8_STAGE(PG8_SA(1, 0), a3, voffA);
            PG8_WAIT_V(8); PG8_WAIT_L(0); PG8_BAR; PG8_MMA(1, 0, At, B0); PG8_MMA(1, 1, At, B1); PG8_BAR; PG8_SCHED;
        }
        if (wr == 0) PG8_BAR;
        if constexpr (!is_fused<Epi>::value) E(acc, cur, wr, wc, fr, fq);
        if (!has_next) break;
#pragma unroll
        for (int a = 0; a < 2; ++a)
#pragma unroll
            for (int b = 0; b < 2; ++b)
#pragma unroll
                for (int m = 0; m < 4; ++m)
#pragma unroll
                    for (int n = 0; n < 2; ++n) acc[a][b][m][n] = (f32x4){0.f, 0.f, 0.f, 0.f};
        cur = nxt; cA = nA; cB = nB; ++ui;
        if (wr == 1) PG8_BAR;
    }
    PG8_WAIT_V(0);
    PG8_BAR;
    if constexpr (is_fused<Epi>::value) E.fused(acc, cur, wr, wc, fr, fq, lds, wid, lane);
#undef PG8_SA
#undef PG8_SB
#undef PG8_STAGE
#undef PG8_LDA
#undef PG8_LDB
#undef PG8_MMA
#undef PG8_WAIT_V
#undef PG8_WAIT_L
#undef PG8_BAR
#undef PG8_SCHED
}

typedef f32x4 Acc[2][2][4][2];
#define EPI_LOOP_BEGIN \
    _Pragma("unroll") for (int ai = 0; ai < 2; ++ai) _Pragma("unroll") for (int m = 0; m < 4; ++m) { const int row = u.pm * BM + wr * 64 + fr + ai * HALF + m * 16; \
    _Pragma("unroll") for (int bj = 0; bj < 2; ++bj) { const f32x4 v0 = acc[ai][bj][m][0], v1 = acc[ai][bj][m][1]; const int col = u.pn * BM + bj * HALF + wc * 32 + 8 * fq;
#define EPI_LOOP_END } }
__device__ __forceinline__ u32x4 pack8(const f32x4 a, const f32x4 b) { u32x4 w; w.x = pk2(a[0], a[1]); w.y = pk2(a[2], a[3]); w.z = pk2(b[0], b[1]); w.w = pk2(b[2], b[3]); return w; }

struct EpiProj { bf16_t* O; int ldc;
    __device__ __forceinline__ void operator()(const Acc& acc, const Unit& u, int wr, int wc, int fr, int fq) const {
        EPI_LOOP_BEGIN
            *(u32x4*)(O + (size_t)row * ldc + col) = pack8(v0, v1);
        EPI_LOOP_END
    } };
__device__ __forceinline__ float gelu_tanh(float x) {
    const float z = x * (1.0f + 0.044715f * x * x) * (2.0f * 0.7978845608028654f * LOG2E);
    return x * __builtin_amdgcn_rcpf(1.0f + ex2(-z));
}
struct EpiHid { bf16_t* O; const float* bias;
    __device__ __forceinline__ void operator()(const Acc& acc, const Unit& u, int wr, int wc, int fr, int fq) const {
        EPI_LOOP_BEGIN
            const int c = col - u.pn * BM; const float* bp = bias + u.pn * 256 + c;
            const f32x4 b0 = *(const f32x4*)bp, b1 = *(const f32x4*)(bp + 4);
            f32x4 a = v0 + b0, b = v1 + b1;
#pragma unroll
            for (int j = 0; j < 4; ++j) { a[j] = gelu_tanh(a[j]); b[j] = gelu_tanh(b[j]); }
            *(u32x4*)(O + (size_t)u.pn * 4096 * 256 + (size_t)row * 256 + c) = pack8(a, b);
        EPI_LOOP_END
    } };
struct EpiCmp { bf16_t* O;
    __device__ __forceinline__ void operator()(const Acc& acc, const Unit& u, int wr, int wc, int fr, int fq) const {
        EPI_LOOP_BEGIN
            const int c = col - u.pn * BM;
            if (c < 64) { u32x4 w = pack8(v0, v1); if ((row & 255) == 255) w = (u32x4){0u, 0u, 0u, 0u};
                *(u32x4*)(O + (size_t)u.pn * 4096 * 64 + (size_t)row * 64 + c) = w; }
        EPI_LOOP_END
    } };
template <int ADD> struct EpiMix { bf16_t* mix; const bf16_t* proj; int gcol;
    __device__ __forceinline__ void operator()(const Acc& acc, const Unit& u, int wr, int wc, int fr, int fq) const {
        EPI_LOOP_BEGIN
            const u32x4 gv = *(const u32x4*)(proj + (size_t)row * PP + gcol + col);
            f32x4 a, b;
            a[0] = sigmoidf_(lo_bf(gv.x)) * v0[0]; a[1] = sigmoidf_(hi_bf(gv.x)) * v0[1]; a[2] = sigmoidf_(lo_bf(gv.y)) * v0[2]; a[3] = sigmoidf_(hi_bf(gv.y)) * v0[3];
            b[0] = sigmoidf_(lo_bf(gv.z)) * v1[0]; b[1] = sigmoidf_(hi_bf(gv.z)) * v1[1]; b[2] = sigmoidf_(lo_bf(gv.w)) * v1[2]; b[3] = sigmoidf_(hi_bf(gv.w)) * v1[3];
            bf16_t* mp = mix + (size_t)row * DM + col;
            if (ADD) { const u32x4 pv = *(const u32x4*)mp;
                a[0] += lo_bf(pv.x); a[1] += hi_bf(pv.x); a[2] += lo_bf(pv.y); a[3] += hi_bf(pv.y); b[0] += lo_bf(pv.z); b[1] += hi_bf(pv.z); b[2] += lo_bf(pv.w); b[3] += hi_bf(pv.w); }
            *(u32x4*)mp = pack8(a, b);
        EPI_LOOP_END
    } };
template <int WB> struct EpiRes { const float* base; float* hf; bf16_t* hb; float* part;
    __device__ __forceinline__ void operator()(const Acc& acc, const Unit& u, int wr, int wc, int fr, int fq) const {
#pragma unroll
        for (int ai = 0; ai < 2; ++ai)
#pragma unroll
            for (int m = 0; m < 4; ++m) { const int row = u.pm * BM + wr * 64 + fr + ai * HALF + m * 16; float ss = 0.f;
#pragma unroll
                for (int bj = 0; bj < 2; ++bj) { const int col = u.pn * BM + bj * HALF + wc * 32 + 8 * fq; const size_t off = (size_t)row * DM + col;
                    const f32x4 x0 = *(const f32x4*)(base + off), x1 = *(const f32x4*)(base + off + 4);
                    const f32x4 a = x0 + acc[ai][bj][m][0], b = x1 + acc[ai][bj][m][1];
                    *(f32x4*)(hf + off) = a; *(f32x4*)(hf + off + 4) = b;
                    if (WB) *(u32x4*)(hb + off) = pack8(a, b);
                    ss += (a[0] * a[0] + a[1] * a[1]) + (a[2] * a[2] + a[3] * a[3]) + (b[0] * b[0] + b[1] * b[1]) + (b[2] * b[2] + b[3] * b[3]); }
                ss += __shfl_xor(ss, 16); ss += __shfl_xor(ss, 32);
                if (fq == 0) part[(size_t)row * 16 + u.pn * 4 + wc] = ss; }
    } };
struct EpiUp { bf16_t* act; const float* part;
    __device__ __forceinline__ void operator()(const Acc& acc, const Unit& u, int wr, int wc, int fr, int fq) const {
#pragma unroll
        for (int ai = 0; ai < 2; ++ai)
#pragma unroll
            for (int m = 0; m < 4; ++m) { const int row = u.pm * BM + wr * 64 + fr + ai * HALF + m * 16;
                const f32x4 pp = *(const f32x4*)(part + (size_t)row * 16 + 4 * fq); float ss = (pp[0] + pp[1]) + (pp[2] + pp[3]);
                ss += __shfl_xor(ss, 16); ss += __shfl_xor(ss, 32);
                const float r = __builtin_amdgcn_rsqf(ss * (1.0f / DM) + EPS);
                f32x4 a, b;
#pragma unroll
                for (int j = 0; j < 4; ++j) { const float g0 = acc[ai][0][m][0][j] * r, u0 = acc[ai][1][m][0][j] * r, g1 = acc[ai][0][m][1][j] * r, u1 = acc[ai][1][m][1][j] * r;
                    a[j] = g0 * sigmoidf_(g0) * u0; b[j] = g1 * sigmoidf_(g1) * u1; }
                *(u32x4*)(act + (size_t)row * DFF + u.pn * 128 + wc * 32 + 8 * fq) = pack8(a, b); }
    } };
struct EpiFinal { static constexpr bool FUSED = true;
    const float* base; float* out; const float* gfin; unsigned* xbuf; unsigned* cnt; unsigned* tmo;
    __device__ __forceinline__ void operator()(const Acc&, const Unit&, int, int, int, int) const {}
    __device__ __forceinline__ void fused(f32x4 (&acc)[2][2][4][2], const Unit& u, int wr, int wc, int fr, int fq, LAS unsigned char* lds, int wid, int lane) const {
        LAS float* P = (LAS float*)lds;
        LAS float* S = (LAS float*)(lds + 8192);
        LAS unsigned* flag = (LAS unsigned*)(lds + 8192 + 2048);
#pragma unroll
        for (int ai = 0; ai < 2; ++ai)
#pragma unroll
            for (int m = 0; m < 4; ++m) { const int rl = ai * HALF + wr * 64 + m * 16 + fr; const int row = u.pm * BM + rl; float ss = 0.f;
#pragma unroll
                for (int bj = 0; bj < 2; ++bj) { const int col = u.pn * BM + bj * HALF + wc * 32 + 8 * fq; const size_t off = (size_t)row * DM + col;
                    const f32x4 x0 = *(const f32x4*)(base + off), x1 = *(const f32x4*)(base + off + 4);
                    const f32x4 a = x0 + acc[ai][bj][m][0], b = x1 + acc[ai][bj][m][1]; acc[ai][bj][m][0] = a; acc[ai][bj][m][1] = b;
                    ss += (a[0] * a[0] + a[1] * a[1]) + (a[2] * a[2] + a[3] * a[3]) + (b[0] * b[0] + b[1] * b[1]) + (b[2] * b[2] + b[3] * b[3]); }
                ss += __shfl_xor(ss, 16); ss += __shfl_xor(ss, 32);
                if (fq == 0) P[rl * 4 + wc] = ss; }
        asm volatile("s_waitcnt lgkmcnt(0)" ::: "memory"); __builtin_amdgcn_s_barrier(); asm volatile("" ::: "memory");
        const int rl = wid * 32 + (lane & 31);
        if (lane < 32) { const float tot = (P[rl * 4 + 0] + P[rl * 4 + 1]) + (P[rl * 4 + 2] + P[rl * 4 + 3]);
            __hip_atomic_store(xbuf + ((size_t)(u.pm * BM + rl) * 4 + u.pn), __float_as_uint(tot), __ATOMIC_RELAXED, __HIP_MEMORY_SCOPE_AGENT); }
        asm volatile("s_waitcnt vmcnt(0)" ::: "memory");
        if (lane == 0) __hip_atomic_fetch_add(cnt + 64 * u.pm, 1u, __ATOMIC_RELAXED, __HIP_MEMORY_SCOPE_AGENT);
        if (wid == 0) {
            unsigned sp = 0u;
            for (;;) {
                if ((unsigned)__builtin_amdgcn_readfirstlane(__hip_atomic_load(cnt + 64 * u.pm, __ATOMIC_RELAXED, __HIP_MEMORY_SCOPE_AGENT)) >= 32u) break;
                __builtin_amdgcn_s_sleep(2);
                if (++sp > (1u << 20)) { if (lane == 0) __hip_atomic_store(tmo, 1u, __ATOMIC_RELAXED, __HIP_MEMORY_SCOPE_AGENT); break; }
            }
            __builtin_amdgcn_fence(__ATOMIC_ACQUIRE, "agent");
            if (lane == 0) flag[0] = 1u;
        }
        asm volatile("s_waitcnt vmcnt(0) lgkmcnt(0)" ::: "memory"); __builtin_amdgcn_s_barrier(); asm volatile("" ::: "memory");
        if (lane < 32) { const unsigned* sl = xbuf + (size_t)(u.pm * BM + rl) * 4; float tot = 0.f;
#pragma unroll
            for (int t = 0; t < 4; ++t) tot += __uint_as_float(__hip_atomic_load(sl + t, __ATOMIC_RELAXED, __HIP_MEMORY_SCOPE_AGENT));
            S[rl] = __builtin_amdgcn_rsqf(tot * (1.0f / DM) + EPS); }
        asm volatile("s_waitcnt lgkmcnt(0)" ::: "memory"); __builtin_amdgcn_s_barrier(); asm volatile("" ::: "memory");
#pragma unroll
        for (int bj = 0; bj < 2; ++bj) { const int col = u.pn * BM + bj * HALF + wc * 32 + 8 * fq;
            const f32x4 g0 = *(const f32x4*)(gfin + col), g1 = *(const f32x4*)(gfin + col + 4);
#pragma unroll
            for (int ai = 0; ai < 2; ++ai)
#pragma unroll
                for (int m = 0; m < 4; ++m) { const int rl2 = ai * HALF + wr * 64 + m * 16 + fr; const float rs = S[rl2]; const size_t off = (size_t)(u.pm * BM + rl2) * DM + col;
                    *(f32x4*)(out + off) = acc[ai][bj][m][0] * rs * g0; *(f32x4*)(out + off + 4) = acc[ai][bj][m][1] * rs * g1; } }
    } };
}

namespace att {
constexpr int KB0 = 0, VB0 = 24576, IMP = 49152, IMPW = 65, SELM = IMP + 4 * 64 * IMPW * 4, WMASK = SELM + 512, WSF = WMASK + 64, STEPS = WSF + 8 * 32 * 4, ATT_LDS = STEPS + 8 * 128;
static_assert(ATT_LDS <= 143360, "attention LDS");
#define MFMA32(a, b, c) __builtin_amdgcn_mfma_f32_32x32x16_bf16((a), (b), (c), 0, 0, 0)
__device__ __forceinline__ int crow(int r, int hi) { return (r & 3) + 8 * (r >> 2) + 4 * hi; }
typedef short v4i16_t __attribute__((ext_vector_type(4)));
__device__ __forceinline__ s16x4 vtr(LAS const unsigned char* p) { return __builtin_bit_cast(s16x4, __builtin_amdgcn_ds_read_tr16_b64_v4i16((LAS v4i16_t*)p)); }

struct St { float m, l; f32x16 o0, o1; };

__device__ __forceinline__ void qk_tile(f32x16& p0, f32x16& p1, LAS const unsigned char* kb, const bf16x8* qf, int r, int h) {
    bf16x8 k0[4], k1[4], qv[4];
#pragma unroll
    for (int d0 = 0; d0 < 4; ++d0) { k0[d0] = *(const LAS bf16x8*)(kb + (2 * d0 + h) * 1024 + r * 16); k1[d0] = *(const LAS bf16x8*)(kb + (2 * d0 + h) * 1024 + 512 + r * 16);
        qv[d0] = qf[d0]; }
#pragma unroll
    for (int i = 0; i < 16; ++i) { p0[i] = 0.f; p1[i] = 0.f; }
    __builtin_amdgcn_sched_barrier(0);
#pragma unroll
    for (int d0 = 0; d0 < 4; ++d0) { p0 = MFMA32(k0[d0], qv[d0], p0); p1 = MFMA32(k1[d0], qv[d0], p1); }
}
__device__ __forceinline__ void apply_mask(f32x16& p0, f32x16& p1, unsigned long long allow, int h) {
    if (__all(allow == ~0ull)) return;
    const unsigned long long a = allow >> (4 * h); const unsigned lo = (unsigned)a, hi = (unsigned)(a >> 32);
#pragma unroll
    for (int i = 0; i < 16; ++i) { const int cb = (i & 3) + 8 * (i >> 2);
        p0[i] = ((lo >> cb) & 1u) ? p0[i] : -INFINITY; p1[i] = ((hi >> cb) & 1u) ? p1[i] : -INFINITY; }
}
__device__ __forceinline__ float rowmax32(const f32x16& p0, const f32x16& p1) {
    float a = fmaxf(p0[0], p1[0]);
#pragma unroll
    for (int i = 1; i < 16; ++i) a = fmaxf(a, fmaxf(p0[i], p1[i]));
    return fmaxf(a, __shfl_xor(a, 32));
}
__device__ __forceinline__ void pv_tile(f32x16& o0, f32x16& o1, LAS const unsigned char* vb, const f32x16& p0, const f32x16& p1, int lane, int h) {
    bf16x8 pa[4];
#pragma unroll
    for (int s = 0; s < 4; ++s) { u32x4 w;
#pragma unroll
        for (int j = 0; j < 4; ++j) { const int i0 = 8 * (s & 1) + 2 * j; w[j] = (s < 2) ? pk2(p0[i0], p0[i0 + 1]) : pk2(p1[i0], p1[i0 + 1]); }
        pa[s] = __builtin_bit_cast(bf16x8, w); }
    LAS const unsigned char* vp = vb + ((lane >> 4) & 1) * 32 + (lane & 3) * 8 + (4 * h + ((lane & 15) >> 2)) * 64;
    s16x4 l0[4], h0[4], l1[4], h1[4];
#pragma unroll
    for (int s = 0; s < 4; ++s) { l0[s] = vtr(vp + s * 1024); h0[s] = vtr(vp + s * 1024 + 512); l1[s] = vtr(vp + 4096 + s * 1024); h1[s] = vtr(vp + 4096 + s * 1024 + 512); }
    __builtin_amdgcn_sched_barrier(0);
#pragma unroll
    for (int s = 0; s < 4; ++s) {
        const bf16x8 v0 = (bf16x8){l0[s][0], l0[s][1], l0[s][2], l0[s][3], h0[s][0], h0[s][1], h0[s][2], h0[s][3]};
        const bf16x8 v1 = (bf16x8){l1[s][0], l1[s][1], l1[s][2], l1[s][3], h1[s][0], h1[s][1], h1[s][2], h1[s][3]};
        o0 = MFMA32(pa[s], v0, o0); o1 = MFMA32(pa[s], v1, o1);
    }
}
__device__ __forceinline__ void tile_online(St& st, LAS const unsigned char* kb, LAS const unsigned char* vb, const bf16x8* qr, unsigned long long allow,
                                            LAS float* wsf, int lane, int r, int h) {
    f32x16 p0, p1; qk_tile(p0, p1, kb, qr, r, h); __builtin_amdgcn_sched_barrier(0); apply_mask(p0, p1, allow, h);
    const float rm = rowmax32(p0, p1), mnew = fmaxf(st.m, rm), f = ex2(st.m - mnew); st.m = mnew;
    float ls = 0.f;
#pragma unroll
    for (int i = 0; i < 16; ++i) { p0[i] = ex2(p0[i] - mnew); p1[i] = ex2(p1[i] - mnew); ls += p0[i] + p1[i]; }
    st.l = st.l * f + ls;
    if (__any(f != 1.0f)) {
        if (h == 0) wsf[r] = f;
#pragma unroll
        for (int i = 0; i < 16; ++i) { const float fi = wsf[crow(i, h)]; st.o0[i] *= fi; st.o1[i] *= fi; }
    }
    pv_tile(st.o0, st.o1, vb, p0, p1, lane, h);
}
__device__ __forceinline__ void tile_stats(float& m, float& l, LAS const unsigned char* kb, const bf16x8* qr, unsigned long long allow, int r, int h) {
    f32x16 p0, p1; qk_tile(p0, p1, kb, qr, r, h); __builtin_amdgcn_sched_barrier(0); apply_mask(p0, p1, allow, h);
    const float rm = rowmax32(p0, p1), mnew = fmaxf(m, rm), f = ex2(m - mnew); m = mnew;
    float ls = 0.f;
#pragma unroll
    for (int i = 0; i < 16; ++i) ls += ex2(p0[i] - mnew) + ex2(p1[i] - mnew);
    l = l * f + ls;
}
__device__ __forceinline__ void tile_exact(f32x16& o0, f32x16& o1, float m, float invl, LAS const unsigned char* kb, LAS const unsigned char* vb, const bf16x8* qr,
                                           unsigned long long allow, LAS float* impw  , float& carry, int j, int lane, int r, int h) {
    f32x16 p0, p1; qk_tile(p0, p1, kb, qr, r, h); __builtin_amdgcn_sched_barrier(0); apply_mask(p0, p1, allow, h);
#pragma unroll
    for (int i = 0; i < 16; ++i) { p0[i] = ex2(p0[i] - m) * invl; p1[i] = ex2(p1[i] - m) * invl; }
#pragma unroll
    for (int pos = 0; pos < 8; ++pos) {
        const int half = pos >> 2, r4 = pos & 3;
        const float P0 = half ? p1[4 * r4] : p0[4 * r4], P1 = half ? p1[4 * r4 + 1] : p0[4 * r4 + 1], P2 = half ? p1[4 * r4 + 2] : p0[4 * r4 + 2], P3 = half ? p1[4 * r4 + 3] : p0[4 * r4 + 3];
        const float a = (P0 + P1) + (P2 + 0.5f * P3), b = 0.5f * P3;
        const float bx = __shfl_xor(b, 32);
        const float add = h ? bx : carry;
        impw[16 * j + 2 * pos + h] = a + add;
        carry = bx;
    }
    pv_tile(o0, o1, vb, p0, p1, lane, h);
}

__device__ __forceinline__ void qk_tile_c(f32x16& p0, f32x16& p1, LAS const unsigned char* kb, const bf16x8* qf, const f32x16& c, int r, int h) {
    bf16x8 k0[4], k1[4], qv[4];
#pragma unroll
    for (int d0 = 0; d0 < 4; ++d0) { k0[d0] = *(const LAS bf16x8*)(kb + (2 * d0 + h) * 1024 + r * 16); k1[d0] = *(const LAS bf16x8*)(kb + (2 * d0 + h) * 1024 + 512 + r * 16);
        qv[d0] = qf[d0]; }
    __builtin_amdgcn_sched_barrier(0);
    p0 = MFMA32(k0[0], qv[0], c); p1 = MFMA32(k1[0], qv[0], c);
#pragma unroll
    for (int d0 = 1; d0 < 4; ++d0) { p0 = MFMA32(k0[d0], qv[d0], p0); p1 = MFMA32(k1[d0], qv[d0], p1); }
}
__device__ __forceinline__ unsigned long long lowmask(int n);
__device__ __forceinline__ void soft_pv(St& st, f32x16& x0, f32x16& x1, float cx, LAS const unsigned char* vb, bool first, int kind, int tq,
                                        LAS float* wsf, int lane, int r, int h) {
    if (first) st.m = cx;
    else { const float d = st.m - cx;
        if (__any(d != 0.f)) {
#pragma unroll
            for (int i = 0; i < 16; ++i) { x0[i] -= d; x1[i] -= d; } } }
    if (kind) apply_mask(x0, x1, kind == 1 ? lowmask(tq + 1) : ~lowmask(tq + 1), h);
    const float rm = rowmax32(x0, x1);
    if (first) {
        const float dl = (rm > -INFINITY) ? rm : 0.f; st.m += dl;
#pragma unroll
        for (int i = 0; i < 16; ++i) { x0[i] -= dl; x1[i] -= dl; }
    } else if (__any(rm > 8.0f)) {
        const float dl = fmaxf(rm, 0.f), f = ex2(-dl); st.m += dl; st.l *= f;
        if (h == 0) wsf[r] = f;
#pragma unroll
        for (int i = 0; i < 16; ++i) { x0[i] -= dl; x1[i] -= dl; }
#pragma unroll
        for (int i = 0; i < 16; ++i) { const float fi = wsf[crow(i, h)]; st.o0[i] *= fi; st.o1[i] *= fi; }
    }
    float ls = 0.f;
#pragma unroll
    for (int i = 0; i < 16; ++i) { x0[i] = ex2(x0[i]); x1[i] = ex2(x1[i]); ls += x0[i] + x1[i]; }
    st.l += ls;
    pv_tile(st.o0, st.o1, vb, x0, x1, lane, h);
}
__device__ __forceinline__ unsigned long long lowmask(int n) { return n >= 64 ? ~0ull : ((1ull << n) - 1ull); }

typedef LAS const char* lds_cptr;
__device__ __forceinline__ void hs_glds16(const void* gsrc, unsigned lds_dst) { unsigned keep;
    asm volatile("s_mov_b32 %0, m0\n\ts_mov_b32 m0, %2\n\ts_nop 0\n\tglobal_load_lds_dwordx4 %1, off\n\ts_mov_b32 m0, %0" : "=&s"(keep) : "v"(gsrc), "s"(lds_dst) : "memory"); }
__device__ __forceinline__ float hs_max3f(float a, float b, float c) { float r; asm("v_max3_f32 %0, %1, %2, %3" : "=v"(r) : "v"(a), "v"(b), "v"(c)); return r; }
__device__ __forceinline__ float hs_max2f(float a, float b) { float r; asm("v_max_f32_e32 %0, %1, %2" : "=v"(r) : "v"(a), "v"(b)); return r; }
__device__ __forceinline__ float hs_fadd(float a, float b) { float r; asm("v_add_f32_e32 %0, %1, %2" : "=v"(r) : "v"(a), "v"(b)); return r; }
__device__ __forceinline__ float hs_fsub(float a, float b) { float r; asm("v_sub_f32_e32 %0, %1, %2" : "=v"(r) : "v"(a), "v"(b)); return r; }
#define HS_SBAR() __builtin_amdgcn_sched_barrier(0)
#define HS_WAIT_BAR(N) asm volatile("s_waitcnt vmcnt(" #N ") lgkmcnt(0)\n\ts_barrier" ::: "memory")
__device__ __forceinline__ void hs_qkt(f32x16& p0, f32x16& p1, const char* Kslot, const bf16x8* qr, const f32x16& negm, int r32, int hi) {
    const char* kb = Kslot + hi * 1024 + r32 * 16;
#pragma unroll
    for (int d0 = 0; d0 < 4; ++d0) {
        const bf16x8 b0 = *reinterpret_cast<const bf16x8*>(kb + d0 * 2048);
        const bf16x8 b1 = *reinterpret_cast<const bf16x8*>(kb + d0 * 2048 + 512);
        if (d0 == 0) { p0 = MFMA32(b0, qr[0], negm); p1 = MFMA32(b1, qr[0], negm); }
        else { p0 = MFMA32(b0, qr[d0], p0); p1 = MFMA32(b1, qr[d0], p1); } }
}
__device__ __forceinline__ void hs_kload8(bf16x8* kf, lds_cptr kp) {
    kf[0] = *(const LAS bf16x8*)(kp);        kf[1] = *(const LAS bf16x8*)(kp + 512);
    kf[2] = *(const LAS bf16x8*)(kp + 2048); kf[3] = *(const LAS bf16x8*)(kp + 2560);
    kf[4] = *(const LAS bf16x8*)(kp + 4096); kf[5] = *(const LAS bf16x8*)(kp + 4608);
    kf[6] = *(const LAS bf16x8*)(kp + 6144); kf[7] = *(const LAS bf16x8*)(kp + 6656);
}
__device__ __forceinline__ void hs_kload2(bf16x8* kf, lds_cptr kp, int j) { kf[2 * j] = *(const LAS bf16x8*)(kp + j * 2048); kf[2 * j + 1] = *(const LAS bf16x8*)(kp + j * 2048 + 512); }
__device__ __forceinline__ s16x4 hs_vtr(lds_cptr p) { return __builtin_bit_cast(s16x4, __builtin_amdgcn_ds_read_tr16_b64_v4i16((LAS v4i16_t*)p)); }
__device__ __forceinline__ float hs_rowmax(const f32x16& p0, const f32x16& p1) {
    float a = hs_max3f(p0[0], p0[1], p1[0]), b = hs_max3f(p0[2], p0[3], p1[1]); a = hs_max3f(a, p1[2], p1[3]);
#pragma unroll
    for (int r = 4; r < 16; r += 4) { a = hs_max3f(a, p0[r], p0[r + 1]); b = hs_max3f(b, p0[r + 2], p0[r + 3]); a = hs_max3f(a, p1[r], p1[r + 1]); b = hs_max3f(b, p1[r + 2], p1[r + 3]); }
    const float m = hs_max2f(a, b);
    auto rr = __builtin_amdgcn_permlane32_swap(__float_as_uint(m), __float_as_uint(m), false, false);
    return hs_max2f(__uint_as_float(rr[0]), __uint_as_float(rr[1]));
}
__device__ __forceinline__ void hs_pv(f32x16* o, int vb, bf16x8 pa0, bf16x8 pa1, bf16x8 pa2, bf16x8 pa3) {
#pragma unroll
    for (int d0 = 0; d0 < 2; ++d0) { s16x4 lo[4], hi[4];
#pragma unroll
        for (int ks = 0; ks < 4; ++ks) {
            asm volatile("ds_read_b64_tr_b16 %0,%1 offset:%c2" : "=&v"(lo[ks]) : "v"(vb), "i"(d0 * 4096 + ks * 1024) : "memory");
            asm volatile("ds_read_b64_tr_b16 %0,%1 offset:%c2" : "=&v"(hi[ks]) : "v"(vb), "i"(d0 * 4096 + ks * 1024 + 512) : "memory"); }
        asm volatile("s_waitcnt lgkmcnt(0)" ::: "memory"); HS_SBAR();
#define HS_PK(k) (bf16x8){lo[k][0], lo[k][1], lo[k][2], lo[k][3], hi[k][0], hi[k][1], hi[k][2], hi[k][3]}
        o[d0] = MFMA32(pa0, HS_PK(0), o[d0]); o[d0] = MFMA32(pa1, HS_PK(1), o[d0]); o[d0] = MFMA32(pa2, HS_PK(2), o[d0]); o[d0] = MFMA32(pa3, HS_PK(3), o[d0]);
#undef HS_PK
    }
}
template <int THRL> __device__ __forceinline__ void run_branch(char* shm, const bf16x8* qr, const bf16_t* ksb, LAS const unsigned char* steps, const int NT,
                                                               const int qb, f32x16* o, float& l_out, const int wid, const int lane) {
    constexpr int SLOTB = 8192, NSLOT = 3;
    { unsigned long long p_ = (unsigned long long)ksb; asm volatile("" : "+s"(p_)); ksb = (const bf16_t*)p_; }
    const int r32 = lane & 31, hi = lane >> 5, tq = (wid & 1) * 32 + r32;
    const unsigned lds0 = (unsigned)(uintptr_t)shm;
    LAS const unsigned long long* selp = (LAS const unsigned long long*)((lds_cptr)shm + SELM) + tq;
    float* wsf = (float*)(shm + WSF) + wid * 32;
    const size_t koff = (size_t)lane * PP + wid * 8, voff = (size_t)(16 * (wid & 3) + (lane >> 2)) * PP + (wid >> 2) * 32 + (lane & 3) * 8 + (C_VS - C_KS);
    const unsigned kdst = lds0 + KB0 + wid * 1024, vdst = lds0 + VB0 + wid * 1024;
#define HS_CODE(t) ((int)__builtin_amdgcn_readfirstlane((int)steps[(t)]))
#define HS_SRC(c) (ksb + (size_t)(((c) & 0x80) ? (C_KW - C_KS) : 0) + (size_t)(((c) == 0x7f) ? 0 : ((c) & 0x7f)) * 64 * PP)
#define DMA_K(t, slot) do { const int c_ = HS_CODE(t); hs_glds16(HS_SRC(c_) + koff, (unsigned)__builtin_amdgcn_readfirstlane(kdst + (slot))); } while (0)
#define DMA_V(t, slot) do { const int c_ = HS_CODE(t); hs_glds16(HS_SRC(c_) + voff, (unsigned)__builtin_amdgcn_readfirstlane(vdst + (slot))); } while (0)
    const int vb0 = (int)(lds0 + VB0) + ((lane >> 4) & 1) * 32 + (lane & 3) * 8 + (4 * hi + ((lane & 15) >> 2)) * 64;
    const char* Kbase = shm + KB0; bf16x8 kf[8];
    const lds_cptr shm3 = (lds_cptr)shm; const lds_cptr kp0 = shm3 + KB0 + hi * 1024 + r32 * 16; const lds_cptr vp0 = shm3 + VB0 + ((lane >> 4) & 1) * 32 + (lane & 3) * 8 + (4 * hi + ((lane & 15) >> 2)) * 64;
    DMA_K(0, 0); DMA_V(0, 0); DMA_K(1, SLOTB);
    float mhat = 0.f, l_reg = 0.f; f32x16 negm;
    { float z = 0.f; asm volatile("" : "+v"(z));
#pragma unroll
      for (int i = 0; i < 16; ++i) { o[0][i] = z; o[1][i] = z; negm[i] = z; } }
    asm volatile("" : "+v"(negm));
#define CMASK(P0, P1, t) do { const int c_ = HS_CODE(t); const bool isw_ = (c_ & 0x80) != 0; const int jj_ = c_ & 0x7f; \
        const bool en_ = isw_ ? true : ((c_ != 0x7f) && (((*selp >> (jj_ & 63)) & 1ull) != 0ull)); \
        if (__any(!en_)) { if (!en_) { _Pragma("unroll") for (int r = 0; r < 16; ++r) { P0[r] = -INFINITY; P1[r] = -INFINITY; } } } \
        int kind_ = 0; if (c_ != 0x7f) { if (jj_ == qb) kind_ = 1; else if (isw_ && jj_ == qb - 8) kind_ = 2; } \
        if (kind_) apply_mask(P0, P1, kind_ == 1 ? lowmask(tq + 1) : ~lowmask(tq + 1), hi); } while (0)
    bool resc = false;
#define START(P0, P1) do { const float rm = hs_rowmax(P0, P1); resc = false; \
        { const float dl = (rm > -INFINITY) ? rm : 0.f; mhat = hs_fadd(mhat, dl); \
          _Pragma("unroll") for (int r = 0; r < 16; ++r) { P0[r] = hs_fsub(P0[r], dl); P1[r] = hs_fsub(P1[r], dl); } \
          _Pragma("unroll") for (int r = 0; r < 16; ++r) negm[r] = -mhat; asm volatile("" : "+v"(negm)); } \
        _Pragma("unroll") for (int r = 0; r < 16; ++r) P0[r] = __builtin_amdgcn_exp2f(P0[r]); } while (0)
#define RESC() do { if (resc) { asm volatile("s_waitcnt lgkmcnt(0)" ::: "memory"); \
        _Pragma("unroll") for (int d_ = 0; d_ < 2; ++d_) _Pragma("unroll") for (int r = 0; r < 16; ++r) o[d_][r] *= wsf[crow(r, hi)]; } } while (0)
    f32x16 pA0, pA1, pB0, pB1;
    int sl_prev = 0, sl_cur = 0, sl_next = SLOTB;
#define ROT() do { sl_prev = sl_cur; sl_cur = sl_next; sl_next = (sl_next == (NSLOT - 1) * SLOTB) ? 0 : sl_next + SLOTB; } while (0)
    DMA_K(2, 2 * SLOTB);
    HS_WAIT_BAR(3);
    hs_qkt(pA0, pA1, Kbase, qr, negm, r32, hi); asm volatile("s_nop 15\n\ts_nop 7" : "+v"(pA0), "+v"(pA1)); CMASK(pA0, pA1, 0);
    START(pA0, pA1);
    _Pragma("unroll") for (int r = 0; r < 16; ++r) pA1[r] = __builtin_amdgcn_exp2f(pA1[r]);
    HS_WAIT_BAR(0);
    DMA_K(3, 0); DMA_V(1, SLOTB);
    ROT();
    hs_kload8(kf, kp0 + sl_cur);
    HS_WAIT_BAR(2);
    s16x4 vlo[8], vhi[8]; u32x4 pw0, pw1, pw2, pw3;
#define PKW(P, B) pk2(P[B], P[B + 1])
#define PAF(k) __builtin_bit_cast(bf16x8, pw##k)
#define VFR(i) (bf16x8){vlo[i][0], vlo[i][1], vlo[i][2], vlo[i][3], vhi[i][0], vhi[i][1], vhi[i][2], vhi[i][3]}
#define PIN(x) asm volatile("" : "+v"(x))
#define MX3(a, b, c) __builtin_fmaxf(__builtin_fmaxf((a), (b)), (c))
#define GAPA(MF, A0, A1, A2, A3, W0, W1, PW) do { MF; sacc += A0; sacc += A1; sacc += A2; sacc += A3; PIN(sacc); W0; W1; PIN(PW); HS_SBAR(); } while (0)
#define EX(v) __builtin_amdgcn_exp2f(v)
#define GAPB(MF, X, B) do { MF; X[B] = EX(X[B]); X[B + 1] = EX(X[B + 1]); X[B + 2] = EX(X[B + 2]); X[B + 3] = EX(X[B + 3]); PIN(X); HS_SBAR(); } while (0)
#define VRD(i) do { vlo[i] = hs_vtr(vp_ + (((i) >> 2) * 4096 + ((i) & 3) * 1024)); vhi[i] = hs_vtr(vp_ + (((i) >> 2) * 4096 + ((i) & 3) * 1024 + 512)); } while (0)
#define KRD(G, j) do { if (G) { hs_kload2(kf, kp0 + sl_next, j); HS_SBAR(); } } while (0)
#define STEP(C0, C1, P0, P1, t, GK, GV, GL) do { HS_SBAR(); \
        const lds_cptr vp_ = vp0 + sl_prev; \
        VRD(0); HS_SBAR(); float sacc = (P0[0] + P0[1]); \
        GAPA(C0 = MFMA32(kf[0], qr[0], negm), P0[2], P0[3], P0[4], P0[5],     pw0[0] = PKW(P0, 0), pw0[1] = PKW(P0, 2), pw0); \
        VRD(4); HS_SBAR(); GAPA(C1 = MFMA32(kf[1], qr[0], negm), P0[6], P0[7], P0[8], P0[9],     pw0[2] = PKW(P0, 4), pw0[3] = PKW(P0, 6), pw0); \
        VRD(1); HS_SBAR(); GAPA(C0 = MFMA32(kf[2], qr[1], C0),   P0[10], P0[11], P0[12], P0[13], pw1[0] = PKW(P0, 8), pw1[1] = PKW(P0, 10), pw1); \
        VRD(5); HS_SBAR(); GAPA(C1 = MFMA32(kf[3], qr[1], C1),   P0[14], P0[15], P1[0], P1[1],   pw1[2] = PKW(P0, 12), pw1[3] = PKW(P0, 14), pw1); \
        VRD(2); HS_SBAR(); GAPA(C0 = MFMA32(kf[4], qr[2], C0),   P1[2], P1[3], P1[4], P1[5],     pw2[0] = PKW(P1, 0), pw2[1] = PKW(P1, 2), pw2); \
        VRD(6); HS_SBAR(); GAPA(C1 = MFMA32(kf[5], qr[2], C1),   P1[6], P1[7], P1[8], P1[9],     pw2[2] = PKW(P1, 4), pw2[3] = PKW(P1, 6), pw2); \
        VRD(3); HS_SBAR(); GAPA(C0 = MFMA32(kf[6], qr[3], C0),   P1[10], P1[11], P1[12], P1[13], pw3[0] = PKW(P1, 8), pw3[1] = PKW(P1, 10), pw3); \
        VRD(7); HS_SBAR(); GAPA(C1 = MFMA32(kf[7], qr[3], C1),   P1[14], P1[15], 0.f, 0.f,       pw3[2] = PKW(P1, 12), pw3[3] = PKW(P1, 14), pw3); \
        l_reg += sacc; \
        if (GK) { DMA_K((t) + 3, sl_cur); } if (GV) { DMA_V((t) + 1, sl_next); } \
        CMASK(C0, C1, t); \
        { float a = MX3(C0[0], C0[1], C1[0]), b = MX3(C0[2], C0[3], C1[1]); a = MX3(a, C1[2], C1[3]); \
          _Pragma("unroll") for (int r = 4; r < 16; r += 4) { a = MX3(a, C0[r], C0[r + 1]); b = MX3(b, C0[r + 2], C0[r + 3]); a = MX3(a, C1[r], C1[r + 1]); b = MX3(b, C1[r + 2], C1[r + 3]); } \
          float rm = __builtin_fmaxf(a, b); { auto rr = __builtin_amdgcn_permlane32_swap(__float_as_uint(rm), __float_as_uint(rm), false, false); rm = __builtin_fmaxf(__uint_as_float(rr[0]), __uint_as_float(rr[1])); } \
          resc = false; \
          if (__builtin_expect(__any(rm > (float)THRL), 0)) { const float dl = __builtin_fmaxf(rm, 0.f); mhat += dl; \
            _Pragma("unroll") for (int r = 0; r < 16; ++r) { C0[r] -= dl; C1[r] -= dl; } \
            _Pragma("unroll") for (int r = 0; r < 16; ++r) negm[r] = -mhat; asm volatile("" : "+v"(negm)); \
            const float f = __builtin_amdgcn_exp2f(-dl); l_reg *= f; if (hi == 0) wsf[r32] = f; resc = true; } } \
        HS_SBAR(); \
        GAPB(o[0] = MFMA32(PAF(0), VFR(0), o[0]), C0, 0); \
        GAPB(o[1] = MFMA32(PAF(0), VFR(4), o[1]), C0, 4); \
        KRD(GL, 0); GAPB(o[0] = MFMA32(PAF(1), VFR(1), o[0]), C0, 8); \
        KRD(GL, 1); GAPB(o[1] = MFMA32(PAF(1), VFR(5), o[1]), C0, 12); \
        KRD(GL, 2); GAPB(o[0] = MFMA32(PAF(2), VFR(2), o[0]), C1, 0); \
        KRD(GL, 3); GAPB(o[1] = MFMA32(PAF(2), VFR(6), o[1]), C1, 4); \
        GAPB(o[0] = MFMA32(PAF(3), VFR(3), o[0]), C1, 8); \
        GAPB(o[1] = MFMA32(PAF(3), VFR(7), o[1]), C1, 12); \
    } while (0)
    int t = 1;
    for (; t + 5 < NT; t += 2) {
        STEP(pB0, pB1, pA0, pA1, t, true, true, true);     HS_WAIT_BAR(2); RESC(); ROT();
        STEP(pA0, pA1, pB0, pB1, t + 1, true, true, true); HS_WAIT_BAR(2); RESC(); ROT();
    }
#define ENDW(tt) do { if ((tt) + 3 < NT) { HS_WAIT_BAR(2); } else if ((tt) + 2 < NT) { HS_WAIT_BAR(1); } else { HS_WAIT_BAR(0); } } while (0)
    for (; t + 1 < NT; t += 2) {
        STEP(pB0, pB1, pA0, pA1, t, (t + 3 < NT), (t + 1 < NT), (t + 1 < NT));         ENDW(t);     RESC(); ROT();
        STEP(pA0, pA1, pB0, pB1, t + 1, (t + 4 < NT), (t + 2 < NT), (t + 2 < NT));     ENDW(t + 1); RESC(); ROT();
    }
    STEP(pB0, pB1, pA0, pA1, NT - 1, false, false, false); RESC();
    { float sacc = pB0[0] + pB0[1]; _Pragma("unroll") for (int r = 2; r < 16; ++r) sacc += pB0[r]; _Pragma("unroll") for (int r = 0; r < 16; ++r) sacc += pB1[r]; l_reg += sacc;
      pw0 = (u32x4){PKW(pB0, 0), PKW(pB0, 2), PKW(pB0, 4), PKW(pB0, 6)}; pw1 = (u32x4){PKW(pB0, 8), PKW(pB0, 10), PKW(pB0, 12), PKW(pB0, 14)};
      pw2 = (u32x4){PKW(pB1, 0), PKW(pB1, 2), PKW(pB1, 4), PKW(pB1, 6)}; pw3 = (u32x4){PKW(pB1, 8), PKW(pB1, 10), PKW(pB1, 12), PKW(pB1, 14)};
      HS_SBAR(); hs_pv(o, vb0 + sl_cur, PAF(0), PAF(1), PAF(2), PAF(3)); }
    { auto rr = __builtin_amdgcn_permlane32_swap(__float_as_uint(l_reg), __float_as_uint(l_reg), false, false); l_out = __uint_as_float(rr[0]) + __uint_as_float(rr[1]); }
    asm volatile("s_waitcnt lgkmcnt(0)\n\ts_barrier" ::: "memory");
#undef PKW
#undef PAF
#undef VFR
#undef PIN
#undef MX3
#undef GAPA
#undef GAPB
#undef EX
#undef VRD
#undef KRD
#undef STEP
#undef ENDW
#undef DMA_K
#undef DMA_V
#undef CMASK
#undef START
#undef RESC
#undef ROT
#undef HS_CODE
#undef HS_SRC
}
__device__ __forceinline__ void attn_unit(LAS unsigned char* lds, bf16_t* proj, const bf16_t* kcmp, const bf16_t* vcmp, int bh, int qb, int skipw) {
    int tid_ = threadIdx.x; asm volatile("" : "+v"(tid_));
    const int tid = tid_, lane = tid & 63, r = lane & 31, h = lane >> 5, wid = __builtin_amdgcn_readfirstlane(tid >> 6);
    const int b = bh >> 2, hk = bh & 3, g = wid >> 1, tq = (wid & 1) * 32 + r;
    const size_t row = (size_t)b * SEQ + (size_t)qb * 64 + tq;
    const int t = qb * 64 + tq;
    bf16_t* qp = proj + row * PP + C_Q + (hk * 4 + g) * 64;
    bf16x8 qreg[4];
#pragma unroll
    for (int d0 = 0; d0 < 4; ++d0) qreg[d0] = *(const bf16x8*)(qp + d0 * 16 + h * 8);
    const bf16x8* qr = qreg;
    float gate[3];
#pragma unroll
    for (int c = 0; c < 3; ++c) gate[c] = sigmoidf_(bf2f(proj[row * PP + C_GBR + c * 16 + hk * 4 + g]));
#ifdef GATE2X
    if (GATE2X & 1) gate[0] *= 2.f; if (GATE2X & 2) gate[1] *= 2.f; if (GATE2X & 4) gate[2] *= 2.f;
#endif
#ifdef GATEZ
    if (GATEZ & 1) gate[0] = 0.f; if (GATEZ & 2) gate[1] = 0.f; if (GATEZ & 4) gate[2] = 0.f;
#endif
    LAS float* wsf = (LAS float*)(lds + WSF) + wid * 32;
    LAS float* impw = (LAS float*)(lds + IMP) + (g * 64 + tq) * IMPW;
    const size_t krow = lane, kcol = wid * 8;
    const size_t vrow = 16 * (wid & 3) + (lane >> 2), vcol = 32 * (wid >> 2) + 8 * (lane & 3);
    LAS unsigned char* kst = lds + KB0 + wid * 1024 + lane * 16;
    LAS unsigned char* vst = lds + VB0 + wid * 1024 + lane * 16;
    u32x4 kreg, vreg;
    LAS float* osl = (LAS float*)(lds + IMP + wid * (32 * IMPW * 4)) + lane;
#define LDK(base, pitch) kreg = *(const u32x4*)((base) + krow * (size_t)(pitch) + kcol)
#define LDV(base, pitch) vreg = *(const u32x4*)((base) + vrow * (size_t)(pitch) + vcol)
#define STK(buf) *(LAS u32x4*)(kst + (buf) * 8192) = kreg
#define STV(buf) *(LAS u32x4*)(vst + (buf) * 8192) = vreg
#define KBUF(buf) (lds + KB0 + (buf) * 8192)
#define VBUF(buf) (lds + VB0 + (buf) * 8192)
#define ACCUM_OUT(scale_expr, FIRST) do { if (h == 0) wsf[r] = (scale_expr); \
        _Pragma("unroll") for (int i = 0; i < 16; ++i) { const float sc = wsf[crow(i, h)]; \
            if (FIRST) { osl[(i * 2) * 64] = st.o0[i] * sc; osl[(i * 2 + 1) * 64] = st.o1[i] * sc; } \
            else { osl[(i * 2) * 64] += st.o0[i] * sc; osl[(i * 2 + 1) * 64] += st.o1[i] * sc; } } } while (0)

    St st;
    const bf16_t* kc = kcmp + (size_t)bh * 256 * 64; const bf16_t* vc = vcmp + (size_t)bh * 256 * 64;
    const int nmax = (t >= 31) ? ((t - 31) >> 4) : -1;
    float carry = 0.f;
    float m1 = -1e30f, l1 = 0.f;
    LDK(kc, 64); STK(0); __syncthreads();
#pragma unroll 1
    for (int j = 0; j < 4; ++j) {
        if (j + 1 < 4) LDK(kc + (size_t)(j + 1) * 64 * 64, 64);
        { const int cnt = nmax - 64 * j + 1; const unsigned long long allow = cnt <= 0 ? 0ull : lowmask(cnt);
          tile_stats(m1, l1, KBUF(j & 1), qr, allow, r, h); }
        if (j + 1 < 4) STK((j + 1) & 1);
        __syncthreads();
    }
    l1 += __shfl_xor(l1, 32);
    const float invl = __builtin_amdgcn_rcpf(fmaxf(l1, 1e-30f));
#pragma unroll
    for (int i = 0; i < 16; ++i) { st.o0[i] = 0.f; st.o1[i] = 0.f; }
    LDK(kc, 64); LDV(vc, 64); STK(0); STV(0); __syncthreads();
#pragma unroll 1
    for (int j = 0; j < 4; ++j) {
        if (j + 1 < 4) { LDK(kc + (size_t)(j + 1) * 64 * 64, 64); LDV(vc + (size_t)(j + 1) * 64 * 64, 64); }
        { const int cnt = nmax - 64 * j + 1; const unsigned long long allow = cnt <= 0 ? 0ull : lowmask(cnt);
          tile_exact(st.o0, st.o1, m1, invl, KBUF(j & 1), VBUF(j & 1), qr, allow, impw, carry, j, lane, r, h); }
        if (j + 1 < 4) { STK((j + 1) & 1); STV((j + 1) & 1); }
        __syncthreads();
    }
    {
        unsigned long long wor = 0ull;
        const unsigned long long valid = lowmask(qb + 1);
        LAS const float* ib = (LAS const float*)(lds + IMP);
        unsigned key[8], T[8];
#pragma unroll
        for (int i = 0; i < 8; ++i) { const int q = wid * 8 + i;
            float v = ((ib[(0 * 64 + q) * IMPW + lane] + ib[(1 * 64 + q) * IMPW + lane]) + ib[(2 * 64 + q) * IMPW + lane]) + ib[(3 * 64 + q) * IMPW + lane];
            if (lane == 0 || lane == qb || lane == qb - 1) v = INFINITY;
            key[i] = (lane <= qb) ? __float_as_uint(fmaxf(v, 0.f)) : 0u; T[i] = 0u; }
#pragma unroll 1
        for (int bb = 30; bb >= 0; --bb) {
#pragma unroll
            for (int i = 0; i < 8; ++i) { const unsigned cand = T[i] | (1u << bb);
                const int c = __popcll(__ballot(key[i] >= cand) & valid); T[i] = (c >= 16) ? cand : T[i]; }
        }
#pragma unroll
        for (int i = 0; i < 8; ++i) { const int q = wid * 8 + i;
            const unsigned long long gt = __ballot(key[i] > T[i]) & valid, eq = __ballot(key[i] == T[i]) & valid;
            const int need = 16 - __popcll(gt);
            const bool pick = ((eq >> lane) & 1ull) && (__popcll(eq & lowmask(lane)) < need);
            const unsigned long long msk = gt | __ballot(pick);
            if (lane == 0) *(LAS unsigned long long*)(lds + SELM + q * 8) = msk;
            wor |= msk; }
        if (lane == 0) *(LAS unsigned long long*)(lds + WMASK + wid * 8) = wor;
    }
    __syncthreads();
    unsigned long long un = 0ull;
#pragma unroll
    for (int w = 0; w < 8; ++w) un |= *(LAS const unsigned long long*)(lds + WMASK + w * 8);
    { const unsigned ulo = __builtin_amdgcn_readfirstlane((unsigned)un), uhi = __builtin_amdgcn_readfirstlane((unsigned)(un >> 32)); un = ((unsigned long long)uhi << 32) | ulo; }
    ACCUM_OUT(gate[0], true);
    {
        LAS unsigned char* steps = lds + STEPS + wid * 128;
        const int nsel = __popcll(un), j0w = qb >= 8 ? qb - 8 : 0, nwin = qb - j0w + 1;
        const int NTs = nsel < 4 ? 4 : ((nsel + 1) & ~1), NTw = nwin < 4 ? 4 : ((nwin + 1) & ~1);
        if ((un >> lane) & 1ull) steps[__popcll(un & lowmask(lane))] = (unsigned char)lane;
        if (lane >= nsel && lane < NTs) steps[lane] = (unsigned char)0x7f;
        if (lane < NTw) steps[64 + lane] = (unsigned char)(lane < nwin ? (0x80 | (j0w + lane)) : 0x7f);
        const bf16_t* ksb = proj + (size_t)b * SEQ * PP + C_KS + hk * 64;
        char* shm = (char*)lds;
        f32x16 ob[2]; float lt;
        run_branch<8>(shm, qr, ksb, steps, NTs, qb, ob, lt, wid, lane);
        {
            int t2 = threadIdx.x; asm volatile("" : "+v"(t2));
            const int lane2 = t2 & 63, r2 = lane2 & 31, h2 = lane2 >> 5, wid2 = __builtin_amdgcn_readfirstlane(t2 >> 6), g2 = wid2 >> 1, tq2 = (wid2 & 1) * 32 + r2;
            LAS float* wsf2 = (LAS float*)(lds + WSF) + wid2 * 32; LAS float* osl2 = (LAS float*)(lds + IMP + wid2 * (32 * IMPW * 4)) + lane2;
            const float g1 = sigmoidf_(bf2f(proj[((size_t)b * SEQ + (size_t)qb * 64 + tq2) * PP + C_GBR + 1 * 16 + hk * 4 + g2]));
            if (h2 == 0) wsf2[r2] = g1 * __builtin_amdgcn_rcpf(fmaxf(lt, 1e-30f));
#pragma unroll
            for (int i = 0; i < 16; ++i) { const float sc = wsf2[crow(i, h2)]; osl2[(i * 2) * 64] += ob[0][i] * sc; osl2[(i * 2 + 1) * 64] += ob[1][i] * sc; }
        }
        {
            int t3 = threadIdx.x; asm volatile("" : "+v"(t3));
            run_branch<8>(shm, qr, ksb, steps + 64, NTw, qb, ob, lt, __builtin_amdgcn_readfirstlane(t3 >> 6), t3 & 63);
        }
        st.o0 = ob[0]; st.o1 = ob[1]; st.l = lt;
    }
    {
        int t2 = threadIdx.x; asm volatile("" : "+v"(t2));
        const int lane2 = t2 & 63, r2 = lane2 & 31, h2 = lane2 >> 5, wid2 = __builtin_amdgcn_readfirstlane(t2 >> 6), g2 = wid2 >> 1, tq2 = (wid2 & 1) * 32 + r2;
        LAS float* wsf2 = (LAS float*)(lds + WSF) + wid2 * 32; LAS float* osl2 = (LAS float*)(lds + IMP + wid2 * (32 * IMPW * 4)) + lane2;
        const float g3 = sigmoidf_(bf2f(proj[((size_t)b * SEQ + (size_t)qb * 64 + tq2) * PP + C_GBR + 2 * 16 + hk * 4 + g2]));
        if (h2 == 0) wsf2[r2] = g3 * __builtin_amdgcn_rcpf(fmaxf(st.l, 1e-30f));
        bf16_t* ob2 = proj + ((size_t)b * SEQ + (size_t)qb * 64 + (wid2 & 1) * 32) * PP + C_Q + (hk * 4 + g2) * 64;
        if (!skipw)
#pragma unroll
        for (int i = 0; i < 16; ++i) { const int q = crow(i, h2); const float sc = wsf2[q];
            const float f0 = osl2[(i * 2) * 64] + st.o0[i] * sc, f1 = osl2[(i * 2 + 1) * 64] + st.o1[i] * sc;
            ob2[(size_t)q * PP + r2] = (bf16_t)(pk2(f0, 0.f) & 0xffffu); ob2[(size_t)q * PP + 32 + r2] = (bf16_t)(pk2(f1, 0.f) & 0xffffu); }
    }
#undef LDK
#undef LDV
#undef STK
#undef STV
#undef KBUF
#undef VBUF
#undef ACCUM_OUT
}
}

__device__ __forceinline__ float wave_sum(float v) {
#pragma unroll
    for (int o = 1; o < 64; o <<= 1) v += __shfl_xor(v, o);
    return v;
}
__device__ __forceinline__ void transpose_item(const float* W, int K, int N, bf16_t* WT, int ldt, int k0, int n0, int drow0, const float* kscale, float cscale, LAS float* scr, int lane) {
#pragma unroll 8
    for (int i = 0; i < 32; ++i) { const int kk = 2 * i + (lane >> 5); const int n = n0 + (lane & 31);
        float v = (n < N) ? W[(size_t)(k0 + kk) * N + n] : 0.f;
        if (kscale) v *= kscale[k0 + kk];
        scr[kk * 33 + (lane & 31)] = v * cscale; }
    asm volatile("s_waitcnt lgkmcnt(0)" ::: "memory");
    const int c = lane & 7;
#pragma unroll
    for (int j = 0; j < 4; ++j) { const int n = (lane >> 3) + 8 * j; const LAS float* s = scr + (8 * c) * 33 + n;
        u32x4 o; o.x = pk2(s[0 * 33], s[1 * 33]); o.y = pk2(s[2 * 33], s[3 * 33]); o.z = pk2(s[4 * 33], s[5 * 33]); o.w = pk2(s[6 * 33], s[7 * 33]);
        *(u32x4*)(WT + (size_t)(drow0 + n) * ldt + k0 + 8 * c) = o; }
    asm volatile("s_waitcnt lgkmcnt(0)" ::: "memory");
}

#define XB_TMO      128
#define XB_XCNT(j)  (256  + 64 * (j))
#define XB_XSUB(j)  (1280 + 64 * (j))
#define XB_XGEN(j)  (2304 + 64 * (j))
#define XB_TOP      3328
#define XB_TOPGEN   3392
#define XCD_BAR_WORDS 3456
#define XB_SPIN_CAP (1u << 18)
__device__ __forceinline__ unsigned xb_ld(unsigned* p)              { return __hip_atomic_load(p, __ATOMIC_RELAXED, __HIP_MEMORY_SCOPE_AGENT); }
__device__ __forceinline__ unsigned xb_add(unsigned* p, unsigned v) { return __hip_atomic_fetch_add(p, v, __ATOMIC_RELAXED, __HIP_MEMORY_SCOPE_AGENT); }
__device__ __forceinline__ unsigned xb_xcc_id() { return (unsigned)__builtin_amdgcn_s_getreg((3 << 11) | 20) & 0xFu; }
#define XB_SPIN(cond, bar) do { unsigned _sp = 0; while (cond) { __builtin_amdgcn_s_sleep(1); \
    if ((++_sp & 255u) == 0u) { if (xb_ld(&(bar)[XB_TMO])) break; if (_sp > XB_SPIN_CAP) { atomicAdd(&(bar)[XB_TMO], 1u); break; } } } } while (0)
struct XcdBarrier { unsigned* bar; unsigned x; volatile LAS unsigned* st; };
__device__ __forceinline__ XcdBarrier xcd_barrier_post(unsigned* bar, volatile LAS unsigned* st) {
    XcdBarrier b; b.bar = bar; b.x = xb_xcc_id(); b.st = st;
    if (threadIdx.x == 0) (void)xb_add(&bar[XB_XCNT(b.x)], 1u);
    return b;
}
__device__ __forceinline__ void xcd_barrier_complete(unsigned* bar, unsigned x, unsigned& nloc, unsigned& nx) {
    const unsigned G = gridDim.x * gridDim.y * gridDim.z;
    unsigned sum, cnt, mine, sp = 0u;
    for (;;) {
        sum = 0u; cnt = 0u; mine = 0u;
#pragma unroll
        for (unsigned j = 0; j < 16; ++j) { const unsigned c = xb_ld(&bar[XB_XCNT(j)]); sum += c; cnt += (c > 0u) ? 1u : 0u; mine = (j == x) ? c : mine; }
        if (sum == G) break;
        __builtin_amdgcn_s_sleep(1);
        if ((++sp & 255u) == 0u) { if (xb_ld(&bar[XB_TMO])) break; if (sp > XB_SPIN_CAP) { atomicAdd(&bar[XB_TMO], 1u); break; } }
    }
    nloc = mine > 0u ? mine : 1u; nx = cnt > 0u ? cnt : 1u;
}
__device__ __forceinline__ void xcd_barrier(const XcdBarrier& b) {
    asm volatile("s_waitcnt vmcnt(0)" ::: "memory");
    __syncthreads();
    if (threadIdx.x == 0) {
        unsigned* bar = b.bar;
        __builtin_amdgcn_s_waitcnt(0);
        unsigned nloc = b.st[0], nx = b.st[1];
        if (nloc == 0u) { xcd_barrier_complete(bar, b.x, nloc, nx); b.st[0] = nloc; b.st[1] = nx; }
        const unsigned old = xb_add(&bar[XB_XSUB(b.x)], 1u);
        const unsigned gen = old / nloc;
        if (old + 1u == (gen + 1u) * nloc) {
            __builtin_amdgcn_fence(__ATOMIC_RELEASE, "agent");
            asm volatile("s_waitcnt vmcnt(0)" ::: "memory");
            const unsigned og = xb_add(&bar[XB_TOP], 1u);
            const unsigned tg = og / nx;
            if (og + 1u == (tg + 1u) * nx) xb_add(&bar[XB_TOPGEN], 1u);
            else XB_SPIN(xb_ld(&bar[XB_TOPGEN]) == tg, bar);
            __builtin_amdgcn_fence(__ATOMIC_ACQUIRE, "agent");
            xb_add(&bar[XB_XGEN(b.x)], 1u);
            asm volatile("s_waitcnt vmcnt(0)" ::: "memory");
        } else {
            XB_SPIN(xb_ld(&bar[XB_XGEN(b.x)]) == gen, bar);
            __builtin_amdgcn_fence(__ATOMIC_ACQUIRE, "agent");
            asm volatile("s_waitcnt vmcnt(0)" ::: "memory");
        }
    }
    __syncthreads();
}

struct Args {
    const float *x, *w_in, *conv_w, *w_conv_out, *pos_k, *w1_k, *w2_k, *pos_v, *w1_v, *w2_v, *w_attn_out, *w_o, *g_mix, *g_ffn, *w_gate, *w_up, *w_down, *g_final;
    float* out; unsigned char* ws; int probe; int pad;
};

__global__ void __launch_bounds__(512, 2) nsa_fwd(Args a) {
    extern __shared__ __attribute__((aligned(16))) unsigned char lds_raw[];
    LAS unsigned char* lds = (LAS unsigned char*)lds_raw;
    cg::grid_group grid = cg::this_grid();
    const int tid = threadIdx.x, lane = tid & 63, wave = __builtin_amdgcn_readfirstlane(tid >> 6);
    const int G = gridDim.x, bx = blockIdx.x;
    const int vcu = (G % 8 == 0) ? (bx % 8) * (G / 8) + bx / 8 : bx;
    unsigned char* ws = a.ws;
    volatile LAS unsigned* bst = (volatile LAS unsigned*)(lds + 143360);
    if (tid < 2) bst[tid] = 0u;
    __syncthreads();
    const XcdBarrier gbar = xcd_barrier_post((unsigned*)(ws + WS_BAR), bst);
#define SEAM() xcd_barrier(gbar)
    float* part1 = (float*)(ws + WS_PART1); float* part2 = (float*)(ws + WS_PART2); float* cbias = (float*)(ws + WS_BIAS);
    bf16_t* Win = (bf16_t*)(ws + WS_WIN); bf16_t* Wconv = (bf16_t*)(ws + WS_WCONV); bf16_t* Wattn = (bf16_t*)(ws + WS_WATTN); bf16_t* Wo = (bf16_t*)(ws + WS_WO);
    bf16_t* Wup = (bf16_t*)(ws + WS_WUP); bf16_t* Wdown = (bf16_t*)(ws + WS_WDOWN); bf16_t* W1 = (bf16_t*)(ws + WS_W1); bf16_t* W2 = (bf16_t*)(ws + WS_W2);
    bf16_t* hid = (bf16_t*)(ws + WS_HID); bf16_t* kcmp = (bf16_t*)(ws + WS_KCMP); bf16_t* proj = (bf16_t*)(ws + WS_PROJ);
    float* h1f = (float*)(ws + WS_H1F); bf16_t* h1b = (bf16_t*)(ws + WS_H1B); bf16_t* act = (bf16_t*)(ws + WS_ACT);
    bf16_t* nb = (bf16_t*)a.out; bf16_t* mix = (bf16_t*)a.out; bf16_t* bc = (bf16_t*)((unsigned char*)a.out + OUT_BC);

    {
        LAS float* scr = (LAS float*)(lds + wave * 16384);
        const int gw = vcu * 8 + wave, NGW = G * 8;
        constexpr int I_IN = 16 * 194, I_CONV = 8 * 32, I_ATT = 16 * 32, I_O = 16 * 32, I_G = 16 * 88, I_U = 16 * 88, I_D = 44 * 32, I_1 = 32 * 8, I_2 = 4 * 2;
        constexpr int NITEMS = I_IN + I_CONV + I_ATT + I_O + 2 * I_1 + 2 * I_2;
        for (int it = gw; it < NITEMS; it += NGW) {
            int q = it;
            if (q < I_IN) { const int kb = q / 194, nbk = q % 194, n0 = 32 * nbk; const float cs = (n0 >= C_Q && n0 < C_KC) ? QSCALE : 1.0f;
                transpose_item(a.w_in, 1024, INCOLS, Win, 1024, 64 * kb, n0, n0, a.g_mix, cs, scr, lane); continue; } q -= I_IN;
            if (q < I_CONV) { const int kb = q / 32, nbk = q % 32; transpose_item(a.w_conv_out, 512, 1024, Wconv, 512, 64 * kb, 32 * nbk, 32 * nbk, nullptr, 1.f, scr, lane); continue; } q -= I_CONV;
            if (q < I_ATT) { const int kb = q / 32, nbk = q % 32; transpose_item(a.w_attn_out, 1024, 1024, Wattn, 1024, 64 * kb, 32 * nbk, 32 * nbk, nullptr, 1.f, scr, lane); continue; } q -= I_ATT;
            if (q < I_O) { const int kb = q / 32, nbk = q % 32; transpose_item(a.w_o, 1024, 1024, Wo, 1024, 64 * kb, 32 * nbk, 32 * nbk, nullptr, 1.f, scr, lane); continue; } q -= I_O;
            if (q < I_1) { const int kb = q / 8, nbk = q % 8; transpose_item(a.w1_k, 2048, 256, W1, 2048, 64 * kb, 32 * nbk, 32 * nbk, nullptr, 1.f, scr, lane); continue; } q -= I_1;
            if (q < I_1) { const int kb = q / 8, nbk = q % 8; transpose_item(a.w1_v, 2048, 256, W1, 2048, 64 * kb, 32 * nbk, 256 + 32 * nbk, nullptr, 1.f, scr, lane); continue; } q -= I_1;
            if (q < I_2) { const int kb = q / 2, nbk = q % 2; transpose_item(a.w2_k, 256, 64, W2, 256, 64 * kb, 32 * nbk, 32 * nbk, nullptr, 1.f, scr, lane); continue; } q -= I_2;
            { const int kb = q / 2, nbk = q % 2; transpose_item(a.w2_v, 256, 64, W2, 256, 64 * kb, 32 * nbk, 256 + 32 * nbk, nullptr, 1.f, scr, lane); }
        }
        const int gt = vcu * 512 + tid, NGT = G * 512;
        for (int i = gt; i < 192 * 1024 / 8; i += NGT) *(u32x4*)(Win + (size_t)6208 * 1024 + (size_t)i * 8) = (u32x4){0u, 0u, 0u, 0u};
        for (int i = gt; i < 2 * 192 * 256 / 8; i += NGT) { const int half = i / (192 * 256 / 8), o = i % (192 * 256 / 8);
            *(u32x4*)(W2 + (size_t)(half * 256 + 64) * 256 + (size_t)o * 8) = (u32x4){0u, 0u, 0u, 0u}; }
        for (int m = gw; m < MTOK; m += NGW) {
            const f32x4* xr = (const f32x4*)(a.x + (size_t)m * DM) + lane; f32x4 v[4]; float s = 0.f;
#pragma unroll
            for (int j = 0; j < 4; ++j) { v[j] = xr[64 * j]; s += (v[j][0] * v[j][0] + v[j][1] * v[j][1]) + (v[j][2] * v[j][2] + v[j][3] * v[j][3]); }
            const float rstd = __builtin_amdgcn_rsqf(wave_sum(s) * (1.0f / DM) + EPS);
            u32x2* o8 = (u32x2*)(nb + (size_t)m * DM) + lane;
#pragma unroll
            for (int j = 0; j < 4; ++j) { u32x2 w; w.x = pk2(v[j][0] * rstd, v[j][1] * rstd); w.y = pk2(v[j][2] * rstd, v[j][3] * rstd); o8[64 * j] = w; }
        }
        if (bx < 2) {
            const float* pos = bx ? a.pos_v : a.pos_k; const float* w1 = bx ? a.w1_v : a.w1_k;
            const int j = tid & 255, part = tid >> 8; float s = 0.f;
            for (int k = part * 1024; k < part * 1024 + 1024; ++k) s += pos[k] * w1[(size_t)k * 256 + j];
            LAS float* red = (LAS float*)(lds + 8 * 16384);
            if (part == 1) red[j] = s;
            __syncthreads();
            if (part == 0) cbias[bx * 256 + j] = s + red[j];
        }
    }
    if (a.probe == 0x7fffffff) grid.sync();
    SEAM();
    {
        const int ncols1 = (G > 64) ? 6144 : PP;
        pg8::Gemm g{nb, Win, MTOK, ncols1, DM, DM, 128, 0}; pg8::StaticOrder S; S.init(MTOK, ncols1, G, bx);
        pg8::EpiProj E{proj, PP};
        pg8::gemm_phase(lds, g, S, E);
    }
    SEAM();
    {
        {
            pg8::Gemm g{proj + C_KC, W1, 4096, 512, 2048, 16 * PP, PP * 2, 1}; pg8::StaticOrder S; S.init(4096, 512, G, bx);
            pg8::EpiHid E{hid, cbias};
            pg8::gemm_phase(lds, g, S, E);
        }
        int wb = bx, wn = G; if (G > 64) { wb = bx - 32; wn = G - 32; }
        if (wb >= 0) {
            for (int it = wb * 512 + tid; it < MTOK * 64; it += wn * 512) {
                const int row = it >> 6, ch = (it & 63) * 8, t = row & (SEQ - 1);
                const bf16_t* pr = proj + (size_t)row * PP;
                float accv[8];
#pragma unroll
                for (int j = 0; j < 8; ++j) accv[j] = 0.f;
#pragma unroll
                for (int k = 0; k < 3; ++k) { const int dt = 2 - k;
                    if (t - dt >= 0) { const u32x4 cv = *(const u32x4*)(pr - (size_t)dt * PP + C_C + ch), hv = *(const u32x4*)(pr - (size_t)dt * PP + C_H + ch);
                        const f32x4 w0 = *(const f32x4*)(a.conv_w + k * 512 + ch), w1 = *(const f32x4*)(a.conv_w + k * 512 + ch + 4);
                        accv[0] += w0[0] * lo_bf(cv.x) * lo_bf(hv.x); accv[1] += w0[1] * hi_bf(cv.x) * hi_bf(hv.x); accv[2] += w0[2] * lo_bf(cv.y) * lo_bf(hv.y); accv[3] += w0[3] * hi_bf(cv.y) * hi_bf(hv.y);
                        accv[4] += w1[0] * lo_bf(cv.z) * lo_bf(hv.z); accv[5] += w1[1] * hi_bf(cv.z) * hi_bf(hv.z); accv[6] += w1[2] * lo_bf(cv.w) * lo_bf(hv.w); accv[7] += w1[3] * hi_bf(cv.w) * hi_bf(hv.w); } }
                const u32x4 bv = *(const u32x4*)(pr + C_B + ch);
                u32x4 o; o.x = pk2(accv[0] * lo_bf(bv.x), accv[1] * hi_bf(bv.x)); o.y = pk2(accv[2] * lo_bf(bv.y), accv[3] * hi_bf(bv.y));
                o.z = pk2(accv[4] * lo_bf(bv.z), accv[5] * hi_bf(bv.z)); o.w = pk2(accv[6] * lo_bf(bv.w), accv[7] * hi_bf(bv.w));
                *(u32x4*)(bc + (size_t)row * 512 + ch) = o;
            }
        }
        if (G > 64 && wb >= 0) {
            { pg8::Gemm g{nb, Win + (size_t)6144 * 1024, MTOK, 256, DM, DM, 128, 0}; pg8::StaticOrder S; S.init(MTOK, 256, wn, wb);
              pg8::EpiProj E{proj + 6144, PP}; pg8::gemm_phase(lds, g, S, E); }
            __syncthreads();
            LAS float* scr = (LAS float*)(lds + wave * 16384);
            constexpr int I_G = 16 * 88, I_U = 16 * 88, I_D = 44 * 32;
            for (int it = wb * 8 + wave; it < I_G + I_U + I_D; it += wn * 8) {
                int q = it;
                if (q < I_G) { const int kb = q / 88, nbk = q % 88, n0 = 32 * nbk; transpose_item(a.w_gate, 1024, DFF, Wup, 1024, 64 * kb, n0, (n0 / 128) * 256 + (n0 % 128), a.g_ffn, 1.f, scr, lane); continue; } q -= I_G;
                if (q < I_U) { const int kb = q / 88, nbk = q % 88, n0 = 32 * nbk; transpose_item(a.w_up, 1024, DFF, Wup, 1024, 64 * kb, n0, (n0 / 128) * 256 + 128 + (n0 % 128), a.g_ffn, 1.f, scr, lane); continue; } q -= I_U;
                { const int kb = q / 32, nbk = q % 32; transpose_item(a.w_down, DFF, 1024, Wdown, DFF, 64 * kb, 32 * nbk, 32 * nbk, nullptr, 1.f, scr, lane); }
            }
        }
    }
    {
        pg8::Gemm g{hid, W2, 4096, 512, 256, 256, 128, 2}; pg8::StaticOrder S; S.init(4096, 512, G, bx);
        pg8::EpiCmp E{kcmp};
        pg8::gemm_phase(lds, g, S, E);
    }
    SEAM();
    {
        for (int v = vcu; v < 256; v += G) {
            const int bh = v >> 4, s = v & 15;
#pragma unroll 1
            for (int i = 0; i < 4; ++i) { const int qb = (i == 0) ? 63 - s : (i == 1) ? 32 + s : (i == 2) ? 31 - s : s;
#if defined(PROBE_ATT2) || defined(PROBE_NOLD)
                att::attn_unit(lds, proj, kcmp, kcmp + 4096 * 64, bh, qb, a.probe);
#endif
                att::attn_unit(lds, proj, kcmp, kcmp + 4096 * 64, bh, qb, 0);
            }
        }
    }
    SEAM();
    {
        { pg8::Gemm g{bc, Wconv, MTOK, DM, 512, 512, 128, 0}; pg8::StaticOrder S; S.init(MTOK, DM, G, bx);
          pg8::EpiMix<0> E{mix, proj, C_GCONV}; pg8::gemm_phase(lds, g, S, E); }
        { pg8::Gemm g{proj + C_Q, Wattn, MTOK, DM, DM, PP, 128, 0}; pg8::StaticOrder S; S.init(MTOK, DM, G, bx);
          pg8::EpiMix<1> E{mix, proj, C_GATTN}; pg8::gemm_phase(lds, g, S, E); }
    }
    SEAM();
    {
        pg8::Gemm g{mix, Wo, MTOK, DM, DM, DM, 128, 0}; pg8::StaticOrder S; S.init(MTOK, DM, G, bx);
        pg8::EpiRes<1> E{a.x, h1f, h1b, part1}; pg8::gemm_phase(lds, g, S, E);
    }
    SEAM();
    {
        pg8::Gemm g{h1b, Wup, MTOK, 2 * DFF, DM, DM, 128, 0}; pg8::StaticOrder S; S.init(MTOK, 2 * DFF, G, bx);
        pg8::EpiUp E{act, part1}; pg8::gemm_phase(lds, g, S, E);
    }
    SEAM();
    if (G == 256) {
        pg8::Gemm g{act, Wdown, MTOK, DM, DFF, DFF, 128, 0}; pg8::StaticOrder S; S.init(MTOK, DM, G, bx);
        pg8::EpiFinal E{h1f, a.out, a.g_final, (unsigned*)part2, (unsigned*)(ws + WS_BAR) + 4096, (unsigned*)(ws + WS_BAR) + XB_TMO};
        pg8::gemm_phase(lds, g, S, E);
        return;
    }
    {
        pg8::Gemm g{act, Wdown, MTOK, DM, DFF, DFF, 128, 0}; pg8::StaticOrder S; S.init(MTOK, DM, G, bx);
        pg8::EpiRes<0> E{h1f, a.out, nullptr, part2}; pg8::gemm_phase(lds, g, S, E);
    }
    SEAM();
    {
        for (int it = bx * 512 + tid; it < MTOK * 256; it += G * 512) {
            const int row = it >> 8, c4 = (it & 255) * 4;
            const f32x4* pp = (const f32x4*)(part2 + (size_t)row * 16); float ss = 0.f;
#pragma unroll
            for (int j = 0; j < 4; ++j) { const f32x4 p = pp[j]; ss += (p[0] + p[1]) + (p[2] + p[3]); }
            const float r = __builtin_amdgcn_rsqf(ss * (1.0f / DM) + EPS);
            f32x4 v = *(f32x4*)(a.out + (size_t)row * DM + c4); const f32x4 gf = *(const f32x4*)(a.g_final + c4);
            v = v * r * gf; *(f32x4*)(a.out + (size_t)row * DM + c4) = v;
        }
    }
}

extern "C" void kernel_launch(void* const* d_in, const int* in_sizes, int n_in, void* d_out, int out_size, void* d_ws, size_t ws_size, hipStream_t stream) {
    static int grid = 0;
    if (grid == 0) {
        if (n_in != 18 || out_size != MTOK * DM || ws_size < WS_NEED) { fprintf(stderr, "kernel_launch: unexpected shapes (n_in %d out %d ws %zu)\n", n_in, out_size, ws_size); grid = -1; return; }
        int dev = 0, cus = 0, per_cu = 0;
        (void)hipGetDevice(&dev);
        (void)hipDeviceGetAttribute(&cus, hipDeviceAttributeMultiprocessorCount, dev);
        (void)hipFuncSetAttribute((const void*)nsa_fwd, hipFuncAttributeMaxDynamicSharedMemorySize, LDS_BYTES);
        (void)hipOccupancyMaxActiveBlocksPerMultiprocessor(&per_cu, (const void*)nsa_fwd, 512, LDS_BYTES);
        if (per_cu < 1) { fprintf(stderr, "kernel_launch: occupancy query says %d blocks/CU\n", per_cu); grid = -1; return; }
        grid = cus;
    }
    if (grid < 0) return;
    (void)hipMemsetAsync((unsigned char*)d_ws + WS_BAR, 0, 32768, stream);
    Args a{};
    a.x = (const float*)d_in[0]; a.w_in = (const float*)d_in[1]; a.conv_w = (const float*)d_in[2]; a.w_conv_out = (const float*)d_in[3];
    a.pos_k = (const float*)d_in[4]; a.w1_k = (const float*)d_in[5]; a.w2_k = (const float*)d_in[6];
    a.pos_v = (const float*)d_in[7]; a.w1_v = (const float*)d_in[8]; a.w2_v = (const float*)d_in[9];
    a.w_attn_out = (const float*)d_in[10]; a.w_o = (const float*)d_in[11]; a.g_mix = (const float*)d_in[12]; a.g_ffn = (const float*)d_in[13];
    a.w_gate = (const float*)d_in[14]; a.w_up = (const float*)d_in[15]; a.w_down = (const float*)d_in[16]; a.g_final = (const float*)d_in[17];
    a.out = (float*)d_out; a.ws = (unsigned char*)d_ws; a.probe = 1; a.pad = 0;
    void* args[] = {&a};
    hipError_t e = hipLaunchCooperativeKernel((void*)nsa_fwd, dim3(grid), dim3(512), args, LDS_BYTES, stream);
    if (e != hipSuccess) fprintf(stderr, "kernel_launch: cooperative launch failed: %s (grid %d)\n", hipGetErrorString(e), grid);
}
```

```cpp
#include <hip/hip_runtime.h>
#include <hip/hip_cooperative_groups.h>
#include <cstdio>
#include <cstdint>
namespace cg = cooperative_groups;

#define LAS __attribute__((address_space(3)))
typedef unsigned short bf16_t;
typedef short bf16x8 __attribute__((ext_vector_type(8)));
typedef short s16x4 __attribute__((ext_vector_type(4)));
typedef float f32x4 __attribute__((ext_vector_type(4)));
typedef float f32x16 __attribute__((ext_vector_type(16)));
typedef unsigned u32x4 __attribute__((ext_vector_type(4)));
typedef unsigned u32x2 __attribute__((ext_vector_type(2)));
typedef float f32x2_t __attribute__((ext_vector_type(2)));
typedef __bf16 bf16x2_t __attribute__((ext_vector_type(2)));

constexpr int MTOK = 16384, DM = 1024, SEQ = 4096, NB = 4;
constexpr int PP = 6400;
constexpr int INCOLS = 6192;
constexpr int C_B = 0, C_C = 512, C_H = 1024, C_Q = 1536, C_KC = 2560, C_VC = 2816, C_KS = 3072, C_VS = 3328, C_KW = 3584, C_VW = 3840,
              C_GBR = 4096, C_GCONV = 4144, C_GATTN = 5168;
constexpr int DFF = 2816;
constexpr float EPS = 1e-6f;
constexpr float LOG2E = 1.4426950408889634f;
constexpr float QSCALE = 0.125f * LOG2E;

constexpr size_t MiB = 1u << 20;
constexpr size_t WS_PART1 = 0;
constexpr size_t WS_PART2 = 1 * MiB;
constexpr size_t WS_BIAS = 2 * MiB;
constexpr size_t WS_BAR = 2 * MiB + 65536;
constexpr size_t WS_WIN = 3 * MiB;
constexpr size_t WS_WCONV = 16 * MiB;
constexpr size_t WS_WATTN = 17 * MiB;
constexpr size_t WS_WO = 19 * MiB;
constexpr size_t WS_WUP = 21 * MiB;
constexpr size_t WS_WDOWN = 32 * MiB;
constexpr size_t WS_W1 = 38 * MiB;
constexpr size_t WS_W2 = 40 * MiB;
constexpr size_t WS_HID = 41 * MiB;
constexpr size_t WS_KCMP = 45 * MiB;
constexpr size_t WS_PROJ = 46 * MiB;
constexpr size_t WS_H1F = 46 * MiB;
constexpr size_t WS_H1B = 110 * MiB;
constexpr size_t WS_ACT = 142 * MiB;
constexpr size_t WS_NEED = 246 * MiB;
constexpr size_t OUT_BC = 32 * MiB;

constexpr int LDS_BYTES = 147456;

__device__ __forceinline__ float bf2f(unsigned short v) { return __uint_as_float(((unsigned)v) << 16); }
__device__ __forceinline__ unsigned pk2(float lo, float hi) { f32x2_t v = {lo, hi}; bf16x2_t b = __builtin_convertvector(v, bf16x2_t); return __builtin_bit_cast(unsigned, b); }
__device__ __forceinline__ float ex2(float x) { return __builtin_amdgcn_exp2f(x); }
__device__ __forceinline__ float sigmoidf_(float x) { return __builtin_amdgcn_rcpf(1.0f + ex2(-x * LOG2E)); }
__device__ __forceinline__ float lo_bf(unsigned w) { return __uint_as_float(w << 16); }
__device__ __forceinline__ float hi_bf(unsigned w) { return __uint_as_float(w & 0xffff0000u); }

namespace pg8 {
constexpr int BM = 256, BK = 64, HALF = 128, HTB = HALF * BK * 2, STAGE_BYTES = 8 * HTB, NXCD = 8, WGM = 8;
__host__ __device__ __forceinline__ int lds_byte(int r, int c) { const int st = (r >> 4) * 2 + (c >> 5), rr = r & 15, cc = c & 31, ob = rr * 64 + cc * 2; return st * 1024 + (ob ^ (((ob >> 9) & 1) << 5)); }
__host__ __device__ __forceinline__ void stage_rc(int b, int& R, int& C) { const int st = b / 1024, sb = b % 1024, swz = sb ^ (((sb >> 9) & 1) << 5); R = (st >> 1) * 16 + swz / 64; C = (st & 1) * 32 + (swz % 64) / 2; }
__host__ __device__ __forceinline__ int perm32(int rho) { const int n = rho >> 4, i = rho & 15; return 8 * (i >> 2) + 4 * n + (i & 3); }

struct Unit { int pm, pn; };
struct Gemm { const bf16_t* A; const bf16_t* Bt; int M, N, K; int lda; int a_kstep; int amode; };

struct StaticOrder {
    int nM, nN, nwg, G, c;
    __host__ __device__ void init(int M, int N, int G_, int c_) { nM = M / BM; nN = N / BM; nwg = nM * nN; G = G_; c = c_; }
    __host__ __device__ bool next(int i, Unit& u) const {
        const long L = (long)i * G + c; if (L >= nwg) return false;
        int wgid = (int)L; { const int q = nwg / NXCD, r = nwg % NXCD, xcd = wgid % NXCD, off = wgid / NXCD; wgid = (xcd < r ? xcd * (q + 1) : r * (q + 1) + (xcd - r) * q) + off; }
        const int nig = WGM * nN, gid = wgid / nig, fm = gid * WGM, gsz = (nM - fm) < WGM ? (nM - fm) : WGM;
        u.pm = fm + ((wgid % nig) % gsz); u.pn = (wgid % nig) / gsz; return true;
    }
};

__device__ __forceinline__ const char* a_tile(const Gemm& g, const Unit& u) {
    if (g.amode == 1) return (const char*)g.A + ((size_t)(u.pm >> 2) * SEQ * PP + (size_t)u.pn * 256 + (size_t)(u.pm & 3) * 64) * 2;
    if (g.amode == 2) return (const char*)g.A + ((size_t)u.pn * 4096 * 256 + (size_t)u.pm * 256 * 256) * 2;
    return (const char*)g.A + (size_t)u.pm * 256 * (size_t)g.lda * 2;
}

template <class T, class = void> struct is_fused { static constexpr bool value = false; };
template <class T> struct is_fused<T, decltype((void)T::FUSED)> { static constexpr bool value = true; };
template <class Epi>
__device__ __forceinline__ void gemm_phase(LAS unsigned char* lds, const Gemm g, const StaticOrder& S, const Epi& E) {
#ifdef NO_GEMM
    return;
#endif
    int tid_ = threadIdx.x; asm volatile("" : "+v"(tid_));
    const int tid = tid_, wid = __builtin_amdgcn_readfirstlane(tid >> 6), lane = tid & 63, wr = wid >> 2, wc = wid & 3, fr = lane & 15, fq = lane >> 4;
    const int K = g.K, nt = K / BK;
    unsigned voffA[2], voffB[2];
#pragma unroll
    for (int i = 0; i < 2; ++i) { int R, C; stage_rc(tid * 16 + i * 8192, R, C); const int Rb = (R & ~31) + perm32(R & 31);
        voffA[i] = (unsigned)(R * g.lda + C) * 2u; voffB[i] = (unsigned)(Rb * K + C) * 2u; }
    const size_t kstepA = (size_t)g.a_kstep, kstepB = (size_t)(BK * 2);
    const size_t hstepA = (size_t)HALF * g.lda * 2, hstepB = (size_t)HALF * K * 2;
    const size_t tstepB = 2 * hstepB;
    const unsigned ldsw = (unsigned)wid * 1024u;
    const int aoff = lds_byte(wr * 64 + fr, fq * 8), boff = lds_byte(wc * 32 + fr, fq * 8);
#define PG8_SA(b, h) (((b) * 2 + (h)) * HTB)
#define PG8_SB(b, h) ((4 + (b) * 2 + (h)) * HTB)
#define PG8_STAGE(bufoff, gbase, voff) do { _Pragma("unroll") for (int _i = 0; _i < 2; ++_i) \
        __builtin_amdgcn_global_load_lds((const unsigned*)((const char*)(gbase) + (voff)[_i]), (LAS unsigned*)(lds + (bufoff) + ldsw + _i * 8192), 16, 0, 0); } while (0)
#define PG8_LDA(dst, b, h) do { _Pragma("unroll") for (int m = 0; m < 4; ++m) _Pragma("unroll") for (int k = 0; k < 2; ++k) dst[m][k] = *(const LAS bf16x8*)(lds + PG8_SA(b, h) + aoff + m * 2048 + k * 1024); } while (0)
#define PG8_LDB(dst, b, h) do { _Pragma("unroll") for (int n = 0; n < 2; ++n) _Pragma("unroll") for (int k = 0; k < 2; ++k) dst[n][k] = *(const LAS bf16x8*)(lds + PG8_SB(b, h) + boff + n * 2048 + k * 1024); } while (0)
#define PG8_MMA(ai, bj, At, Bt) do { __builtin_amdgcn_s_setprio(1); _Pragma("unroll") for (int m = 0; m < 4; ++m) _Pragma("unroll") for (int n = 0; n < 2; ++n) _Pragma("unroll") for (int k = 0; k < 2; ++k) \
        acc[ai][bj][m][n] = __builtin_amdgcn_mfma_f32_16x16x32_bf16(Bt[n][k], At[m][k], acc[ai][bj][m][n], 0, 0, 0); __builtin_amdgcn_s_setprio(0); } while (0)
#define PG8_WAIT_V(n) asm volatile("s_waitcnt vmcnt(" #n ")" ::: "memory")
#define PG8_WAIT_L(n) asm volatile("s_waitcnt lgkmcnt(" #n ")" ::: "memory")
#define PG8_BAR __builtin_amdgcn_s_barrier()
#define PG8_SCHED __builtin_amdgcn_sched_barrier(0)
    Unit cur, nxt; int ui = 0;
    if (!S.next(0, cur)) return;
    f32x4 acc[2][2][4][2];
#pragma unroll
    for (int a = 0; a < 2; ++a)
#pragma unroll
        for (int b = 0; b < 2; ++b)
#pragma unroll
            for (int m = 0; m < 4; ++m)
#pragma unroll
                for (int n = 0; n < 2; ++n) acc[a][b][m][n] = (f32x4){0.f, 0.f, 0.f, 0.f};
    bf16x8 At[4][2], B0[2][2], B1[2][2];
    const char* cA = a_tile(g, cur); const char* cB = (const char*)g.Bt + (size_t)cur.pn * tstepB;
    PG8_STAGE(PG8_SB(0, 0), cB, voffB); PG8_STAGE(PG8_SB(0, 1), cB + hstepB, voffB); PG8_STAGE(PG8_SA(0, 0), cA, voffA); PG8_STAGE(PG8_SA(0, 1), cA + hstepA, voffA);
    if (wr == 1) PG8_BAR;
    PG8_WAIT_V(2); PG8_BAR;
    PG8_STAGE(PG8_SB(1, 0), cB + kstepB, voffB); PG8_STAGE(PG8_SA(1, 0), cA + kstepA, voffA); PG8_STAGE(PG8_SB(1, 1), cB + hstepB + kstepB, voffB);
    PG8_WAIT_V(6); PG8_BAR;
    for (;;) {
        const bool has_next = S.next(ui + 1, nxt);
        const char* nA = has_next ? a_tile(g, nxt) : cA; const char* nB = has_next ? (const char*)g.Bt + (size_t)nxt.pn * tstepB : cB;
        for (int t = 0; t < nt; t += 2) {
            const bool last = (t == nt - 2);
            const char* a1 = cA + (size_t)(t + 1) * kstepA;
            const char* a2 = last ? nA : cA + (size_t)(t + 2) * kstepA; const char* b2 = last ? nB : cB + (size_t)(t + 2) * kstepB;
            const char* a3 = a2 + kstepA; const char* b3 = b2 + kstepB;
            PG8_LDB(B0, 0, 0); PG8_LDB(B1, 0, 1); PG8_SCHED; PG8_LDA(At, 0, 0); PG8_STAGE(PG8_SA(1, 1), a1 + hstepA, voffA);
            PG8_WAIT_V(8); PG8_WAIT_L(0); PG8_BAR; PG8_MMA(0, 0, At, B0); PG8_MMA(0, 1, At, B1); PG8_BAR; PG8_SCHED;
            PG8_LDA(At, 0, 1); PG8_STAGE(PG8_SB(0, 0), b2, voffB); PG8_STAGE(PG8_SB(0, 1), b2 + hstepB, voffB); PG8_STAGE(PG8_SA(0, 0), a2, voffA);
            PG8_WAIT_V(8); PG8_WAIT_L(0); PG8_BAR; PG8_MMA(1, 0, At, B0); PG8_MMA(1, 1, At, B1); PG8_BAR; PG8_SCHED;
            PG8_LDB(B0, 1, 0); PG8_LDB(B1, 1, 1); PG8_SCHED; PG8_LDA(At, 1, 0); PG8_STAGE(PG8_SA(0, 1), a2 + hstepA, voffA);
            PG8_WAIT_V(8); PG8_WAIT_L(0); PG8_BAR; PG8_MMA(0, 0, At, B0); PG8_MMA(0, 1, At, B1); PG8_BAR; PG8_SCHED;
            PG8_LDA(At, 1, 1); PG8_STAGE(PG8_SB(1, 0), b3, voffB); PG8_STAGE(PG8_SB(1, 1), b3 + hstepB, voffB); PG8_STAGE(PG8_SA(1, 0), a3, voffA);
            PG8_WAIT_V(8); PG8_WAIT_L(0); PG8_BAR; PG8_MMA(1, 0, At, B0); PG8_MMA(1, 1, At, B1); PG8_BAR; PG8_SCHED;
        }
        if (wr == 0) PG8_BAR;
        if constexpr (!is_fused<Epi>::value) E(acc, cur, wr, wc, fr, fq);
        if (!has_next) break;
#pragma unroll
        for (int a = 0; a < 2; ++a)
#pragma unroll
            for (int b = 0; b < 2; ++b)
#pragma unroll
                for (int m = 0; m < 4; ++m)
#pragma unroll
                    for (int n = 0; n < 2; ++n) acc[a][b][m][n] = (f32x4){0.f, 0.f, 0.f, 0.f};
        cur = nxt; cA = nA; cB = nB; ++ui;
        if (wr == 1) PG8_BAR;
    }
    PG8_WAIT_V(0);
    PG8_BAR;
    if constexpr (is_fused<Epi>::value) E.fused(acc, cur, wr, wc, fr, fq, lds, wid, lane);
#undef PG8_SA
#undef PG8_SB
#undef PG8_STAGE
#undef PG8_LDA
#undef PG8_LDB
#undef PG8_MMA
#undef PG8_WAIT_V
#undef PG8_WAIT_L
#undef PG8_BAR
#undef PG8_SCHED
}

typedef f32x4 Acc[2][2][4][2];
#define EPI_LOOP_BEGIN \
    _Pragma("unroll") for (int ai = 0; ai < 2; ++ai) _Pragma("unroll") for (int m = 0; m < 4; ++m) { const int row = u.pm * BM + wr * 64 + fr + ai * HALF + m * 16; \
    _Pragma("unroll") for (int bj = 0; bj < 2; ++bj) { const f32x4 v0 = acc[ai][bj][m][0], v1 = acc[ai][bj][m][1]; const int col = u.pn * BM + bj * HALF + wc * 32 + 8 * fq;
#define EPI_LOOP_END } }
__device__ __forceinline__ u32x4 pack8(const f32x4 a, const f32x4 b) { u32x4 w; w.x = pk2(a[0], a[1]); w.y = pk2(a[2], a[3]); w.z = pk2(b[0], b[1]); w.w = pk2(b[2], b[3]); return w; }

struct EpiProj { bf16_t* O; int ldc;
    __device__ __forceinline__ void operator()(const Acc& acc, const Unit& u, int wr, int wc, int fr, int fq) const {
        EPI_LOOP_BEGIN
            *(u32x4*)(O + (size_t)row * ldc + col) = pack8(v0, v1);
        EPI_LOOP_END
    } };
__device__ __forceinline__ float gelu_tanh(float x) {
    const float z = x * (1.0f + 0.044715f * x * x) * (2.0f * 0.7978845608028654f * LOG2E);
    return x * __builtin_amdgcn_rcpf(1.0f + ex2(-z));
}
struct EpiHid { bf16_t* O; const float* bias;
    __device__ __forceinline__ void operator()(const Acc& acc, const Unit& u, int wr, int wc, int fr, int fq) const {
        EPI_LOOP_BEGIN
            const int c = col - u.pn * BM; const float* bp = bias + u.pn * 256 + c;
            const f32x4 b0 = *(const f32x4*)bp, b1 = *(const f32x4*)(bp + 4);
            f32x4 a = v0 + b0, b = v1 + b1;
#pragma unroll
            for (int j = 0; j < 4; ++j) { a[j] = gelu_tanh(a[j]); b[j] = gelu_tanh(b[j]); }
            *(u32x4*)(O + (size_t)u.pn * 4096 * 256 + (size_t)row * 256 + c) = pack8(a, b);
        EPI_LOOP_END
    } };
struct EpiCmp { bf16_t* O;
    __device__ __forceinline__ void operator()(const Acc& acc, const Unit& u, int wr, int wc, int fr, int fq) const {
        EPI_LOOP_BEGIN
            const int c = col - u.pn * BM;
            if (c < 64) { u32x4 w = pack8(v0, v1); if ((row & 255) == 255) w = (u32x4){0u, 0u, 0u, 0u};
                *(u32x4*)(O + (size_t)u.pn * 4096 * 64 + (size_t)row * 64 + c) = w; }
        EPI_LOOP_END
    } };
template <int ADD> struct EpiMix { bf16_t* mix; const bf16_t* proj; int gcol;
    __device__ __forceinline__ void operator()(const Acc& acc, const Unit& u, int wr, int wc, int fr, int fq) const {
        EPI_LOOP_BEGIN
            const u32x4 gv = *(const u32x4*)(proj + (size_t)row * PP + gcol + col);
            f32x4 a, b;
            a[0] = sigmoidf_(lo_bf(gv.x)) * v0[0]; a[1] = sigmoidf_(hi_bf(gv.x)) * v0[1]; a[2] = sigmoidf_(lo_bf(gv.y)) * v0[2]; a[3] = sigmoidf_(hi_bf(gv.y)) * v0[3];
            b[0] = sigmoidf_(lo_bf(gv.z)) * v1[0]; b[1] = sigmoidf_(hi_bf(gv.z)) * v1[1]; b[2] = sigmoidf_(lo_bf(gv.w)) * v1[2]; b[3] = sigmoidf_(hi_bf(gv.w)) * v1[3];
            bf16_t* mp = mix + (size_t)row * DM + col;
            if (ADD) { const u32x4 pv = *(const u32x4*)mp;
                a[0] += lo_bf(pv.x); a[1] += hi_bf(pv.x); a[2] += lo_bf(pv.y); a[3] += hi_bf(pv.y); b[0] += lo_bf(pv.z); b[1] += hi_bf(pv.z); b[2] += lo_bf(pv.w); b[3] += hi_bf(pv.w); }
            *(u32x4*)mp = pack8(a, b);
        EPI_LOOP_END
    } };
template <int WB> struct EpiRes { const float* base; float* hf; bf16_t* hb; float* part;
    __device__ __forceinline__ void operator()(const Acc& acc, const Unit& u, int wr, int wc, int fr, int fq) const {
#pragma unroll
        for (int ai = 0; ai < 2; ++ai)
#pragma unroll
            for (int m = 0; m < 4; ++m) { const int row = u.pm * BM + wr * 64 + fr + ai * HALF + m * 16; float ss = 0.f;
#pragma unroll
                for (int bj = 0; bj < 2; ++bj) { const int col = u.pn * BM + bj * HALF + wc * 32 + 8 * fq; const size_t off = (size_t)row * DM + col;
                    const f32x4 x0 = *(const f32x4*)(base + off), x1 = *(const f32x4*)(base + off + 4);
                    const f32x4 a = x0 + acc[ai][bj][m][0], b = x1 + acc[ai][bj][m][1];
                    *(f32x4*)(hf + off) = a; *(f32x4*)(hf + off + 4) = b;
                    if (WB) *(u32x4*)(hb + off) = pack8(a, b);
                    ss += (a[0] * a[0] + a[1] * a[1]) + (a[2] * a[2] + a[3] * a[3]) + (b[0] * b[0] + b[1] * b[1]) + (b[2] * b[2] + b[3] * b[3]); }
                ss += __shfl_xor(ss, 16); ss += __shfl_xor(ss, 32);
                if (fq == 0) part[(size_t)row * 16 + u.pn * 4 + wc] = ss; }
    } };
struct EpiUp { bf16_t* act; const float* part;
    __device__ __forceinline__ void operator()(const Acc& acc, const Unit& u, int wr, int wc, int fr, int fq) const {
#pragma unroll
        for (int ai = 0; ai < 2; ++ai)
#pragma unroll
            for (int m = 0; m < 4; ++m) { const int row = u.pm * BM + wr * 64 + fr + ai * HALF + m * 16;
                const f32x4 pp = *(const f32x4*)(part + (size_t)row * 16 + 4 * fq); float ss = (pp[0] + pp[1]) + (pp[2] + pp[3]);
                ss += __shfl_xor(ss, 16); ss += __shfl_xor(ss, 32);
                const float r = __builtin_amdgcn_rsqf(ss * (1.0f / DM) + EPS);
                f32x4 a, b;
#pragma unroll
                for (int j = 0; j < 4; ++j) { const float g0 = acc[ai][0][m][0][j] * r, u0 = acc[ai][1][m][0][j] * r, g1 = acc[ai][0][m][1][j] * r, u1 = acc[ai][1][m][1][j] * r;
                    a[j] = g0 * sigmoidf_(g0) * u0; b[j] = g1 * sigmoidf_(g1) * u1; }
                *(u32x4*)(act + (size_t)row * DFF + u.pn * 128 + wc * 32 + 8 * fq) = pack8(a, b); }
    } };
struct EpiFinal { static constexpr bool FUSED = true;
    const float* base; float* out; const float* gfin; unsigned* xbuf; unsigned* cnt; unsigned* tmo;
    __device__ __forceinline__ void operator()(const Acc&, const Unit&, int, int, int, int) const {}
    __device__ __forceinline__ void fused(f32x4 (&acc)[2][2][4][2], const Unit& u, int wr, int wc, int fr, int fq, LAS unsigned char* lds, int wid, int lane) const {
        LAS float* P = (LAS float*)lds;
        LAS float* S = (LAS float*)(lds + 8192);
        LAS unsigned* flag = (LAS unsigned*)(lds + 8192 + 2048);
#pragma unroll
        for (int ai = 0; ai < 2; ++ai)
#pragma unroll
            for (int m = 0; m < 4; ++m) { const int rl = ai * HALF + wr * 64 + m * 16 + fr; const int row = u.pm * BM + rl; float ss = 0.f;
#pragma unroll
                for (int bj = 0; bj < 2; ++bj) { const int col = u.pn * BM + bj * HALF + wc * 32 + 8 * fq; const size_t off = (size_t)row * DM + col;
                    const f32x4 x0 = *(const f32x4*)(base + off), x1 = *(const f32x4*)(base + off + 4);
                    const f32x4 a = x0 + acc[ai][bj][m][0], b = x1 + acc[ai][bj][m][1]; acc[ai][bj][m][0] = a; acc[ai][bj][m][1] = b;
                    ss += (a[0] * a[0] + a[1] * a[1]) + (a[2] * a[2] + a[3] * a[3]) + (b[0] * b[0] + b[1] * b[1]) + (b[2] * b[2] + b[3] * b[3]); }
                ss += __shfl_xor(ss, 16); ss += __shfl_xor(ss, 32);
                if (fq == 0) P[rl * 4 + wc] = ss; }
        asm volatile("s_waitcnt lgkmcnt(0)" ::: "memory"); __builtin_amdgcn_s_barrier(); asm volatile("" ::: "memory");
        const int rl = wid * 32 + (lane & 31);
        if (lane < 32) { const float tot = (P[rl * 4 + 0] + P[rl * 4 + 1]) + (P[rl * 4 + 2] + P[rl * 4 + 3]);
            __hip_atomic_store(xbuf + ((size_t)(u.pm * BM + rl) * 4 + u.pn), __float_as_uint(tot), __ATOMIC_RELAXED, __HIP_MEMORY_SCOPE_AGENT); }
        asm volatile("s_waitcnt vmcnt(0)" ::: "memory");
        if (lane == 0) __hip_atomic_fetch_add(cnt + 64 * u.pm, 1u, __ATOMIC_RELAXED, __HIP_MEMORY_SCOPE_AGENT);
        if (wid == 0) {
            unsigned sp = 0u;
            for (;;) {
                if ((unsigned)__builtin_amdgcn_readfirstlane(__hip_atomic_load(cnt + 64 * u.pm, __ATOMIC_RELAXED, __HIP_MEMORY_SCOPE_AGENT)) >= 32u) break;
                __builtin_amdgcn_s_sleep(2);
                if (++sp > (1u << 20)) { if (lane == 0) __hip_atomic_store(tmo, 1u, __ATOMIC_RELAXED, __HIP_MEMORY_SCOPE_AGENT); break; }
            }
            __builtin_amdgcn_fence(__ATOMIC_ACQUIRE, "agent");
            if (lane == 0) flag[0] = 1u;
        }
        asm volatile("s_waitcnt vmcnt(0) lgkmcnt(0)" ::: "memory"); __builtin_amdgcn_s_barrier(); asm volatile("" ::: "memory");
        if (lane < 32) { const unsigned* sl = xbuf + (size_t)(u.pm * BM + rl) * 4; float tot = 0.f;
#pragma unroll
            for (int t = 0; t < 4; ++t) tot += __uint_as_float(__hip_atomic_load(sl + t, __ATOMIC_RELAXED, __HIP_MEMORY_SCOPE_AGENT));
            S[rl] = __builtin_amdgcn_rsqf(tot * (1.0f / DM) + EPS); }
        asm volatile("s_waitcnt lgkmcnt(0)" ::: "memory"); __builtin_amdgcn_s_barrier(); asm volatile("" ::: "memory");
#pragma unroll
        for (int bj = 0; bj < 2; ++bj) { const int col = u.pn * BM + bj * HALF + wc * 32 + 8 * fq;
            const f32x4 g0 = *(const f32x4*)(gfin + col), g1 = *(const f32x4*)(gfin + col + 4);
#pragma unroll
            for (int ai = 0; ai < 2; ++ai)
#pragma unroll
                for (int m = 0; m < 4; ++m) { const int rl2 = ai * HALF + wr * 64 + m * 16 + fr; const float rs = S[rl2]; const size_t off = (size_t)(u.pm * BM + rl2) * DM + col;
                    *(f32x4*)(out + off) = acc[ai][bj][m][0] * rs * g0; *(f32x4*)(out + off + 4) = acc[ai][bj][m][1] * rs * g1; } }
    } };
}

namespace att {
constexpr int KB0 = 0, VB0 = 24576, IMP = 49152, IMPW = 65, SELM = IMP + 4 * 64 * IMPW * 4, WMASK = SELM + 512, WSF = WMASK + 64, STEPS = WSF + 8 * 32 * 4, ATT_LDS = STEPS + 8 * 128;
static_assert(ATT_LDS <= 143360, "attention LDS");
#define MFMA32(a, b, c) __builtin_amdgcn_mfma_f32_32x32x16_bf16((a), (b), (c), 0, 0, 0)
__device__ __forceinline__ int crow(int r, int hi) { return (r & 3) + 8 * (r >> 2) + 4 * hi; }
typedef short v4i16_t __attribute__((ext_vector_type(4)));
__device__ __forceinline__ s16x4 vtr(LAS const unsigned char* p) { return __builtin_bit_cast(s16x4, __builtin_amdgcn_ds_read_tr16_b64_v4i16((LAS v4i16_t*)p)); }

struct St { float m, l; f32x16 o0, o1; };

__device__ __forceinline__ void qk_tile(f32x16& p0, f32x16& p1, LAS const unsigned char* kb, const bf16x8* qf, int r, int h) {
    bf16x8 k0[4], k1[4], qv[4];
#pragma unroll
    for (int d0 = 0; d0 < 4; ++d0) { k0[d0] = *(const LAS bf16x8*)(kb + (2 * d0 + h) * 1024 + r * 16); k1[d0] = *(const LAS bf16x8*)(kb + (2 * d0 + h) * 1024 + 512 + r * 16);
        qv[d0] = qf[d0]; }
#pragma unroll
    for (int i = 0; i < 16; ++i) { p0[i] = 0.f; p1[i] = 0.f; }
    __builtin_amdgcn_sched_barrier(0);
#pragma unroll
    for (int d0 = 0; d0 < 4; ++d0) { p0 = MFMA32(k0[d0], qv[d0], p0); p1 = MFMA32(k1[d0], qv[d0], p1); }
}
__device__ __forceinline__ void apply_mask(f32x16& p0, f32x16& p1, unsigned long long allow, int h) {
    if (__all(allow == ~0ull)) return;
    const unsigned long long a = allow >> (4 * h); const unsigned lo = (unsigned)a, hi = (unsigned)(a >> 32);
#pragma unroll
    for (int i = 0; i < 16; ++i) { const int cb = (i & 3) + 8 * (i >> 2);
        p0[i] = ((lo >> cb) & 1u) ? p0[i] : -INFINITY; p1[i] = ((hi >> cb) & 1u) ? p1[i] : -INFINITY; }
}
__device__ __forceinline__ float rowmax32(const f32x16& p0, const f32x16& p1) {
    float a = fmaxf(p0[0], p1[0]);
#pragma unroll
    for (int i = 1; i < 16; ++i) a = fmaxf(a, fmaxf(p0[i], p1[i]));
    return fmaxf(a, __shfl_xor(a, 32));
}
__device__ __forceinline__ void pv_tile(f32x16& o0, f32x16& o1, LAS const unsigned char* vb, const f32x16& p0, const f32x16& p1, int lane, int h) {
    bf16x8 pa[4];
#pragma unroll
    for (int s = 0; s < 4; ++s) { u32x4 w;
#pragma unroll
        for (int j = 0; j < 4; ++j) { const int i0 = 8 * (s & 1) + 2 * j; w[j] = (s < 2) ? pk2(p0[i0], p0[i0 + 1]) : pk2(p1[i0], p1[i0 + 1]); }
        pa[s] = __builtin_bit_cast(bf16x8, w); }
    LAS const unsigned char* vp = vb + ((lane >> 4) & 1) * 32 + (lane & 3) * 8 + (4 * h + ((lane & 15) >> 2)) * 64;
    s16x4 l0[4], h0[4], l1[4], h1[4];
#pragma unroll
    for (int s = 0; s < 4; ++s) { l0[s] = vtr(vp + s * 1024); h0[s] = vtr(vp + s * 1024 + 512); l1[s] = vtr(vp + 4096 + s * 1024); h1[s] = vtr(vp + 4096 + s * 1024 + 512); }
    __builtin_amdgcn_sched_barrier(0);
#pragma unroll
    for (int s = 0; s < 4; ++s) {
        const bf16x8 v0 = (bf16x8){l0[s][0], l0[s][1], l0[s][2], l0[s][3], h0[s][0], h0[s][1], h0[s][2], h0[s][3]};
        const bf16x8 v1 = (bf16x8){l1[s][0], l1[s][1], l1[s][2], l1[s][3], h1[s][0], h1[s][1], h1[s][2], h1[s][3]};
        o0 = MFMA32(pa[s], v0, o0); o1 = MFMA32(pa[s], v1, o1);
    }
}
__device__ __forceinline__ void tile_online(St& st, LAS const unsigned char* kb, LAS const unsigned char* vb, const bf16x8* qr, unsigned long long allow,
                                            LAS float* wsf, int lane, int r, int h) {
    f32x16 p0, p1; qk_tile(p0, p1, kb, qr, r, h); __builtin_amdgcn_sched_barrier(0); apply_mask(p0, p1, allow, h);
    const float rm = rowmax32(p0, p1), mnew = fmaxf(st.m, rm), f = ex2(st.m - mnew); st.m = mnew;
    float ls = 0.f;
#pragma unroll
    for (int i = 0; i < 16; ++i) { p0[i] = ex2(p0[i] - mnew); p1[i] = ex2(p1[i] - mnew); ls += p0[i] + p1[i]; }
    st.l = st.l * f + ls;
    if (__any(f != 1.0f)) {
        if (h == 0) wsf[r] = f;
#pragma unroll
        for (int i = 0; i < 16; ++i) { const float fi = wsf[crow(i, h)]; st.o0[i] *= fi; st.o1[i] *= fi; }
    }
    pv_tile(st.o0, st.o1, vb, p0, p1, lane, h);
}
__device__ __forceinline__ void tile_stats(float& m, float& l, LAS const unsigned char* kb, const bf16x8* qr, unsigned long long allow, int r, int h) {
    f32x16 p0, p1; qk_tile(p0, p1, kb, qr, r, h); __builtin_amdgcn_sched_barrier(0); apply_mask(p0, p1, allow, h);
    const float rm = rowmax32(p0, p1), mnew = fmaxf(m, rm), f = ex2(m - mnew); m = mnew;
    float ls = 0.f;
#pragma unroll
    for (int i = 0; i < 16; ++i) ls += ex2(p0[i] - mnew) + ex2(p1[i] - mnew);
    l = l * f + ls;
}
__device__ __forceinline__ void tile_exact(f32x16& o0, f32x16& o1, float m, float invl, LAS const unsigned char* kb, LAS const unsigned char* vb, const bf16x8* qr,
                                           unsigned long long allow, LAS float* impw  , float& carry, int j, int lane, int r, int h) {
    f32x16 p0, p1; qk_tile(p0, p1, kb, qr, r, h); __builtin_amdgcn_sched_barrier(0); apply_mask(p0, p1, allow, h);
#pragma unroll
    for (int i = 0; i < 16; ++i) { p0[i] = ex2(p0[i] - m) * invl; p1[i] = ex2(p1[i] - m) * invl; }
#pragma unroll
    for (int pos = 0; pos < 8; ++pos) {
        const int half = pos >> 2, r4 = pos & 3;
        const float P0 = half ? p1[4 * r4] : p0[4 * r4], P1 = half ? p1[4 * r4 + 1] : p0[4 * r4 + 1], P2 = half ? p1[4 * r4 + 2] : p0[4 * r4 + 2], P3 = half ? p1[4 * r4 + 3] : p0[4 * r4 + 3];
        const float a = (P0 + P1) + (P2 + 0.5f * P3), b = 0.5f * P3;
        const float bx = __shfl_xor(b, 32);
        const float add = h ? bx : carry;
        impw[16 * j + 2 * pos + h] = a + add;
        carry = bx;
    }
    pv_tile(o0, o1, vb, p0, p1, lane, h);
}

__device__ __forceinline__ void qk_tile_c(f32x16& p0, f32x16& p1, LAS const unsigned char* kb, const bf16x8* qf, const f32x16& c, int r, int h) {
    bf16x8 k0[4], k1[4], qv[4];
#pragma unroll
    for (int d0 = 0; d0 < 4; ++d0) { k0[d0] = *(const LAS bf16x8*)(kb + (2 * d0 + h) * 1024 + r * 16); k1[d0] = *(const LAS bf16x8*)(kb + (2 * d0 + h) * 1024 + 512 + r * 16);
        qv[d0] = qf[d0]; }
    __builtin_amdgcn_sched_barrier(0);
    p0 = MFMA32(k0[0], qv[0], c); p1 = MFMA32(k1[0], qv[0], c);
#pragma unroll
    for (int d0 = 1; d0 < 4; ++d0) { p0 = MFMA32(k0[d0], qv[d0], p0); p1 = MFMA32(k1[d0], qv[d0], p1); }
}
__device__ __forceinline__ unsigned long long lowmask(int n);
__device__ __forceinline__ void soft_pv(St& st, f32x16& x0, f32x16& x1, float cx, LAS const unsigned char* vb, bool first, int kind, int tq,
                                        LAS float* wsf, int lane, int r, int h) {
    if (first) st.m = cx;
    else { const float d = st.m - cx;
        if (__any(d != 0.f)) {
#pragma unroll
            for (int i = 0; i < 16; ++i) { x0[i] -= d; x1[i] -= d; } } }
    if (kind) apply_mask(x0, x1, kind == 1 ? lowmask(tq + 1) : ~lowmask(tq + 1), h);
    const float rm = rowmax32(x0, x1);
    if (first) {
        const float dl = (rm > -INFINITY) ? rm : 0.f; st.m += dl;
#pragma unroll
        for (int i = 0; i < 16; ++i) { x0[i] -= dl; x1[i] -= dl; }
    } else if (__any(rm > 8.0f)) {
        const float dl = fmaxf(rm, 0.f), f = ex2(-dl); st.m += dl; st.l *= f;
        if (h == 0) wsf[r] = f;
#pragma unroll
        for (int i = 0; i < 16; ++i) { x0[i] -= dl; x1[i] -= dl; }
#pragma unroll
        for (int i = 0; i < 16; ++i) { const float fi = wsf[crow(i, h)]; st.o0[i] *= fi; st.o1[i] *= fi; }
    }
    float ls = 0.f;
#pragma unroll
    for (int i = 0; i < 16; ++i) { x0[i] = ex2(x0[i]); x1[i] = ex2(x1[i]); ls += x0[i] + x1[i]; }
    st.l += ls;
    pv_tile(st.o0, st.o1, vb, x0, x1, lane, h);
}
__device__ __forceinline__ unsigned long long lowmask(int n) { return n >= 64 ? ~0ull : ((1ull << n) - 1ull); }

typedef LAS const char* lds_cptr;
__device__ __forceinline__ void hs_glds16(const void* gsrc, unsigned lds_dst) { unsigned keep;
    asm volatile("s_mov_b32 %0, m0\n\ts_mov_b32 m0, %2\n\ts_nop 0\n\tglobal_load_lds_dwordx4 %1, off\n\ts_mov_b32 m0, %0" : "=&s"(keep) : "v"(gsrc), "s"(lds_dst) : "memory"); }
__device__ __forceinline__ float hs_max3f(float a, float b, float c) { float r; asm("v_max3_f32 %0, %1, %2, %3" : "=v"(r) : "v"(a), "v"(b), "v"(c)); return r; }
__device__ __forceinline__ float hs_max2f(float a, float b) { float r; asm("v_max_f32_e32 %0, %1, %2" : "=v"(r) : "v"(a), "v"(b)); return r; }
__device__ __forceinline__ float hs_fadd(float a, float b) { float r; asm("v_add_f32_e32 %0, %1, %2" : "=v"(r) : "v"(a), "v"(b)); return r; }
__device__ __forceinline__ float hs_fsub(float a, float b) { float r; asm("v_sub_f32_e32 %0, %1, %2" : "=v"(r) : "v"(a), "v"(b)); return r; }
#define HS_SBAR() __builtin_amdgcn_sched_barrier(0)
#define HS_WAIT_BAR(N) asm volatile("s_waitcnt vmcnt(" #N ") lgkmcnt(0)\n\ts_barrier" ::: "memory")
__device__ __forceinline__ void hs_qkt(f32x16& p0, f32x16& p1, const char* Kslot, const bf16x8* qr, const f32x16& negm, int r32, int hi) {
    const char* kb = Kslot + hi * 1024 + r32 * 16;
#pragma unroll
    for (int d0 = 0; d0 < 4; ++d0) {
        const bf16x8 b0 = *reinterpret_cast<const bf16x8*>(kb + d0 * 2048);
        const bf16x8 b1 = *reinterpret_cast<const bf16x8*>(kb + d0 * 2048 + 512);
        if (d0 == 0) { p0 = MFMA32(b0, qr[0], negm); p1 = MFMA32(b1, qr[0], negm); }
        else { p0 = MFMA32(b0, qr[d0], p0); p1 = MFMA32(b1, qr[d0], p1); } }
}
__device__ __forceinline__ void hs_kload8(bf16x8* kf, lds_cptr kp) {
    kf[0] = *(const LAS bf16x8*)(kp);        kf[1] = *(const LAS bf16x8*)(kp + 512);
    kf[2] = *(const LAS bf16x8*)(kp + 2048); kf[3] = *(const LAS bf16x8*)(kp + 2560);
    kf[4] = *(const LAS bf16x8*)(kp + 4096); kf[5] = *(const LAS bf16x8*)(kp + 4608);
    kf[6] = *(const LAS bf16x8*)(kp + 6144); kf[7] = *(const LAS bf16x8*)(kp + 6656);
}
__device__ __forceinline__ void hs_kload2(bf16x8* kf, lds_cptr kp, int j) { kf[2 * j] = *(const LAS bf16x8*)(kp + j * 2048); kf[2 * j + 1] = *(const LAS bf16x8*)(kp + j * 2048 + 512); }
__device__ __forceinline__ s16x4 hs_vtr(lds_cptr p) { return __builtin_bit_cast(s16x4, __builtin_amdgcn_ds_read_tr16_b64_v4i16((LAS v4i16_t*)p)); }
__device__ __forceinline__ float hs_rowmax(const f32x16& p0, const f32x16& p1) {
    float a = hs_max3f(p0[0], p0[1], p1[0]), b = hs_max3f(p0[2], p0[3], p1[1]); a = hs_max3f(a, p1[2], p1[3]);
#pragma unroll
    for (int r = 4; r < 16; r += 4) { a = hs_max3f(a, p0[r], p0[r + 1]); b = hs_max3f(b, p0[r + 2], p0[r + 3]); a = hs_max3f(a, p1[r], p1[r + 1]); b = hs_max3f(b, p1[r + 2], p1[r + 3]); }
    const float m = hs_max2f(a, b);
    auto rr = __builtin_amdgcn_permlane32_swap(__float_as_uint(m), __float_as_uint(m), false, false);
    return hs_max2f(__uint_as_float(rr[0]), __uint_as_float(rr[1]));
}
__device__ __forceinline__ void hs_pv(f32x16* o, int vb, bf16x8 pa0, bf16x8 pa1, bf16x8 pa2, bf16x8 pa3) {
#pragma unroll
    for (int d0 = 0; d0 < 2; ++d0) { s16x4 lo[4], hi[4];
#pragma unroll
        for (int ks = 0; ks < 4; ++ks) {
            asm volatile("ds_read_b64_tr_b16 %0,%1 offset:%c2" : "=&v"(lo[ks]) : "v"(vb), "i"(d0 * 4096 + ks * 1024) : "memory");
            asm volatile("ds_read_b64_tr_b16 %0,%1 offset:%c2" : "=&v"(hi[ks]) : "v"(vb), "i"(d0 * 4096 + ks * 1024 + 512) : "memory"); }
        asm volatile("s_waitcnt lgkmcnt(0)" ::: "memory"); HS_SBAR();
#define HS_PK(k) (bf16x8){lo[k][0], lo[k][1], lo[k][2], lo[k][3], hi[k][0], hi[k][1], hi[k][2], hi[k][3]}
        o[d0] = MFMA32(pa0, HS_PK(0), o[d0]); o[d0] = MFMA32(pa1, HS_PK(1), o[d0]); o[d0] = MFMA32(pa2, HS_PK(2), o[d0]); o[d0] = MFMA32(pa3, HS_PK(3), o[d0]);
#undef HS_PK
    }
}
template <int THRL> __device__ __forceinline__ void run_branch(char* shm, const bf16x8* qr, const bf16_t* ksb, LAS const unsigned char* steps, const int NT,
                                                               const int qb, f32x16* o, float& l_out, const int wid, const int lane) {
    constexpr int SLOTB = 8192, NSLOT = 3;
    { unsigned long long p_ = (unsigned long long)ksb; asm volatile("" : "+s"(p_)); ksb = (const bf16_t*)p_; }
    const int r32 = lane & 31, hi = lane >> 5, tq = (wid & 1) * 32 + r32;
    const unsigned lds0 = (unsigned)(uintptr_t)shm;
    const unsigned long long mysel = *((LAS const unsigned long long*)((lds_cptr)shm + SELM) + tq);
    const int vcodes = (int)steps[lane];
    float* wsf = (float*)(shm + WSF) + wid * 32;
    const size_t koff = (size_t)lane * PP + wid * 8, voff = (size_t)(16 * (wid & 3) + (lane >> 2)) * PP + (wid >> 2) * 32 + (lane & 3) * 8 + (C_VS - C_KS);
    const unsigned kdst = lds0 + KB0 + wid * 1024, vdst = lds0 + VB0 + wid * 1024;
#define HS_CODE(t) ((int)__builtin_amdgcn_readlane(vcodes, (t)))
#define HS_SRC(c) (ksb + (size_t)(((c) & 0x80) ? (C_KW - C_KS) : 0) + (size_t)(((c) == 0x7f) ? 0 : ((c) & 0x7f)) * 64 * PP)
#define DMA_K(t, slot) do { const int c_ = HS_CODE(t); hs_glds16(HS_SRC(c_) + koff, (unsigned)__builtin_amdgcn_readfirstlane(kdst + (slot))); } while (0)
#define DMA_V(t, slot) do { const int c_ = HS_CODE(t); hs_glds16(HS_SRC(c_) + voff, (unsigned)__builtin_amdgcn_readfirstlane(vdst + (slot))); } while (0)
    const int vb0 = (int)(lds0 + VB0) + ((lane >> 4) & 1) * 32 + (lane & 3) * 8 + (4 * hi + ((lane & 15) >> 2)) * 64;
    const char* Kbase = shm + KB0; bf16x8 kf[8];
    const lds_cptr shm3 = (lds_cptr)shm; const lds_cptr kp0 = shm3 + KB0 + hi * 1024 + r32 * 16; const lds_cptr vp0 = shm3 + VB0 + ((lane >> 4) & 1) * 32 + (lane & 3) * 8 + (4 * hi + ((lane & 15) >> 2)) * 64;
    DMA_K(0, 0); DMA_V(0, 0); DMA_K(1, SLOTB);
    float mhat = 0.f, l_reg = 0.f; f32x16 negm;
    { float z = 0.f; asm volatile("" : "+v"(z));
#pragma unroll
      for (int i = 0; i < 16; ++i) { o[0][i] = z; o[1][i] = z; negm[i] = z; } }
    asm volatile("" : "+v"(negm));
#define CMASK(P0, P1, t) do { const int c_ = HS_CODE(t); const bool isw_ = (c_ & 0x80) != 0; const int jj_ = c_ & 0x7f; \
        const bool en_ = isw_ ? true : ((c_ != 0x7f) && (((mysel >> (jj_ & 63)) & 1ull) != 0ull)); \
        if (__any(!en_)) { if (!en_) { _Pragma("unroll") for (int r = 0; r < 16; ++r) { P0[r] = -INFINITY; P1[r] = -INFINITY; } } } \
        int kind_ = 0; if (c_ != 0x7f) { if (jj_ == qb) kind_ = 1; else if (isw_ && jj_ == qb - 8) kind_ = 2; } \
        if (kind_) apply_mask(P0, P1, kind_ == 1 ? lowmask(tq + 1) : ~lowmask(tq + 1), hi); } while (0)
    bool resc = false;
#define START(P0, P1) do { const float rm = hs_rowmax(P0, P1); resc = false; \
        { const float dl = (rm > -INFINITY) ? rm : 0.f; mhat = hs_fadd(mhat, dl); \
          _Pragma("unroll") for (int r = 0; r < 16; ++r) { P0[r] = hs_fsub(P0[r], dl); P1[r] = hs_fsub(P1[r], dl); } \
          _Pragma("unroll") for (int r = 0; r < 16; ++r) negm[r] = -mhat; asm volatile("" : "+v"(negm)); } \
        _Pragma("unroll") for (int r = 0; r < 16; ++r) P0[r] = __builtin_amdgcn_exp2f(P0[r]); } while (0)
#define RESC() do { if (resc) { asm volatile("s_waitcnt lgkmcnt(0)" ::: "memory"); \
        _Pragma("unroll") for (int d_ = 0; d_ < 2; ++d_) _Pragma("unroll") for (int r = 0; r < 16; ++r) o[d_][r] *= wsf[crow(r, hi)]; } } while (0)
    f32x16 pA0, pA1, pB0, pB1;
    int sl_prev = 0, sl_cur = 0, sl_next = SLOTB;
#define ROT() do { sl_prev = sl_cur; sl_cur = sl_next; sl_next = (sl_next == (NSLOT - 1) * SLOTB) ? 0 : sl_next + SLOTB; } while (0)
    DMA_K(2, 2 * SLOTB);
    HS_WAIT_BAR(3);
    hs_qkt(pA0, pA1, Kbase, qr, negm, r32, hi); asm volatile("s_nop 15\n\ts_nop 7" : "+v"(pA0), "+v"(pA1)); CMASK(pA0, pA1, 0);
    START(pA0, pA1);
    _Pragma("unroll") for (int r = 0; r < 16; ++r) pA1[r] = __builtin_amdgcn_exp2f(pA1[r]);
    HS_WAIT_BAR(0);
    DMA_K(3, 0); DMA_V(1, SLOTB);
    ROT();
    hs_kload8(kf, kp0 + sl_cur);
    HS_WAIT_BAR(2);
    s16x4 vlo[8], vhi[8]; u32x4 pw0, pw1, pw2, pw3;
#define PKW(P, B) pk2(P[B], P[B + 1])
#define PAF(k) __builtin_bit_cast(bf16x8, pw##k)
#define VFR(i) (bf16x8){vlo[i][0], vlo[i][1], vlo[i][2], vlo[i][3], vhi[i][0], vhi[i][1], vhi[i][2], vhi[i][3]}
#define PIN(x) asm volatile("" : "+v"(x))
#define MX3(a, b, c) __builtin_fmaxf(__builtin_fmaxf((a), (b)), (c))
#define GAPA(MF, A0, A1, A2, A3, W0, W1, PW) do { MF; sacc += A0; sacc += A1; sacc += A2; sacc += A3; PIN(sacc); W0; W1; PIN(PW); HS_SBAR(); } while (0)
#define EX(v) __builtin_amdgcn_exp2f(v)
#define GAPB(MF, X, B) do { MF; X[B] = EX(X[B]); X[B + 1] = EX(X[B + 1]); X[B + 2] = EX(X[B + 2]); X[B + 3] = EX(X[B + 3]); PIN(X); HS_SBAR(); } while (0)
#define VRD(i) do { vlo[i] = hs_vtr(vp_ + (((i) >> 2) * 4096 + ((i) & 3) * 1024)); vhi[i] = hs_vtr(vp_ + (((i) >> 2) * 4096 + ((i) & 3) * 1024 + 512)); } while (0)
#define KRD(G, j) do { if (G) { hs_kload2(kf, kp0 + sl_next, j); HS_SBAR(); } } while (0)
#define STEP(C0, C1, P0, P1, t, GK, GV, GL) do { HS_SBAR(); \
        const lds_cptr vp_ = vp0 + sl_prev; \
        VRD(0); HS_SBAR(); float sacc = (P0[0] + P0[1]); \
        GAPA(C0 = MFMA32(kf[0], qr[0], negm), P0[2], P0[3], P0[4], P0[5],     pw0[0] = PKW(P0, 0), pw0[1] = PKW(P0, 2), pw0); \
        VRD(4); HS_SBAR(); GAPA(C1 = MFMA32(kf[1], qr[0], negm), P0[6], P0[7], P0[8], P0[9],     pw0[2] = PKW(P0, 4), pw0[3] = PKW(P0, 6), pw0); \
        VRD(1); HS_SBAR(); GAPA(C0 = MFMA32(kf[2], qr[1], C0),   P0[10], P0[11], P0[12], P0[13], pw1[0] = PKW(P0, 8), pw1[1] = PKW(P0, 10), pw1); \
        VRD(5); HS_SBAR(); GAPA(C1 = MFMA32(kf[3], qr[1], C1),   P0[14], P0[15], P1[0], P1[1],   pw1[2] = PKW(P0, 12), pw1[3] = PKW(P0, 14), pw1); \
        VRD(2); HS_SBAR(); GAPA(C0 = MFMA32(kf[4], qr[2], C0),   P1[2], P1[3], P1[4], P1[5],     pw2[0] = PKW(P1, 0), pw2[1] = PKW(P1, 2), pw2); \
        VRD(6); HS_SBAR(); GAPA(C1 = MFMA32(kf[5], qr[2], C1),   P1[6], P1[7], P1[8], P1[9],     pw2[2] = PKW(P1, 4), pw2[3] = PKW(P1, 6), pw2); \
        VRD(3); HS_SBAR(); GAPA(C0 = MFMA32(kf[6], qr[3], C0),   P1[10], P1[11], P1[12], P1[13], pw3[0] = PKW(P1, 8), pw3[1] = PKW(P1, 10), pw3); \
        VRD(7); HS_SBAR(); GAPA(C1 = MFMA32(kf[7], qr[3], C1),   P1[14], P1[15], 0.f, 0.f,       pw3[2] = PKW(P1, 12), pw3[3] = PKW(P1, 14), pw3); \
        l_reg += sacc; \
        if (GK) { DMA_K((t) + 3, sl_cur); } if (GV) { DMA_V((t) + 1, sl_next); } \
        CMASK(C0, C1, t); \
        { float a = MX3(C0[0], C0[1], C1[0]), b = MX3(C0[2], C0[3], C1[1]); a = MX3(a, C1[2], C1[3]); \
          _Pragma("unroll") for (int r = 4; r < 16; r += 4) { a = MX3(a, C0[r], C0[r + 1]); b = MX3(b, C0[r + 2], C0[r + 3]); a = MX3(a, C1[r], C1[r + 1]); b = MX3(b, C1[r + 2], C1[r + 3]); } \
          float rm = __builtin_fmaxf(a, b); { auto rr = __builtin_amdgcn_permlane32_swap(__float_as_uint(rm), __float_as_uint(rm), false, false); rm = __builtin_fmaxf(__uint_as_float(rr[0]), __uint_as_float(rr[1])); } \
          resc = false; \
          if (__builtin_expect(__any(rm > (float)THRL), 0)) { const float dl = __builtin_fmaxf(rm, 0.f); mhat += dl; \
            _Pragma("unroll") for (int r = 0; r < 16; ++r) { C0[r] -= dl; C1[r] -= dl; } \
            _Pragma("unroll") for (int r = 0; r < 16; ++r) negm[r] = -mhat; asm volatile("" : "+v"(negm)); \
            const float f = __builtin_amdgcn_exp2f(-dl); l_reg *= f; if (hi == 0) wsf[r32] = f; resc = true; } } \
        HS_SBAR(); \
        GAPB(o[0] = MFMA32(PAF(0), VFR(0), o[0]), C0, 0); \
        GAPB(o[1] = MFMA32(PAF(0), VFR(4), o[1]), C0, 4); \
        KRD(GL, 0); GAPB(o[0] = MFMA32(PAF(1), VFR(1), o[0]), C0, 8); \
        KRD(GL, 1); GAPB(o[1] = MFMA32(PAF(1), VFR(5), o[1]), C0, 12); \
        KRD(GL, 2); GAPB(o[0] = MFMA32(PAF(2), VFR(2), o[0]), C1, 0); \
        KRD(GL, 3); GAPB(o[1] = MFMA32(PAF(2), VFR(6), o[1]), C1, 4); \
        GAPB(o[0] = MFMA32(PAF(3), VFR(3), o[0]), C1, 8); \
        GAPB(o[1] = MFMA32(PAF(3), VFR(7), o[1]), C1, 12); \
    } while (0)
    int t = 1;
    for (; t + 5 < NT; t += 2) {
        STEP(pB0, pB1, pA0, pA1, t, true, true, true);     HS_WAIT_BAR(2); RESC(); ROT();
        STEP(pA0, pA1, pB0, pB1, t + 1, true, true, true); HS_WAIT_BAR(2); RESC(); ROT();
    }
#define ENDW(tt) do { if ((tt) + 3 < NT) { HS_WAIT_BAR(2); } else if ((tt) + 2 < NT) { HS_WAIT_BAR(1); } else { HS_WAIT_BAR(0); } } while (0)
    for (; t + 1 < NT; t += 2) {
        STEP(pB0, pB1, pA0, pA1, t, (t + 3 < NT), (t + 1 < NT), (t + 1 < NT));         ENDW(t);     RESC(); ROT();
        STEP(pA0, pA1, pB0, pB1, t + 1, (t + 4 < NT), (t + 2 < NT), (t + 2 < NT));     ENDW(t + 1); RESC(); ROT();
    }
    STEP(pB0, pB1, pA0, pA1, NT - 1, false, false, false); RESC();
    { float sacc = pB0[0] + pB0[1]; _Pragma("unroll") for (int r = 2; r < 16; ++r) sacc += pB0[r]; _Pragma("unroll") for (int r = 0; r < 16; ++r) sacc += pB1[r]; l_reg += sacc;
      pw0 = (u32x4){PKW(pB0, 0), PKW(pB0, 2), PKW(pB0, 4), PKW(pB0, 6)}; pw1 = (u32x4){PKW(pB0, 8), PKW(pB0, 10), PKW(pB0, 12), PKW(pB0, 14)};
      pw2 = (u32x4){PKW(pB1, 0), PKW(pB1, 2), PKW(pB1, 4), PKW(pB1, 6)}; pw3 = (u32x4){PKW(pB1, 8), PKW(pB1, 10), PKW(pB1, 12), PKW(pB1, 14)};
      HS_SBAR(); hs_pv(o, vb0 + sl_cur, PAF(0), PAF(1), PAF(2), PAF(3)); }
    { auto rr = __builtin_amdgcn_permlane32_swap(__float_as_uint(l_reg), __float_as_uint(l_reg), false, false); l_out = __uint_as_float(rr[0]) + __uint_as_float(rr[1]); }
    asm volatile("s_waitcnt lgkmcnt(0)\n\ts_barrier" ::: "memory");
#undef PKW
#undef PAF
#undef VFR
#undef PIN
#undef MX3
#undef GAPA
#undef GAPB
#undef EX
#undef VRD
#undef KRD
#undef STEP
#undef ENDW
#undef DMA_K
#undef DMA_V
#undef CMASK
#undef START
#undef RESC
#undef ROT
#undef HS_CODE
#undef HS_SRC
}
__device__ __forceinline__ void attn_unit(LAS unsigned char* lds, bf16_t* proj, const bf16_t* kcmp, const bf16_t* vcmp, int bh, int qb, int skipw) {
    int tid_ = threadIdx.x; asm volatile("" : "+v"(tid_));
    const int tid = tid_, lane = tid & 63, r = lane & 31, h = lane >> 5, wid = __builtin_amdgcn_readfirstlane(tid >> 6);
    const int b = bh >> 2, hk = bh & 3, g = wid >> 1, tq = (wid & 1) * 32 + r;
    const size_t row = (size_t)b * SEQ + (size_t)qb * 64 + tq;
    const int t = qb * 64 + tq;
    bf16_t* qp = proj + row * PP + C_Q + (hk * 4 + g) * 64;
    bf16x8 qreg[4];
#pragma unroll
    for (int d0 = 0; d0 < 4; ++d0) qreg[d0] = *(const bf16x8*)(qp + d0 * 16 + h * 8);
    const bf16x8* qr = qreg;
    float gate[3];
#pragma unroll
    for (int c = 0; c < 3; ++c) gate[c] = sigmoidf_(bf2f(proj[row * PP + C_GBR + c * 16 + hk * 4 + g]));
#ifdef GATE2X
    if (GATE2X & 1) gate[0] *= 2.f; if (GATE2X & 2) gate[1] *= 2.f; if (GATE2X & 4) gate[2] *= 2.f;
#endif
#ifdef GATEZ
    if (GATEZ & 1) gate[0] = 0.f; if (GATEZ & 2) gate[1] = 0.f; if (GATEZ & 4) gate[2] = 0.f;
#endif
    LAS float* wsf = (LAS float*)(lds + WSF) + wid * 32;
    LAS float* impw = (LAS float*)(lds + IMP) + (g * 64 + tq) * IMPW;
    const size_t krow = lane, kcol = wid * 8;
    const size_t vrow = 16 * (wid & 3) + (lane >> 2), vcol = 32 * (wid >> 2) + 8 * (lane & 3);
    LAS unsigned char* kst = lds + KB0 + wid * 1024 + lane * 16;
    LAS unsigned char* vst = lds + VB0 + wid * 1024 + lane * 16;
    u32x4 kreg, vreg;
    LAS float* osl = (LAS float*)(lds + IMP + wid * (32 * IMPW * 4)) + lane;
#define LDK(base, pitch) kreg = *(const u32x4*)((base) + krow * (size_t)(pitch) + kcol)
#define LDV(base, pitch) vreg = *(const u32x4*)((base) + vrow * (size_t)(pitch) + vcol)
#define STK(buf) *(LAS u32x4*)(kst + (buf) * 8192) = kreg
#define STV(buf) *(LAS u32x4*)(vst + (buf) * 8192) = vreg
#define KBUF(buf) (lds + KB0 + (buf) * 8192)
#define VBUF(buf) (lds + VB0 + (buf) * 8192)
#define ACCUM_OUT(scale_expr, FIRST) do { if (h == 0) wsf[r] = (scale_expr); \
        _Pragma("unroll") for (int i = 0; i < 16; ++i) { const float sc = wsf[crow(i, h)]; \
            if (FIRST) { osl[(i * 2) * 64] = st.o0[i] * sc; osl[(i * 2 + 1) * 64] = st.o1[i] * sc; } \
            else { osl[(i * 2) * 64] += st.o0[i] * sc; osl[(i * 2 + 1) * 64] += st.o1[i] * sc; } } } while (0)

    St st;
    const bf16_t* kc = kcmp + (size_t)bh * 256 * 64; const bf16_t* vc = vcmp + (size_t)bh * 256 * 64;
    const int nmax = (t >= 31) ? ((t - 31) >> 4) : -1;
    float carry = 0.f;
    float m1 = -1e30f, l1 = 0.f;
    LDK(kc, 64); STK(0); __syncthreads();
#pragma unroll 1
    for (int j = 0; j < 4; ++j) {
        if (j + 1 < 4) LDK(kc + (size_t)(j + 1) * 64 * 64, 64);
        { const int cnt = nmax - 64 * j + 1; const unsigned long long allow = cnt <= 0 ? 0ull : lowmask(cnt);
          tile_stats(m1, l1, KBUF(j & 1), qr, allow, r, h); }
        if (j + 1 < 4) STK((j + 1) & 1);
        __syncthreads();
    }
    l1 += __shfl_xor(l1, 32);
    const float invl = __builtin_amdgcn_rcpf(fmaxf(l1, 1e-30f));
#pragma unroll
    for (int i = 0; i < 16; ++i) { st.o0[i] = 0.f; st.o1[i] = 0.f; }
    LDK(kc, 64); LDV(vc, 64); STK(0); STV(0); __syncthreads();
#pragma unroll 1
    for (int j = 0; j < 4; ++j) {
        if (j + 1 < 4) { LDK(kc + (size_t)(j + 1) * 64 * 64, 64); LDV(vc + (size_t)(j + 1) * 64 * 64, 64); }
        { const int cnt = nmax - 64 * j + 1; const unsigned long long allow = cnt <= 0 ? 0ull : lowmask(cnt);
          tile_exact(st.o0, st.o1, m1, invl, KBUF(j & 1), VBUF(j & 1), qr, allow, impw, carry, j, lane, r, h); }
        if (j + 1 < 4) { STK((j + 1) & 1); STV((j + 1) & 1); }
        __syncthreads();
    }
    {
        unsigned long long wor = 0ull;
        const unsigned long long valid = lowmask(qb + 1);
        LAS const float* ib = (LAS const float*)(lds + IMP);
        unsigned key[8], T[8];
#pragma unroll
        for (int i = 0; i < 8; ++i) { const int q = wid * 8 + i;
            float v = ((ib[(0 * 64 + q) * IMPW + lane] + ib[(1 * 64 + q) * IMPW + lane]) + ib[(2 * 64 + q) * IMPW + lane]) + ib[(3 * 64 + q) * IMPW + lane];
            if (lane == 0 || lane == qb || lane == qb - 1) v = INFINITY;
            key[i] = (lane <= qb) ? __float_as_uint(fmaxf(v, 0.f)) : 0u; T[i] = 0u; }
#pragma unroll 1
        for (int bb = 30; bb >= 0; --bb) {
#pragma unroll
            for (int i = 0; i < 8; ++i) { const unsigned cand = T[i] | (1u << bb);
                const int c = __popcll(__ballot(key[i] >= cand) & valid); T[i] = (c >= 16) ? cand : T[i]; }
        }
#pragma unroll
        for (int i = 0; i < 8; ++i) { const int q = wid * 8 + i;
            const unsigned long long gt = __ballot(key[i] > T[i]) & valid, eq = __ballot(key[i] == T[i]) & valid;
            const int need = 16 - __popcll(gt);
            const bool pick = ((eq >> lane) & 1ull) && (__popcll(eq & lowmask(lane)) < need);
            const unsigned long long msk = gt | __ballot(pick);
            if (lane == 0) *(LAS unsigned long long*)(lds + SELM + q * 8) = msk;
            wor |= msk; }
        if (lane == 0) *(LAS unsigned long long*)(lds + WMASK + wid * 8) = wor;
    }
    __syncthreads();
    unsigned long long un = 0ull;
#pragma unroll
    for (int w = 0; w < 8; ++w) un |= *(LAS const unsigned long long*)(lds + WMASK + w * 8);
    { const unsigned ulo = __builtin_amdgcn_readfirstlane((unsigned)un), uhi = __builtin_amdgcn_readfirstlane((unsigned)(un >> 32)); un = ((unsigned long long)uhi << 32) | ulo; }
    ACCUM_OUT(gate[0], true);
    {
        LAS unsigned char* steps = lds + STEPS + wid * 128;
        const int nsel = __popcll(un), j0w = qb >= 8 ? qb - 8 : 0, nwin = qb - j0w + 1;
        const int NTs = nsel < 4 ? 4 : ((nsel + 1) & ~1), NTw = nwin < 4 ? 4 : ((nwin + 1) & ~1);
        if ((un >> lane) & 1ull) steps[__popcll(un & lowmask(lane))] = (unsigned char)lane;
        if (lane >= nsel && lane < NTs) steps[lane] = (unsigned char)0x7f;
        if (lane < NTw) steps[64 + lane] = (unsigned char)(lane < nwin ? (0x80 | (j0w + lane)) : 0x7f);
        const bf16_t* ksb = proj + (size_t)b * SEQ * PP + C_KS + hk * 64;
        char* shm = (char*)lds;
        f32x16 ob[2]; float lt;
        run_branch<8>(shm, qr, ksb, steps, NTs, qb, ob, lt, wid, lane);
        {
            int t2 = threadIdx.x; asm volatile("" : "+v"(t2));
            const int lane2 = t2 & 63, r2 = lane2 & 31, h2 = lane2 >> 5, wid2 = __builtin_amdgcn_readfirstlane(t2 >> 6), g2 = wid2 >> 1, tq2 = (wid2 & 1) * 32 + r2;
            LAS float* wsf2 = (LAS float*)(lds + WSF) + wid2 * 32; LAS float* osl2 = (LAS float*)(lds + IMP + wid2 * (32 * IMPW * 4)) + lane2;
            const float g1 = sigmoidf_(bf2f(proj[((size_t)b * SEQ + (size_t)qb * 64 + tq2) * PP + C_GBR + 1 * 16 + hk * 4 + g2]));
            if (h2 == 0) wsf2[r2] = g1 * __builtin_amdgcn_rcpf(fmaxf(lt, 1e-30f));
#pragma unroll
            for (int i = 0; i < 16; ++i) { const float sc = wsf2[crow(i, h2)]; osl2[(i * 2) * 64] += ob[0][i] * sc; osl2[(i * 2 + 1) * 64] += ob[1][i] * sc; }
        }
        {
            int t3 = threadIdx.x; asm volatile("" : "+v"(t3));
            run_branch<8>(shm, qr, ksb, steps + 64, NTw, qb, ob, lt, __builtin_amdgcn_readfirstlane(t3 >> 6), t3 & 63);
        }
        st.o0 = ob[0]; st.o1 = ob[1]; st.l = lt;
    }
    {
        int t2 = threadIdx.x; asm volatile("" : "+v"(t2));
        const int lane2 = t2 & 63, r2 = lane2 & 31, h2 = lane2 >> 5, wid2 = __builtin_amdgcn_readfirstlane(t2 >> 6), g2 = wid2 >> 1, tq2 = (wid2 & 1) * 32 + r2;
        LAS float* wsf2 = (LAS float*)(lds + WSF) + wid2 * 32; LAS float* osl2 = (LAS float*)(lds + IMP + wid2 * (32 * IMPW * 4)) + lane2;
        const float g3 = sigmoidf_(bf2f(proj[((size_t)b * SEQ + (size_t)qb * 64 + tq2) * PP + C_GBR + 2 * 16 + hk * 4 + g2]));
        if (h2 == 0) wsf2[r2] = g3 * __builtin_amdgcn_rcpf(fmaxf(st.l, 1e-30f));
        bf16_t* ob2 = proj + ((size_t)b * SEQ + (size_t)qb * 64 + (wid2 & 1) * 32) * PP + C_Q + (hk * 4 + g2) * 64;
        if (!skipw)
#pragma unroll
        for (int i = 0; i < 16; ++i) { const int q = crow(i, h2); const float sc = wsf2[q];
            const float f0 = osl2[(i * 2) * 64] + st.o0[i] * sc, f1 = osl2[(i * 2 + 1) * 64] + st.o1[i] * sc;
            ob2[(size_t)q * PP + r2] = (bf16_t)(pk2(f0, 0.f) & 0xffffu); ob2[(size_t)q * PP + 32 + r2] = (bf16_t)(pk2(f1, 0.f) & 0xffffu); }
    }
#undef LDK
#undef LDV
#undef STK
#undef STV
#undef KBUF
#undef VBUF
#undef ACCUM_OUT
}
}

__device__ __forceinline__ float wave_sum(float v) {
#pragma unroll
    for (int o = 1; o < 64; o <<= 1) v += __shfl_xor(v, o);
    return v;
}
__device__ __forceinline__ void transpose_item(const float* W, int K, int N, bf16_t* WT, int ldt, int k0, int n0, int drow0, const float* kscale, float cscale, LAS float* scr, int lane) {
#pragma unroll 8
    for (int i = 0; i < 32; ++i) { const int kk = 2 * i + (lane >> 5); const int n = n0 + (lane & 31);
        float v = (n < N) ? W[(size_t)(k0 + kk) * N + n] : 0.f;
        if (kscale) v *= kscale[k0 + kk];
        scr[kk * 33 + (lane & 31)] = v * cscale; }
    asm volatile("s_waitcnt lgkmcnt(0)" ::: "memory");
    const int c = lane & 7;
#pragma unroll
    for (int j = 0; j < 4; ++j) { const int n = (lane >> 3) + 8 * j; const LAS float* s = scr + (8 * c) * 33 + n;
        u32x4 o; o.x = pk2(s[0 * 33], s[1 * 33]); o.y = pk2(s[2 * 33], s[3 * 33]); o.z = pk2(s[4 * 33], s[5 * 33]); o.w = pk2(s[6 * 33], s[7 * 33]);
        *(u32x4*)(WT + (size_t)(drow0 + n) * ldt + k0 + 8 * c) = o; }
    asm volatile("s_waitcnt lgkmcnt(0)" ::: "memory");
}

#define XB_TMO      128
#define XB_XCNT(j)  (256  + 64 * (j))
#define XB_XSUB(j)  (1280 + 64 * (j))
#define XB_XGEN(j)  (2304 + 64 * (j))
#define XB_TOP      3328
#define XB_TOPGEN   3392
#define XCD_BAR_WORDS 3456
#define XB_SPIN_CAP (1u << 18)
__device__ __forceinline__ unsigned xb_ld(unsigned* p)              { return __hip_atomic_load(p, __ATOMIC_RELAXED, __HIP_MEMORY_SCOPE_AGENT); }
__device__ __forceinline__ unsigned xb_add(unsigned* p, unsigned v) { return __hip_atomic_fetch_add(p, v, __ATOMIC_RELAXED, __HIP_MEMORY_SCOPE_AGENT); }
__device__ __forceinline__ unsigned xb_xcc_id() { return (unsigned)__builtin_amdgcn_s_getreg((3 << 11) | 20) & 0xFu; }
#define XB_SPIN(cond, bar) do { unsigned _sp = 0; while (cond) { __builtin_amdgcn_s_sleep(1); \
    if ((++_sp & 255u) == 0u) { if (xb_ld(&(bar)[XB_TMO])) break; if (_sp > XB_SPIN_CAP) { atomicAdd(&(bar)[XB_TMO], 1u); break; } } } } while (0)
struct XcdBarrier { unsigned* bar; unsigned x; volatile LAS unsigned* st; };
__device__ __forceinline__ XcdBarrier xcd_barrier_post(unsigned* bar, volatile LAS unsigned* st) {
    XcdBarrier b; b.bar = bar; b.x = xb_xcc_id(); b.st = st;
    if (threadIdx.x == 0) (void)xb_add(&bar[XB_XCNT(b.x)], 1u);
    return b;
}
__device__ __forceinline__ void xcd_barrier_complete(unsigned* bar, unsigned x, unsigned& nloc, unsigned& nx) {
    const unsigned G = gridDim.x * gridDim.y * gridDim.z;
    unsigned sum, cnt, mine, sp = 0u;
    for (;;) {
        sum = 0u; cnt = 0u; mine = 0u;
#pragma unroll
        for (unsigned j = 0; j < 16; ++j) { const unsigned c = xb_ld(&bar[XB_XCNT(j)]); sum += c; cnt += (c > 0u) ? 1u : 0u; mine = (j == x) ? c : mine; }
        if (sum == G) break;
        __builtin_amdgcn_s_sleep(1);
        if ((++sp & 255u) == 0u) { if (xb_ld(&bar[XB_TMO])) break; if (sp > XB_SPIN_CAP) { atomicAdd(&bar[XB_TMO], 1u); break; } }
    }
    nloc = mine > 0u ? mine : 1u; nx = cnt > 0u ? cnt : 1u;
}
__device__ __forceinline__ void xcd_barrier(const XcdBarrier& b) {
    asm volatile("s_waitcnt vmcnt(0)" ::: "memory");
    __syncthreads();
    if (threadIdx.x == 0) {
        unsigned* bar = b.bar;
        __builtin_amdgcn_s_waitcnt(0);
        unsigned nloc = b.st[0], nx = b.st[1];
        if (nloc == 0u) { xcd_barrier_complete(bar, b.x, nloc, nx); b.st[0] = nloc; b.st[1] = nx; }
        const unsigned old = xb_add(&bar[XB_XSUB(b.x)], 1u);
        const unsigned gen = old / nloc;
        if (old + 1u == (gen + 1u) * nloc) {
            __builtin_amdgcn_fence(__ATOMIC_RELEASE, "agent");
            asm volatile("s_waitcnt vmcnt(0)" ::: "memory");
            const unsigned og = xb_add(&bar[XB_TOP], 1u);
            const unsigned tg = og / nx;
            if (og + 1u == (tg + 1u) * nx) xb_add(&bar[XB_TOPGEN], 1u);
            else XB_SPIN(xb_ld(&bar[XB_TOPGEN]) == tg, bar);
            __builtin_amdgcn_fence(__ATOMIC_ACQUIRE, "agent");
            xb_add(&bar[XB_XGEN(b.x)], 1u);
            asm volatile("s_waitcnt vmcnt(0)" ::: "memory");
        } else {
            XB_SPIN(xb_ld(&bar[XB_XGEN(b.x)]) == gen, bar);
            __builtin_amdgcn_fence(__ATOMIC_ACQUIRE, "agent");
            asm volatile("s_waitcnt vmcnt(0)" ::: "memory");
        }
    }
    __syncthreads();
}

struct Args {
    const float *x, *w_in, *conv_w, *w_conv_out, *pos_k, *w1_k, *w2_k, *pos_v, *w1_v, *w2_v, *w_attn_out, *w_o, *g_mix, *g_ffn, *w_gate, *w_up, *w_down, *g_final;
    float* out; unsigned char* ws; int probe; int pad;
};

__global__ void __launch_bounds__(512, 2) nsa_fwd(Args a) {
    extern __shared__ __attribute__((aligned(16))) unsigned char lds_raw[];
    LAS unsigned char* lds = (LAS unsigned char*)lds_raw;
    cg::grid_group grid = cg::this_grid();
    const int tid = threadIdx.x, lane = tid & 63, wave = __builtin_amdgcn_readfirstlane(tid >> 6);
    const int G = gridDim.x, bx = blockIdx.x;
    const int vcu = (G % 8 == 0) ? (bx % 8) * (G / 8) + bx / 8 : bx;
    unsigned char* ws = a.ws;
    volatile LAS unsigned* bst = (volatile LAS unsigned*)(lds + 143360);
    if (tid < 2) bst[tid] = 0u;
    __syncthreads();
    const XcdBarrier gbar = xcd_barrier_post((unsigned*)(ws + WS_BAR), bst);
#define SEAM() xcd_barrier(gbar)
    float* part1 = (float*)(ws + WS_PART1); float* part2 = (float*)(ws + WS_PART2); float* cbias = (float*)(ws + WS_BIAS);
    bf16_t* Win = (bf16_t*)(ws + WS_WIN); bf16_t* Wconv = (bf16_t*)(ws + WS_WCONV); bf16_t* Wattn = (bf16_t*)(ws + WS_WATTN); bf16_t* Wo = (bf16_t*)(ws + WS_WO);
    bf16_t* Wup = (bf16_t*)(ws + WS_WUP); bf16_t* Wdown = (bf16_t*)(ws + WS_WDOWN); bf16_t* W1 = (bf16_t*)(ws + WS_W1); bf16_t* W2 = (bf16_t*)(ws + WS_W2);
    bf16_t* hid = (bf16_t*)(ws + WS_HID); bf16_t* kcmp = (bf16_t*)(ws + WS_KCMP); bf16_t* proj = (bf16_t*)(ws + WS_PROJ);
    float* h1f = (float*)(ws + WS_H1F); bf16_t* h1b = (bf16_t*)(ws + WS_H1B); bf16_t* act = (bf16_t*)(ws + WS_ACT);
    bf16_t* nb = (bf16_t*)a.out; bf16_t* mix = (bf16_t*)a.out; bf16_t* bc = (bf16_t*)((unsigned char*)a.out + OUT_BC);

    {
        LAS float* scr = (LAS float*)(lds + wave * 16384);
        const int gw = vcu * 8 + wave, NGW = G * 8;
        constexpr int I_IN = 16 * 194, I_CONV = 8 * 32, I_ATT = 16 * 32, I_O = 16 * 32, I_G = 16 * 88, I_U = 16 * 88, I_D = 44 * 32, I_1 = 32 * 8, I_2 = 4 * 2;
        constexpr int NITEMS = I_IN + I_CONV + I_ATT + I_O + 2 * I_1 + 2 * I_2;
        for (int it = gw; it < NITEMS; it += NGW) {
            int q = it;
            if (q < I_IN) { const int kb = q / 194, nbk = q % 194, n0 = 32 * nbk; const float cs = (n0 >= C_Q && n0 < C_KC) ? QSCALE : 1.0f;
                transpose_item(a.w_in, 1024, INCOLS, Win, 1024, 64 * kb, n0, n0, a.g_mix, cs, scr, lane); continue; } q -= I_IN;
            if (q < I_CONV) { const int kb = q / 32, nbk = q % 32; transpose_item(a.w_conv_out, 512, 1024, Wconv, 512, 64 * kb, 32 * nbk, 32 * nbk, nullptr, 1.f, scr, lane); continue; } q -= I_CONV;
            if (q < I_ATT) { const int kb = q / 32, nbk = q % 32; transpose_item(a.w_attn_out, 1024, 1024, Wattn, 1024, 64 * kb, 32 * nbk, 32 * nbk, nullptr, 1.f, scr, lane); continue; } q -= I_ATT;
            if (q < I_O) { const int kb = q / 32, nbk = q % 32; transpose_item(a.w_o, 1024, 1024, Wo, 1024, 64 * kb, 32 * nbk, 32 * nbk, nullptr, 1.f, scr, lane); continue; } q -= I_O;
            if (q < I_1) { const int kb = q / 8, nbk = q % 8; transpose_item(a.w1_k, 2048, 256, W1, 2048, 64 * kb, 32 * nbk, 32 * nbk, nullptr, 1.f, scr, lane); continue; } q -= I_1;
            if (q < I_1) { const int kb = q / 8, nbk = q % 8; transpose_item(a.w1_v, 2048, 256, W1, 2048, 64 * kb, 32 * nbk, 256 + 32 * nbk, nullptr, 1.f, scr, lane); continue; } q -= I_1;
            if (q < I_2) { const int kb = q / 2, nbk = q % 2; transpose_item(a.w2_k, 256, 64, W2, 256, 64 * kb, 32 * nbk, 32 * nbk, nullptr, 1.f, scr, lane); continue; } q -= I_2;
            { const int kb = q / 2, nbk = q % 2; transpose_item(a.w2_v, 256, 64, W2, 256, 64 * kb, 32 * nbk, 256 + 32 * nbk, nullptr, 1.f, scr, lane); }
        }
        const int gt = vcu * 512 + tid, NGT = G * 512;
        for (int i = gt; i < 192 * 1024 / 8; i += NGT) *(u32x4*)(Win + (size_t)6208 * 1024 + (size_t)i * 8) = (u32x4){0u, 0u, 0u, 0u};
        for (int i = gt; i < 2 * 192 * 256 / 8; i += NGT) { const int half = i / (192 * 256 / 8), o = i % (192 * 256 / 8);
            *(u32x4*)(W2 + (size_t)(half * 256 + 64) * 256 + (size_t)o * 8) = (u32x4){0u, 0u, 0u, 0u}; }
        for (int m = gw; m < MTOK; m += NGW) {
            const f32x4* xr = (const f32x4*)(a.x + (size_t)m * DM) + lane; f32x4 v[4]; float s = 0.f;
#pragma unroll
            for (int j = 0; j < 4; ++j) { v[j] = xr[64 * j]; s += (v[j][0] * v[j][0] + v[j][1] * v[j][1]) + (v[j][2] * v[j][2] + v[j][3] * v[j][3]); }
            const float rstd = __builtin_amdgcn_rsqf(wave_sum(s) * (1.0f / DM) + EPS);
            u32x2* o8 = (u32x2*)(nb + (size_t)m * DM) + lane;
#pragma unroll
            for (int j = 0; j < 4; ++j) { u32x2 w; w.x = pk2(v[j][0] * rstd, v[j][1] * rstd); w.y = pk2(v[j][2] * rstd, v[j][3] * rstd); o8[64 * j] = w; }
        }
        if (bx < 2) {
            const float* pos = bx ? a.pos_v : a.pos_k; const float* w1 = bx ? a.w1_v : a.w1_k;
            const int j = tid & 255, part = tid >> 8; float s = 0.f;
            for (int k = part * 1024; k < part * 1024 + 1024; ++k) s += pos[k] * w1[(size_t)k * 256 + j];
            LAS float* red = (LAS float*)(lds + 8 * 16384);
            if (part == 1) red[j] = s;
            __syncthreads();
            if (part == 0) cbias[bx * 256 + j] = s + red[j];
        }
    }
    if (a.probe == 0x7fffffff) grid.sync();
    SEAM();
    {
        const int ncols1 = (G > 64) ? 6144 : PP;
        pg8::Gemm g{nb, Win, MTOK, ncols1, DM, DM, 128, 0}; pg8::StaticOrder S; S.init(MTOK, ncols1, G, bx);
        pg8::EpiProj E{proj, PP};
        pg8::gemm_phase(lds, g, S, E);
    }
    SEAM();
    {
        {
            pg8::Gemm g{proj + C_KC, W1, 4096, 512, 2048, 16 * PP, PP * 2, 1}; pg8::StaticOrder S; S.init(4096, 512, G, bx);
            pg8::EpiHid E{hid, cbias};
            pg8::gemm_phase(lds, g, S, E);
        }
        int wb = bx, wn = G; if (G > 64) { wb = bx - 32; wn = G - 32; }
        if (wb >= 0) {
            for (int it = wb * 512 + tid; it < MTOK * 64; it += wn * 512) {
                const int row = it >> 6, ch = (it & 63) * 8, t = row & (SEQ - 1);
                const bf16_t* pr = proj + (size_t)row * PP;
                float accv[8];
#pragma unroll
                for (int j = 0; j < 8; ++j) accv[j] = 0.f;
#pragma unroll
                for (int k = 0; k < 3; ++k) { const int dt = 2 - k;
                    if (t - dt >= 0) { const u32x4 cv = *(const u32x4*)(pr - (size_t)dt * PP + C_C + ch), hv = *(const u32x4*)(pr - (size_t)dt * PP + C_H + ch);
                        const f32x4 w0 = *(const f32x4*)(a.conv_w + k * 512 + ch), w1 = *(const f32x4*)(a.conv_w + k * 512 + ch + 4);
                        accv[0] += w0[0] * lo_bf(cv.x) * lo_bf(hv.x); accv[1] += w0[1] * hi_bf(cv.x) * hi_bf(hv.x); accv[2] += w0[2] * lo_bf(cv.y) * lo_bf(hv.y); accv[3] += w0[3] * hi_bf(cv.y) * hi_bf(hv.y);
                        accv[4] += w1[0] * lo_bf(cv.z) * lo_bf(hv.z); accv[5] += w1[1] * hi_bf(cv.z) * hi_bf(hv.z); accv[6] += w1[2] * lo_bf(cv.w) * lo_bf(hv.w); accv[7] += w1[3] * hi_bf(cv.w) * hi_bf(hv.w); } }
                const u32x4 bv = *(const u32x4*)(pr + C_B + ch);
                u32x4 o; o.x = pk2(accv[0] * lo_bf(bv.x), accv[1] * hi_bf(bv.x)); o.y = pk2(accv[2] * lo_bf(bv.y), accv[3] * hi_bf(bv.y));
                o.z = pk2(accv[4] * lo_bf(bv.z), accv[5] * hi_bf(bv.z)); o.w = pk2(accv[6] * lo_bf(bv.w), accv[7] * hi_bf(bv.w));
                *(u32x4*)(bc + (size_t)row * 512 + ch) = o;
            }
        }
        if (G > 64 && wb >= 0) {
            { pg8::Gemm g{nb, Win + (size_t)6144 * 1024, MTOK, 256, DM, DM, 128, 0}; pg8::StaticOrder S; S.init(MTOK, 256, wn, wb);
              pg8::EpiProj E{proj + 6144, PP}; pg8::gemm_phase(lds, g, S, E); }
            __syncthreads();
            LAS float* scr = (LAS float*)(lds + wave * 16384);
            constexpr int I_G = 16 * 88, I_U = 16 * 88, I_D = 44 * 32;
            for (int it = wb * 8 + wave; it < I_G + I_U + I_D; it += wn * 8) {
                int q = it;
                if (q < I_G) { const int kb = q / 88, nbk = q % 88, n0 = 32 * nbk; transpose_item(a.w_gate, 1024, DFF, Wup, 1024, 64 * kb, n0, (n0 / 128) * 256 + (n0 % 128), a.g_ffn, 1.f, scr, lane); continue; } q -= I_G;
                if (q < I_U) { const int kb = q / 88, nbk = q % 88, n0 = 32 * nbk; transpose_item(a.w_up, 1024, DFF, Wup, 1024, 64 * kb, n0, (n0 / 128) * 256 + 128 + (n0 % 128), a.g_ffn, 1.f, scr, lane); continue; } q -= I_U;
                { const int kb = q / 32, nbk = q % 32; transpose_item(a.w_down, DFF, 1024, Wdown, DFF, 64 * kb, 32 * nbk, 32 * nbk, nullptr, 1.f, scr, lane); }
            }
        }
    }
    {
        pg8::Gemm g{hid, W2, 4096, 512, 256, 256, 128, 2}; pg8::StaticOrder S; S.init(4096, 512, G, bx);
        pg8::EpiCmp E{kcmp};
        pg8::gemm_phase(lds, g, S, E);
    }
    SEAM();
    {
        for (int v = vcu; v < 256; v += G) {
            const int bh = v >> 4, s = v & 15;
#pragma unroll 1
            for (int i = 0; i < 4; ++i) { const int qb = (i == 0) ? 63 - s : (i == 1) ? 32 + s : (i == 2) ? 31 - s : s;
#if defined(PROBE_ATT2) || defined(PROBE_NOLD)
                att::attn_unit(lds, proj, kcmp, kcmp + 4096 * 64, bh, qb, a.probe);
#endif
                att::attn_unit(lds, proj, kcmp, kcmp + 4096 * 64, bh, qb, 0);
            }
        }
    }
    SEAM();
    {
        { pg8::Gemm g{bc, Wconv, MTOK, DM, 512, 512, 128, 0}; pg8::StaticOrder S; S.init(MTOK, DM, G, bx);
          pg8::EpiMix<0> E{mix, proj, C_GCONV}; pg8::gemm_phase(lds, g, S, E); }
        { pg8::Gemm g{proj + C_Q, Wattn, MTOK, DM, DM, PP, 128, 0}; pg8::StaticOrder S; S.init(MTOK, DM, G, bx);
          pg8::EpiMix<1> E{mix, proj, C_GATTN}; pg8::gemm_phase(lds, g, S, E); }
    }
    SEAM();
    {
        pg8::Gemm g{mix, Wo, MTOK, DM, DM, DM, 128, 0}; pg8::StaticOrder S; S.init(MTOK, DM, G, bx);
        pg8::EpiRes<1> E{a.x, h1f, h1b, part1}; pg8::gemm_phase(lds, g, S, E);
    }
    SEAM();
    {
        pg8::Gemm g{h1b, Wup, MTOK, 2 * DFF, DM, DM, 128, 0}; pg8::StaticOrder S; S.init(MTOK, 2 * DFF, G, bx);
        pg8::EpiUp E{act, part1}; pg8::gemm_phase(lds, g, S, E);
    }
    SEAM();
    if (G == 256) {
        pg8::Gemm g{act, Wdown, MTOK, DM, DFF, DFF, 128, 0}; pg8::StaticOrder S; S.init(MTOK, DM, G, bx);
        pg8::EpiFinal E{h1f, a.out, a.g_final, (unsigned*)part2, (unsigned*)(ws + WS_BAR) + 4096, (unsigned*)(ws + WS_BAR) + XB_TMO};
        pg8::gemm_phase(lds, g, S, E);
        return;
    }
    {
        pg8::Gemm g{act, Wdown, MTOK, DM, DFF, DFF, 128, 0}; pg8::StaticOrder S; S.init(MTOK, DM, G, bx);
        pg8::EpiRes<0> E{h1f, a.out, nullptr, part2}; pg8::gemm_phase(lds, g, S, E);
    }
    SEAM();
    {
        for (int it = bx * 512 + tid; it < MTOK * 256; it += G * 512) {
            const int row = it >> 8, c4 = (it & 255) * 4;
            const f32x4* pp = (const f32x4*)(part2 + (size_t)row * 16); float ss = 0.f;
#pragma unroll
            for (int j = 0; j < 4; ++j) { const f32x4 p = pp[j]; ss += (p[0] + p[1]) + (p[2] + p[3]); }
            const float r = __builtin_amdgcn_rsqf(ss * (1.0f / DM) + EPS);
            f32x4 v = *(f32x4*)(a.out + (size_t)row * DM + c4); const f32x4 gf = *(const f32x4*)(a.g_final + c4);
            v = v * r * gf; *(f32x4*)(a.out + (size_t)row * DM + c4) = v;
        }
    }
}

extern "C" void kernel_launch(void* const* d_in, const int* in_sizes, int n_in, void* d_out, int out_size, void* d_ws, size_t ws_size, hipStream_t stream) {
    static int grid = 0;
    if (grid == 0) {
        if (n_in != 18 || out_size != MTOK * DM || ws_size < WS_NEED) { fprintf(stderr, "kernel_launch: unexpected shapes (n_in %d out %d ws %zu)\n", n_in, out_size, ws_size); grid = -1; return; }
        int dev = 0, cus = 0, per_cu = 0;
        (void)hipGetDevice(&dev);
        (void)hipDeviceGetAttribute(&cus, hipDeviceAttributeMultiprocessorCount, dev);
        (void)hipFuncSetAttribute((const void*)nsa_fwd, hipFuncAttributeMaxDynamicSharedMemorySize, LDS_BYTES);
        (void)hipOccupancyMaxActiveBlocksPerMultiprocessor(&per_cu, (const void*)nsa_fwd, 512, LDS_BYTES);
        if (per_cu < 1) { fprintf(stderr, "kernel_launch: occupancy query says %d blocks/CU\n", per_cu); grid = -1; return; }
        grid = cus;
    }
    if (grid < 0) return;
    (void)hipMemsetAsync((unsigned char*)d_ws + WS_BAR, 0, 32768, stream);
    Args a{};
    a.x = (const float*)d_in[0]; a.w_in = (const float*)d_in[1]; a.conv_w = (const float*)d_in[2]; a.w_conv_out = (const float*)d_in[3];
    a.pos_k = (const float*)d_in[4]; a.w1_k = (const float*)d_in[5]; a.w2_k = (const float*)d_in[6];
    a.pos_v = (const float*)d_in[7]; a.w1_v = (const float*)d_in[8]; a.w2_v = (const float*)d_in[9];
    a.w_attn_out = (const float*)d_in[10]; a.w_o = (const float*)d_in[11]; a.g_mix = (const float*)d_in[12]; a.g_ffn = (const float*)d_in[13];
    a.w_gate = (const float*)d_in[14]; a.w_up = (const float*)d_in[15]; a.w_down = (const float*)d_in[16]; a.g_final = (const float*)d_in[17];
    a.out = (float*)d_out; a.ws = (unsigned char*)d_ws; a.probe = 1; a.pad = 0;
    void* args[] = {&a};
    hipError_t e = hipLaunchCooperativeKernel((void*)nsa_fwd, dim3(grid), dim3(512), args, LDS_BYTES, stream);
    if (e != hipSuccess) fprintf(stderr, "kernel_launch: cooperative launch failed: %s (grid %d)\n", hipGetErrorString(e), grid);
}
```

```cpp
#include <hip/hip_runtime.h>
#include <hip/hip_cooperative_groups.h>
#include <cstdio>
#include <cstdint>
namespace cg = cooperative_groups;

#define LAS __attribute__((address_space(3)))
typedef unsigned short bf16_t;
typedef short bf16x8 __attribute__((ext_vector_type(8)));
typedef short s16x4 __attribute__((ext_vector_type(4)));
typedef float f32x4 __attribute__((ext_vector_type(4)));
typedef float f32x16 __attribute__((ext_vector_type(16)));
typedef unsigned u32x4 __attribute__((ext_vector_type(4)));
typedef unsigned u32x2 __attribute__((ext_vector_type(2)));
typedef float f32x2_t __attribute__((ext_vector_type(2)));
typedef __bf16 bf16x2_t __attribute__((ext_vector_type(2)));

constexpr int MTOK = 16384, DM = 1024, SEQ = 4096, NB = 4;
constexpr int PP = 6400;
constexpr int INCOLS = 6192;
constexpr int C_B = 0, C_C = 512, C_H = 1024, C_Q = 1536, C_KC = 2560, C_VC = 2816, C_KS = 3072, C_VS = 3328, C_KW = 3584, C_VW = 3840,
              C_GBR = 4096, C_GCONV = 4144, C_GATTN = 5168;
constexpr int DFF = 2816;
constexpr float EPS = 1e-6f;
constexpr float LOG2E = 1.4426950408889634f;
constexpr float QSCALE = 0.125f * LOG2E;

constexpr size_t MiB = 1u << 20;
constexpr size_t WS_PART1 = 0;
constexpr size_t WS_PART2 = 1 * MiB;
constexpr size_t WS_BIAS = 2 * MiB;
constexpr size_t WS_BAR = 2 * MiB + 65536;
constexpr size_t WS_WIN = 3 * MiB;
constexpr size_t WS_WCONV = 16 * MiB;
constexpr size_t WS_WATTN = 17 * MiB;
constexpr size_t WS_WO = 19 * MiB;
constexpr size_t WS_WUP = 21 * MiB;
constexpr size_t WS_WDOWN = 32 * MiB;
constexpr size_t WS_W1 = 38 * MiB;
constexpr size_t WS_W2 = 40 * MiB;
constexpr size_t WS_HID = 41 * MiB;
constexpr size_t WS_KCMP = 45 * MiB;
constexpr size_t WS_PROJ = 46 * MiB;
constexpr size_t WS_H1F = 46 * MiB;
constexpr size_t WS_H1B = 110 * MiB;
constexpr size_t WS_ACT = 142 * MiB;
constexpr size_t WS_NEED = 246 * MiB;
constexpr size_t OUT_BC = 32 * MiB;

constexpr int LDS_BYTES = 147456;

__device__ __forceinline__ float bf2f(unsigned short v) { return __uint_as_float(((unsigned)v) << 16); }
__device__ __forceinline__ unsigned pk2(float lo, float hi) { f32x2_t v = {lo, hi}; bf16x2_t b = __builtin_convertvector(v, bf16x2_t); return __builtin_bit_cast(unsigned, b); }
__device__ __forceinline__ float ex2(float x) { return __builtin_amdgcn_exp2f(x); }
__device__ __forceinline__ float sigmoidf_(float x) { return __builtin_amdgcn_rcpf(1.0f + ex2(-x * LOG2E)); }
__device__ __forceinline__ float lo_bf(unsigned w) { return __uint_as_float(w << 16); }
__device__ __forceinline__ float hi_bf(unsigned w) { return __uint_as_float(w & 0xffff0000u); }

namespace pg8 {
constexpr int BM = 256, BK = 64, HALF = 128, HTB = HALF * BK * 2, STAGE_BYTES = 8 * HTB, NXCD = 8, WGM = 8;
__host__ __device__ __forceinline__ int lds_byte(int r, int c) { const int st = (r >> 4) * 2 + (c >> 5), rr = r & 15, cc = c & 31, ob = rr * 64 + cc * 2; return st * 1024 + (ob ^ (((ob >> 9) & 1) << 5)); }
__host__ __device__ __forceinline__ void stage_rc(int b, int& R, int& C) { const int st = b / 1024, sb = b % 1024, swz = sb ^ (((sb >> 9) & 1) << 5); R = (st >> 1) * 16 + swz / 64; C = (st & 1) * 32 + (swz % 64) / 2; }
__host__ __device__ __forceinline__ int perm32(int rho) { const int n = rho >> 4, i = rho & 15; return 8 * (i >> 2) + 4 * n + (i & 3); }

struct Unit { int pm, pn; };
struct Gemm { const bf16_t* A; const bf16_t* Bt; int M, N, K; int lda; int a_kstep; int amode; };

struct StaticOrder {
    int nM, nN, nwg, G, c;
    __host__ __device__ void init(int M, int N, int G_, int c_) { nM = M / BM; nN = N / BM; nwg = nM * nN; G = G_; c = c_; }
    __host__ __device__ bool next(int i, Unit& u) const {
        const long L = (long)i * G + c; if (L >= nwg) return false;
        int wgid = (int)L; { const int q = nwg / NXCD, r = nwg % NXCD, xcd = wgid % NXCD, off = wgid / NXCD; wgid = (xcd < r ? xcd * (q + 1) : r * (q + 1) + (xcd - r) * q) + off; }
        const int nig = WGM * nN, gid = wgid / nig, fm = gid * WGM, gsz = (nM - fm) < WGM ? (nM - fm) : WGM;
        u.pm = fm + ((wgid % nig) % gsz); u.pn = (wgid % nig) / gsz; return true;
    }
};

__device__ __forceinline__ const char* a_tile(const Gemm& g, const Unit& u) {
    if (g.amode == 1) return (const char*)g.A + ((size_t)(u.pm >> 2) * SEQ * PP + (size_t)u.pn * 256 + (size_t)(u.pm & 3) * 64) * 2;
    if (g.amode == 2) return (const char*)g.A + ((size_t)u.pn * 4096 * 256 + (size_t)u.pm * 256 * 256) * 2;
    return (const char*)g.A + (size_t)u.pm * 256 * (size_t)g.lda * 2;
}

template <class T, class = void> struct is_fused { static constexpr bool value = false; };
template <class T> struct is_fused<T, decltype((void)T::FUSED)> { static constexpr bool value = true; };
template <class Epi>
__device__ __forceinline__ void gemm_phase(LAS unsigned char* lds, const Gemm g, const StaticOrder& S, const Epi& E) {
#ifdef NO_GEMM
    return;
#endif
    int tid_ = threadIdx.x; asm volatile("" : "+v"(tid_));
    const int tid = tid_, wid = __builtin_amdgcn_readfirstlane(tid >> 6), lane = tid & 63, wr = wid >> 2, wc = wid & 3, fr = lane & 15, fq = lane >> 4;
    const int K = g.K, nt = K / BK;
    unsigned voffA[2], voffB[2];
#pragma unroll
    for (int i = 0; i < 2; ++i) { int R, C; stage_rc(tid * 16 + i * 8192, R, C); const int Rb = (R & ~31) + perm32(R & 31);
        voffA[i] = (unsigned)(R * g.lda + C) * 2u; voffB[i] = (unsigned)(Rb * K + C) * 2u; }
    const size_t kstepA = (size_t)g.a_kstep, kstepB = (size_t)(BK * 2);
    const size_t hstepA = (size_t)HALF * g.lda * 2, hstepB = (size_t)HALF * K * 2;
    const size_t tstepB = 2 * hstepB;
    const unsigned ldsw = (unsigned)wid * 1024u;
    const int aoff = lds_byte(wr * 64 + fr, fq * 8), boff = lds_byte(wc * 32 + fr, fq * 8);
#define PG8_SA(b, h) (((b) * 2 + (h)) * HTB)
#define PG8_SB(b, h) ((4 + (b) * 2 + (h)) * HTB)
#define PG8_STAGE(bufoff, gbase, voff) do { _Pragma("unroll") for (int _i = 0; _i < 2; ++_i) \
        __builtin_amdgcn_global_load_lds((const unsigned*)((const char*)(gbase) + (voff)[_i]), (LAS unsigned*)(lds + (bufoff) + ldsw + _i * 8192), 16, 0, 0); } while (0)
#define PG8_LDA(dst, b, h) do { _Pragma("unroll") for (int m = 0; m < 4; ++m) _Pragma("unroll") for (int k = 0; k < 2; ++k) dst[m][k] = *(const LAS bf16x8*)(lds + PG8_SA(b, h) + aoff + m * 2048 + k * 1024); } while (0)
#define PG8_LDB(dst, b, h) do { _Pragma("unroll") for (int n = 0; n < 2; ++n) _Pragma("unroll") for (int k = 0; k < 2; ++k) dst[n][k] = *(const LAS bf16x8*)(lds + PG8_SB(b, h) + boff + n * 2048 + k * 1024); } while (0)
#define PG8_MMA(ai, bj, At, Bt) do { __builtin_amdgcn_s_setprio(1); _Pragma("unroll") for (int m = 0; m < 4; ++m) _Pragma("unroll") for (int n = 0; n < 2; ++n) _Pragma("unroll") for (int k = 0; k < 2; ++k) \
        acc[ai][bj][m][n] = __builtin_amdgcn_mfma_f32_16x16x32_bf16(Bt[n][k], At[m][k], acc[ai][bj][m][n], 0, 0, 0); __builtin_amdgcn_s_setprio(0); } while (0)
#define PG8_WAIT_V(n) asm volatile("s_waitcnt vmcnt(" #n ")" ::: "memory")
#define PG8_WAIT_L(n) asm volatile("s_waitcnt lgkmcnt(" #n ")" ::: "memory")
#define PG8_BAR __builtin_amdgcn_s_barrier()
#define PG8_SCHED __builtin_amdgcn_sched_barrier(0)
    Unit cur, nxt; int ui = 0;
    if (!S.next(0, cur)) return;
    f32x4 acc[2][2][4][2];
#pragma unroll
    for (int a = 0; a < 2; ++a)
#pragma unroll
        for (int b = 0; b < 2; ++b)
#pragma unroll
            for (int m = 0; m < 4; ++m)
#pragma unroll
                for (int n = 0; n < 2; ++n) acc[a][b][m][n] = (f32x4){0.f, 0.f, 0.f, 0.f};
    bf16x8 At[4][2], B0[2][2], B1[2][2];
    const char* cA = a_tile(g, cur); const char* cB = (const char*)g.Bt + (size_t)cur.pn * tstepB;
    PG8_STAGE(PG8_SB(0, 0), cB, voffB); PG8_STAGE(PG8_SB(0, 1), cB + hstepB, voffB); PG8_STAGE(PG8_SA(0, 0), cA, voffA); PG8_STAGE(PG8_SA(0, 1), cA + hstepA, voffA);
    if (wr == 1) PG8_BAR;
    PG8_WAIT_V(2); PG8_BAR;
    PG8_STAGE(PG8_SB(1, 0), cB + kstepB, voffB); PG8_STAGE(PG8_SA(1, 0), cA + kstepA, voffA); PG8_STAGE(PG8_SB(1, 1), cB + hstepB + kstepB, voffB);
    PG8_WAIT_V(6); PG8_BAR;
    for (;;) {
        const bool has_next = S.next(ui + 1, nxt);
        const char* nA = has_next ? a_tile(g, nxt) : cA; const char* nB = has_next ? (const char*)g.Bt + (size_t)nxt.pn * tstepB : cB;
        for (int t = 0; t < nt; t += 2) {
            const bool last = (t == nt - 2);
            const char* a1 = cA + (size_t)(t + 1) * kstepA;
            const char* a2 = last ? nA : cA + (size_t)(t + 2) * kstepA; const char* b2 = last ? nB : cB + (size_t)(t + 2) * kstepB;
            const char* a3 = a2 + kstepA; const char* b3 = b2 + kstepB;
            PG8_LDB(B0, 0, 0); PG8_LDB(B1, 0, 1); PG8_SCHED; PG8_LDA(At, 0, 0); PG8_STAGE(PG8_SA(1, 1), a1 + hstepA, voffA);
            PG8_WAIT_V(8); PG8_WAIT_L(0); PG8_BAR; PG8_MMA(0, 0, At, B0); PG8_MMA(0, 1, At, B1); PG8_BAR; PG8_SCHED;
            PG8_LDA(At, 0, 1); PG8_STAGE(PG8_SB(0, 0), b2, voffB); PG8_STAGE(PG8_SB(0, 1), b2 + hstepB, voffB); PG8_STAGE(PG8_SA(0, 0), a2, voffA);
            PG8_WAIT_V(8); PG8_WAIT_L(0); PG8_BAR; PG8_MMA(1, 0, At, B0); PG8_MMA(1, 1, At, B1); PG8_BAR; PG8_SCHED;
            PG8_LDB(B0, 1, 0); PG8_LDB(B1, 1, 1); PG8_SCHED; PG8_LDA(At, 1, 0); PG8_STAGE(PG8_SA(0, 1), a2 + hstepA, voffA);
            PG8_WAIT_V(8); PG8_WAIT_L(0); PG8_BAR; PG8_MMA(0, 0, At, B0); PG8_MMA(0, 1, At, B1); PG8_BAR; PG8_SCHED;
            PG8_LDA(At, 1, 1); PG8_STAGE(PG8_SB(1, 0), b3, voffB); PG8_STAGE(PG8_SB(1, 1), b3 + hstepB, voffB); PG8_STAGE(PG8_SA(1, 0), a3, voffA);
            PG8_WAIT_V(8); PG8_WAIT_L(0); PG8_BAR; PG8_MMA(1, 0, At, B0); PG8_MMA(1, 1, At, B1); PG8_BAR; PG8_SCHED;
        }
        if (wr == 0) PG8_BAR;
        if constexpr (!is_fused<Epi>::value) E(acc, cur, wr, wc, fr, fq);
        if (!has_next) break;
#pragma unroll
        for (int a = 0; a < 2; ++a)
#pragma unroll
            for (int b = 0; b < 2; ++b)
#pragma unroll
                for (int m = 0; m < 4; ++m)
#pragma unroll
                    for (int n = 0; n < 2; ++n) acc[a][b][m][n] = (f32x4){0.f, 0.f, 0.f, 0.f};
        cur = nxt; cA = nA; cB = nB; ++ui;
        if (wr == 1) PG8_BAR;
    }
    PG8_WAIT_V(0);
    PG8_BAR;
    if constexpr (is_fused<Epi>::value) E.fused(acc, cur, wr, wc, fr, fq, lds, wid, lane);
#undef PG8_SA
#undef PG8_SB
#undef PG8_STAGE
#undef PG8_LDA
#undef PG8_LDB
#undef PG8_MMA
#undef PG8_WAIT_V
#undef PG8_WAIT_L
#undef PG8_BAR
#undef PG8_SCHED
}

typedef f32x4 Acc[2][2][4][2];
#define EPI_LOOP_BEGIN \
    _Pragma("unroll") for (int ai = 0; ai < 2; ++ai) _Pragma("unroll") for (int m = 0; m < 4; ++m) { const int row = u.pm * BM + wr * 64 + fr + ai * HALF + m * 16; \
    _Pragma("unroll") for (int bj = 0; bj < 2; ++bj) { const f32x4 v0 = acc[ai][bj][m][0], v1 = acc[ai][bj][m][1]; const int col = u.pn * BM + bj * HALF + wc * 32 + 8 * fq;
#define EPI_LOOP_END } }
__device__ __forceinline__ u32x4 pack8(const f32x4 a, const f32x4 b) { u32x4 w; w.x = pk2(a[0], a[1]); w.y = pk2(a[2], a[3]); w.z = pk2(b[0], b[1]); w.w = pk2(b[2], b[3]); return w; }

struct EpiProj { bf16_t* O; int ldc;
    __device__ __forceinline__ void operator()(const Acc& acc, const Unit& u, int wr, int wc, int fr, int fq) const {
        EPI_LOOP_BEGIN
            *(u32x4*)(O + (size_t)row * ldc + col) = pack8(v0, v1);
        EPI_LOOP_END
    } };
__device__ __forceinline__ float gelu_tanh(float x) {
    const float z = x * (1.0f + 0.044715f * x * x) * (2.0f * 0.7978845608028654f * LOG2E);
    return x * __builtin_amdgcn_rcpf(1.0f + ex2(-z));
}
struct EpiHid { bf16_t* O; const float* bias;
    __device__ __forceinline__ void operator()(const Acc& acc, const Unit& u, int wr, int wc, int fr, int fq) const {
        EPI_LOOP_BEGIN
            const int c = col - u.pn * BM; const float* bp = bias + u.pn * 256 + c;
            const f32x4 b0 = *(const f32x4*)bp, b1 = *(const f32x4*)(bp + 4);
            f32x4 a = v0 + b0, b = v1 + b1;
#pragma unroll
            for (int j = 0; j < 4; ++j) { a[j] = gelu_tanh(a[j]); b[j] = gelu_tanh(b[j]); }
            *(u32x4*)(O + (size_t)u.pn * 4096 * 256 + (size_t)row * 256 + c) = pack8(a, b);
        EPI_LOOP_END
    } };
struct EpiCmp { bf16_t* O;
    __device__ __forceinline__ void operator()(const Acc& acc, const Unit& u, int wr, int wc, int fr, int fq) const {
        EPI_LOOP_BEGIN
            const int c = col - u.pn * BM;
            if (c < 64) { u32x4 w = pack8(v0, v1); if ((row & 255) == 255) w = (u32x4){0u, 0u, 0u, 0u};
                *(u32x4*)(O + (size_t)u.pn * 4096 * 64 + (size_t)row * 64 + c) = w; }
        EPI_LOOP_END
    } };
template <int ADD> struct EpiMix { bf16_t* mix; const bf16_t* proj; int gcol;
    __device__ __forceinline__ void operator()(const Acc& acc, const Unit& u, int wr, int wc, int fr, int fq) const {
        EPI_LOOP_BEGIN
            const u32x4 gv = *(const u32x4*)(proj + (size_t)row * PP + gcol + col);
            f32x4 a, b;
            a[0] = sigmoidf_(lo_bf(gv.x)) * v0[0]; a[1] = sigmoidf_(hi_bf(gv.x)) * v0[1]; a[2] = sigmoidf_(lo_bf(gv.y)) * v0[2]; a[3] = sigmoidf_(hi_bf(gv.y)) * v0[3];
            b[0] = sigmoidf_(lo_bf(gv.z)) * v1[0]; b[1] = sigmoidf_(hi_bf(gv.z)) * v1[1]; b[2] = sigmoidf_(lo_bf(gv.w)) * v1[2]; b[3] = sigmoidf_(hi_bf(gv.w)) * v1[3];
            bf16_t* mp = mix + (size_t)row * DM + col;
            if (ADD) { const u32x4 pv = *(const u32x4*)mp;
                a[0] += lo_bf(pv.x); a[1] += hi_bf(pv.x); a[2] += lo_bf(pv.y); a[3] += hi_bf(pv.y); b[0] += lo_bf(pv.z); b[1] += hi_bf(pv.z); b[2] += lo_bf(pv.w); b[3] += hi_bf(pv.w); }
            *(u32x4*)mp = pack8(a, b);
        EPI_LOOP_END
    } };
template <int WB> struct EpiRes { const float* base; float* hf; bf16_t* hb; float* part;
    __device__ __forceinline__ void operator()(const Acc& acc, const Unit& u, int wr, int wc, int fr, int fq) const {
#pragma unroll
        for (int ai = 0; ai < 2; ++ai)
#pragma unroll
            for (int m = 0; m < 4; ++m) { const int row = u.pm * BM + wr * 64 + fr + ai * HALF + m * 16; float ss = 0.f;
#pragma unroll
                for (int bj = 0; bj < 2; ++bj) { const int col = u.pn * BM + bj * HALF + wc * 32 + 8 * fq; const size_t off = (size_t)row * DM + col;
                    const f32x4 x0 = *(const f32x4*)(base + off), x1 = *(const f32x4*)(base + off + 4);
                    const f32x4 a = x0 + acc[ai][bj][m][0], b = x1 + acc[ai][bj][m][1];
                    *(f32x4*)(hf + off) = a; *(f32x4*)(hf + off + 4) = b;
                    if (WB) *(u32x4*)(hb + off) = pack8(a, b);
                    ss += (a[0] * a[0] + a[1] * a[1]) + (a[2] * a[2] + a[3] * a[3]) + (b[0] * b[0] + b[1] * b[1]) + (b[2] * b[2] + b[3] * b[3]); }
                ss += __shfl_xor(ss, 16); ss += __shfl_xor(ss, 32);
                if (fq == 0) part[(size_t)row * 16 + u.pn * 4 + wc] = ss; }
    } };
struct EpiUp { bf16_t* act; const float* part;
    __device__ __forceinline__ void operator()(const Acc& acc, const Unit& u, int wr, int wc, int fr, int fq) const {
#pragma unroll
        for (int ai = 0; ai < 2; ++ai)
#pragma unroll
            for (int m = 0; m < 4; ++m) { const int row = u.pm * BM + wr * 64 + fr + ai * HALF + m * 16;
                const f32x4 pp = *(const f32x4*)(part + (size_t)row * 16 + 4 * fq); float ss = (pp[0] + pp[1]) + (pp[2] + pp[3]);
                ss += __shfl_xor(ss, 16); ss += __shfl_xor(ss, 32);
                const float r = __builtin_amdgcn_rsqf(ss * (1.0f / DM) + EPS);
                f32x4 a, b;
#pragma unroll
                for (int j = 0; j < 4; ++j) { const float g0 = acc[ai][0][m][0][j] * r, u0 = acc[ai][1][m][0][j] * r, g1 = acc[ai][0][m][1][j] * r, u1 = acc[ai][1][m][1][j] * r;
                    a[j] = g0 * sigmoidf_(g0) * u0; b[j] = g1 * sigmoidf_(g1) * u1; }
                *(u32x4*)(act + (size_t)row * DFF + u.pn * 128 + wc * 32 + 8 * fq) = pack8(a, b); }
    } };
struct EpiFinal { static constexpr bool FUSED = true;
    const float* base; float* out; const float* gfin; unsigned* xbuf; unsigned* cnt; unsigned* tmo;
    __device__ __forceinline__ void operator()(const Acc&, const Unit&, int, int, int, int) const {}
    __device__ __forceinline__ void fused(f32x4 (&acc)[2][2][4][2], const Unit& u, int wr, int wc, int fr, int fq, LAS unsigned char* lds, int wid, int lane) const {
        LAS float* P = (LAS float*)lds;
        LAS float* S = (LAS float*)(lds + 8192);
        LAS unsigned* flag = (LAS unsigned*)(lds + 8192 + 2048);
#pragma unroll
        for (int ai = 0; ai < 2; ++ai)
#pragma unroll
            for (int m = 0; m < 4; ++m) { const int rl = ai * HALF + wr * 64 + m * 16 + fr; const int row = u.pm * BM + rl; float ss = 0.f;
#pragma unroll
                for (int bj = 0; bj < 2; ++bj) { const int col = u.pn * BM + bj * HALF + wc * 32 + 8 * fq; const size_t off = (size_t)row * DM + col;
                    const f32x4 x0 = *(const f32x4*)(base + off), x1 = *(const f32x4*)(base + off + 4);
                    const f32x4 a = x0 + acc[ai][bj][m][0], b = x1 + acc[ai][bj][m][1]; acc[ai][bj][m][0] = a; acc[ai][bj][m][1] = b;
                    ss += (a[0] * a[0] + a[1] * a[1]) + (a[2] * a[2] + a[3] * a[3]) + (b[0] * b[0] + b[1] * b[1]) + (b[2] * b[2] + b[3] * b[3]); }
                ss += __shfl_xor(ss, 16); ss += __shfl_xor(ss, 32);
                if (fq == 0) P[rl * 4 + wc] = ss; }
        asm volatile("s_waitcnt lgkmcnt(0)" ::: "memory"); __builtin_amdgcn_s_barrier(); asm volatile("" ::: "memory");
        const int rl = wid * 32 + (lane & 31);
        if (lane < 32) { const float tot = (P[rl * 4 + 0] + P[rl * 4 + 1]) + (P[rl * 4 + 2] + P[rl * 4 + 3]);
            __hip_atomic_store(xbuf + ((size_t)(u.pm * BM + rl) * 4 + u.pn), __float_as_uint(tot), __ATOMIC_RELAXED, __HIP_MEMORY_SCOPE_AGENT); }
        asm volatile("s_waitcnt vmcnt(0)" ::: "memory");
        if (lane == 0) __hip_atomic_fetch_add(cnt + 64 * u.pm, 1u, __ATOMIC_RELAXED, __HIP_MEMORY_SCOPE_AGENT);
        if (wid == 0) {
            unsigned sp = 0u;
            for (;;) {
                if ((unsigned)__builtin_amdgcn_readfirstlane(__hip_atomic_load(cnt + 64 * u.pm, __ATOMIC_RELAXED, __HIP_MEMORY_SCOPE_AGENT)) >= 32u) break;
                __builtin_amdgcn_s_sleep(2);
                if (++sp > (1u << 20)) { if (lane == 0) __hip_atomic_store(tmo, 1u, __ATOMIC_RELAXED, __HIP_MEMORY_SCOPE_AGENT); break; }
            }
            __builtin_amdgcn_fence(__ATOMIC_ACQUIRE, "agent");
            if (lane == 0) flag[0] = 1u;
        }
        asm volatile("s_waitcnt vmcnt(0) lgkmcnt(0)" ::: "memory"); __builtin_amdgcn_s_barrier(); asm volatile("" ::: "memory");
        if (lane < 32) { const unsigned* sl = xbuf + (size_t)(u.pm * BM + rl) * 4; float tot = 0.f;
#pragma unroll
            for (int t = 0; t < 4; ++t) tot += __uint_as_float(__hip_atomic_load(sl + t, __ATOMIC_RELAXED, __HIP_MEMORY_SCOPE_AGENT));
            S[rl] = __builtin_amdgcn_rsqf(tot * (1.0f / DM) + EPS); }
        asm volatile("s_waitcnt lgkmcnt(0)" ::: "memory"); __builtin_amdgcn_s_barrier(); asm volatile("" ::: "memory");
#pragma unroll
        for (int bj = 0; bj < 2; ++bj) { const int col = u.pn * BM + bj * HALF + wc * 32 + 8 * fq;
            const f32x4 g0 = *(const f32x4*)(gfin + col), g1 = *(const f32x4*)(gfin + col + 4);
#pragma unroll
            for (int ai = 0; ai < 2; ++ai)
#pragma unroll
                for (int m = 0; m < 4; ++m) { const int rl2 = ai * HALF + wr * 64 + m * 16 + fr; const float rs = S[rl2]; const size_t off = (size_t)(u.pm * BM + rl2) * DM + col;
                    *(f32x4*)(out + off) = acc[ai][bj][m][0] * rs * g0; *(f32x4*)(out + off + 4) = acc[ai][bj][m][1] * rs * g1; } }
    } };
}

namespace att {
constexpr int KB0 = 0, VB0 = 24576, IMP = 49152, IMPW = 65, SELM = IMP + 4 * 64 * IMPW * 4, WMASK = SELM + 512, WSF = WMASK + 64, STEPS = WSF + 8 * 32 * 4, ATT_LDS = STEPS + 8 * 128;
static_assert(ATT_LDS <= 143360, "attention LDS");
#define MFMA32(a, b, c) __builtin_amdgcn_mfma_f32_32x32x16_bf16((a), (b), (c), 0, 0, 0)
__device__ __forceinline__ int crow(int r, int hi) { return (r & 3) + 8 * (r >> 2) + 4 * hi; }
typedef short v4i16_t __attribute__((ext_vector_type(4)));
__device__ __forceinline__ s16x4 vtr(LAS const unsigned char* p) { return __builtin_bit_cast(s16x4, __builtin_amdgcn_ds_read_tr16_b64_v4i16((LAS v4i16_t*)p)); }

struct St { float m, l; f32x16 o0, o1; };

__device__ __forceinline__ void qk_tile(f32x16& p0, f32x16& p1, LAS const unsigned char* kb, const bf16x8* qf, int r, int h) {
    bf16x8 k0[4], k1[4], qv[4];
#pragma unroll
    for (int d0 = 0; d0 < 4; ++d0) { k0[d0] = *(const LAS bf16x8*)(kb + (2 * d0 + h) * 1024 + r * 16); k1[d0] = *(const LAS bf16x8*)(kb + (2 * d0 + h) * 1024 + 512 + r * 16);
        qv[d0] = qf[d0]; }
#pragma unroll
    for (int i = 0; i < 16; ++i) { p0[i] = 0.f; p1[i] = 0.f; }
    __builtin_amdgcn_sched_barrier(0);
#pragma unroll
    for (int d0 = 0; d0 < 4; ++d0) { p0 = MFMA32(k0[d0], qv[d0], p0); p1 = MFMA32(k1[d0], qv[d0], p1); }
}
__device__ __forceinline__ void apply_mask(f32x16& p0, f32x16& p1, unsigned long long allow, int h) {
    if (__all(allow == ~0ull)) return;
    const unsigned long long a = allow >> (4 * h); const unsigned lo = (unsigned)a, hi = (unsigned)(a >> 32);
#pragma unroll
    for (int i = 0; i < 16; ++i) { const int cb = (i & 3) + 8 * (i >> 2);
        p0[i] = ((lo >> cb) & 1u) ? p0[i] : -INFINITY; p1[i] = ((hi >> cb) & 1u) ? p1[i] : -INFINITY; }
}
__device__ __forceinline__ float rowmax32(const f32x16& p0, const f32x16& p1) {
    float a = fmaxf(p0[0], p1[0]);
#pragma unroll
    for (int i = 1; i < 16; ++i) a = fmaxf(a, fmaxf(p0[i], p1[i]));
    return fmaxf(a, __shfl_xor(a, 32));
}
__device__ __forceinline__ void pv_tile(f32x16& o0, f32x16& o1, LAS const unsigned char* vb, const f32x16& p0, const f32x16& p1, int lane, int h) {
    bf16x8 pa[4];
#pragma unroll
    for (int s = 0; s < 4; ++s) { u32x4 w;
#pragma unroll
        for (int j = 0; j < 4; ++j) { const int i0 = 8 * (s & 1) + 2 * j; w[j] = (s < 2) ? pk2(p0[i0], p0[i0 + 1]) : pk2(p1[i0], p1[i0 + 1]); }
        pa[s] = __builtin_bit_cast(bf16x8, w); }
    LAS const unsigned char* vp = vb + ((lane >> 4) & 1) * 32 + (lane & 3) * 8 + (4 * h + ((lane & 15) >> 2)) * 64;
    s16x4 l0[4], h0[4], l1[4], h1[4];
#pragma unroll
    for (int s = 0; s < 4; ++s) { l0[s] = vtr(vp + s * 1024); h0[s] = vtr(vp + s * 1024 + 512); l1[s] = vtr(vp + 4096 + s * 1024); h1[s] = vtr(vp + 4096 + s * 1024 + 512); }
    __builtin_amdgcn_sched_barrier(0);
#pragma unroll
    for (int s = 0; s < 4; ++s) {
        const bf16x8 v0 = (bf16x8){l0[s][0], l0[s][1], l0[s][2], l0[s][3], h0[s][0], h0[s][1], h0[s][2], h0[s][3]};
        const bf16x8 v1 = (bf16x8){l1[s][0], l1[s][1], l1[s][2], l1[s][3], h1[s][0], h1[s][1], h1[s][2], h1[s][3]};
        o0 = MFMA32(pa[s], v0, o0); o1 = MFMA32(pa[s], v1, o1);
    }
}
__device__ __forceinline__ void tile_online(St& st, LAS const unsigned char* kb, LAS const unsigned char* vb, const bf16x8* qr, unsigned long long allow,
                                            LAS float* wsf, int lane, int r, int h) {
    f32x16 p0, p1; qk_tile(p0, p1, kb, qr, r, h); __builtin_amdgcn_sched_barrier(0); apply_mask(p0, p1, allow, h);
    const float rm = rowmax32(p0, p1), mnew = fmaxf(st.m, rm), f = ex2(st.m - mnew); st.m = mnew;
    float ls = 0.f;
#pragma unroll
    for (int i = 0; i < 16; ++i) { p0[i] = ex2(p0[i] - mnew); p1[i] = ex2(p1[i] - mnew); ls += p0[i] + p1[i]; }
    st.l = st.l * f + ls;
    if (__any(f != 1.0f)) {
        if (h == 0) wsf[r] = f;
#pragma unroll
        for (int i = 0; i < 16; ++i) { const float fi = wsf[crow(i, h)]; st.o0[i] *= fi; st.o1[i] *= fi; }
    }
    pv_tile(st.o0, st.o1, vb, p0, p1, lane, h);
}
__device__ __forceinline__ void tile_stats(float& m, float& l, LAS const unsigned char* kb, const bf16x8* qr, unsigned long long allow, int r, int h) {
    f32x16 p0, p1; qk_tile(p0, p1, kb, qr, r, h); __builtin_amdgcn_sched_barrier(0); apply_mask(p0, p1, allow, h);
    const float rm = rowmax32(p0, p1), mnew = fmaxf(m, rm), f = ex2(m - mnew); m = mnew;
    float ls = 0.f;
#pragma unroll
    for (int i = 0; i < 16; ++i) ls += ex2(p0[i] - mnew) + ex2(p1[i] - mnew);
    l = l * f + ls;
}
__device__ __forceinline__ void tile_exact(f32x16& o0, f32x16& o1, float m, float invl, LAS const unsigned char* kb, LAS const unsigned char* vb, const bf16x8* qr,
                                           unsigned long long allow, LAS float* impw  , float& carry, int j, int lane, int r, int h) {
    f32x16 p0, p1; qk_tile(p0, p1, kb, qr, r, h); __builtin_amdgcn_sched_barrier(0); apply_mask(p0, p1, allow, h);
#pragma unroll
    for (int i = 0; i < 16; ++i) { p0[i] = ex2(p0[i] - m) * invl; p1[i] = ex2(p1[i] - m) * invl; }
#pragma unroll
    for (int pos = 0; pos < 8; ++pos) {
        const int half = pos >> 2, r4 = pos & 3;
        const float P0 = half ? p1[4 * r4] : p0[4 * r4], P1 = half ? p1[4 * r4 + 1] : p0[4 * r4 + 1], P2 = half ? p1[4 * r4 + 2] : p0[4 * r4 + 2], P3 = half ? p1[4 * r4 + 3] : p0[4 * r4 + 3];
        const float a = (P0 + P1) + (P2 + 0.5f * P3), b = 0.5f * P3;
        const float bx = __shfl_xor(b, 32);
        const float add = h ? bx : carry;
        impw[16 * j + 2 * pos + h] = a + add;
        carry = bx;
    }
    pv_tile(o0, o1, vb, p0, p1, lane, h);
}

__device__ __forceinline__ void qk_tile_c(f32x16& p0, f32x16& p1, LAS const unsigned char* kb, const bf16x8* qf, const f32x16& c, int r, int h) {
    bf16x8 k0[4], k1[4], qv[4];
#pragma unroll
    for (int d0 = 0; d0 < 4; ++d0) { k0[d0] = *(const LAS bf16x8*)(kb + (2 * d0 + h) * 1024 + r * 16); k1[d0] = *(const LAS bf16x8*)(kb + (2 * d0 + h) * 1024 + 512 + r * 16);
        qv[d0] = qf[d0]; }
    __builtin_amdgcn_sched_barrier(0);
    p0 = MFMA32(k0[0], qv[0], c); p1 = MFMA32(k1[0], qv[0], c);
#pragma unroll
    for (int d0 = 1; d0 < 4; ++d0) { p0 = MFMA32(k0[d0], qv[d0], p0); p1 = MFMA32(k1[d0], qv[d0], p1); }
}
__device__ __forceinline__ unsigned long long lowmask(int n);
__device__ __forceinline__ void soft_pv(St& st, f32x16& x0, f32x16& x1, float cx, LAS const unsigned char* vb, bool first, int kind, int tq,
                                        LAS float* wsf, int lane, int r, int h) {
    if (first) st.m = cx;
    else { const float d = st.m - cx;
        if (__any(d != 0.f)) {
#pragma unroll
            for (int i = 0; i < 16; ++i) { x0[i] -= d; x1[i] -= d; } } }
    if (kind) apply_mask(x0, x1, kind == 1 ? lowmask(tq + 1) : ~lowmask(tq + 1), h);
    const float rm = rowmax32(x0, x1);
    if (first) {
        const float dl = (rm > -INFINITY) ? rm : 0.f; st.m += dl;
#pragma unroll
        for (int i = 0; i < 16; ++i) { x0[i] -= dl; x1[i] -= dl; }
    } else if (__any(rm > 8.0f)) {
        const float dl = fmaxf(rm, 0.f), f = ex2(-dl); st.m += dl; st.l *= f;
        if (h == 0) wsf[r] = f;
#pragma unroll
        for (int i = 0; i < 16; ++i) { x0[i] -= dl; x1[i] -= dl; }
#pragma unroll
        for (int i = 0; i < 16; ++i) { const float fi = wsf[crow(i, h)]; st.o0[i] *= fi; st.o1[i] *= fi; }
    }
    float ls = 0.f;
#pragma unroll
    for (int i = 0; i < 16; ++i) { x0[i] = ex2(x0[i]); x1[i] = ex2(x1[i]); ls += x0[i] + x1[i]; }
    st.l += ls;
    pv_tile(st.o0, st.o1, vb, x0, x1, lane, h);
}
__device__ __forceinline__ unsigned long long lowmask(int n) { return n >= 64 ? ~0ull : ((1ull << n) - 1ull); }

typedef LAS const char* lds_cptr;
__device__ __forceinline__ void hs_glds16(const void* gsrc, unsigned lds_dst) { unsigned keep;
    asm volatile("s_mov_b32 %0, m0\n\ts_mov_b32 m0, %2\n\ts_nop 0\n\tglobal_load_lds_dwordx4 %1, off\n\ts_mov_b32 m0, %0" : "=&s"(keep) : "v"(gsrc), "s"(lds_dst) : "memory"); }
__device__ __forceinline__ float hs_max3f(float a, float b, float c) { float r; asm("v_max3_f32 %0, %1, %2, %3" : "=v"(r) : "v"(a), "v"(b), "v"(c)); return r; }
__device__ __forceinline__ float hs_max2f(float a, float b) { float r; asm("v_max_f32_e32 %0, %1, %2" : "=v"(r) : "v"(a), "v"(b)); return r; }
__device__ __forceinline__ float hs_fadd(float a, float b) { float r; asm("v_add_f32_e32 %0, %1, %2" : "=v"(r) : "v"(a), "v"(b)); return r; }
__device__ __forceinline__ float hs_fsub(float a, float b) { float r; asm("v_sub_f32_e32 %0, %1, %2" : "=v"(r) : "v"(a), "v"(b)); return r; }
#define HS_SBAR() __builtin_amdgcn_sched_barrier(0)
#define HS_WAIT_BAR(N) asm volatile("s_waitcnt vmcnt(" #N ") lgkmcnt(0)\n\ts_barrier" ::: "memory")
__device__ __forceinline__ void hs_qkt(f32x16& p0, f32x16& p1, const char* Kslot, const bf16x8* qr, const f32x16& negm, int r32, int hi) {
    const char* kb = Kslot + hi * 1024 + r32 * 16;
#pragma unroll
    for (int d0 = 0; d0 < 4; ++d0) {
        const bf16x8 b0 = *reinterpret_cast<const bf16x8*>(kb + d0 * 2048);
        const bf16x8 b1 = *reinterpret_cast<const bf16x8*>(kb + d0 * 2048 + 512);
        if (d0 == 0) { p0 = MFMA32(b0, qr[0], negm); p1 = MFMA32(b1, qr[0], negm); }
        else { p0 = MFMA32(b0, qr[d0], p0); p1 = MFMA32(b1, qr[d0], p1); } }
}
__device__ __forceinline__ void hs_kload8(bf16x8* kf, lds_cptr kp) {
    kf[0] = *(const LAS bf16x8*)(kp);        kf[1] = *(const LAS bf16x8*)(kp + 512);
    kf[2] = *(const LAS bf16x8*)(kp + 2048); kf[3] = *(const LAS bf16x8*)(kp + 2560);
    kf[4] = *(const LAS bf16x8*)(kp + 4096); kf[5] = *(const LAS bf16x8*)(kp + 4608);
    kf[6] = *(const LAS bf16x8*)(kp + 6144); kf[7] = *(const LAS bf16x8*)(kp + 6656);
}
__device__ __forceinline__ void hs_kload2(bf16x8* kf, lds_cptr kp, int j) { kf[2 * j] = *(const LAS bf16x8*)(kp + j * 2048); kf[2 * j + 1] = *(const LAS bf16x8*)(kp + j * 2048 + 512); }
__device__ __forceinline__ s16x4 hs_vtr(lds_cptr p) { return __builtin_bit_cast(s16x4, __builtin_amdgcn_ds_read_tr16_b64_v4i16((LAS v4i16_t*)p)); }
__device__ __forceinline__ float hs_rowmax(const f32x16& p0, const f32x16& p1) {
    float a = hs_max3f(p0[0], p0[1], p1[0]), b = hs_max3f(p0[2], p0[3], p1[1]); a = hs_max3f(a, p1[2], p1[3]);
#pragma unroll
    for (int r = 4; r < 16; r += 4) { a = hs_max3f(a, p0[r], p0[r + 1]); b = hs_max3f(b, p0[r + 2], p0[r + 3]); a = hs_max3f(a, p1[r], p1[r + 1]); b = hs_max3f(b, p1[r + 2], p1[r + 3]); }
    const float m = hs_max2f(a, b);
    auto rr = __builtin_amdgcn_permlane32_swap(__float_as_uint(m), __float_as_uint(m), false, false);
    return hs_max2f(__uint_as_float(rr[0]), __uint_as_float(rr[1]));
}
__device__ __forceinline__ void hs_pv(f32x16* o, int vb, bf16x8 pa0, bf16x8 pa1, bf16x8 pa2, bf16x8 pa3) {
#pragma unroll
    for (int d0 = 0; d0 < 2; ++d0) { s16x4 lo[4], hi[4];
#pragma unroll
        for (int ks = 0; ks < 4; ++ks) {
            asm volatile("ds_read_b64_tr_b16 %0,%1 offset:%c2" : "=&v"(lo[ks]) : "v"(vb), "i"(d0 * 4096 + ks * 1024) : "memory");
            asm volatile("ds_read_b64_tr_b16 %0,%1 offset:%c2" : "=&v"(hi[ks]) : "v"(vb), "i"(d0 * 4096 + ks * 1024 + 512) : "memory"); }
        asm volatile("s_waitcnt lgkmcnt(0)" ::: "memory"); HS_SBAR();
#define HS_PK(k) (bf16x8){lo[k][0], lo[k][1], lo[k][2], lo[k][3], hi[k][0], hi[k][1], hi[k][2], hi[k][3]}
        o[d0] = MFMA32(pa0, HS_PK(0), o[d0]); o[d0] = MFMA32(pa1, HS_PK(1), o[d0]); o[d0] = MFMA32(pa2, HS_PK(2), o[d0]); o[d0] = MFMA32(pa3, HS_PK(3), o[d0]);
#undef HS_PK
    }
}
template <int THRL> __device__ __forceinline__ void run_branch(char* shm, const bf16x8* qr, const bf16_t* ksb, LAS const unsigned char* steps, const int NT,
                                                               const int qb, f32x16* o, float& l_out, const int wid, const int lane) {
    constexpr int SLOTB = 8192, NSLOT = 3;
    { unsigned long long p_ = (unsigned long long)ksb; asm volatile("" : "+s"(p_)); ksb = (const bf16_t*)p_; }
    const int r32 = lane & 31, hi = lane >> 5, tq = (wid & 1) * 32 + r32;
    const unsigned lds0 = (unsigned)(uintptr_t)shm;
    const unsigned long long mysel = *((LAS const unsigned long long*)((lds_cptr)shm + SELM) + tq);
    const int vcodes = (int)steps[lane];
    float* wsf = (float*)(shm + WSF) + wid * 32;
    const size_t koff = (size_t)lane * PP + wid * 8, voff = (size_t)(16 * (wid & 3) + (lane >> 2)) * PP + (wid >> 2) * 32 + (lane & 3) * 8 + (C_VS - C_KS);
    const unsigned kdst = lds0 + KB0 + wid * 1024, vdst = lds0 + VB0 + wid * 1024;
#define HS_CODE(t) ((int)__builtin_amdgcn_readlane(vcodes, (t)))
#define HS_SRC(c) (ksb + (size_t)(((c) & 0x80) ? (C_KW - C_KS) : 0) + (size_t)(((c) == 0x7f) ? 0 : ((c) & 0x7f)) * 64 * PP)
#define DMA_K(t, slot) do { const int c_ = HS_CODE(t); hs_glds16(HS_SRC(c_) + koff, (unsigned)__builtin_amdgcn_readfirstlane(kdst + (slot))); } while (0)
#define DMA_V(t, slot) do { const int c_ = HS_CODE(t); hs_glds16(HS_SRC(c_) + voff, (unsigned)__builtin_amdgcn_readfirstlane(vdst + (slot))); } while (0)
    const int vb0 = (int)(lds0 + VB0) + ((lane >> 4) & 1) * 32 + (lane & 3) * 8 + (4 * hi + ((lane & 15) >> 2)) * 64;
    const char* Kbase = shm + KB0; bf16x8 kf[8];
    const lds_cptr shm3 = (lds_cptr)shm; const lds_cptr kp0 = shm3 + KB0 + hi * 1024 + r32 * 16; const lds_cptr vp0 = shm3 + VB0 + ((lane >> 4) & 1) * 32 + (lane & 3) * 8 + (4 * hi + ((lane & 15) >> 2)) * 64;
    DMA_K(0, 0); DMA_V(0, 0); DMA_K(1, SLOTB);
    float mhat = 0.f, l_reg = 0.f; f32x16 negm;
    { float z = 0.f; asm volatile("" : "+v"(z));
#pragma unroll
      for (int i = 0; i < 16; ++i) { o[0][i] = z; o[1][i] = z; negm[i] = z; } }
    asm volatile("" : "+v"(negm));
#define CMASK(P0, P1, t) do { const int c_ = HS_CODE(t); const bool isw_ = (c_ & 0x80) != 0; const int jj_ = c_ & 0x7f; \
        const bool en_ = isw_ ? true : ((c_ != 0x7f) && (((mysel >> (jj_ & 63)) & 1ull) != 0ull)); \
        if (__any(!en_)) { if (!en_) { _Pragma("unroll") for (int r = 0; r < 16; ++r) { P0[r] = -INFINITY; P1[r] = -INFINITY; } } } \
        int kind_ = 0; if (c_ != 0x7f) { if (jj_ == qb) kind_ = 1; else if (isw_ && jj_ == qb - 8) kind_ = 2; } \
        if (kind_) apply_mask(P0, P1, kind_ == 1 ? lowmask(tq + 1) : ~lowmask(tq + 1), hi); } while (0)
    bool resc = false;
#define START(P0, P1) do { const float rm = hs_rowmax(P0, P1); resc = false; \
        { const float dl = (rm > -INFINITY) ? rm : 0.f; mhat = hs_fadd(mhat, dl); \
          _Pragma("unroll") for (int r = 0; r < 16; ++r) { P0[r] = hs_fsub(P0[r], dl); P1[r] = hs_fsub(P1[r], dl); } \
          _Pragma("unroll") for (int r = 0; r < 16; ++r) negm[r] = -mhat; asm volatile("" : "+v"(negm)); } \
        _Pragma("unroll") for (int r = 0; r < 16; ++r) P0[r] = __builtin_amdgcn_exp2f(P0[r]); } while (0)
#define RESC() do { if (resc) { asm volatile("s_waitcnt lgkmcnt(0)" ::: "memory"); \
        _Pragma("unroll") for (int d_ = 0; d_ < 2; ++d_) _Pragma("unroll") for (int r = 0; r < 16; ++r) o[d_][r] *= wsf[crow(r, hi)]; } } while (0)
    f32x16 pA0, pA1, pB0, pB1;
    int sl_prev = 0, sl_cur = 0, sl_next = SLOTB;
#define ROT() do { sl_prev = sl_cur; sl_cur = sl_next; sl_next = (sl_next == (NSLOT - 1) * SLOTB) ? 0 : sl_next + SLOTB; } while (0)
    DMA_K(2, 2 * SLOTB);
    HS_WAIT_BAR(3);
    hs_qkt(pA0, pA1, Kbase, qr, negm, r32, hi); asm volatile("s_nop 15\n\ts_nop 7" : "+v"(pA0), "+v"(pA1)); CMASK(pA0, pA1, 0);
    START(pA0, pA1);
    _Pragma("unroll") for (int r = 0; r < 16; ++r) pA1[r] = __builtin_amdgcn_exp2f(pA1[r]);
    HS_WAIT_BAR(0);
    DMA_K(3, 0); DMA_V(1, SLOTB);
    ROT();
    hs_kload8(kf, kp0 + sl_cur);
    HS_WAIT_BAR(2);
    s16x4 vlo[8], vhi[8]; u32x4 pw0, pw1, pw2, pw3;
#define PKW(P, B) pk2(P[B], P[B + 1])
#define PAF(k) __builtin_bit_cast(bf16x8, pw##k)
#define VFR(i) (bf16x8){vlo[i][0], vlo[i][1], vlo[i][2], vlo[i][3], vhi[i][0], vhi[i][1], vhi[i][2], vhi[i][3]}
#define PIN(x) asm volatile("" : "+v"(x))
#define MX3(a, b, c) __builtin_fmaxf(__builtin_fmaxf((a), (b)), (c))
#define GAPA(MF, A0, A1, A2, A3, W0, W1, PW) do { MF; sacc += A0; sacc += A1; sacc += A2; sacc += A3; PIN(sacc); W0; W1; PIN(PW); HS_SBAR(); } while (0)
#define EX(v) __builtin_amdgcn_exp2f(v)
#define GAPB(MF, X, B) do { MF; X[B] = EX(X[B]); X[B + 1] = EX(X[B + 1]); X[B + 2] = EX(X[B + 2]); X[B + 3] = EX(X[B + 3]); PIN(X); HS_SBAR(); } while (0)
#define VRD(i) do { vlo[i] = hs_vtr(vp_ + (((i) >> 2) * 4096 + ((i) & 3) * 1024)); vhi[i] = hs_vtr(vp_ + (((i) >> 2) * 4096 + ((i) & 3) * 1024 + 512)); } while (0)
#define KRD(G, j) do { if (G) { hs_kload2(kf, kp0 + sl_next, j); HS_SBAR(); } } while (0)
#define STEP(C0, C1, P0, P1, t, GK, GV, GL) do { HS_SBAR(); \
        const lds_cptr vp_ = vp0 + sl_prev; \
        VRD(0); HS_SBAR(); float sacc = (P0[0] + P0[1]); \
        GAPA(C0 = MFMA32(kf[0], qr[0], negm), P0[2], P0[3], P0[4], P0[5],     pw0[0] = PKW(P0, 0), pw0[1] = PKW(P0, 2), pw0); \
        VRD(4); HS_SBAR(); GAPA(C1 = MFMA32(kf[1], qr[0], negm), P0[6], P0[7], P0[8], P0[9],     pw0[2] = PKW(P0, 4), pw0[3] = PKW(P0, 6), pw0); \
        VRD(1); HS_SBAR(); GAPA(C0 = MFMA32(kf[2], qr[1], C0),   P0[10], P0[11], P0[12], P0[13], pw1[0] = PKW(P0, 8), pw1[1] = PKW(P0, 10), pw1); \
        VRD(5); HS_SBAR(); GAPA(C1 = MFMA32(kf[3], qr[1], C1),   P0[14], P0[15], P1[0], P1[1],   pw1[2] = PKW(P0, 12), pw1[3] = PKW(P0, 14), pw1); \
        VRD(2); HS_SBAR(); GAPA(C0 = MFMA32(kf[4], qr[2], C0),   P1[2], P1[3], P1[4], P1[5],     pw2[0] = PKW(P1, 0), pw2[1] = PKW(P1, 2), pw2); \
        VRD(6); HS_SBAR(); GAPA(C1 = MFMA32(kf[5], qr[2], C1),   P1[6], P1[7], P1[8], P1[9],     pw2[2] = PKW(P1, 4), pw2[3] = PKW(P1, 6), pw2); \
        VRD(3); HS_SBAR(); GAPA(C0 = MFMA32(kf[6], qr[3], C0),   P1[10], P1[11], P1[12], P1[13], pw3[0] = PKW(P1, 8), pw3[1] = PKW(P1, 10), pw3); \
        VRD(7); HS_SBAR(); GAPA(C1 = MFMA32(kf[7], qr[3], C1),   P1[14], P1[15], 0.f, 0.f,       pw3[2] = PKW(P1, 12), pw3[3] = PKW(P1, 14), pw3); \
        l_reg += sacc; \
        if (GK) { DMA_K((t) + 3, sl_cur); } if (GV) { DMA_V((t) + 1, sl_next); } \
        CMASK(C0, C1, t); \
        { float a = MX3(C0[0], C0[1], C1[0]), b = MX3(C0[2], C0[3], C1[1]); a = MX3(a, C1[2], C1[3]); \
          _Pragma("unroll") for (int r = 4; r < 16; r += 4) { a = MX3(a, C0[r], C0[r + 1]); b = MX3(b, C0[r + 2], C0[r + 3]); a = MX3(a, C1[r], C1[r + 1]); b = MX3(b, C1[r + 2], C1[r + 3]); } \
          float rm = __builtin_fmaxf(a, b); { auto rr = __builtin_amdgcn_permlane32_swap(__float_as_uint(rm), __float_as_uint(rm), false, false); rm = __builtin_fmaxf(__uint_as_float(rr[0]), __uint_as_float(rr[1])); } \
          resc = false; \
          if (__builtin_expect(__any(rm > (float)THRL), 0)) { const float dl = __builtin_fmaxf(rm, 0.f); mhat += dl; \
            _Pragma("unroll") for (int r = 0; r < 16; ++r) { C0[r] -= dl; C1[r] -= dl; } \
            _Pragma("unroll") for (int r = 0; r < 16; ++r) negm[r] = -mhat; asm volatile("" : "+v"(negm)); \
            const float f = __builtin_amdgcn_exp2f(-dl); l_reg *= f; if (hi == 0) wsf[r32] = f; resc = true; } } \
        HS_SBAR(); \
        GAPB(o[0] = MFMA32(PAF(0), VFR(0), o[0]), C0, 0); \
        GAPB(o[1] = MFMA32(PAF(0), VFR(4), o[1]), C0, 4); \
        KRD(GL, 0); GAPB(o[0] = MFMA32(PAF(1), VFR(1), o[0]), C0, 8); \
        KRD(GL, 1); GAPB(o[1] = MFMA32(PAF(1), VFR(5), o[1]), C0, 12); \
        KRD(GL, 2); GAPB(o[0] = MFMA32(PAF(2), VFR(2), o[0]), C1, 0); \
        KRD(GL, 3); GAPB(o[1] = MFMA32(PAF(2), VFR(6), o[1]), C1, 4); \
        GAPB(o[0] = MFMA32(PAF(3), VFR(3), o[0]), C1, 8); \
        GAPB(o[1] = MFMA32(PAF(3), VFR(7), o[1]), C1, 12); \
    } while (0)
    int t = 1;
    for (; t + 5 < NT; t += 2) {
        STEP(pB0, pB1, pA0, pA1, t, true, true, true);     HS_WAIT_BAR(2); RESC(); ROT();
        STEP(pA0, pA1, pB0, pB1, t + 1, true, true, true); HS_WAIT_BAR(2); RESC(); ROT();
    }
#define ENDW(tt) do { if ((tt) + 3 < NT) { HS_WAIT_BAR(2); } else if ((tt) + 2 < NT) { HS_WAIT_BAR(1); } else { HS_WAIT_BAR(0); } } while (0)
    for (; t + 1 < NT; t += 2) {
        STEP(pB0, pB1, pA0, pA1, t, (t + 3 < NT), (t + 1 < NT), (t + 1 < NT));         ENDW(t);     RESC(); ROT();
        STEP(pA0, pA1, pB0, pB1, t + 1, (t + 4 < NT), (t + 2 < NT), (t + 2 < NT));     ENDW(t + 1); RESC(); ROT();
    }
#define DRAIN(PX0, PX1, SL) do { float sacc = PX0[0] + PX0[1]; _Pragma("unroll") for (int r = 2; r < 16; ++r) sacc += PX0[r]; _Pragma("unroll") for (int r = 0; r < 16; ++r) sacc += PX1[r]; l_reg += sacc; \
      pw0 = (u32x4){PKW(PX0, 0), PKW(PX0, 2), PKW(PX0, 4), PKW(PX0, 6)}; pw1 = (u32x4){PKW(PX0, 8), PKW(PX0, 10), PKW(PX0, 12), PKW(PX0, 14)}; \
      pw2 = (u32x4){PKW(PX1, 0), PKW(PX1, 2), PKW(PX1, 4), PKW(PX1, 6)}; pw3 = (u32x4){PKW(PX1, 8), PKW(PX1, 10), PKW(PX1, 12), PKW(PX1, 14)}; \
      HS_SBAR(); hs_pv(o, vb0 + (SL), PAF(0), PAF(1), PAF(2), PAF(3)); } while (0)
    if (NT & 1) {
        DRAIN(pA0, pA1, sl_prev);
    } else {
        STEP(pB0, pB1, pA0, pA1, NT - 1, false, false, false); RESC();
        DRAIN(pB0, pB1, sl_cur);
    }
#undef DRAIN
    { auto rr = __builtin_amdgcn_permlane32_swap(__float_as_uint(l_reg), __float_as_uint(l_reg), false, false); l_out = __uint_as_float(rr[0]) + __uint_as_float(rr[1]); }
    asm volatile("s_waitcnt lgkmcnt(0)\n\ts_barrier" ::: "memory");
#undef PKW
#undef PAF
#undef VFR
#undef PIN
#undef MX3
#undef GAPA
#undef GAPB
#undef EX
#undef VRD
#undef KRD
#undef STEP
#undef ENDW
#undef DMA_K
#undef DMA_V
#undef CMASK
#undef START
#undef RESC
#undef ROT
#undef HS_CODE
#undef HS_SRC
}
__device__ __forceinline__ void attn_unit(LAS unsigned char* lds, bf16_t* proj, const bf16_t* kcmp, const bf16_t* vcmp, int bh, int qb, int skipw) {
    int tid_ = threadIdx.x; asm volatile("" : "+v"(tid_));
    const int tid = tid_, lane = tid & 63, r = lane & 31, h = lane >> 5, wid = __builtin_amdgcn_readfirstlane(tid >> 6);
    const int b = bh >> 2, hk = bh & 3, g = wid >> 1, tq = (wid & 1) * 32 + r;
    const size_t row = (size_t)b * SEQ + (size_t)qb * 64 + tq;
    const int t = qb * 64 + tq;
    bf16_t* qp = proj + row * PP + C_Q + (hk * 4 + g) * 64;
    bf16x8 qreg[4];
#pragma unroll
    for (int d0 = 0; d0 < 4; ++d0) qreg[d0] = *(const bf16x8*)(qp + d0 * 16 + h * 8);
    const bf16x8* qr = qreg;
    float gate[3];
#pragma unroll
    for (int c = 0; c < 3; ++c) gate[c] = sigmoidf_(bf2f(proj[row * PP + C_GBR + c * 16 + hk * 4 + g]));
#ifdef GATE2X
    if (GATE2X & 1) gate[0] *= 2.f; if (GATE2X & 2) gate[1] *= 2.f; if (GATE2X & 4) gate[2] *= 2.f;
#endif
#ifdef GATEZ
    if (GATEZ & 1) gate[0] = 0.f; if (GATEZ & 2) gate[1] = 0.f; if (GATEZ & 4) gate[2] = 0.f;
#endif
    LAS float* wsf = (LAS float*)(lds + WSF) + wid * 32;
    LAS float* impw = (LAS float*)(lds + IMP) + (g * 64 + tq) * IMPW;
    const size_t krow = lane, kcol = wid * 8;
    const size_t vrow = 16 * (wid & 3) + (lane >> 2), vcol = 32 * (wid >> 2) + 8 * (lane & 3);
    LAS unsigned char* kst = lds + KB0 + wid * 1024 + lane * 16;
    LAS unsigned char* vst = lds + VB0 + wid * 1024 + lane * 16;
    u32x4 kreg, vreg;
    LAS float* osl = (LAS float*)(lds + IMP + wid * (32 * IMPW * 4)) + lane;
#define LDK(base, pitch) kreg = *(const u32x4*)((base) + krow * (size_t)(pitch) + kcol)
#define LDV(base, pitch) vreg = *(const u32x4*)((base) + vrow * (size_t)(pitch) + vcol)
#define STK(buf) *(LAS u32x4*)(kst + (buf) * 8192) = kreg
#define STV(buf) *(LAS u32x4*)(vst + (buf) * 8192) = vreg
#define KBUF(buf) (lds + KB0 + (buf) * 8192)
#define VBUF(buf) (lds + VB0 + (buf) * 8192)
#define ACCUM_OUT(scale_expr, FIRST) do { if (h == 0) wsf[r] = (scale_expr); \
        _Pragma("unroll") for (int i = 0; i < 16; ++i) { const float sc = wsf[crow(i, h)]; \
            if (FIRST) { osl[(i * 2) * 64] = st.o0[i] * sc; osl[(i * 2 + 1) * 64] = st.o1[i] * sc; } \
            else { osl[(i * 2) * 64] += st.o0[i] * sc; osl[(i * 2 + 1) * 64] += st.o1[i] * sc; } } } while (0)

    St st;
    const bf16_t* kc = kcmp + (size_t)bh * 256 * 64; const bf16_t* vc = vcmp + (size_t)bh * 256 * 64;
    const int nmax = (t >= 31) ? ((t - 31) >> 4) : -1;
    float carry = 0.f;
    float m1 = -1e30f, l1 = 0.f;
    LDK(kc, 64); STK(0); __syncthreads();
#pragma unroll 1
    for (int j = 0; j < 4; ++j) {
        if (j + 1 < 4) LDK(kc + (size_t)(j + 1) * 64 * 64, 64);
        { const int cnt = nmax - 64 * j + 1; const unsigned long long allow = cnt <= 0 ? 0ull : lowmask(cnt);
          tile_stats(m1, l1, KBUF(j & 1), qr, allow, r, h); }
        if (j + 1 < 4) STK((j + 1) & 1);
        __syncthreads();
    }
    l1 += __shfl_xor(l1, 32);
    const float invl = __builtin_amdgcn_rcpf(fmaxf(l1, 1e-30f));
#pragma unroll
    for (int i = 0; i < 16; ++i) { st.o0[i] = 0.f; st.o1[i] = 0.f; }
    LDK(kc, 64); LDV(vc, 64); STK(0); STV(0); __syncthreads();
#pragma unroll 1
    for (int j = 0; j < 4; ++j) {
        if (j + 1 < 4) { LDK(kc + (size_t)(j + 1) * 64 * 64, 64); LDV(vc + (size_t)(j + 1) * 64 * 64, 64); }
        { const int cnt = nmax - 64 * j + 1; const unsigned long long allow = cnt <= 0 ? 0ull : lowmask(cnt);
          tile_exact(st.o0, st.o1, m1, invl, KBUF(j & 1), VBUF(j & 1), qr, allow, impw, carry, j, lane, r, h); }
        if (j + 1 < 4) { STK((j + 1) & 1); STV((j + 1) & 1); }
        __syncthreads();
    }
    {
        unsigned long long wor = 0ull;
        const unsigned long long valid = lowmask(qb + 1);
        LAS const float* ib = (LAS const float*)(lds + IMP);
        unsigned key[8], T[8];
#pragma unroll
        for (int i = 0; i < 8; ++i) { const int q = wid * 8 + i;
            float v = ((ib[(0 * 64 + q) * IMPW + lane] + ib[(1 * 64 + q) * IMPW + lane]) + ib[(2 * 64 + q) * IMPW + lane]) + ib[(3 * 64 + q) * IMPW + lane];
            if (lane == 0 || lane == qb || lane == qb - 1) v = INFINITY;
            key[i] = (lane <= qb) ? __float_as_uint(fmaxf(v, 0.f)) : 0u; T[i] = 0u; }
#pragma unroll 1
        for (int bb = 30; bb >= 0; --bb) {
#pragma unroll
            for (int i = 0; i < 8; ++i) { const unsigned cand = T[i] | (1u << bb);
                const int c = __popcll(__ballot(key[i] >= cand) & valid); T[i] = (c >= 16) ? cand : T[i]; }
        }
#pragma unroll
        for (int i = 0; i < 8; ++i) { const int q = wid * 8 + i;
            const unsigned long long gt = __ballot(key[i] > T[i]) & valid, eq = __ballot(key[i] == T[i]) & valid;
            const int need = 16 - __popcll(gt);
            const bool pick = ((eq >> lane) & 1ull) && (__popcll(eq & lowmask(lane)) < need);
            const unsigned long long msk = gt | __ballot(pick);
            if (lane == 0) *(LAS unsigned long long*)(lds + SELM + q * 8) = msk;
            wor |= msk; }
        if (lane == 0) *(LAS unsigned long long*)(lds + WMASK + wid * 8) = wor;
    }
    __syncthreads();
    unsigned long long un = 0ull;
#pragma unroll
    for (int w = 0; w < 8; ++w) un |= *(LAS const unsigned long long*)(lds + WMASK + w * 8);
    { const unsigned ulo = __builtin_amdgcn_readfirstlane((unsigned)un), uhi = __builtin_amdgcn_readfirstlane((unsigned)(un >> 32)); un = ((unsigned long long)uhi << 32) | ulo; }
    ACCUM_OUT(gate[0], true);
    {
        LAS unsigned char* steps = lds + STEPS + wid * 128;
        const int nsel = __popcll(un), j0w = qb >= 8 ? qb - 8 : 0, nwin = qb - j0w + 1;
        const int NTs = nsel < 4 ? 4 : nsel, NTw = nwin < 4 ? 4 : nwin;
        if ((un >> lane) & 1ull) steps[__popcll(un & lowmask(lane))] = (unsigned char)lane;
        if (lane >= nsel && lane < NTs) steps[lane] = (unsigned char)0x7f;
        if (lane < NTw) steps[64 + lane] = (unsigned char)(lane < nwin ? (0x80 | (j0w + lane)) : 0x7f);
        const bf16_t* ksb = proj + (size_t)b * SEQ * PP + C_KS + hk * 64;
        char* shm = (char*)lds;
        f32x16 ob[2]; float lt;
        run_branch<8>(shm, qr, ksb, steps, NTs, qb, ob, lt, wid, lane);
        {
            int t2 = threadIdx.x; asm volatile("" : "+v"(t2));
            const int lane2 = t2 & 63, r2 = lane2 & 31, h2 = lane2 >> 5, wid2 = __builtin_amdgcn_readfirstlane(t2 >> 6), g2 = wid2 >> 1, tq2 = (wid2 & 1) * 32 + r2;
            LAS float* wsf2 = (LAS float*)(lds + WSF) + wid2 * 32; LAS float* osl2 = (LAS float*)(lds + IMP + wid2 * (32 * IMPW * 4)) + lane2;
            const float g1 = sigmoidf_(bf2f(proj[((size_t)b * SEQ + (size_t)qb * 64 + tq2) * PP + C_GBR + 1 * 16 + hk * 4 + g2]));
            if (h2 == 0) wsf2[r2] = g1 * __builtin_amdgcn_rcpf(fmaxf(lt, 1e-30f));
#pragma unroll
            for (int i = 0; i < 16; ++i) { const float sc = wsf2[crow(i, h2)]; osl2[(i * 2) * 64] += ob[0][i] * sc; osl2[(i * 2 + 1) * 64] += ob[1][i] * sc; }
        }
        {
            int t3 = threadIdx.x; asm volatile("" : "+v"(t3));
            run_branch<8>(shm, qr, ksb, steps + 64, NTw, qb, ob, lt, __builtin_amdgcn_readfirstlane(t3 >> 6), t3 & 63);
        }
        st.o0 = ob[0]; st.o1 = ob[1]; st.l = lt;
    }
    {
        int t2 = threadIdx.x; asm volatile("" : "+v"(t2));
        const int lane2 = t2 & 63, r2 = lane2 & 31, h2 = lane2 >> 5, wid2 = __builtin_amdgcn_readfirstlane(t2 >> 6), g2 = wid2 >> 1, tq2 = (wid2 & 1) * 32 + r2;
        LAS float* wsf2 = (LAS float*)(lds + WSF) + wid2 * 32; LAS float* osl2 = (LAS float*)(lds + IMP + wid2 * (32 * IMPW * 4)) + lane2;
        const float g3 = sigmoidf_(bf2f(proj[((size_t)b * SEQ + (size_t)qb * 64 + tq2) * PP + C_GBR + 2 * 16 + hk * 4 + g2]));
        if (h2 == 0) wsf2[r2] = g3 * __builtin_amdgcn_rcpf(fmaxf(st.l, 1e-30f));
        bf16_t* ob2 = proj + ((size_t)b * SEQ + (size_t)qb * 64 + (wid2 & 1) * 32) * PP + C_Q + (hk * 4 + g2) * 64;
        if (!skipw)
#pragma unroll
        for (int i = 0; i < 16; ++i) { const int q = crow(i, h2); const float sc = wsf2[q];
            const float f0 = osl2[(i * 2) * 64] + st.o0[i] * sc, f1 = osl2[(i * 2 + 1) * 64] + st.o1[i] * sc;
            ob2[(size_t)q * PP + r2] = (bf16_t)(pk2(f0, 0.f) & 0xffffu); ob2[(size_t)q * PP + 32 + r2] = (bf16_t)(pk2(f1, 0.f) & 0xffffu); }
    }
#undef LDK
#undef LDV
#undef STK
#undef STV
#undef KBUF
#undef VBUF
#undef ACCUM_OUT
}
}

__device__ __forceinline__ float wave_sum(float v) {
#pragma unroll
    for (int o = 1; o < 64; o <<= 1) v += __shfl_xor(v, o);
    return v;
}
__device__ __forceinline__ void transpose_item(const float* W, int K, int N, bf16_t* WT, int ldt, int k0, int n0, int drow0, const float* kscale, float cscale, LAS float* scr, int lane) {
#pragma unroll 8
    for (int i = 0; i < 32; ++i) { const int kk = 2 * i + (lane >> 5); const int n = n0 + (lane & 31);
        float v = (n < N) ? W[(size_t)(k0 + kk) * N + n] : 0.f;
        if (kscale) v *= kscale[k0 + kk];
        scr[kk * 33 + (lane & 31)] = v * cscale; }
    asm volatile("s_waitcnt lgkmcnt(0)" ::: "memory");
    const int c = lane & 7;
#pragma unroll
    for (int j = 0; j < 4; ++j) { const int n = (lane >> 3) + 8 * j; const LAS float* s = scr + (8 * c) * 33 + n;
        u32x4 o; o.x = pk2(s[0 * 33], s[1 * 33]); o.y = pk2(s[2 * 33], s[3 * 33]); o.z = pk2(s[4 * 33], s[5 * 33]); o.w = pk2(s[6 * 33], s[7 * 33]);
        *(u32x4*)(WT + (size_t)(drow0 + n) * ldt + k0 + 8 * c) = o; }
    asm volatile("s_waitcnt lgkmcnt(0)" ::: "memory");
}

#define XB_TMO      128
#define XB_XCNT(j)  (256  + 64 * (j))
#define XB_XSUB(j)  (1280 + 64 * (j))
#define XB_XGEN(j)  (2304 + 64 * (j))
#define XB_TOP      3328
#define XB_TOPGEN   3392
#define XCD_BAR_WORDS 3456
#define XB_SPIN_CAP (1u << 18)
__device__ __forceinline__ unsigned xb_ld(unsigned* p)              { return __hip_atomic_load(p, __ATOMIC_RELAXED, __HIP_MEMORY_SCOPE_AGENT); }
__device__ __forceinline__ unsigned xb_add(unsigned* p, unsigned v) { return __hip_atomic_fetch_add(p, v, __ATOMIC_RELAXED, __HIP_MEMORY_SCOPE_AGENT); }
__device__ __forceinline__ unsigned xb_xcc_id() { return (unsigned)__builtin_amdgcn_s_getreg((3 << 11) | 20) & 0xFu; }
#define XB_SPIN(cond, bar) do { unsigned _sp = 0; while (cond) { __builtin_amdgcn_s_sleep(1); \
    if ((++_sp & 255u) == 0u) { if (xb_ld(&(bar)[XB_TMO])) break; if (_sp > XB_SPIN_CAP) { atomicAdd(&(bar)[XB_TMO], 1u); break; } } } } while (0)
struct XcdBarrier { unsigned* bar; unsigned x; volatile LAS unsigned* st; };
__device__ __forceinline__ XcdBarrier xcd_barrier_post(unsigned* bar, volatile LAS unsigned* st) {
    XcdBarrier b; b.bar = bar; b.x = xb_xcc_id(); b.st = st;
    if (threadIdx.x == 0) (void)xb_add(&bar[XB_XCNT(b.x)], 1u);
    return b;
}
__device__ __forceinline__ void xcd_barrier_complete(unsigned* bar, unsigned x, unsigned& nloc, unsigned& nx) {
    const unsigned G = gridDim.x * gridDim.y * gridDim.z;
    unsigned sum, cnt, mine, sp = 0u;
    for (;;) {
        sum = 0u; cnt = 0u; mine = 0u;
#pragma unroll
        for (unsigned j = 0; j < 16; ++j) { const unsigned c = xb_ld(&bar[XB_XCNT(j)]); sum += c; cnt += (c > 0u) ? 1u : 0u; mine = (j == x) ? c : mine; }
        if (sum == G) break;
        __builtin_amdgcn_s_sleep(1);
        if ((++sp & 255u) == 0u) { if (xb_ld(&bar[XB_TMO])) break; if (sp > XB_SPIN_CAP) { atomicAdd(&bar[XB_TMO], 1u); break; } }
    }
    nloc = mine > 0u ? mine : 1u; nx = cnt > 0u ? cnt : 1u;
}
__device__ __forceinline__ void xcd_barrier(const XcdBarrier& b) {
    asm volatile("s_waitcnt vmcnt(0)" ::: "memory");
    __syncthreads();
    if (threadIdx.x == 0) {
        unsigned* bar = b.bar;
        __builtin_amdgcn_s_waitcnt(0);
        unsigned nloc = b.st[0], nx = b.st[1];
        if (nloc == 0u) { xcd_barrier_complete(bar, b.x, nloc, nx); b.st[0] = nloc; b.st[1] = nx; }
        const unsigned old = xb_add(&bar[XB_XSUB(b.x)], 1u);
        const unsigned gen = old / nloc;
        if (old + 1u == (gen + 1u) * nloc) {
            __builtin_amdgcn_fence(__ATOMIC_RELEASE, "agent");
            asm volatile("s_waitcnt vmcnt(0)" ::: "memory");
            const unsigned og = xb_add(&bar[XB_TOP], 1u);
            const unsigned tg = og / nx;
            if (og + 1u == (tg + 1u) * nx) xb_add(&bar[XB_TOPGEN], 1u);
            else XB_SPIN(xb_ld(&bar[XB_TOPGEN]) == tg, bar);
            __builtin_amdgcn_fence(__ATOMIC_ACQUIRE, "agent");
            xb_add(&bar[XB_XGEN(b.x)], 1u);
            asm volatile("s_waitcnt vmcnt(0)" ::: "memory");
        } else {
            XB_SPIN(xb_ld(&bar[XB_XGEN(b.x)]) == gen, bar);
            __builtin_amdgcn_fence(__ATOMIC_ACQUIRE, "agent");
            asm volatile("s_waitcnt vmcnt(0)" ::: "memory");
        }
    }
    __syncthreads();
}

struct Args {
    const float *x, *w_in, *conv_w, *w_conv_out, *pos_k, *w1_k, *w2_k, *pos_v, *w1_v, *w2_v, *w_attn_out, *w_o, *g_mix, *g_ffn, *w_gate, *w_up, *w_down, *g_final;
    float* out; unsigned char* ws; int probe; int pad;
};

__global__ void __launch_bounds__(512, 2) nsa_fwd(Args a) {
    extern __shared__ __attribute__((aligned(16))) unsigned char lds_raw[];
    LAS unsigned char* lds = (LAS unsigned char*)lds_raw;
    cg::grid_group grid = cg::this_grid();
    const int tid = threadIdx.x, lane = tid & 63, wave = __builtin_amdgcn_readfirstlane(tid >> 6);
    const int G = gridDim.x, bx = blockIdx.x;
    const int vcu = (G % 8 == 0) ? (bx % 8) * (G / 8) + bx / 8 : bx;
    unsigned char* ws = a.ws;
    volatile LAS unsigned* bst = (volatile LAS unsigned*)(lds + 143360);
    if (tid < 2) bst[tid] = 0u;
    __syncthreads();
    const XcdBarrier gbar = xcd_barrier_post((unsigned*)(ws + WS_BAR), bst);
#define SEAM() xcd_barrier(gbar)
    float* part1 = (float*)(ws + WS_PART1); float* part2 = (float*)(ws + WS_PART2); float* cbias = (float*)(ws + WS_BIAS);
    bf16_t* Win = (bf16_t*)(ws + WS_WIN); bf16_t* Wconv = (bf16_t*)(ws + WS_WCONV); bf16_t* Wattn = (bf16_t*)(ws + WS_WATTN); bf16_t* Wo = (bf16_t*)(ws + WS_WO);
    bf16_t* Wup = (bf16_t*)(ws + WS_WUP); bf16_t* Wdown = (bf16_t*)(ws + WS_WDOWN); bf16_t* W1 = (bf16_t*)(ws + WS_W1); bf16_t* W2 = (bf16_t*)(ws + WS_W2);
    bf16_t* hid = (bf16_t*)(ws + WS_HID); bf16_t* kcmp = (bf16_t*)(ws + WS_KCMP); bf16_t* proj = (bf16_t*)(ws + WS_PROJ);
    float* h1f = (float*)(ws + WS_H1F); bf16_t* h1b = (bf16_t*)(ws + WS_H1B); bf16_t* act = (bf16_t*)(ws + WS_ACT);
    bf16_t* nb = (bf16_t*)a.out; bf16_t* mix = (bf16_t*)a.out; bf16_t* bc = (bf16_t*)((unsigned char*)a.out + OUT_BC);

    {
        LAS float* scr = (LAS float*)(lds + wave * 16384);
        const int gw = vcu * 8 + wave, NGW = G * 8;
        constexpr int I_IN = 16 * 194, I_CONV = 8 * 32, I_ATT = 16 * 32, I_O = 16 * 32, I_G = 16 * 88, I_U = 16 * 88, I_D = 44 * 32, I_1 = 32 * 8, I_2 = 4 * 2;
        constexpr int NITEMS = I_IN + I_CONV + I_ATT + I_O + 2 * I_1 + 2 * I_2;
        for (int it = gw; it < NITEMS; it += NGW) {
            int q = it;
            if (q < I_IN) { const int kb = q / 194, nbk = q % 194, n0 = 32 * nbk; const float cs = (n0 >= C_Q && n0 < C_KC) ? QSCALE : 1.0f;
                transpose_item(a.w_in, 1024, INCOLS, Win, 1024, 64 * kb, n0, n0, a.g_mix, cs, scr, lane); continue; } q -= I_IN;
            if (q < I_CONV) { const int kb = q / 32, nbk = q % 32; transpose_item(a.w_conv_out, 512, 1024, Wconv, 512, 64 * kb, 32 * nbk, 32 * nbk, nullptr, 1.f, scr, lane); continue; } q -= I_CONV;
            if (q < I_ATT) { const int kb = q / 32, nbk = q % 32; transpose_item(a.w_attn_out, 1024, 1024, Wattn, 1024, 64 * kb, 32 * nbk, 32 * nbk, nullptr, 1.f, scr, lane); continue; } q -= I_ATT;
            if (q < I_O) { const int kb = q / 32, nbk = q % 32; transpose_item(a.w_o, 1024, 1024, Wo, 1024, 64 * kb, 32 * nbk, 32 * nbk, nullptr, 1.f, scr, lane); continue; } q -= I_O;
            if (q < I_1) { const int kb = q / 8, nbk = q % 8; transpose_item(a.w1_k, 2048, 256, W1, 2048, 64 * kb, 32 * nbk, 32 * nbk, nullptr, 1.f, scr, lane); continue; } q -= I_1;
            if (q < I_1) { const int kb = q / 8, nbk = q % 8; transpose_item(a.w1_v, 2048, 256, W1, 2048, 64 * kb, 32 * nbk, 256 + 32 * nbk, nullptr, 1.f, scr, lane); continue; } q -= I_1;
            if (q < I_2) { const int kb = q / 2, nbk = q % 2; transpose_item(a.w2_k, 256, 64, W2, 256, 64 * kb, 32 * nbk, 32 * nbk, nullptr, 1.f, scr, lane); continue; } q -= I_2;
            { const int kb = q / 2, nbk = q % 2; transpose_item(a.w2_v, 256, 64, W2, 256, 64 * kb, 32 * nbk, 256 + 32 * nbk, nullptr, 1.f, scr, lane); }
        }
        const int gt = vcu * 512 + tid, NGT = G * 512;
        for (int i = gt; i < 192 * 1024 / 8; i += NGT) *(u32x4*)(Win + (size_t)6208 * 1024 + (size_t)i * 8) = (u32x4){0u, 0u, 0u, 0u};
        for (int i = gt; i < 2 * 192 * 256 / 8; i += NGT) { const int half = i / (192 * 256 / 8), o = i % (192 * 256 / 8);
            *(u32x4*)(W2 + (size_t)(half * 256 + 64) * 256 + (size_t)o * 8) = (u32x4){0u, 0u, 0u, 0u}; }
        for (int m = gw; m < MTOK; m += NGW) {
            const f32x4* xr = (const f32x4*)(a.x + (size_t)m * DM) + lane; f32x4 v[4]; float s = 0.f;
#pragma unroll
            for (int j = 0; j < 4; ++j) { v[j] = xr[64 * j]; s += (v[j][0] * v[j][0] + v[j][1] * v[j][1]) + (v[j][2] * v[j][2] + v[j][3] * v[j][3]); }
            const float rstd = __builtin_amdgcn_rsqf(wave_sum(s) * (1.0f / DM) + EPS);
            u32x2* o8 = (u32x2*)(nb + (size_t)m * DM) + lane;
#pragma unroll
            for (int j = 0; j < 4; ++j) { u32x2 w; w.x = pk2(v[j][0] * rstd, v[j][1] * rstd); w.y = pk2(v[j][2] * rstd, v[j][3] * rstd); o8[64 * j] = w; }
        }
        if (bx < 2) {
            const float* pos = bx ? a.pos_v : a.pos_k; const float* w1 = bx ? a.w1_v : a.w1_k;
            const int j = tid & 255, part = tid >> 8; float s = 0.f;
            for (int k = part * 1024; k < part * 1024 + 1024; ++k) s += pos[k] * w1[(size_t)k * 256 + j];
            LAS float* red = (LAS float*)(lds + 8 * 16384);
            if (part == 1) red[j] = s;
            __syncthreads();
            if (part == 0) cbias[bx * 256 + j] = s + red[j];
        }
    }
    if (a.probe == 0x7fffffff) grid.sync();
    SEAM();
    {
        const int ncols1 = (G > 64) ? 6144 : PP;
        pg8::Gemm g{nb, Win, MTOK, ncols1, DM, DM, 128, 0}; pg8::StaticOrder S; S.init(MTOK, ncols1, G, bx);
        pg8::EpiProj E{proj, PP};
        pg8::gemm_phase(lds, g, S, E);
    }
    SEAM();
    {
        {
            pg8::Gemm g{proj + C_KC, W1, 4096, 512, 2048, 16 * PP, PP * 2, 1}; pg8::StaticOrder S; S.init(4096, 512, G, bx);
            pg8::EpiHid E{hid, cbias};
            pg8::gemm_phase(lds, g, S, E);
        }
        int wb = bx, wn = G; if (G > 64) { wb = bx - 32; wn = G - 32; }
        if (wb >= 0) {
            for (int it = wb * 512 + tid; it < MTOK * 64; it += wn * 512) {
                const int row = it >> 6, ch = (it & 63) * 8, t = row & (SEQ - 1);
                const bf16_t* pr = proj + (size_t)row * PP;
                float accv[8];
#pragma unroll
                for (int j = 0; j < 8; ++j) accv[j] = 0.f;
#pragma unroll
                for (int k = 0; k < 3; ++k) { const int dt = 2 - k;
                    if (t - dt >= 0) { const u32x4 cv = *(const u32x4*)(pr - (size_t)dt * PP + C_C + ch), hv = *(const u32x4*)(pr - (size_t)dt * PP + C_H + ch);
                        const f32x4 w0 = *(const f32x4*)(a.conv_w + k * 512 + ch), w1 = *(const f32x4*)(a.conv_w + k * 512 + ch + 4);
                        accv[0] += w0[0] * lo_bf(cv.x) * lo_bf(hv.x); accv[1] += w0[1] * hi_bf(cv.x) * hi_bf(hv.x); accv[2] += w0[2] * lo_bf(cv.y) * lo_bf(hv.y); accv[3] += w0[3] * hi_bf(cv.y) * hi_bf(hv.y);
                        accv[4] += w1[0] * lo_bf(cv.z) * lo_bf(hv.z); accv[5] += w1[1] * hi_bf(cv.z) * hi_bf(hv.z); accv[6] += w1[2] * lo_bf(cv.w) * lo_bf(hv.w); accv[7] += w1[3] * hi_bf(cv.w) * hi_bf(hv.w); } }
                const u32x4 bv = *(const u32x4*)(pr + C_B + ch);
                u32x4 o; o.x = pk2(accv[0] * lo_bf(bv.x), accv[1] * hi_bf(bv.x)); o.y = pk2(accv[2] * lo_bf(bv.y), accv[3] * hi_bf(bv.y));
                o.z = pk2(accv[4] * lo_bf(bv.z), accv[5] * hi_bf(bv.z)); o.w = pk2(accv[6] * lo_bf(bv.w), accv[7] * hi_bf(bv.w));
                *(u32x4*)(bc + (size_t)row * 512 + ch) = o;
            }
        }
        if (G > 64 && wb >= 0) {
            { pg8::Gemm g{nb, Win + (size_t)6144 * 1024, MTOK, 256, DM, DM, 128, 0}; pg8::StaticOrder S; S.init(MTOK, 256, wn, wb);
              pg8::EpiProj E{proj + 6144, PP}; pg8::gemm_phase(lds, g, S, E); }
            __syncthreads();
            LAS float* scr = (LAS float*)(lds + wave * 16384);
            constexpr int I_G = 16 * 88, I_U = 16 * 88, I_D = 44 * 32;
            for (int it = wb * 8 + wave; it < I_G + I_U + I_D; it += wn * 8) {
                int q = it;
                if (q < I_G) { const int kb = q / 88, nbk = q % 88, n0 = 32 * nbk; transpose_item(a.w_gate, 1024, DFF, Wup, 1024, 64 * kb, n0, (n0 / 128) * 256 + (n0 % 128), a.g_ffn, 1.f, scr, lane); continue; } q -= I_G;
                if (q < I_U) { const int kb = q / 88, nbk = q % 88, n0 = 32 * nbk; transpose_item(a.w_up, 1024, DFF, Wup, 1024, 64 * kb, n0, (n0 / 128) * 256 + 128 + (n0 % 128), a.g_ffn, 1.f, scr, lane); continue; } q -= I_U;
                { const int kb = q / 32, nbk = q % 32; transpose_item(a.w_down, DFF, 1024, Wdown, DFF, 64 * kb, 32 * nbk, 32 * nbk, nullptr, 1.f, scr, lane); }
            }
        }
    }
    {
        pg8::Gemm g{hid, W2, 4096, 512, 256, 256, 128, 2}; pg8::StaticOrder S; S.init(4096, 512, G, bx);
        pg8::EpiCmp E{kcmp};
        pg8::gemm_phase(lds, g, S, E);
    }
    SEAM();
    {
        for (int v = vcu; v < 256; v += G) {
            const int bh = v >> 4, s = v & 15;
#pragma unroll 1
            for (int i = 0; i < 4; ++i) { const int qb = (i == 0) ? 63 - s : (i == 1) ? 32 + s : (i == 2) ? 31 - s : s;
#if defined(PROBE_ATT2) || defined(PROBE_NOLD)
                att::attn_unit(lds, proj, kcmp, kcmp + 4096 * 64, bh, qb, a.probe);
#endif
                att::attn_unit(lds, proj, kcmp, kcmp + 4096 * 64, bh, qb, 0);
            }
        }
    }
    SEAM();
    {
        { pg8::Gemm g{bc, Wconv, MTOK, DM, 512, 512, 128, 0}; pg8::StaticOrder S; S.init(MTOK, DM, G, bx);
          pg8::EpiMix<0> E{mix, proj, C_GCONV}; pg8::gemm_phase(lds, g, S, E); }
        { pg8::Gemm g{proj + C_Q, Wattn, MTOK, DM, DM, PP, 128, 0}; pg8::StaticOrder S; S.init(MTOK, DM, G, bx);
          pg8::EpiMix<1> E{mix, proj, C_GATTN}; pg8::gemm_phase(lds, g, S, E); }
    }
    SEAM();
    {
        pg8::Gemm g{mix, Wo, MTOK, DM, DM, DM, 128, 0}; pg8::StaticOrder S; S.init(MTOK, DM, G, bx);
        pg8::EpiRes<1> E{a.x, h1f, h1b, part1}; pg8::gemm_phase(lds, g, S, E);
    }
    SEAM();
    {
        pg8::Gemm g{h1b, Wup, MTOK, 2 * DFF, DM, DM, 128, 0}; pg8::StaticOrder S; S.init(MTOK, 2 * DFF, G, bx);
        pg8::EpiUp E{act, part1}; pg8::gemm_phase(lds, g, S, E);
    }
    SEAM();
    if (G == 256) {
        pg8::Gemm g{act, Wdown, MTOK, DM, DFF, DFF, 128, 0}; pg8::StaticOrder S; S.init(MTOK, DM, G, bx);
        pg8::EpiFinal E{h1f, a.out, a.g_final, (unsigned*)part2, (unsigned*)(ws + WS_BAR) + 4096, (unsigned*)(ws + WS_BAR) + XB_TMO};
        pg8::gemm_phase(lds, g, S, E);
        return;
    }
    {
        pg8::Gemm g{act, Wdown, MTOK, DM, DFF, DFF, 128, 0}; pg8::StaticOrder S; S.init(MTOK, DM, G, bx);
        pg8::EpiRes<0> E{h1f, a.out, nullptr, part2}; pg8::gemm_phase(lds, g, S, E);
    }
    SEAM();
    {
        for (int it = bx * 512 + tid; it < MTOK * 256; it += G * 512) {
            const int row = it >> 8, c4 = (it & 255) * 4;
            const f32x4* pp = (const f32x4*)(part2 + (size_t)row * 16); float ss = 0.f;
#pragma unroll
            for (int j = 0; j < 4; ++j) { const f32x4 p = pp[j]; ss += (p[0] + p[1]) + (p[2] + p[3]); }
            const float r = __builtin_amdgcn_rsqf(ss * (1.0f / DM) + EPS);
            f32x4 v = *(f32x4*)(a.out + (size_t)row * DM + c4); const f32x4 gf = *(const f32x4*)(a.g_final + c4);
            v = v * r * gf; *(f32x4*)(a.out + (size_t)row * DM + c4) = v;
        }
    }
}

extern "C" void kernel_launch(void* const* d_in, const int* in_sizes, int n_in, void* d_out, int out_size, void* d_ws, size_t ws_size, hipStream_t stream) {
    static int grid = 0;
    if (grid == 0) {
        if (n_in != 18 || out_size != MTOK * DM || ws_size < WS_NEED) { fprintf(stderr, "kernel_launch: unexpected shapes (n_in %d out %d ws %zu)\n", n_in, out_size, ws_size); grid = -1; return; }
        int dev = 0, cus = 0, per_cu = 0;
        (void)hipGetDevice(&dev);
        (void)hipDeviceGetAttribute(&cus, hipDeviceAttributeMultiprocessorCount, dev);
        (void)hipFuncSetAttribute((const void*)nsa_fwd, hipFuncAttributeMaxDynamicSharedMemorySize, LDS_BYTES);
        (void)hipOccupancyMaxActiveBlocksPerMultiprocessor(&per_cu, (const void*)nsa_fwd, 512, LDS_BYTES);
        if (per_cu < 1) { fprintf(stderr, "kernel_launch: occupancy query says %d blocks/CU\n", per_cu); grid = -1; return; }
        grid = cus;
    }
    if (grid < 0) return;
    (void)hipMemsetAsync((unsigned char*)d_ws + WS_BAR, 0, 32768, stream);
    Args a{};
    a.x = (const float*)d_in[0]; a.w_in = (const float*)d_in[1]; a.conv_w = (const float*)d_in[2]; a.w_conv_out = (const float*)d_in[3];
    a.pos_k = (const float*)d_in[4]; a.w1_k = (const float*)d_in[5]; a.w2_k = (const float*)d_in[6];
    a.pos_v = (const float*)d_in[7]; a.w1_v = (const float*)d_in[8]; a.w2_v = (const float*)d_in[9];
    a.w_attn_out = (const float*)d_in[10]; a.w_o = (const float*)d_in[11]; a.g_mix = (const float*)d_in[12]; a.g_ffn = (const float*)d_in[13];
    a.w_gate = (const float*)d_in[14]; a.w_up = (const float*)d_in[15]; a.w_down = (const float*)d_in[16]; a.g_final = (const float*)d_in[17];
    a.out = (float*)d_out; a.ws = (unsigned char*)d_ws; a.probe = 1; a.pad = 0;
    void* args[] = {&a};
    hipError_t e = hipLaunchCooperativeKernel((void*)nsa_fwd, dim3(grid), dim3(512), args, LDS_BYTES, stream);
    if (e != hipSuccess) fprintf(stderr, "kernel_launch: cooperative launch failed: %s (grid %d)\n", hipGetErrorString(e), grid);
}
```

```cpp
#include <hip/hip_runtime.h>
#include <hip/hip_cooperative_groups.h>
#include <cstdio>
#include <cstdint>
namespace cg = cooperative_groups;

#define LAS __attribute__((address_space(3)))
typedef unsigned short bf16_t;
typedef short bf16x8 __attribute__((ext_vector_type(8)));
typedef short s16x4 __attribute__((ext_vector_type(4)));
typedef float f32x4 __attribute__((ext_vector_type(4)));
typedef float f32x16 __attribute__((ext_vector_type(16)));
typedef unsigned u32x4 __attribute__((ext_vector_type(4)));
typedef unsigned u32x2 __attribute__((ext_vector_type(2)));
typedef float f32x2_t __attribute__((ext_vector_type(2)));
typedef __bf16 bf16x2_t __attribute__((ext_vector_type(2)));

constexpr int MTOK = 16384, DM = 1024, SEQ = 4096, NB = 4;
constexpr int PP = 6400;
constexpr int INCOLS = 6192;
constexpr int C_B = 0, C_C = 512, C_H = 1024, C_Q = 1536, C_KC = 2560, C_VC = 2816, C_KS = 3072, C_VS = 3328, C_KW = 3584, C_VW = 3840,
              C_GBR = 4096, C_GCONV = 4144, C_GATTN = 5168;
constexpr int DFF = 2816;
constexpr float EPS = 1e-6f;
constexpr float LOG2E = 1.4426950408889634f;
constexpr float QSCALE = 0.125f * LOG2E;

constexpr size_t MiB = 1u << 20;
constexpr size_t WS_PART1 = 0;
constexpr size_t WS_PART2 = 1 * MiB;
constexpr size_t WS_BIAS = 2 * MiB;
constexpr size_t WS_BAR = 2 * MiB + 65536;
constexpr size_t WS_WIN = 3 * MiB;
constexpr size_t WS_WCONV = 16 * MiB;
constexpr size_t WS_WATTN = 17 * MiB;
constexpr size_t WS_WO = 19 * MiB;
constexpr size_t WS_WUP = 21 * MiB;
constexpr size_t WS_WDOWN = 32 * MiB;
constexpr size_t WS_W1 = 38 * MiB;
constexpr size_t WS_W2 = 40 * MiB;
constexpr size_t WS_HID = 41 * MiB;
constexpr size_t WS_KCMP = 45 * MiB;
constexpr size_t WS_PROJ = 46 * MiB;
constexpr size_t WS_H1F = 46 * MiB;
constexpr size_t WS_H1B = 110 * MiB;
constexpr size_t WS_ACT = 142 * MiB;
constexpr size_t WS_NEED = 246 * MiB;
constexpr size_t OUT_BC = 32 * MiB;

constexpr int LDS_BYTES = 147456;

__device__ __forceinline__ float bf2f(unsigned short v) { return __uint_as_float(((unsigned)v) << 16); }
__device__ __forceinline__ unsigned pk2(float lo, float hi) { f32x2_t v = {lo, hi}; bf16x2_t b = __builtin_convertvector(v, bf16x2_t); return __builtin_bit_cast(unsigned, b); }
__device__ __forceinline__ float ex2(float x) { return __builtin_amdgcn_exp2f(x); }
__device__ __forceinline__ float sigmoidf_(float x) { return __builtin_amdgcn_rcpf(1.0f + ex2(-x * LOG2E)); }
__device__ __forceinline__ float lo_bf(unsigned w) { return __uint_as_float(w << 16); }
__device__ __forceinline__ float hi_bf(unsigned w) { return __uint_as_float(w & 0xffff0000u); }

namespace pg8 {
constexpr int BM = 256, BK = 64, HALF = 128, HTB = HALF * BK * 2, STAGE_BYTES = 8 * HTB, NXCD = 8, WGM = 8;
__host__ __device__ __forceinline__ int lds_byte(int r, int c) { const int st = (r >> 4) * 2 + (c >> 5), rr = r & 15, cc = c & 31, ob = rr * 64 + cc * 2; return st * 1024 + (ob ^ (((ob >> 9) & 1) << 5)); }
__host__ __device__ __forceinline__ void stage_rc(int b, int& R, int& C) { const int st = b / 1024, sb = b % 1024, swz = sb ^ (((sb >> 9) & 1) << 5); R = (st >> 1) * 16 + swz / 64; C = (st & 1) * 32 + (swz % 64) / 2; }
__host__ __device__ __forceinline__ int perm32(int rho) { const int n = rho >> 4, i = rho & 15; return 8 * (i >> 2) + 4 * n + (i & 3); }

struct Unit { int pm, pn; };
struct Gemm { const bf16_t* A; const bf16_t* Bt; int M, N, K; int lda; int a_kstep; int amode; };

struct StaticOrder {
    int nM, nN, nwg, G, c;
    __host__ __device__ void init(int M, int N, int G_, int c_) { nM = M / BM; nN = N / BM; nwg = nM * nN; G = G_; c = c_; }
    __host__ __device__ bool next(int i, Unit& u) const {
        const long L = (long)i * G + c; if (L >= nwg) return false;
        int wgid = (int)L; { const int q = nwg / NXCD, r = nwg % NXCD, xcd = wgid % NXCD, off = wgid / NXCD; wgid = (xcd < r ? xcd * (q + 1) : r * (q + 1) + (xcd - r) * q) + off; }
        const int nig = WGM * nN, gid = wgid / nig, fm = gid * WGM, gsz = (nM - fm) < WGM ? (nM - fm) : WGM;
        u.pm = fm + ((wgid % nig) % gsz); u.pn = (wgid % nig) / gsz; return true;
    }
};

__device__ __forceinline__ const char* a_tile(const Gemm& g, const Unit& u) {
    if (g.amode == 1) return (const char*)g.A + ((size_t)(u.pm >> 2) * SEQ * PP + (size_t)u.pn * 256 + (size_t)(u.pm & 3) * 64) * 2;
    if (g.amode == 2) return (const char*)g.A + ((size_t)u.pn * 4096 * 256 + (size_t)u.pm * 256 * 256) * 2;
    return (const char*)g.A + (size_t)u.pm * 256 * (size_t)g.lda * 2;
}

template <class T, class = void> struct is_fused { static constexpr bool value = false; };
template <class T> struct is_fused<T, decltype((void)T::FUSED)> { static constexpr bool value = true; };
template <class Epi>
__device__ __forceinline__ void gemm_phase(LAS unsigned char* lds, const Gemm g, const StaticOrder& S, const Epi& E) {
#ifdef NO_GEMM
    return;
#endif
    int tid_ = threadIdx.x; asm volatile("" : "+v"(tid_));
    const int tid = tid_, wid = __builtin_amdgcn_readfirstlane(tid >> 6), lane = tid & 63, wr = wid >> 2, wc = wid & 3, fr = lane & 15, fq = lane >> 4;
    const int K = g.K, nt = K / BK;
    unsigned voffA[2], voffB[2];
#pragma unroll
    for (int i = 0; i < 2; ++i) { int R, C; stage_rc(tid * 16 + i * 8192, R, C); const int Rb = (R & ~31) + perm32(R & 31);
        voffA[i] = (unsigned)(R * g.lda + C) * 2u; voffB[i] = (unsigned)(Rb * K + C) * 2u; }
    const size_t kstepA = (size_t)g.a_kstep, kstepB = (size_t)(BK * 2);
    const size_t hstepA = (size_t)HALF * g.lda * 2, hstepB = (size_t)HALF * K * 2;
    const size_t tstepB = 2 * hstepB;
    const unsigned ldsw = (unsigned)wid * 1024u;
    const int aoff = lds_byte(wr * 64 + fr, fq * 8), boff = lds_byte(wc * 32 + fr, fq * 8);
#define PG8_SA(b, h) (((b) * 2 + (h)) * HTB)
#define PG8_SB(b, h) ((4 + (b) * 2 + (h)) * HTB)
#define PG8_STAGE(bufoff, gbase, voff) do { _Pragma("unroll") for (int _i = 0; _i < 2; ++_i) \
        __builtin_amdgcn_global_load_lds((const unsigned*)((const char*)(gbase) + (voff)[_i]), (LAS unsigned*)(lds + (bufoff) + ldsw + _i * 8192), 16, 0, 0); } while (0)
#define PG8_LDA(dst, b, h) do { _Pragma("unroll") for (int m = 0; m < 4; ++m) _Pragma("unroll") for (int k = 0; k < 2; ++k) dst[m][k] = *(const LAS bf16x8*)(lds + PG8_SA(b, h) + aoff + m * 2048 + k * 1024); } while (0)
#define PG8_LDB(dst, b, h) do { _Pragma("unroll") for (int n = 0; n < 2; ++n) _Pragma("unroll") for (int k = 0; k < 2; ++k) dst[n][k] = *(const LAS bf16x8*)(lds + PG8_SB(b, h) + boff + n * 2048 + k * 1024); } while (0)
#define PG8_MMA(ai, bj, At, Bt) do { __builtin_amdgcn_s_setprio(1); _Pragma("unroll") for (int m = 0; m < 4; ++m) _Pragma("unroll") for (int n = 0; n < 2; ++n) _Pragma("unroll") for (int k = 0; k < 2; ++k) \
        acc[ai][bj][m][n] = __builtin_amdgcn_mfma_f32_16x16x32_bf16(Bt[n][k], At[m][k], acc[ai][bj][m][n], 0, 0, 0); __builtin_amdgcn_s_setprio(0); } while (0)
#define PG8_WAIT_V(n) asm volatile("s_waitcnt vmcnt(" #n ")" ::: "memory")
#define PG8_WAIT_L(n) asm volatile("s_waitcnt lgkmcnt(" #n ")" ::: "memory")
#define PG8_BAR __builtin_amdgcn_s_barrier()
#define PG8_SCHED __builtin_amdgcn_sched_barrier(0)
    Unit cur, nxt; int ui = 0;
    if (!S.next(0, cur)) return;
    f32x4 acc[2][2][4][2];
#pragma unroll
    for (int a = 0; a < 2; ++a)
#pragma unroll
        for (int b = 0; b < 2; ++b)
#pragma unroll
            for (int m = 0; m < 4; ++m)
#pragma unroll
                for (int n = 0; n < 2; ++n) acc[a][b][m][n] = (f32x4){0.f, 0.f, 0.f, 0.f};
    bf16x8 At[4][2], B0[2][2], B1[2][2];
    const char* cA = a_tile(g, cur); const char* cB = (const char*)g.Bt + (size_t)cur.pn * tstepB;
    PG8_STAGE(PG8_SB(0, 0), cB, voffB); PG8_STAGE(PG8_SB(0, 1), cB + hstepB, voffB); PG8_STAGE(PG8_SA(0, 0), cA, voffA); PG8_STAGE(PG8_SA(0, 1), cA + hstepA, voffA);
    if (wr == 1) PG8_BAR;
    PG8_WAIT_V(2); PG8_BAR;
    PG8_STAGE(PG8_SB(1, 0), cB + kstepB, voffB); PG8_STAGE(PG8_SA(1, 0), cA + kstepA, voffA); PG8_STAGE(PG8_SB(1, 1), cB + hstepB + kstepB, voffB);
    PG8_WAIT_V(6); PG8_BAR;
    for (;;) {
        const bool has_next = S.next(ui + 1, nxt);
        const char* nA = has_next ? a_tile(g, nxt) : cA; const char* nB = has_next ? (const char*)g.Bt + (size_t)nxt.pn * tstepB : cB;
        for (int t = 0; t < nt; t += 2) {
            const bool last = (t == nt - 2);
            const char* a1 = cA + (size_t)(t + 1) * kstepA;
            const char* a2 = last ? nA : cA + (size_t)(t + 2) * kstepA; const char* b2 = last ? nB : cB + (size_t)(t + 2) * kstepB;
            const char* a3 = a2 + kstepA; const char* b3 = b2 + kstepB;
            PG8_LDB(B0, 0, 0); PG8_LDB(B1, 0, 1); PG8_SCHED; PG8_LDA(At, 0, 0); PG8_STAGE(PG8_SA(1, 1), a1 + hstepA, voffA);
            PG8_WAIT_V(8); PG8_WAIT_L(0); PG8_BAR; PG8_MMA(0, 0, At, B0); PG8_MMA(0, 1, At, B1); PG8_BAR; PG8_SCHED;
            PG8_LDA(At, 0, 1); PG8_STAGE(PG8_SB(0, 0), b2, voffB); PG8_STAGE(PG8_SB(0, 1), b2 + hstepB, voffB); PG8_STAGE(PG8_SA(0, 0), a2, voffA);
            PG8_WAIT_V(8); PG8_WAIT_L(0); PG8_BAR; PG8_MMA(1, 0, At, B0); PG8_MMA(1, 1, At, B1); PG8_BAR; PG8_SCHED;
            PG8_LDB(B0, 1, 0); PG8_LDB(B1, 1, 1); PG8_SCHED; PG8_LDA(At, 1, 0); PG8_STAGE(PG8_SA(0, 1), a2 + hstepA, voffA);
            PG8_WAIT_V(8); PG8_WAIT_L(0); PG8_BAR; PG8_MMA(0, 0, At, B0); PG8_MMA(0, 1, At, B1); PG8_BAR; PG8_SCHED;
            PG8_LDA(At, 1, 1); PG8_STAGE(PG8_SB(1, 0), b3, voffB); PG8_STAGE(PG8_SB(1, 1), b3 + hstepB, voffB); PG8_STAGE(PG8_SA(1, 0), a3, voffA);
            PG8_WAIT_V(8); PG8_WAIT_L(0); PG8_BAR; PG8_MMA(1, 0, At, B0); PG8_MMA(1, 1, At, B1); PG8_BAR; PG8_SCHED;
        }
        if (wr == 0) PG8_BAR;
        if constexpr (!is_fused<Epi>::value) E(acc, cur, wr, wc, fr, fq);
        if (!has_next) break;
#pragma unroll
        for (int a = 0; a < 2; ++a)
#pragma unroll
            for (int b = 0; b < 2; ++b)
#pragma unroll
                for (int m = 0; m < 4; ++m)
#pragma unroll
                    for (int n = 0; n < 2; ++n) acc[a][b][m][n] = (f32x4){0.f, 0.f, 0.f, 0.f};
        cur = nxt; cA = nA; cB = nB; ++ui;
        if (wr == 1) PG8_BAR;
    }
    PG8_WAIT_V(0);
    PG8_BAR;
    if constexpr (is_fused<Epi>::value) E.fused(acc, cur, wr, wc, fr, fq, lds, wid, lane);
#undef PG8_SA
#undef PG8_SB
#undef PG8_STAGE
#undef PG8_LDA
#undef PG8_LDB
#undef PG8_MMA
#undef PG8_WAIT_V
#undef PG8_WAIT_L
#undef PG8_BAR
#undef PG8_SCHED
}

typedef f32x4 Acc[2][2][4][2];
#define EPI_LOOP_BEGIN \
    _Pragma("unroll") for (int ai = 0; ai < 2; ++ai) _Pragma("unroll") for (int m = 0; m < 4; ++m) { const int row = u.pm * BM + wr * 64 + fr + ai * HALF + m * 16; \
    _Pragma("unroll") for (int bj = 0; bj < 2; ++bj) { const f32x4 v0 = acc[ai][bj][m][0], v1 = acc[ai][bj][m][1]; const int col = u.pn * BM + bj * HALF + wc * 32 + 8 * fq;
#define EPI_LOOP_END } }
__device__ __forceinline__ u32x4 pack8(const f32x4 a, const f32x4 b) { u32x4 w; w.x = pk2(a[0], a[1]); w.y = pk2(a[2], a[3]); w.z = pk2(b[0], b[1]); w.w = pk2(b[2], b[3]); return w; }

struct EpiProj { bf16_t* O; int ldc;
    __device__ __forceinline__ void operator()(const Acc& acc, const Unit& u, int wr, int wc, int fr, int fq) const {
        EPI_LOOP_BEGIN
            *(u32x4*)(O + (size_t)row * ldc + col) = pack8(v0, v1);
        EPI_LOOP_END
    } };
__device__ __forceinline__ float gelu_tanh(float x) {
    const float z = x * (1.0f + 0.044715f * x * x) * (2.0f * 0.7978845608028654f * LOG2E);
    return x * __builtin_amdgcn_rcpf(1.0f + ex2(-z));
}
struct EpiHid { bf16_t* O; const float* bias;
    __device__ __forceinline__ void operator()(const Acc& acc, const Unit& u, int wr, int wc, int fr, int fq) const {
        EPI_LOOP_BEGIN
            const int c = col - u.pn * BM; const float* bp = bias + u.pn * 256 + c;
            const f32x4 b0 = *(const f32x4*)bp, b1 = *(const f32x4*)(bp + 4);
            f32x4 a = v0 + b0, b = v1 + b1;
#pragma unroll
            for (int j = 0; j < 4; ++j) { a[j] = gelu_tanh(a[j]); b[j] = gelu_tanh(b[j]); }
            *(u32x4*)(O + (size_t)u.pn * 4096 * 256 + (size_t)row * 256 + c) = pack8(a, b);
        EPI_LOOP_END
    } };
struct EpiCmp { bf16_t* O;
    __device__ __forceinline__ void operator()(const Acc& acc, const Unit& u, int wr, int wc, int fr, int fq) const {
        EPI_LOOP_BEGIN
            const int c = col - u.pn * BM;
            if (c < 64) { u32x4 w = pack8(v0, v1); if ((row & 255) == 255) w = (u32x4){0u, 0u, 0u, 0u};
                *(u32x4*)(O + (size_t)u.pn * 4096 * 64 + (size_t)row * 64 + c) = w; }
        EPI_LOOP_END
    } };
template <int ADD> struct EpiMix { bf16_t* mix; const bf16_t* proj; int gcol;
    __device__ __forceinline__ void operator()(const Acc& acc, const Unit& u, int wr, int wc, int fr, int fq) const {
        EPI_LOOP_BEGIN
            const u32x4 gv = *(const u32x4*)(proj + (size_t)row * PP + gcol + col);
            f32x4 a, b;
            a[0] = sigmoidf_(lo_bf(gv.x)) * v0[0]; a[1] = sigmoidf_(hi_bf(gv.x)) * v0[1]; a[2] = sigmoidf_(lo_bf(gv.y)) * v0[2]; a[3] = sigmoidf_(hi_bf(gv.y)) * v0[3];
            b[0] = sigmoidf_(lo_bf(gv.z)) * v1[0]; b[1] = sigmoidf_(hi_bf(gv.z)) * v1[1]; b[2] = sigmoidf_(lo_bf(gv.w)) * v1[2]; b[3] = sigmoidf_(hi_bf(gv.w)) * v1[3];
            bf16_t* mp = mix + (size_t)row * DM + col;
            if (ADD) { const u32x4 pv = *(const u32x4*)mp;
                a[0] += lo_bf(pv.x); a[1] += hi_bf(pv.x); a[2] += lo_bf(pv.y); a[3] += hi_bf(pv.y); b[0] += lo_bf(pv.z); b[1] += hi_bf(pv.z); b[2] += lo_bf(pv.w); b[3] += hi_bf(pv.w); }
            *(u32x4*)mp = pack8(a, b);
        EPI_LOOP_END
    } };
template <int WB> struct EpiRes { const float* base; float* hf; bf16_t* hb; float* part;
    __device__ __forceinline__ void operator()(const Acc& acc, const Unit& u, int wr, int wc, int fr, int fq) const {
#pragma unroll
        for (int ai = 0; ai < 2; ++ai)
#pragma unroll
            for (int m = 0; m < 4; ++m) { const int row = u.pm * BM + wr * 64 + fr + ai * HALF + m * 16; float ss = 0.f;
#pragma unroll
                for (int bj = 0; bj < 2; ++bj) { const int col = u.pn * BM + bj * HALF + wc * 32 + 8 * fq; const size_t off = (size_t)row * DM + col;
                    const f32x4 x0 = *(const f32x4*)(base + off), x1 = *(const f32x4*)(base + off + 4);
                    const f32x4 a = x0 + acc[ai][bj][m][0], b = x1 + acc[ai][bj][m][1];
                    *(f32x4*)(hf + off) = a; *(f32x4*)(hf + off + 4) = b;
                    if (WB) *(u32x4*)(hb + off) = pack8(a, b);
                    ss += (a[0] * a[0] + a[1] * a[1]) + (a[2] * a[2] + a[3] * a[3]) + (b[0] * b[0] + b[1] * b[1]) + (b[2] * b[2] + b[3] * b[3]); }
                ss += __shfl_xor(ss, 16); ss += __shfl_xor(ss, 32);
                if (fq == 0) part[(size_t)row * 16 + u.pn * 4 + wc] = ss; }
    } };
struct EpiUp { bf16_t* act; const float* part;
    __device__ __forceinline__ void operator()(const Acc& acc, const Unit& u, int wr, int wc, int fr, int fq) const {
#pragma unroll
        for (int ai = 0; ai < 2; ++ai)
#pragma unroll
            for (int m = 0; m < 4; ++m) { const int row = u.pm * BM + wr * 64 + fr + ai * HALF + m * 16;
                const f32x4 pp = *(const f32x4*)(part + (size_t)row * 16 + 4 * fq); float ss = (pp[0] + pp[1]) + (pp[2] + pp[3]);
                ss += __shfl_xor(ss, 16); ss += __shfl_xor(ss, 32);
                const float r = __builtin_amdgcn_rsqf(ss * (1.0f / DM) + EPS);
                f32x4 a, b;
#pragma unroll
                for (int j = 0; j < 4; ++j) { const float g0 = acc[ai][0][m][0][j] * r, u0 = acc[ai][1][m][0][j] * r, g1 = acc[ai][0][m][1][j] * r, u1 = acc[ai][1][m][1][j] * r;
                    a[j] = g0 * sigmoidf_(g0) * u0; b[j] = g1 * sigmoidf_(g1) * u1; }
                *(u32x4*)(act + (size_t)row * DFF + u.pn * 128 + wc * 32 + 8 * fq) = pack8(a, b); }
    } };
struct EpiFinal { static constexpr bool FUSED = true;
    const float* base; float* out; const float* gfin; unsigned* xbuf; unsigned* cnt; unsigned* tmo;
    __device__ __forceinline__ void operator()(const Acc&, const Unit&, int, int, int, int) const {}
    __device__ __forceinline__ void fused(f32x4 (&acc)[2][2][4][2], const Unit& u, int wr, int wc, int fr, int fq, LAS unsigned char* lds, int wid, int lane) const {
        LAS float* P = (LAS float*)lds;
        LAS float* S = (LAS float*)(lds + 8192);
        LAS unsigned* flag = (LAS unsigned*)(lds + 8192 + 2048);
#pragma unroll
        for (int ai = 0; ai < 2; ++ai)
#pragma unroll
            for (int m = 0; m < 4; ++m) { const int rl = ai * HALF + wr * 64 + m * 16 + fr; const int row = u.pm * BM + rl; float ss = 0.f;
#pragma unroll
                for (int bj = 0; bj < 2; ++bj) { const int col = u.pn * BM + bj * HALF + wc * 32 + 8 * fq; const size_t off = (size_t)row * DM + col;
                    const f32x4 x0 = *(const f32x4*)(base + off), x1 = *(const f32x4*)(base + off + 4);
                    const f32x4 a = x0 + acc[ai][bj][m][0], b = x1 + acc[ai][bj][m][1]; acc[ai][bj][m][0] = a; acc[ai][bj][m][1] = b;
                    ss += (a[0] * a[0] + a[1] * a[1]) + (a[2] * a[2] + a[3] * a[3]) + (b[0] * b[0] + b[1] * b[1]) + (b[2] * b[2] + b[3] * b[3]); }
                ss += __shfl_xor(ss, 16); ss += __shfl_xor(ss, 32);
                if (fq == 0) P[rl * 4 + wc] = ss; }
        asm volatile("s_waitcnt lgkmcnt(0)" ::: "memory"); __builtin_amdgcn_s_barrier(); asm volatile("" ::: "memory");
        const int rl = wid * 32 + (lane & 31);
        if (lane < 32) { const float tot = (P[rl * 4 + 0] + P[rl * 4 + 1]) + (P[rl * 4 + 2] + P[rl * 4 + 3]);
            __hip_atomic_store(xbuf + ((size_t)(u.pm * BM + rl) * 4 + u.pn), __float_as_uint(tot), __ATOMIC_RELAXED, __HIP_MEMORY_SCOPE_AGENT); }
        asm volatile("s_waitcnt vmcnt(0)" ::: "memory");
        if (lane == 0) __hip_atomic_fetch_add(cnt + 64 * u.pm, 1u, __ATOMIC_RELAXED, __HIP_MEMORY_SCOPE_AGENT);
        if (wid == 0) {
            unsigned sp = 0u;
            for (;;) {
                if ((unsigned)__builtin_amdgcn_readfirstlane(__hip_atomic_load(cnt + 64 * u.pm, __ATOMIC_RELAXED, __HIP_MEMORY_SCOPE_AGENT)) >= 32u) break;
                __builtin_amdgcn_s_sleep(2);
                if (++sp > (1u << 20)) { if (lane == 0) __hip_atomic_store(tmo, 1u, __ATOMIC_RELAXED, __HIP_MEMORY_SCOPE_AGENT); break; }
            }
            __builtin_amdgcn_fence(__ATOMIC_ACQUIRE, "agent");
            if (lane == 0) flag[0] = 1u;
        }
        asm volatile("s_waitcnt vmcnt(0) lgkmcnt(0)" ::: "memory"); __builtin_amdgcn_s_barrier(); asm volatile("" ::: "memory");
        if (lane < 32) { const unsigned* sl = xbuf + (size_t)(u.pm * BM + rl) * 4; float tot = 0.f;
#pragma unroll
            for (int t = 0; t < 4; ++t) tot += __uint_as_float(__hip_atomic_load(sl + t, __ATOMIC_RELAXED, __HIP_MEMORY_SCOPE_AGENT));
            S[rl] = __builtin_amdgcn_rsqf(tot * (1.0f / DM) + EPS); }
        asm volatile("s_waitcnt lgkmcnt(0)" ::: "memory"); __builtin_amdgcn_s_barrier(); asm volatile("" ::: "memory");
#pragma unroll
        for (int bj = 0; bj < 2; ++bj) { const int col = u.pn * BM + bj * HALF + wc * 32 + 8 * fq;
            const f32x4 g0 = *(const f32x4*)(gfin + col), g1 = *(const f32x4*)(gfin + col + 4);
#pragma unroll
            for (int ai = 0; ai < 2; ++ai)
#pragma unroll
                for (int m = 0; m < 4; ++m) { const int rl2 = ai * HALF + wr * 64 + m * 16 + fr; const float rs = S[rl2]; const size_t off = (size_t)(u.pm * BM + rl2) * DM + col;
                    *(f32x4*)(out + off) = acc[ai][bj][m][0] * rs * g0; *(f32x4*)(out + off + 4) = acc[ai][bj][m][1] * rs * g1; } }
    } };
}

namespace att {
constexpr int KB0 = 0, VB0 = 24576, IMP = 49152, IMPW = 65, SELM = IMP + 4 * 64 * IMPW * 4, WMASK = SELM + 512, WSF = WMASK + 64, STEPS = WSF + 8 * 32 * 4, CMPX = STEPS + 8 * 128, ATT_LDS = CMPX + 16384;
static_assert(ATT_LDS <= 143360, "attention LDS");
#define MFMA32(a, b, c) __builtin_amdgcn_mfma_f32_32x32x16_bf16((a), (b), (c), 0, 0, 0)
__device__ __forceinline__ int crow(int r, int hi) { return (r & 3) + 8 * (r >> 2) + 4 * hi; }
typedef short v4i16_t __attribute__((ext_vector_type(4)));
__device__ __forceinline__ s16x4 vtr(LAS const unsigned char* p) { return __builtin_bit_cast(s16x4, __builtin_amdgcn_ds_read_tr16_b64_v4i16((LAS v4i16_t*)p)); }

struct St { float m, l; f32x16 o0, o1; };

__device__ __forceinline__ void qk_tile(f32x16& p0, f32x16& p1, LAS const unsigned char* kb, const bf16x8* qf, int r, int h) {
    bf16x8 k0[4], k1[4], qv[4];
#pragma unroll
    for (int d0 = 0; d0 < 4; ++d0) { k0[d0] = *(const LAS bf16x8*)(kb + (2 * d0 + h) * 1024 + r * 16); k1[d0] = *(const LAS bf16x8*)(kb + (2 * d0 + h) * 1024 + 512 + r * 16);
        qv[d0] = qf[d0]; }
#pragma unroll
    for (int i = 0; i < 16; ++i) { p0[i] = 0.f; p1[i] = 0.f; }
    __builtin_amdgcn_sched_barrier(0);
#pragma unroll
    for (int d0 = 0; d0 < 4; ++d0) { p0 = MFMA32(k0[d0], qv[d0], p0); p1 = MFMA32(k1[d0], qv[d0], p1); }
}
__device__ __forceinline__ void apply_mask(f32x16& p0, f32x16& p1, unsigned long long allow, int h) {
    if (__all(allow == ~0ull)) return;
    const unsigned long long a = allow >> (4 * h); const unsigned lo = (unsigned)a, hi = (unsigned)(a >> 32);
#pragma unroll
    for (int i = 0; i < 16; ++i) { const int cb = (i & 3) + 8 * (i >> 2);
        p0[i] = ((lo >> cb) & 1u) ? p0[i] : -INFINITY; p1[i] = ((hi >> cb) & 1u) ? p1[i] : -INFINITY; }
}
__device__ __forceinline__ float rowmax32(const f32x16& p0, const f32x16& p1) {
    float a = fmaxf(p0[0], p1[0]);
#pragma unroll
    for (int i = 1; i < 16; ++i) a = fmaxf(a, fmaxf(p0[i], p1[i]));
    return fmaxf(a, __shfl_xor(a, 32));
}
__device__ __forceinline__ void pv_tile(f32x16& o0, f32x16& o1, LAS const unsigned char* vb, const f32x16& p0, const f32x16& p1, int lane, int h) {
    bf16x8 pa[4];
#pragma unroll
    for (int s = 0; s < 4; ++s) { u32x4 w;
#pragma unroll
        for (int j = 0; j < 4; ++j) { const int i0 = 8 * (s & 1) + 2 * j; w[j] = (s < 2) ? pk2(p0[i0], p0[i0 + 1]) : pk2(p1[i0], p1[i0 + 1]); }
        pa[s] = __builtin_bit_cast(bf16x8, w); }
    LAS const unsigned char* vp = vb + ((lane >> 4) & 1) * 32 + (lane & 3) * 8 + (4 * h + ((lane & 15) >> 2)) * 64;
    s16x4 l0[4], h0[4], l1[4], h1[4];
#pragma unroll
    for (int s = 0; s < 4; ++s) { l0[s] = vtr(vp + s * 1024); h0[s] = vtr(vp + s * 1024 + 512); l1[s] = vtr(vp + 4096 + s * 1024); h1[s] = vtr(vp + 4096 + s * 1024 + 512); }
    __builtin_amdgcn_sched_barrier(0);
#pragma unroll
    for (int s = 0; s < 4; ++s) {
        const bf16x8 v0 = (bf16x8){l0[s][0], l0[s][1], l0[s][2], l0[s][3], h0[s][0], h0[s][1], h0[s][2], h0[s][3]};
        const bf16x8 v1 = (bf16x8){l1[s][0], l1[s][1], l1[s][2], l1[s][3], h1[s][0], h1[s][1], h1[s][2], h1[s][3]};
        o0 = MFMA32(pa[s], v0, o0); o1 = MFMA32(pa[s], v1, o1);
    }
}
__device__ __forceinline__ void tile_online(St& st, LAS const unsigned char* kb, LAS const unsigned char* vb, const bf16x8* qr, unsigned long long allow,
                                            LAS float* wsf, int lane, int r, int h) {
    f32x16 p0, p1; qk_tile(p0, p1, kb, qr, r, h); __builtin_amdgcn_sched_barrier(0); apply_mask(p0, p1, allow, h);
    const float rm = rowmax32(p0, p1), mnew = fmaxf(st.m, rm), f = ex2(st.m - mnew); st.m = mnew;
    float ls = 0.f;
#pragma unroll
    for (int i = 0; i < 16; ++i) { p0[i] = ex2(p0[i] - mnew); p1[i] = ex2(p1[i] - mnew); ls += p0[i] + p1[i]; }
    st.l = st.l * f + ls;
    if (__any(f != 1.0f)) {
        if (h == 0) wsf[r] = f;
#pragma unroll
        for (int i = 0; i < 16; ++i) { const float fi = wsf[crow(i, h)]; st.o0[i] *= fi; st.o1[i] *= fi; }
    }
    pv_tile(st.o0, st.o1, vb, p0, p1, lane, h);
}
__device__ __forceinline__ void tile_stats(float& m, float& l, LAS const unsigned char* kb, const bf16x8* qr, unsigned long long allow, int r, int h) {
    f32x16 p0, p1; qk_tile(p0, p1, kb, qr, r, h); __builtin_amdgcn_sched_barrier(0); apply_mask(p0, p1, allow, h);
    const float rm = rowmax32(p0, p1), mnew = fmaxf(m, rm), f = ex2(m - mnew); m = mnew;
    float ls = 0.f;
#pragma unroll
    for (int i = 0; i < 16; ++i) ls += ex2(p0[i] - mnew) + ex2(p1[i] - mnew);
    l = l * f + ls;
}
__device__ __forceinline__ void tile_exact(f32x16& o0, f32x16& o1, float m, float invl, LAS const unsigned char* kb, LAS const unsigned char* vb, const bf16x8* qr,
                                           unsigned long long allow, LAS float* impw  , float& carry, int j, int lane, int r, int h) {
    f32x16 p0, p1; qk_tile(p0, p1, kb, qr, r, h); __builtin_amdgcn_sched_barrier(0); apply_mask(p0, p1, allow, h);
#pragma unroll
    for (int i = 0; i < 16; ++i) { p0[i] = ex2(p0[i] - m) * invl; p1[i] = ex2(p1[i] - m) * invl; }
#pragma unroll
    for (int pos = 0; pos < 8; ++pos) {
        const int half = pos >> 2, r4 = pos & 3;
        const float P0 = half ? p1[4 * r4] : p0[4 * r4], P1 = half ? p1[4 * r4 + 1] : p0[4 * r4 + 1], P2 = half ? p1[4 * r4 + 2] : p0[4 * r4 + 2], P3 = half ? p1[4 * r4 + 3] : p0[4 * r4 + 3];
        const float a = (P0 + P1) + (P2 + 0.5f * P3), b = 0.5f * P3;
        const float bx = __shfl_xor(b, 32);
        const float add = h ? bx : carry;
        impw[16 * j + 2 * pos + h] = a + add;
        carry = bx;
    }
    pv_tile(o0, o1, vb, p0, p1, lane, h);
}

__device__ __forceinline__ void qk_tile_c(f32x16& p0, f32x16& p1, LAS const unsigned char* kb, const bf16x8* qf, const f32x16& c, int r, int h) {
    bf16x8 k0[4], k1[4], qv[4];
#pragma unroll
    for (int d0 = 0; d0 < 4; ++d0) { k0[d0] = *(const LAS bf16x8*)(kb + (2 * d0 + h) * 1024 + r * 16); k1[d0] = *(const LAS bf16x8*)(kb + (2 * d0 + h) * 1024 + 512 + r * 16);
        qv[d0] = qf[d0]; }
    __builtin_amdgcn_sched_barrier(0);
    p0 = MFMA32(k0[0], qv[0], c); p1 = MFMA32(k1[0], qv[0], c);
#pragma unroll
    for (int d0 = 1; d0 < 4; ++d0) { p0 = MFMA32(k0[d0], qv[d0], p0); p1 = MFMA32(k1[d0], qv[d0], p1); }
}
__device__ __forceinline__ unsigned long long lowmask(int n);
__device__ __forceinline__ void soft_pv(St& st, f32x16& x0, f32x16& x1, float cx, LAS const unsigned char* vb, bool first, int kind, int tq,
                                        LAS float* wsf, int lane, int r, int h) {
    if (first) st.m = cx;
    else { const float d = st.m - cx;
        if (__any(d != 0.f)) {
#pragma unroll
            for (int i = 0; i < 16; ++i) { x0[i] -= d; x1[i] -= d; } } }
    if (kind) apply_mask(x0, x1, kind == 1 ? lowmask(tq + 1) : ~lowmask(tq + 1), h);
    const float rm = rowmax32(x0, x1);
    if (first) {
        const float dl = (rm > -INFINITY) ? rm : 0.f; st.m += dl;
#pragma unroll
        for (int i = 0; i < 16; ++i) { x0[i] -= dl; x1[i] -= dl; }
    } else if (__any(rm > 8.0f)) {
        const float dl = fmaxf(rm, 0.f), f = ex2(-dl); st.m += dl; st.l *= f;
        if (h == 0) wsf[r] = f;
#pragma unroll
        for (int i = 0; i < 16; ++i) { x0[i] -= dl; x1[i] -= dl; }
#pragma unroll
        for (int i = 0; i < 16; ++i) { const float fi = wsf[crow(i, h)]; st.o0[i] *= fi; st.o1[i] *= fi; }
    }
    float ls = 0.f;
#pragma unroll
    for (int i = 0; i < 16; ++i) { x0[i] = ex2(x0[i]); x1[i] = ex2(x1[i]); ls += x0[i] + x1[i]; }
    st.l += ls;
    pv_tile(st.o0, st.o1, vb, x0, x1, lane, h);
}
__device__ __forceinline__ unsigned long long lowmask(int n) { return n >= 64 ? ~0ull : ((1ull << n) - 1ull); }

typedef LAS const char* lds_cptr;
__device__ __forceinline__ void hs_glds16(const void* gsrc, unsigned lds_dst) { unsigned keep;
    asm volatile("s_mov_b32 %0, m0\n\ts_mov_b32 m0, %2\n\ts_nop 0\n\tglobal_load_lds_dwordx4 %1, off\n\ts_mov_b32 m0, %0" : "=&s"(keep) : "v"(gsrc), "s"(lds_dst) : "memory"); }
__device__ __forceinline__ float hs_max3f(float a, float b, float c) { float r; asm("v_max3_f32 %0, %1, %2, %3" : "=v"(r) : "v"(a), "v"(b), "v"(c)); return r; }
__device__ __forceinline__ float hs_max2f(float a, float b) { float r; asm("v_max_f32_e32 %0, %1, %2" : "=v"(r) : "v"(a), "v"(b)); return r; }
__device__ __forceinline__ float hs_fadd(float a, float b) { float r; asm("v_add_f32_e32 %0, %1, %2" : "=v"(r) : "v"(a), "v"(b)); return r; }
__device__ __forceinline__ float hs_fsub(float a, float b) { float r; asm("v_sub_f32_e32 %0, %1, %2" : "=v"(r) : "v"(a), "v"(b)); return r; }
#define HS_SBAR() __builtin_amdgcn_sched_barrier(0)
#define HS_WAIT_BAR(N) asm volatile("s_waitcnt vmcnt(" #N ") lgkmcnt(0)\n\ts_barrier" ::: "memory")
__device__ __forceinline__ void hs_qkt(f32x16& p0, f32x16& p1, const char* Kslot, const bf16x8* qr, const f32x16& negm, int r32, int hi) {
    const char* kb = Kslot + hi * 1024 + r32 * 16;
#pragma unroll
    for (int d0 = 0; d0 < 4; ++d0) {
        const bf16x8 b0 = *reinterpret_cast<const bf16x8*>(kb + d0 * 2048);
        const bf16x8 b1 = *reinterpret_cast<const bf16x8*>(kb + d0 * 2048 + 512);
        if (d0 == 0) { p0 = MFMA32(b0, qr[0], negm); p1 = MFMA32(b1, qr[0], negm); }
        else { p0 = MFMA32(b0, qr[d0], p0); p1 = MFMA32(b1, qr[d0], p1); } }
}
__device__ __forceinline__ void hs_kload8(bf16x8* kf, lds_cptr kp) {
    kf[0] = *(const LAS bf16x8*)(kp);        kf[1] = *(const LAS bf16x8*)(kp + 512);
    kf[2] = *(const LAS bf16x8*)(kp + 2048); kf[3] = *(const LAS bf16x8*)(kp + 2560);
    kf[4] = *(const LAS bf16x8*)(kp + 4096); kf[5] = *(const LAS bf16x8*)(kp + 4608);
    kf[6] = *(const LAS bf16x8*)(kp + 6144); kf[7] = *(const LAS bf16x8*)(kp + 6656);
}
__device__ __forceinline__ void hs_kload2(bf16x8* kf, lds_cptr kp, int j) { kf[2 * j] = *(const LAS bf16x8*)(kp + j * 2048); kf[2 * j + 1] = *(const LAS bf16x8*)(kp + j * 2048 + 512); }
__device__ __forceinline__ s16x4 hs_vtr(lds_cptr p) { return __builtin_bit_cast(s16x4, __builtin_amdgcn_ds_read_tr16_b64_v4i16((LAS v4i16_t*)p)); }
__device__ __forceinline__ float hs_rowmax(const f32x16& p0, const f32x16& p1) {
    float a = hs_max3f(p0[0], p0[1], p1[0]), b = hs_max3f(p0[2], p0[3], p1[1]); a = hs_max3f(a, p1[2], p1[3]);
#pragma unroll
    for (int r = 4; r < 16; r += 4) { a = hs_max3f(a, p0[r], p0[r + 1]); b = hs_max3f(b, p0[r + 2], p0[r + 3]); a = hs_max3f(a, p1[r], p1[r + 1]); b = hs_max3f(b, p1[r + 2], p1[r + 3]); }
    const float m = hs_max2f(a, b);
    auto rr = __builtin_amdgcn_permlane32_swap(__float_as_uint(m), __float_as_uint(m), false, false);
    return hs_max2f(__uint_as_float(rr[0]), __uint_as_float(rr[1]));
}
__device__ __forceinline__ void hs_pv(f32x16* o, int vb, bf16x8 pa0, bf16x8 pa1, bf16x8 pa2, bf16x8 pa3) {
#pragma unroll
    for (int d0 = 0; d0 < 2; ++d0) { s16x4 lo[4], hi[4];
#pragma unroll
        for (int ks = 0; ks < 4; ++ks) {
            asm volatile("ds_read_b64_tr_b16 %0,%1 offset:%c2" : "=&v"(lo[ks]) : "v"(vb), "i"(d0 * 4096 + ks * 1024) : "memory");
            asm volatile("ds_read_b64_tr_b16 %0,%1 offset:%c2" : "=&v"(hi[ks]) : "v"(vb), "i"(d0 * 4096 + ks * 1024 + 512) : "memory"); }
        asm volatile("s_waitcnt lgkmcnt(0)" ::: "memory"); HS_SBAR();
#define HS_PK(k) (bf16x8){lo[k][0], lo[k][1], lo[k][2], lo[k][3], hi[k][0], hi[k][1], hi[k][2], hi[k][3]}
        o[d0] = MFMA32(pa0, HS_PK(0), o[d0]); o[d0] = MFMA32(pa1, HS_PK(1), o[d0]); o[d0] = MFMA32(pa2, HS_PK(2), o[d0]); o[d0] = MFMA32(pa3, HS_PK(3), o[d0]);
#undef HS_PK
    }
}
template <int THRL> __device__ __forceinline__ void run_branch(char* shm, const bf16x8* qr, const bf16_t* ksb, LAS const unsigned char* steps, const int NT,
                                                               const int qb, f32x16* o, float& l_out, const int wid, const int lane) {
    constexpr int SLOTB = 8192, NSLOT = 3;
    { unsigned long long p_ = (unsigned long long)ksb; asm volatile("" : "+s"(p_)); ksb = (const bf16_t*)p_; }
    const int r32 = lane & 31, hi = lane >> 5, tq = (wid & 1) * 32 + r32;
    const unsigned lds0 = (unsigned)(uintptr_t)shm;
    const unsigned long long mysel = *((LAS const unsigned long long*)((lds_cptr)shm + SELM) + tq);
    const int vcodes = (int)steps[lane];
    float* wsf = (float*)(shm + WSF) + wid * 32;
    const size_t koff = (size_t)lane * PP + wid * 8, voff = (size_t)(16 * (wid & 3) + (lane >> 2)) * PP + (wid >> 2) * 32 + (lane & 3) * 8 + (C_VS - C_KS);
    const unsigned kdst = lds0 + KB0 + wid * 1024, vdst = lds0 + VB0 + wid * 1024;
#define HS_CODE(t) ((int)__builtin_amdgcn_readlane(vcodes, (t)))
#define HS_SRC(c) (ksb + (size_t)(((c) & 0x80) ? (C_KW - C_KS) : 0) + (size_t)(((c) == 0x7f) ? 0 : ((c) & 0x7f)) * 64 * PP)
#define DMA_K(t, slot) do { const int c_ = HS_CODE(t); hs_glds16(HS_SRC(c_) + koff, (unsigned)__builtin_amdgcn_readfirstlane(kdst + (slot))); } while (0)
#define DMA_V(t, slot) do { const int c_ = HS_CODE(t); hs_glds16(HS_SRC(c_) + voff, (unsigned)__builtin_amdgcn_readfirstlane(vdst + (slot))); } while (0)
    const int vb0 = (int)(lds0 + VB0) + ((lane >> 4) & 1) * 32 + (lane & 3) * 8 + (4 * hi + ((lane & 15) >> 2)) * 64;
    const char* Kbase = shm + KB0; bf16x8 kf[8];
    const lds_cptr shm3 = (lds_cptr)shm; const lds_cptr kp0 = shm3 + KB0 + hi * 1024 + r32 * 16; const lds_cptr vp0 = shm3 + VB0 + ((lane >> 4) & 1) * 32 + (lane & 3) * 8 + (4 * hi + ((lane & 15) >> 2)) * 64;
    DMA_K(0, 0); DMA_V(0, 0); DMA_K(1, SLOTB);
    float mhat = 0.f, l_reg = 0.f; f32x16 negm;
    { float z = 0.f; asm volatile("" : "+v"(z));
#pragma unroll
      for (int i = 0; i < 16; ++i) { o[0][i] = z; o[1][i] = z; negm[i] = z; } }
    asm volatile("" : "+v"(negm));
#define CMASK(P0, P1, t) do { const int c_ = HS_CODE(t); const bool isw_ = (c_ & 0x80) != 0; const int jj_ = c_ & 0x7f; \
        const bool en_ = isw_ ? true : ((c_ != 0x7f) && (((mysel >> (jj_ & 63)) & 1ull) != 0ull)); \
        if (__any(!en_)) { if (!en_) { _Pragma("unroll") for (int r = 0; r < 16; ++r) { P0[r] = -INFINITY; P1[r] = -INFINITY; } } } \
        int kind_ = 0; if (c_ != 0x7f) { if (jj_ == qb) kind_ = 1; else if (isw_ && jj_ == qb - 8) kind_ = 2; } \
        if (kind_) apply_mask(P0, P1, kind_ == 1 ? lowmask(tq + 1) : ~lowmask(tq + 1), hi); } while (0)
    bool resc = false;
#define START(P0, P1) do { const float rm = hs_rowmax(P0, P1); resc = false; \
        { const float dl = (rm > -INFINITY) ? rm : 0.f; mhat = hs_fadd(mhat, dl); \
          _Pragma("unroll") for (int r = 0; r < 16; ++r) { P0[r] = hs_fsub(P0[r], dl); P1[r] = hs_fsub(P1[r], dl); } \
          _Pragma("unroll") for (int r = 0; r < 16; ++r) negm[r] = -mhat; asm volatile("" : "+v"(negm)); } \
        _Pragma("unroll") for (int r = 0; r < 16; ++r) P0[r] = __builtin_amdgcn_exp2f(P0[r]); } while (0)
#define RESC() do { if (resc) { asm volatile("s_waitcnt lgkmcnt(0)" ::: "memory"); \
        _Pragma("unroll") for (int d_ = 0; d_ < 2; ++d_) _Pragma("unroll") for (int r = 0; r < 16; ++r) o[d_][r] *= wsf[crow(r, hi)]; } } while (0)
    f32x16 pA0, pA1, pB0, pB1;
    int sl_prev = 0, sl_cur = 0, sl_next = SLOTB;
#define ROT() do { sl_prev = sl_cur; sl_cur = sl_next; sl_next = (sl_next == (NSLOT - 1) * SLOTB) ? 0 : sl_next + SLOTB; } while (0)
    DMA_K(2, 2 * SLOTB);
    HS_WAIT_BAR(3);
    hs_qkt(pA0, pA1, Kbase, qr, negm, r32, hi); asm volatile("s_nop 15\n\ts_nop 7" : "+v"(pA0), "+v"(pA1)); CMASK(pA0, pA1, 0);
    START(pA0, pA1);
    _Pragma("unroll") for (int r = 0; r < 16; ++r) pA1[r] = __builtin_amdgcn_exp2f(pA1[r]);
    HS_WAIT_BAR(0);
    DMA_K(3, 0); DMA_V(1, SLOTB);
    ROT();
    hs_kload8(kf, kp0 + sl_cur);
    HS_WAIT_BAR(2);
    s16x4 vlo[8], vhi[8]; u32x4 pw0, pw1, pw2, pw3;
#define PKW(P, B) pk2(P[B], P[B + 1])
#define PAF(k) __builtin_bit_cast(bf16x8, pw##k)
#define VFR(i) (bf16x8){vlo[i][0], vlo[i][1], vlo[i][2], vlo[i][3], vhi[i][0], vhi[i][1], vhi[i][2], vhi[i][3]}
#define PIN(x) asm volatile("" : "+v"(x))
#define MX3(a, b, c) __builtin_fmaxf(__builtin_fmaxf((a), (b)), (c))
#define GAPA(MF, A0, A1, A2, A3, W0, W1, PW) do { MF; sacc += A0; sacc += A1; sacc += A2; sacc += A3; PIN(sacc); W0; W1; PIN(PW); HS_SBAR(); } while (0)
#define EX(v) __builtin_amdgcn_exp2f(v)
#define GAPB(MF, X, B) do { MF; X[B] = EX(X[B]); X[B + 1] = EX(X[B + 1]); X[B + 2] = EX(X[B + 2]); X[B + 3] = EX(X[B + 3]); PIN(X); HS_SBAR(); } while (0)
#define VRD(i) do { vlo[i] = hs_vtr(vp_ + (((i) >> 2) * 4096 + ((i) & 3) * 1024)); vhi[i] = hs_vtr(vp_ + (((i) >> 2) * 4096 + ((i) & 3) * 1024 + 512)); } while (0)
#define KRD(G, j) do { if (G) { hs_kload2(kf, kp0 + sl_next, j); HS_SBAR(); } } while (0)
#define STEP(C0, C1, P0, P1, t, GK, GV, GL) do { HS_SBAR(); \
        const lds_cptr vp_ = vp0 + sl_prev; \
        VRD(0); HS_SBAR(); float sacc = (P0[0] + P0[1]); \
        GAPA(C0 = MFMA32(kf[0], qr[0], negm), P0[2], P0[3], P0[4], P0[5],     pw0[0] = PKW(P0, 0), pw0[1] = PKW(P0, 2), pw0); \
        VRD(4); HS_SBAR(); GAPA(C1 = MFMA32(kf[1], qr[0], negm), P0[6], P0[7], P0[8], P0[9],     pw0[2] = PKW(P0, 4), pw0[3] = PKW(P0, 6), pw0); \
        VRD(1); HS_SBAR(); GAPA(C0 = MFMA32(kf[2], qr[1], C0),   P0[10], P0[11], P0[12], P0[13], pw1[0] = PKW(P0, 8), pw1[1] = PKW(P0, 10), pw1); \
        VRD(5); HS_SBAR(); GAPA(C1 = MFMA32(kf[3], qr[1], C1),   P0[14], P0[15], P1[0], P1[1],   pw1[2] = PKW(P0, 12), pw1[3] = PKW(P0, 14), pw1); \
        VRD(2); HS_SBAR(); GAPA(C0 = MFMA32(kf[4], qr[2], C0),   P1[2], P1[3], P1[4], P1[5],     pw2[0] = PKW(P1, 0), pw2[1] = PKW(P1, 2), pw2); \
        VRD(6); HS_SBAR(); GAPA(C1 = MFMA32(kf[5], qr[2], C1),   P1[6], P1[7], P1[8], P1[9],     pw2[2] = PKW(P1, 4), pw2[3] = PKW(P1, 6), pw2); \
        VRD(3); HS_SBAR(); GAPA(C0 = MFMA32(kf[6], qr[3], C0),   P1[10], P1[11], P1[12], P1[13], pw3[0] = PKW(P1, 8), pw3[1] = PKW(P1, 10), pw3); \
        VRD(7); HS_SBAR(); GAPA(C1 = MFMA32(kf[7], qr[3], C1),   P1[14], P1[15], 0.f, 0.f,       pw3[2] = PKW(P1, 12), pw3[3] = PKW(P1, 14), pw3); \
        l_reg += sacc; \
        if (GK) { DMA_K((t) + 3, sl_cur); } if (GV) { DMA_V((t) + 1, sl_next); } \
        CMASK(C0, C1, t); \
        { float a = MX3(C0[0], C0[1], C1[0]), b = MX3(C0[2], C0[3], C1[1]); a = MX3(a, C1[2], C1[3]); \
          _Pragma("unroll") for (int r = 4; r < 16; r += 4) { a = MX3(a, C0[r], C0[r + 1]); b = MX3(b, C0[r + 2], C0[r + 3]); a = MX3(a, C1[r], C1[r + 1]); b = MX3(b, C1[r + 2], C1[r + 3]); } \
          float rm = __builtin_fmaxf(a, b); { auto rr = __builtin_amdgcn_permlane32_swap(__float_as_uint(rm), __float_as_uint(rm), false, false); rm = __builtin_fmaxf(__uint_as_float(rr[0]), __uint_as_float(rr[1])); } \
          resc = false; \
          if (__builtin_expect(__any(rm > (float)THRL), 0)) { const float dl = __builtin_fmaxf(rm, 0.f); mhat += dl; \
            _Pragma("unroll") for (int r = 0; r < 16; ++r) { C0[r] -= dl; C1[r] -= dl; } \
            _Pragma("unroll") for (int r = 0; r < 16; ++r) negm[r] = -mhat; asm volatile("" : "+v"(negm)); \
            const float f = __builtin_amdgcn_exp2f(-dl); l_reg *= f; if (hi == 0) wsf[r32] = f; resc = true; } } \
        HS_SBAR(); \
        GAPB(o[0] = MFMA32(PAF(0), VFR(0), o[0]), C0, 0); \
        GAPB(o[1] = MFMA32(PAF(0), VFR(4), o[1]), C0, 4); \
        KRD(GL, 0); GAPB(o[0] = MFMA32(PAF(1), VFR(1), o[0]), C0, 8); \
        KRD(GL, 1); GAPB(o[1] = MFMA32(PAF(1), VFR(5), o[1]), C0, 12); \
        KRD(GL, 2); GAPB(o[0] = MFMA32(PAF(2), VFR(2), o[0]), C1, 0); \
        KRD(GL, 3); GAPB(o[1] = MFMA32(PAF(2), VFR(6), o[1]), C1, 4); \
        GAPB(o[0] = MFMA32(PAF(3), VFR(3), o[0]), C1, 8); \
        GAPB(o[1] = MFMA32(PAF(3), VFR(7), o[1]), C1, 12); \
    } while (0)
    int t = 1;
    for (; t + 5 < NT; t += 2) {
        STEP(pB0, pB1, pA0, pA1, t, true, true, true);     HS_WAIT_BAR(2); RESC(); ROT();
        STEP(pA0, pA1, pB0, pB1, t + 1, true, true, true); HS_WAIT_BAR(2); RESC(); ROT();
    }
#define ENDW(tt) do { if ((tt) + 3 < NT) { HS_WAIT_BAR(2); } else if ((tt) + 2 < NT) { HS_WAIT_BAR(1); } else { HS_WAIT_BAR(0); } } while (0)
    for (; t + 1 < NT; t += 2) {
        STEP(pB0, pB1, pA0, pA1, t, (t + 3 < NT), (t + 1 < NT), (t + 1 < NT));         ENDW(t);     RESC(); ROT();
        STEP(pA0, pA1, pB0, pB1, t + 1, (t + 4 < NT), (t + 2 < NT), (t + 2 < NT));     ENDW(t + 1); RESC(); ROT();
    }
#define DRAIN(PX0, PX1, SL) do { float sacc = PX0[0] + PX0[1]; _Pragma("unroll") for (int r = 2; r < 16; ++r) sacc += PX0[r]; _Pragma("unroll") for (int r = 0; r < 16; ++r) sacc += PX1[r]; l_reg += sacc; \
      pw0 = (u32x4){PKW(PX0, 0), PKW(PX0, 2), PKW(PX0, 4), PKW(PX0, 6)}; pw1 = (u32x4){PKW(PX0, 8), PKW(PX0, 10), PKW(PX0, 12), PKW(PX0, 14)}; \
      pw2 = (u32x4){PKW(PX1, 0), PKW(PX1, 2), PKW(PX1, 4), PKW(PX1, 6)}; pw3 = (u32x4){PKW(PX1, 8), PKW(PX1, 10), PKW(PX1, 12), PKW(PX1, 14)}; \
      HS_SBAR(); hs_pv(o, vb0 + (SL), PAF(0), PAF(1), PAF(2), PAF(3)); } while (0)
    if (NT & 1) {
        DRAIN(pA0, pA1, sl_prev);
    } else {
        STEP(pB0, pB1, pA0, pA1, NT - 1, false, false, false); RESC();
        DRAIN(pB0, pB1, sl_cur);
    }
#undef DRAIN
    { auto rr = __builtin_amdgcn_permlane32_swap(__float_as_uint(l_reg), __float_as_uint(l_reg), false, false); l_out = __uint_as_float(rr[0]) + __uint_as_float(rr[1]); }
    asm volatile("s_waitcnt lgkmcnt(0)\n\ts_barrier" ::: "memory");
#undef PKW
#undef PAF
#undef VFR
#undef PIN
#undef MX3
#undef GAPA
#undef GAPB
#undef EX
#undef VRD
#undef KRD
#undef STEP
#undef ENDW
#undef DMA_K
#undef DMA_V
#undef CMASK
#undef START
#undef RESC
#undef ROT
#undef HS_CODE
#undef HS_SRC
}
__device__ __forceinline__ void attn_unit(LAS unsigned char* lds, bf16_t* proj, const bf16_t* kcmp, const bf16_t* vcmp, int bh, int qb, int skipw) {
    int tid_ = threadIdx.x; asm volatile("" : "+v"(tid_));
    const int tid = tid_, lane = tid & 63, r = lane & 31, h = lane >> 5, wid = __builtin_amdgcn_readfirstlane(tid >> 6);
    const int b = bh >> 2, hk = bh & 3, g = wid >> 1, tq = (wid & 1) * 32 + r;
    const size_t row = (size_t)b * SEQ + (size_t)qb * 64 + tq;
    const int t = qb * 64 + tq;
    bf16_t* qp = proj + row * PP + C_Q + (hk * 4 + g) * 64;
    bf16x8 qreg[4];
#pragma unroll
    for (int d0 = 0; d0 < 4; ++d0) qreg[d0] = *(const bf16x8*)(qp + d0 * 16 + h * 8);
    const bf16x8* qr = qreg;
    float gate[3];
#pragma unroll
    for (int c = 0; c < 3; ++c) gate[c] = sigmoidf_(bf2f(proj[row * PP + C_GBR + c * 16 + hk * 4 + g]));
#ifdef GATE2X
    if (GATE2X & 1) gate[0] *= 2.f; if (GATE2X & 2) gate[1] *= 2.f; if (GATE2X & 4) gate[2] *= 2.f;
#endif
#ifdef GATEZ
    if (GATEZ & 1) gate[0] = 0.f; if (GATEZ & 2) gate[1] = 0.f; if (GATEZ & 4) gate[2] = 0.f;
#endif
    LAS float* wsf = (LAS float*)(lds + WSF) + wid * 32;
    LAS float* impw = (LAS float*)(lds + IMP) + (g * 64 + tq) * IMPW;
    const size_t krow = lane, kcol = wid * 8;
    const size_t vrow = 16 * (wid & 3) + (lane >> 2), vcol = 32 * (wid >> 2) + 8 * (lane & 3);
    LAS unsigned char* kst = lds + KB0 + wid * 1024 + lane * 16;
    LAS unsigned char* vst = lds + VB0 + wid * 1024 + lane * 16;
    u32x4 kreg, vreg;
    LAS float* osl = (LAS float*)(lds + IMP + wid * (32 * IMPW * 4)) + lane;
#define LDK(base, pitch) kreg = *(const u32x4*)((base) + krow * (size_t)(pitch) + kcol)
#define LDV(base, pitch) vreg = *(const u32x4*)((base) + vrow * (size_t)(pitch) + vcol)
#define STK(buf) *(LAS u32x4*)(kst + (buf) * 8192) = kreg
#define STV(buf) *(LAS u32x4*)(vst + (buf) * 8192) = vreg
#define KBUF(buf) (lds + KB0 + (buf) * 8192)
#define VBUF(buf) (lds + VB0 + (buf) * 8192)
#define ACCUM_OUT(scale_expr, FIRST) do { if (h == 0) wsf[r] = (scale_expr); \
        _Pragma("unroll") for (int i = 0; i < 16; ++i) { const float sc = wsf[crow(i, h)]; \
            if (FIRST) { osl[(i * 2) * 64] = st.o0[i] * sc; osl[(i * 2 + 1) * 64] = st.o1[i] * sc; } \
            else { osl[(i * 2) * 64] += st.o0[i] * sc; osl[(i * 2 + 1) * 64] += st.o1[i] * sc; } } } while (0)

    St st;
    const bf16_t* kc = kcmp + (size_t)bh * 256 * 64; const bf16_t* vc = vcmp + (size_t)bh * 256 * 64;
    const int nmax = (t >= 31) ? ((t - 31) >> 4) : -1;
#define CMP_KT(j) (lds + (j) * 8192)
#define CMP_VT(j) ((j) < 2 ? lds + 32768 + (j) * 8192 : lds + CMPX + ((j) - 2) * 8192)
    {
        u32x4 kr4[4], vr4[4];
#pragma unroll
        for (int j = 0; j < 4; ++j) { kr4[j] = *(const u32x4*)(kc + (size_t)j * 4096 + krow * 64 + kcol); vr4[j] = *(const u32x4*)(vc + (size_t)j * 4096 + vrow * 64 + vcol); }
#pragma unroll
        for (int j = 0; j < 4; ++j) { *(LAS u32x4*)(CMP_KT(j) + wid * 1024 + lane * 16) = kr4[j]; *(LAS u32x4*)(CMP_VT(j) + wid * 1024 + lane * 16) = vr4[j]; }
    }
    __syncthreads();
    float carry = 0.f;
    float m1 = -1e30f, l1 = 0.f;
#pragma unroll 1
    for (int j = 0; j < 4; ++j) {
        const int cnt = nmax - 64 * j + 1; const unsigned long long allow = cnt <= 0 ? 0ull : lowmask(cnt);
        tile_stats(m1, l1, CMP_KT(j), qr, allow, r, h);
    }
    l1 += __shfl_xor(l1, 32);
    const float invl = __builtin_amdgcn_rcpf(fmaxf(l1, 1e-30f));
#pragma unroll
    for (int i = 0; i < 16; ++i) { st.o0[i] = 0.f; st.o1[i] = 0.f; }
#pragma unroll 1
    for (int j = 0; j < 4; ++j) {
        const int cnt = nmax - 64 * j + 1; const unsigned long long allow = cnt <= 0 ? 0ull : lowmask(cnt);
        tile_exact(st.o0, st.o1, m1, invl, CMP_KT(j), CMP_VT(j), qr, allow, impw, carry, j, lane, r, h);
    }
    __syncthreads();
#undef CMP_KT
#undef CMP_VT
    {
        unsigned long long wor = 0ull;
        const unsigned long long valid = lowmask(qb + 1);
        LAS const float* ib = (LAS const float*)(lds + IMP);
        unsigned key[8], T[8];
#pragma unroll
        for (int i = 0; i < 8; ++i) { const int q = wid * 8 + i;
            float v = ((ib[(0 * 64 + q) * IMPW + lane] + ib[(1 * 64 + q) * IMPW + lane]) + ib[(2 * 64 + q) * IMPW + lane]) + ib[(3 * 64 + q) * IMPW + lane];
            if (lane == 0 || lane == qb || lane == qb - 1) v = INFINITY;
            key[i] = (lane <= qb) ? __float_as_uint(fmaxf(v, 0.f)) : 0u; T[i] = 0u; }
#pragma unroll 1
        for (int bb = 30; bb >= 0; --bb) {
#pragma unroll
            for (int i = 0; i < 8; ++i) { const unsigned cand = T[i] | (1u << bb);
                const int c = __popcll(__ballot(key[i] >= cand) & valid); T[i] = (c >= 16) ? cand : T[i]; }
        }
#pragma unroll
        for (int i = 0; i < 8; ++i) { const int q = wid * 8 + i;
            const unsigned long long gt = __ballot(key[i] > T[i]) & valid, eq = __ballot(key[i] == T[i]) & valid;
            const int need = 16 - __popcll(gt);
            const bool pick = ((eq >> lane) & 1ull) && (__popcll(eq & lowmask(lane)) < need);
            const unsigned long long msk = gt | __ballot(pick);
            if (lane == 0) *(LAS unsigned long long*)(lds + SELM + q * 8) = msk;
            wor |= msk; }
        if (lane == 0) *(LAS unsigned long long*)(lds + WMASK + wid * 8) = wor;
    }
    __syncthreads();
    unsigned long long un = 0ull;
#pragma unroll
    for (int w = 0; w < 8; ++w) un |= *(LAS const unsigned long long*)(lds + WMASK + w * 8);
    { const unsigned ulo = __builtin_amdgcn_readfirstlane((unsigned)un), uhi = __builtin_amdgcn_readfirstlane((unsigned)(un >> 32)); un = ((unsigned long long)uhi << 32) | ulo; }
    ACCUM_OUT(gate[0], true);
    {
        LAS unsigned char* steps = lds + STEPS + wid * 128;
        const int nsel = __popcll(un), j0w = qb >= 8 ? qb - 8 : 0, nwin = qb - j0w + 1;
        const int NTs = nsel < 4 ? 4 : nsel, NTw = nwin < 4 ? 4 : nwin;
        if ((un >> lane) & 1ull) steps[__popcll(un & lowmask(lane))] = (unsigned char)lane;
        if (lane >= nsel && lane < NTs) steps[lane] = (unsigned char)0x7f;
        if (lane < NTw) steps[64 + lane] = (unsigned char)(lane < nwin ? (0x80 | (j0w + lane)) : 0x7f);
        const bf16_t* ksb = proj + (size_t)b * SEQ * PP + C_KS + hk * 64;
        char* shm = (char*)lds;
        f32x16 ob[2]; float lt;
        run_branch<8>(shm, qr, ksb, steps, NTs, qb, ob, lt, wid, lane);
        {
            int t2 = threadIdx.x; asm volatile("" : "+v"(t2));
            const int lane2 = t2 & 63, r2 = lane2 & 31, h2 = lane2 >> 5, wid2 = __builtin_amdgcn_readfirstlane(t2 >> 6), g2 = wid2 >> 1, tq2 = (wid2 & 1) * 32 + r2;
            LAS float* wsf2 = (LAS float*)(lds + WSF) + wid2 * 32; LAS float* osl2 = (LAS float*)(lds + IMP + wid2 * (32 * IMPW * 4)) + lane2;
            const float g1 = sigmoidf_(bf2f(proj[((size_t)b * SEQ + (size_t)qb * 64 + tq2) * PP + C_GBR + 1 * 16 + hk * 4 + g2]));
            if (h2 == 0) wsf2[r2] = g1 * __builtin_amdgcn_rcpf(fmaxf(lt, 1e-30f));
#pragma unroll
            for (int i = 0; i < 16; ++i) { const float sc = wsf2[crow(i, h2)]; osl2[(i * 2) * 64] += ob[0][i] * sc; osl2[(i * 2 + 1) * 64] += ob[1][i] * sc; }
        }
        {
            int t3 = threadIdx.x; asm volatile("" : "+v"(t3));
            run_branch<8>(shm, qr, ksb, steps + 64, NTw, qb, ob, lt, __builtin_amdgcn_readfirstlane(t3 >> 6), t3 & 63);
        }
        st.o0 = ob[0]; st.o1 = ob[1]; st.l = lt;
    }
    {
        int t2 = threadIdx.x; asm volatile("" : "+v"(t2));
        const int lane2 = t2 & 63, r2 = lane2 & 31, h2 = lane2 >> 5, wid2 = __builtin_amdgcn_readfirstlane(t2 >> 6), g2 = wid2 >> 1, tq2 = (wid2 & 1) * 32 + r2;
        LAS float* wsf2 = (LAS float*)(lds + WSF) + wid2 * 32; LAS float* osl2 = (LAS float*)(lds + IMP + wid2 * (32 * IMPW * 4)) + lane2;
        const float g3 = sigmoidf_(bf2f(proj[((size_t)b * SEQ + (size_t)qb * 64 + tq2) * PP + C_GBR + 2 * 16 + hk * 4 + g2]));
        if (h2 == 0) wsf2[r2] = g3 * __builtin_amdgcn_rcpf(fmaxf(st.l, 1e-30f));
        bf16_t* ob2 = proj + ((size_t)b * SEQ + (size_t)qb * 64 + (wid2 & 1) * 32) * PP + C_Q + (hk * 4 + g2) * 64;
        if (!skipw)
#pragma unroll
        for (int i = 0; i < 16; ++i) { const int q = crow(i, h2); const float sc = wsf2[q];
            const float f0 = osl2[(i * 2) * 64] + st.o0[i] * sc, f1 = osl2[(i * 2 + 1) * 64] + st.o1[i] * sc;
            ob2[(size_t)q * PP + r2] = (bf16_t)(pk2(f0, 0.f) & 0xffffu); ob2[(size_t)q * PP + 32 + r2] = (bf16_t)(pk2(f1, 0.f) & 0xffffu); }
    }
#undef LDK
#undef LDV
#undef STK
#undef STV
#undef KBUF
#undef VBUF
#undef ACCUM_OUT
}
}

__device__ __forceinline__ float wave_sum(float v) {
#pragma unroll
    for (int o = 1; o < 64; o <<= 1) v += __shfl_xor(v, o);
    return v;
}
__device__ __forceinline__ void transpose_item(const float* W, int K, int N, bf16_t* WT, int ldt, int k0, int n0, int drow0, const float* kscale, float cscale, LAS float* scr, int lane) {
#pragma unroll 8
    for (int i = 0; i < 32; ++i) { const int kk = 2 * i + (lane >> 5); const int n = n0 + (lane & 31);
        float v = (n < N) ? W[(size_t)(k0 + kk) * N + n] : 0.f;
        if (kscale) v *= kscale[k0 + kk];
        scr[kk * 33 + (lane & 31)] = v * cscale; }
    asm volatile("s_waitcnt lgkmcnt(0)" ::: "memory");
    const int c = lane & 7;
#pragma unroll
    for (int j = 0; j < 4; ++j) { const int n = (lane >> 3) + 8 * j; const LAS float* s = scr + (8 * c) * 33 + n;
        u32x4 o; o.x = pk2(s[0 * 33], s[1 * 33]); o.y = pk2(s[2 * 33], s[3 * 33]); o.z = pk2(s[4 * 33], s[5 * 33]); o.w = pk2(s[6 * 33], s[7 * 33]);
        *(u32x4*)(WT + (size_t)(drow0 + n) * ldt + k0 + 8 * c) = o; }
    asm volatile("s_waitcnt lgkmcnt(0)" ::: "memory");
}

#define XB_TMO      128
#define XB_XCNT(j)  (256  + 64 * (j))
#define XB_XSUB(j)  (1280 + 64 * (j))
#define XB_XGEN(j)  (2304 + 64 * (j))
#define XB_TOP      3328
#define XB_TOPGEN   3392
#define XCD_BAR_WORDS 3456
#define XB_SPIN_CAP (1u << 18)
__device__ __forceinline__ unsigned xb_ld(unsigned* p)              { return __hip_atomic_load(p, __ATOMIC_RELAXED, __HIP_MEMORY_SCOPE_AGENT); }
__device__ __forceinline__ unsigned xb_add(unsigned* p, unsigned v) { return __hip_atomic_fetch_add(p, v, __ATOMIC_RELAXED, __HIP_MEMORY_SCOPE_AGENT); }
__device__ __forceinline__ unsigned xb_xcc_id() { return (unsigned)__builtin_amdgcn_s_getreg((3 << 11) | 20) & 0xFu; }
#define XB_SPIN(cond, bar) do { unsigned _sp = 0; while (cond) { __builtin_amdgcn_s_sleep(1); \
    if ((++_sp & 255u) == 0u) { if (xb_ld(&(bar)[XB_TMO])) break; if (_sp > XB_SPIN_CAP) { atomicAdd(&(bar)[XB_TMO], 1u); break; } } } } while (0)
struct XcdBarrier { unsigned* bar; unsigned x; volatile LAS unsigned* st; };
__device__ __forceinline__ XcdBarrier xcd_barrier_post(unsigned* bar, volatile LAS unsigned* st) {
    XcdBarrier b; b.bar = bar; b.x = xb_xcc_id(); b.st = st;
    if (threadIdx.x == 0) (void)xb_add(&bar[XB_XCNT(b.x)], 1u);
    return b;
}
__device__ __forceinline__ void xcd_barrier_complete(unsigned* bar, unsigned x, unsigned& nloc, unsigned& nx) {
    const unsigned G = gridDim.x * gridDim.y * gridDim.z;
    unsigned sum, cnt, mine, sp = 0u;
    for (;;) {
        sum = 0u; cnt = 0u; mine = 0u;
#pragma unroll
        for (unsigned j = 0; j < 16; ++j) { const unsigned c = xb_ld(&bar[XB_XCNT(j)]); sum += c; cnt += (c > 0u) ? 1u : 0u; mine = (j == x) ? c : mine; }
        if (sum == G) break;
        __builtin_amdgcn_s_sleep(1);
        if ((++sp & 255u) == 0u) { if (xb_ld(&bar[XB_TMO])) break; if (sp > XB_SPIN_CAP) { atomicAdd(&bar[XB_TMO], 1u); break; } }
    }
    nloc = mine > 0u ? mine : 1u; nx = cnt > 0u ? cnt : 1u;
}
__device__ __forceinline__ void xcd_barrier(const XcdBarrier& b) {
    asm volatile("s_waitcnt vmcnt(0)" ::: "memory");
    __syncthreads();
    if (threadIdx.x == 0) {
        unsigned* bar = b.bar;
        __builtin_amdgcn_s_waitcnt(0);
        unsigned nloc = b.st[0], nx = b.st[1];
        if (nloc == 0u) { xcd_barrier_complete(bar, b.x, nloc, nx); b.st[0] = nloc; b.st[1] = nx; }
        const unsigned old = xb_add(&bar[XB_XSUB(b.x)], 1u);
        const unsigned gen = old / nloc;
        if (old + 1u == (gen + 1u) * nloc) {
            __builtin_amdgcn_fence(__ATOMIC_RELEASE, "agent");
            asm volatile("s_waitcnt vmcnt(0)" ::: "memory");
            const unsigned og = xb_add(&bar[XB_TOP], 1u);
            const unsigned tg = og / nx;
            if (og + 1u == (tg + 1u) * nx) xb_add(&bar[XB_TOPGEN], 1u);
            else XB_SPIN(xb_ld(&bar[XB_TOPGEN]) == tg, bar);
            __builtin_amdgcn_fence(__ATOMIC_ACQUIRE, "agent");
            xb_add(&bar[XB_XGEN(b.x)], 1u);
            asm volatile("s_waitcnt vmcnt(0)" ::: "memory");
        } else {
            XB_SPIN(xb_ld(&bar[XB_XGEN(b.x)]) == gen, bar);
            __builtin_amdgcn_fence(__ATOMIC_ACQUIRE, "agent");
            asm volatile("s_waitcnt vmcnt(0)" ::: "memory");
        }
    }
    __syncthreads();
}

struct Args {
    const float *x, *w_in, *conv_w, *w_conv_out, *pos_k, *w1_k, *w2_k, *pos_v, *w1_v, *w2_v, *w_attn_out, *w_o, *g_mix, *g_ffn, *w_gate, *w_up, *w_down, *g_final;
    float* out; unsigned char* ws; int probe; int pad;
};

__global__ void __launch_bounds__(512, 2) nsa_fwd(Args a) {
    extern __shared__ __attribute__((aligned(16))) unsigned char lds_raw[];
    LAS unsigned char* lds = (LAS unsigned char*)lds_raw;
    cg::grid_group grid = cg::this_grid();
    const int tid = threadIdx.x, lane = tid & 63, wave = __builtin_amdgcn_readfirstlane(tid >> 6);
    const int G = gridDim.x, bx = blockIdx.x;
    const int vcu = (G % 8 == 0) ? (bx % 8) * (G / 8) + bx / 8 : bx;
    unsigned char* ws = a.ws;
    volatile LAS unsigned* bst = (volatile LAS unsigned*)(lds + 143360);
    if (tid < 2) bst[tid] = 0u;
    __syncthreads();
    const XcdBarrier gbar = xcd_barrier_post((unsigned*)(ws + WS_BAR), bst);
#define SEAM() xcd_barrier(gbar)
    float* part1 = (float*)(ws + WS_PART1); float* part2 = (float*)(ws + WS_PART2); float* cbias = (float*)(ws + WS_BIAS);
    bf16_t* Win = (bf16_t*)(ws + WS_WIN); bf16_t* Wconv = (bf16_t*)(ws + WS_WCONV); bf16_t* Wattn = (bf16_t*)(ws + WS_WATTN); bf16_t* Wo = (bf16_t*)(ws + WS_WO);
    bf16_t* Wup = (bf16_t*)(ws + WS_WUP); bf16_t* Wdown = (bf16_t*)(ws + WS_WDOWN); bf16_t* W1 = (bf16_t*)(ws + WS_W1); bf16_t* W2 = (bf16_t*)(ws + WS_W2);
    bf16_t* hid = (bf16_t*)(ws + WS_HID); bf16_t* kcmp = (bf16_t*)(ws + WS_KCMP); bf16_t* proj = (bf16_t*)(ws + WS_PROJ);
    float* h1f = (float*)(ws + WS_H1F); bf16_t* h1b = (bf16_t*)(ws + WS_H1B); bf16_t* act = (bf16_t*)(ws + WS_ACT);
    bf16_t* nb = (bf16_t*)a.out; bf16_t* mix = (bf16_t*)a.out; bf16_t* bc = (bf16_t*)((unsigned char*)a.out + OUT_BC);

    {
        LAS float* scr = (LAS float*)(lds + wave * 16384);
        const int gw = vcu * 8 + wave, NGW = G * 8;
        constexpr int I_IN = 16 * 194, I_CONV = 8 * 32, I_ATT = 16 * 32, I_O = 16 * 32, I_G = 16 * 88, I_U = 16 * 88, I_D = 44 * 32, I_1 = 32 * 8, I_2 = 4 * 2;
        constexpr int NITEMS = I_IN + I_CONV + I_ATT + I_O + 2 * I_1 + 2 * I_2;
        for (int it = gw; it < NITEMS; it += NGW) {
            int q = it;
            if (q < I_IN) { const int kb = q / 194, nbk = q % 194, n0 = 32 * nbk; const float cs = (n0 >= C_Q && n0 < C_KC) ? QSCALE : 1.0f;
                transpose_item(a.w_in, 1024, INCOLS, Win, 1024, 64 * kb, n0, n0, a.g_mix, cs, scr, lane); continue; } q -= I_IN;
            if (q < I_CONV) { const int kb = q / 32, nbk = q % 32; transpose_item(a.w_conv_out, 512, 1024, Wconv, 512, 64 * kb, 32 * nbk, 32 * nbk, nullptr, 1.f, scr, lane); continue; } q -= I_CONV;
            if (q < I_ATT) { const int kb = q / 32, nbk = q % 32; transpose_item(a.w_attn_out, 1024, 1024, Wattn, 1024, 64 * kb, 32 * nbk, 32 * nbk, nullptr, 1.f, scr, lane); continue; } q -= I_ATT;
            if (q < I_O) { const int kb = q / 32, nbk = q % 32; transpose_item(a.w_o, 1024, 1024, Wo, 1024, 64 * kb, 32 * nbk, 32 * nbk, nullptr, 1.f, scr, lane); continue; } q -= I_O;
            if (q < I_1) { const int kb = q / 8, nbk = q % 8; transpose_item(a.w1_k, 2048, 256, W1, 2048, 64 * kb, 32 * nbk, 32 * nbk, nullptr, 1.f, scr, lane); continue; } q -= I_1;
            if (q < I_1) { const int kb = q / 8, nbk = q % 8; transpose_item(a.w1_v, 2048, 256, W1, 2048, 64 * kb, 32 * nbk, 256 + 32 * nbk, nullptr, 1.f, scr, lane); continue; } q -= I_1;
            if (q < I_2) { const int kb = q / 2, nbk = q % 2; transpose_item(a.w2_k, 256, 64, W2, 256, 64 * kb, 32 * nbk, 32 * nbk, nullptr, 1.f, scr, lane); continue; } q -= I_2;
            { const int kb = q / 2, nbk = q % 2; transpose_item(a.w2_v, 256, 64, W2, 256, 64 * kb, 32 * nbk, 256 + 32 * nbk, nullptr, 1.f, scr, lane); }
        }
        const int gt = vcu * 512 + tid, NGT = G * 512;
        for (int i = gt; i < 192 * 1024 / 8; i += NGT) *(u32x4*)(Win + (size_t)6208 * 1024 + (size_t)i * 8) = (u32x4){0u, 0u, 0u, 0u};
        for (int i = gt; i < 2 * 192 * 256 / 8; i += NGT) { const int half = i / (192 * 256 / 8), o = i % (192 * 256 / 8);
            *(u32x4*)(W2 + (size_t)(half * 256 + 64) * 256 + (size_t)o * 8) = (u32x4){0u, 0u, 0u, 0u}; }
        for (int m = gw; m < MTOK; m += NGW) {
            const f32x4* xr = (const f32x4*)(a.x + (size_t)m * DM) + lane; f32x4 v[4]; float s = 0.f;
#pragma unroll
            for (int j = 0; j < 4; ++j) { v[j] = xr[64 * j]; s += (v[j][0] * v[j][0] + v[j][1] * v[j][1]) + (v[j][2] * v[j][2] + v[j][3] * v[j][3]); }
            const float rstd = __builtin_amdgcn_rsqf(wave_sum(s) * (1.0f / DM) + EPS);
            u32x2* o8 = (u32x2*)(nb + (size_t)m * DM) + lane;
#pragma unroll
            for (int j = 0; j < 4; ++j) { u32x2 w; w.x = pk2(v[j][0] * rstd, v[j][1] * rstd); w.y = pk2(v[j][2] * rstd, v[j][3] * rstd); o8[64 * j] = w; }
        }
        if (bx < 2) {
            const float* pos = bx ? a.pos_v : a.pos_k; const float* w1 = bx ? a.w1_v : a.w1_k;
            const int j = tid & 255, part = tid >> 8; float s = 0.f;
            for (int k = part * 1024; k < part * 1024 + 1024; ++k) s += pos[k] * w1[(size_t)k * 256 + j];
            LAS float* red = (LAS float*)(lds + 8 * 16384);
            if (part == 1) red[j] = s;
            __syncthreads();
            if (part == 0) cbias[bx * 256 + j] = s + red[j];
        }
    }
    if (a.probe == 0x7fffffff) grid.sync();
    SEAM();
    {
        const int ncols1 = (G > 64) ? 6144 : PP;
        pg8::Gemm g{nb, Win, MTOK, ncols1, DM, DM, 128, 0}; pg8::StaticOrder S; S.init(MTOK, ncols1, G, bx);
        pg8::EpiProj E{proj, PP};
        pg8::gemm_phase(lds, g, S, E);
    }
    SEAM();
    {
        {
            pg8::Gemm g{proj + C_KC, W1, 4096, 512, 2048, 16 * PP, PP * 2, 1}; pg8::StaticOrder S; S.init(4096, 512, G, bx);
            pg8::EpiHid E{hid, cbias};
            pg8::gemm_phase(lds, g, S, E);
        }
        int wb = bx, wn = G; if (G > 64) { wb = bx - 32; wn = G - 32; }
        if (wb >= 0) {
            for (int it = wb * 512 + tid; it < MTOK * 64; it += wn * 512) {
                const int row = it >> 6, ch = (it & 63) * 8, t = row & (SEQ - 1);
                const bf16_t* pr = proj + (size_t)row * PP;
                float accv[8];
#pragma unroll
                for (int j = 0; j < 8; ++j) accv[j] = 0.f;
#pragma unroll
                for (int k = 0; k < 3; ++k) { const int dt = 2 - k;
                    if (t - dt >= 0) { const u32x4 cv = *(const u32x4*)(pr - (size_t)dt * PP + C_C + ch), hv = *(const u32x4*)(pr - (size_t)dt * PP + C_H + ch);
                        const f32x4 w0 = *(const f32x4*)(a.conv_w + k * 512 + ch), w1 = *(const f32x4*)(a.conv_w + k * 512 + ch + 4);
                        accv[0] += w0[0] * lo_bf(cv.x) * lo_bf(hv.x); accv[1] += w0[1] * hi_bf(cv.x) * hi_bf(hv.x); accv[2] += w0[2] * lo_bf(cv.y) * lo_bf(hv.y); accv[3] += w0[3] * hi_bf(cv.y) * hi_bf(hv.y);
                        accv[4] += w1[0] * lo_bf(cv.z) * lo_bf(hv.z); accv[5] += w1[1] * hi_bf(cv.z) * hi_bf(hv.z); accv[6] += w1[2] * lo_bf(cv.w) * lo_bf(hv.w); accv[7] += w1[3] * hi_bf(cv.w) * hi_bf(hv.w); } }
                const u32x4 bv = *(const u32x4*)(pr + C_B + ch);
                u32x4 o; o.x = pk2(accv[0] * lo_bf(bv.x), accv[1] * hi_bf(bv.x)); o.y = pk2(accv[2] * lo_bf(bv.y), accv[3] * hi_bf(bv.y));
                o.z = pk2(accv[4] * lo_bf(bv.z), accv[5] * hi_bf(bv.z)); o.w = pk2(accv[6] * lo_bf(bv.w), accv[7] * hi_bf(bv.w));
                *(u32x4*)(bc + (size_t)row * 512 + ch) = o;
            }
        }
        if (G > 64 && wb >= 0) {
            { pg8::Gemm g{nb, Win + (size_t)6144 * 1024, MTOK, 256, DM, DM, 128, 0}; pg8::StaticOrder S; S.init(MTOK, 256, wn, wb);
              pg8::EpiProj E{proj + 6144, PP}; pg8::gemm_phase(lds, g, S, E); }
            __syncthreads();
            LAS float* scr = (LAS float*)(lds + wave * 16384);
            constexpr int I_G = 16 * 88, I_U = 16 * 88, I_D = 44 * 32;
            for (int it = wb * 8 + wave; it < I_G + I_U + I_D; it += wn * 8) {
                int q = it;
                if (q < I_G) { const int kb = q / 88, nbk = q % 88, n0 = 32 * nbk; transpose_item(a.w_gate, 1024, DFF, Wup, 1024, 64 * kb, n0, (n0 / 128) * 256 + (n0 % 128), a.g_ffn, 1.f, scr, lane); continue; } q -= I_G;
                if (q < I_U) { const int kb = q / 88, nbk = q % 88, n0 = 32 * nbk; transpose_item(a.w_up, 1024, DFF, Wup, 1024, 64 * kb, n0, (n0 / 128) * 256 + 128 + (n0 % 128), a.g_ffn, 1.f, scr, lane); continue; } q -= I_U;
                { const int kb = q / 32, nbk = q % 32; transpose_item(a.w_down, DFF, 1024, Wdown, DFF, 64 * kb, 32 * nbk, 32 * nbk, nullptr, 1.f, scr, lane); }
            }
        }
    }
    {
        pg8::Gemm g{hid, W2, 4096, 512, 256, 256, 128, 2}; pg8::StaticOrder S; S.init(4096, 512, G, bx);
        pg8::EpiCmp E{kcmp};
        pg8::gemm_phase(lds, g, S, E);
    }
    SEAM();
    {
        for (int v = vcu; v < 256; v += G) {
            const int bh = v >> 4, s = v & 15;
#pragma unroll 1
            for (int i = 0; i < 4; ++i) { const int qb = (i == 0) ? 63 - s : (i == 1) ? 32 + s : (i == 2) ? 31 - s : s;
#if defined(PROBE_ATT2) || defined(PROBE_NOLD)
                att::attn_unit(lds, proj, kcmp, kcmp + 4096 * 64, bh, qb, a.probe);
#endif
                att::attn_unit(lds, proj, kcmp, kcmp + 4096 * 64, bh, qb, 0);
            }
        }
    }
    SEAM();
    {
        { pg8::Gemm g{bc, Wconv, MTOK, DM, 512, 512, 128, 0}; pg8::StaticOrder S; S.init(MTOK, DM, G, bx);
          pg8::EpiMix<0> E{mix, proj, C_GCONV}; pg8::gemm_phase(lds, g, S, E); }
        { pg8::Gemm g{proj + C_Q, Wattn, MTOK, DM, DM, PP, 128, 0}; pg8::StaticOrder S; S.init(MTOK, DM, G, bx);
          pg8::EpiMix<1> E{mix, proj, C_GATTN}; pg8::gemm_phase(lds, g, S, E); }
    }
    SEAM();
    {
        pg8::Gemm g{mix, Wo, MTOK, DM, DM, DM, 128, 0}; pg8::StaticOrder S; S.init(MTOK, DM, G, bx);
        pg8::EpiRes<1> E{a.x, h1f, h1b, part1}; pg8::gemm_phase(lds, g, S, E);
    }
    SEAM();
    {
        pg8::Gemm g{h1b, Wup, MTOK, 2 * DFF, DM, DM, 128, 0}; pg8::StaticOrder S; S.init(MTOK, 2 * DFF, G, bx);
        pg8::EpiUp E{act, part1}; pg8::gemm_phase(lds, g, S, E);
    }
    SEAM();
    if (G == 256) {
        pg8::Gemm g{act, Wdown, MTOK, DM, DFF, DFF, 128, 0}; pg8::StaticOrder S; S.init(MTOK, DM, G, bx);
        pg8::EpiFinal E{h1f, a.out, a.g_final, (unsigned*)part2, (unsigned*)(ws + WS_BAR) + 4096, (unsigned*)(ws + WS_BAR) + XB_TMO};
        pg8::gemm_phase(lds, g, S, E);
        return;
    }
    {
        pg8::Gemm g{act, Wdown, MTOK, DM, DFF, DFF, 128, 0}; pg8::StaticOrder S; S.init(MTOK, DM, G, bx);
        pg8::EpiRes<0> E{h1f, a.out, nullptr, part2}; pg8::gemm_phase(lds, g, S, E);
    }
    SEAM();
    {
        for (int it = bx * 512 + tid; it < MTOK * 256; it += G * 512) {
            const int row = it >> 8, c4 = (it & 255) * 4;
            const f32x4* pp = (const f32x4*)(part2 + (size_t)row * 16); float ss = 0.f;
#pragma unroll
            for (int j = 0; j < 4; ++j) { const f32x4 p = pp[j]; ss += (p[0] + p[1]) + (p[2] + p[3]); }
            const float r = __builtin_amdgcn_rsqf(ss * (1.0f / DM) + EPS);
            f32x4 v = *(f32x4*)(a.out + (size_t)row * DM + c4); const f32x4 gf = *(const f32x4*)(a.g_final + c4);
            v = v * r * gf; *(f32x4*)(a.out + (size_t)row * DM + c4) = v;
        }
    }
}

extern "C" void kernel_launch(void* const* d_in, const int* in_sizes, int n_in, void* d_out, int out_size, void* d_ws, size_t ws_size, hipStream_t stream) {
    static int grid = 0;
    if (grid == 0) {
        if (n_in != 18 || out_size != MTOK * DM || ws_size < WS_NEED) { fprintf(stderr, "kernel_launch: unexpected shapes (n_in %d out %d ws %zu)\n", n_in, out_size, ws_size); grid = -1; return; }
        int dev = 0, cus = 0, per_cu = 0;
        (void)hipGetDevice(&dev);
        (void)hipDeviceGetAttribute(&cus, hipDeviceAttributeMultiprocessorCount, dev);
        (void)hipFuncSetAttribute((const void*)nsa_fwd, hipFuncAttributeMaxDynamicSharedMemorySize, LDS_BYTES);
        (void)hipOccupancyMaxActiveBlocksPerMultiprocessor(&per_cu, (const void*)nsa_fwd, 512, LDS_BYTES);
        if (per_cu < 1) { fprintf(stderr, "kernel_launch: occupancy query says %d blocks/CU\n", per_cu); grid = -1; return; }
        grid = cus;
    }
    if (grid < 0) return;
    (void)hipMemsetAsync((unsigned char*)d_ws + WS_BAR, 0, 32768, stream);
    Args a{};
    a.x = (const float*)d_in[0]; a.w_in = (const float*)d_in[1]; a.conv_w = (const float*)d_in[2]; a.w_conv_out = (const float*)d_in[3];
    a.pos_k = (const float*)d_in[4]; a.w1_k = (const float*)d_in[5]; a.w2_k = (const float*)d_in[6];
    a.pos_v = (const float*)d_in[7]; a.w1_v = (const float*)d_in[8]; a.w2_v = (const float*)d_in[9];
    a.w_attn_out = (const float*)d_in[10]; a.w_o = (const float*)d_in[11]; a.g_mix = (const float*)d_in[12]; a.g_ffn = (const float*)d_in[13];
    a.w_gate = (const float*)d_in[14]; a.w_up = (const float*)d_in[15]; a.w_down = (const float*)d_in[16]; a.g_final = (const float*)d_in[17];
    a.out = (float*)d_out; a.ws = (unsigned char*)d_ws; a.probe = 1; a.pad = 0;
    void* args[] = {&a};
    hipError_t e = hipLaunchCooperativeKernel((void*)nsa_fwd, dim3(grid), dim3(512), args, LDS_BYTES, stream);
    if (e != hipSuccess) fprintf(stderr, "kernel_launch: cooperative launch failed: %s (grid %d)\n", hipGetErrorString(e), grid);
}
```

```cpp
#include <hip/hip_runtime.h>
#include <hip/hip_cooperative_groups.h>
#include <cstdio>
#include <cstdint>
namespace cg = cooperative_groups;

#define LAS __attribute__((address_space(3)))
typedef unsigned short bf16_t;
typedef short bf16x8 __attribute__((ext_vector_type(8)));
typedef short s16x4 __attribute__((ext_vector_type(4)));
typedef float f32x4 __attribute__((ext_vector_type(4)));
typedef float f32x16 __attribute__((ext_vector_type(16)));
typedef unsigned u32x4 __attribute__((ext_vector_type(4)));
typedef unsigned u32x2 __attribute__((ext_vector_type(2)));
typedef float f32x2_t __attribute__((ext_vector_type(2)));
typedef __bf16 bf16x2_t __attribute__((ext_vector_type(2)));

constexpr int MTOK = 16384, DM = 1024, SEQ = 4096, NB = 4;
constexpr int PP = 6400;
constexpr int INCOLS = 6192;
constexpr int C_B = 0, C_C = 512, C_H = 1024, C_Q = 1536, C_KC = 2560, C_VC = 2816, C_KS = 3072, C_VS = 3328, C_KW = 3584, C_VW = 3840,
              C_GBR = 4096, C_GCONV = 4144, C_GATTN = 5168;
constexpr int DFF = 2816;
constexpr float EPS = 1e-6f;
constexpr float LOG2E = 1.4426950408889634f;
constexpr float QSCALE = 0.125f * LOG2E;

constexpr size_t MiB = 1u << 20;
constexpr size_t WS_PART1 = 0;
constexpr size_t WS_PART2 = 1 * MiB;
constexpr size_t WS_BIAS = 2 * MiB;
constexpr size_t WS_BAR = 2 * MiB + 65536;
constexpr size_t WS_WIN = 3 * MiB;
constexpr size_t WS_WCONV = 16 * MiB;
constexpr size_t WS_WATTN = 17 * MiB;
constexpr size_t WS_WO = 19 * MiB;
constexpr size_t WS_WUP = 21 * MiB;
constexpr size_t WS_WDOWN = 32 * MiB;
constexpr size_t WS_W1 = 38 * MiB;
constexpr size_t WS_W2 = 40 * MiB;
constexpr size_t WS_HID = 41 * MiB;
constexpr size_t WS_KCMP = 45 * MiB;
constexpr size_t WS_PROJ = 46 * MiB;
constexpr size_t WS_H1F = 46 * MiB;
constexpr size_t WS_H1B = 110 * MiB;
constexpr size_t WS_ACT = 142 * MiB;
constexpr size_t WS_NEED = 246 * MiB;
constexpr size_t OUT_BC = 32 * MiB;

constexpr int LDS_BYTES = 147456;

__device__ __forceinline__ float bf2f(unsigned short v) { return __uint_as_float(((unsigned)v) << 16); }
__device__ __forceinline__ unsigned pk2(float lo, float hi) { f32x2_t v = {lo, hi}; bf16x2_t b = __builtin_convertvector(v, bf16x2_t); return __builtin_bit_cast(unsigned, b); }
__device__ __forceinline__ float ex2(float x) { return __builtin_amdgcn_exp2f(x); }
__device__ __forceinline__ float sigmoidf_(float x) { return __builtin_amdgcn_rcpf(1.0f + ex2(-x * LOG2E)); }
__device__ __forceinline__ float lo_bf(unsigned w) { return __uint_as_float(w << 16); }
__device__ __forceinline__ float hi_bf(unsigned w) { return __uint_as_float(w & 0xffff0000u); }

namespace pg8 {
constexpr int BM = 256, BK = 64, HALF = 128, HTB = HALF * BK * 2, STAGE_BYTES = 8 * HTB, NXCD = 8, WGM = 8;
__host__ __device__ __forceinline__ int lds_byte(int r, int c) { const int st = (r >> 4) * 2 + (c >> 5), rr = r & 15, cc = c & 31, ob = rr * 64 + cc * 2; return st * 1024 + (ob ^ (((ob >> 9) & 1) << 5)); }
__host__ __device__ __forceinline__ void stage_rc(int b, int& R, int& C) { const int st = b / 1024, sb = b % 1024, swz = sb ^ (((sb >> 9) & 1) << 5); R = (st >> 1) * 16 + swz / 64; C = (st & 1) * 32 + (swz % 64) / 2; }
__host__ __device__ __forceinline__ int perm32(int rho) { const int n = rho >> 4, i = rho & 15; return 8 * (i >> 2) + 4 * n + (i & 3); }

struct Unit { int pm, pn; };
struct Gemm { const bf16_t* A; const bf16_t* Bt; int M, N, K; int lda; int a_kstep; int amode; };

struct StaticOrder {
    int nM, nN, nwg, G, c;
    __host__ __device__ void init(int M, int N, int G_, int c_) { nM = M / BM; nN = N / BM; nwg = nM * nN; G = G_; c = c_; }
    __host__ __device__ bool next(int i, Unit& u) const {
        const long L = (long)i * G + c; if (L >= nwg) return false;
        int wgid = (int)L; { const int q = nwg / NXCD, r = nwg % NXCD, xcd = wgid % NXCD, off = wgid / NXCD; wgid = (xcd < r ? xcd * (q + 1) : r * (q + 1) + (xcd - r) * q) + off; }
        const int nig = WGM * nN, gid = wgid / nig, fm = gid * WGM, gsz = (nM - fm) < WGM ? (nM - fm) : WGM;
        u.pm = fm + ((wgid % nig) % gsz); u.pn = (wgid % nig) / gsz; return true;
    }
};

__device__ __forceinline__ const char* a_tile(const Gemm& g, const Unit& u) {
    if (g.amode == 1) return (const char*)g.A + ((size_t)(u.pm >> 2) * SEQ * PP + (size_t)u.pn * 256 + (size_t)(u.pm & 3) * 64) * 2;
    if (g.amode == 2) return (const char*)g.A + ((size_t)u.pn * 4096 * 256 + (size_t)u.pm * 256 * 256) * 2;
    return (const char*)g.A + (size_t)u.pm * 256 * (size_t)g.lda * 2;
}

template <class T, class = void> struct is_fused { static constexpr bool value = false; };
template <class T> struct is_fused<T, decltype((void)T::FUSED)> { static constexpr bool value = true; };
template <class Epi>
__device__ __forceinline__ void gemm_phase(LAS unsigned char* lds, const Gemm g, const StaticOrder& S, const Epi& E) {
#ifdef NO_GEMM
    return;
#endif
    int tid_ = threadIdx.x; asm volatile("" : "+v"(tid_));
    const int tid = tid_, wid = __builtin_amdgcn_readfirstlane(tid >> 6), lane = tid & 63, wr = wid >> 2, wc = wid & 3, fr = lane & 15, fq = lane >> 4;
    const int K = g.K, nt = K / BK;
    unsigned voffA[2], voffB[2];
#pragma unroll
    for (int i = 0; i < 2; ++i) { int R, C; stage_rc(tid * 16 + i * 8192, R, C); const int Rb = (R & ~31) + perm32(R & 31);
        voffA[i] = (unsigned)(R * g.lda + C) * 2u; voffB[i] = (unsigned)(Rb * K + C) * 2u; }
    const size_t kstepA = (size_t)g.a_kstep, kstepB = (size_t)(BK * 2);
    const size_t hstepA = (size_t)HALF * g.lda * 2, hstepB = (size_t)HALF * K * 2;
    const size_t tstepB = 2 * hstepB;
    const unsigned ldsw = (unsigned)wid * 1024u;
    const int aoff = lds_byte(wr * 64 + fr, fq * 8), boff = lds_byte(wc * 32 + fr, fq * 8);
#define PG8_SA(b, h) (((b) * 2 + (h)) * HTB)
#define PG8_SB(b, h) ((4 + (b) * 2 + (h)) * HTB)
#define PG8_STAGE(bufoff, gbase, voff) do { _Pragma("unroll") for (int _i = 0; _i < 2; ++_i) \
        __builtin_amdgcn_global_load_lds((const unsigned*)((const char*)(gbase) + (voff)[_i]), (LAS unsigned*)(lds + (bufoff) + ldsw + _i * 8192), 16, 0, 0); } while (0)
#define PG8_LDA(dst, b, h) do { _Pragma("unroll") for (int m = 0; m < 4; ++m) _Pragma("unroll") for (int k = 0; k < 2; ++k) dst[m][k] = *(const LAS bf16x8*)(lds + PG8_SA(b, h) + aoff + m * 2048 + k * 1024); } while (0)
#define PG8_LDB(dst, b, h) do { _Pragma("unroll") for (int n = 0; n < 2; ++n) _Pragma("unroll") for (int k = 0; k < 2; ++k) dst[n][k] = *(const LAS bf16x8*)(lds + PG8_SB(b, h) + boff + n * 2048 + k * 1024); } while (0)
#define PG8_MMA(ai, bj, At, Bt) do { __builtin_amdgcn_s_setprio(1); _Pragma("unroll") for (int m = 0; m < 4; ++m) _Pragma("unroll") for (int n = 0; n < 2; ++n) _Pragma("unroll") for (int k = 0; k < 2; ++k) \
        acc[ai][bj][m][n] = __builtin_amdgcn_mfma_f32_16x16x32_bf16(Bt[n][k], At[m][k], acc[ai][bj][m][n], 0, 0, 0); __builtin_amdgcn_s_setprio(0); } while (0)
#define PG8_WAIT_V(n) asm volatile("s_waitcnt vmcnt(" #n ")" ::: "memory")
#define PG8_WAIT_L(n) asm volatile("s_waitcnt lgkmcnt(" #n ")" ::: "memory")
#define PG8_BAR __builtin_amdgcn_s_barrier()
#define PG8_SCHED __builtin_amdgcn_sched_barrier(0)
    Unit cur, nxt; int ui = 0;
    if (!S.next(0, cur)) return;
    f32x4 acc[2][2][4][2];
#pragma unroll
    for (int a = 0; a < 2; ++a)
#pragma unroll
        for (int b = 0; b < 2; ++b)
#pragma unroll
            for (int m = 0; m < 4; ++m)
#pragma unroll
                for (int n = 0; n < 2; ++n) acc[a][b][m][n] = (f32x4){0.f, 0.f, 0.f, 0.f};
    bf16x8 At[4][2], B0[2][2], B1[2][2];
    const char* cA = a_tile(g, cur); const char* cB = (const char*)g.Bt + (size_t)cur.pn * tstepB;
    PG8_STAGE(PG8_SB(0, 0), cB, voffB); PG8_STAGE(PG8_SB(0, 1), cB + hstepB, voffB); PG8_STAGE(PG8_SA(0, 0), cA, voffA); PG8_STAGE(PG8_SA(0, 1), cA + hstepA, voffA);
    if (wr == 1) PG8_BAR;
    PG8_WAIT_V(2); PG8_BAR;
    PG8_STAGE(PG8_SB(1, 0), cB + kstepB, voffB); PG8_STAGE(PG8_SA(1, 0), cA + kstepA, voffA); PG8_STAGE(PG8_SB(1, 1), cB + hstepB + kstepB, voffB);
    PG8_WAIT_V(6); PG8_BAR;
    for (;;) {
        const bool has_next = S.next(ui + 1, nxt);
        const char* nA = has_next ? a_tile(g, nxt) : cA; const char* nB = has_next ? (const char*)g.Bt + (size_t)nxt.pn * tstepB : cB;
        for (int t = 0; t < nt; t += 2) {
            const bool last = (t == nt - 2);
            const char* a1 = cA + (size_t)(t + 1) * kstepA;
            const char* a2 = last ? nA : cA + (size_t)(t + 2) * kstepA; const char* b2 = last ? nB : cB + (size_t)(t + 2) * kstepB;
            const char* a3 = a2 + kstepA; const char* b3 = b2 + kstepB;
            PG8_LDB(B0, 0, 0); PG8_LDB(B1, 0, 1); PG8_SCHED; PG8_LDA(At, 0, 0); PG8_STAGE(PG8_SA(1, 1), a1 + hstepA, voffA);
            PG8_WAIT_V(8); PG8_WAIT_L(0); PG8_BAR; PG8_MMA(0, 0, At, B0); PG8_MMA(0, 1, At, B1); PG8_BAR; PG8_SCHED;
            PG8_LDA(At, 0, 1); PG8_STAGE(PG8_SB(0, 0), b2, voffB); PG8_STAGE(PG8_SB(0, 1), b2 + hstepB, voffB); PG8_STAGE(PG8_SA(0, 0), a2, voffA);
            PG8_WAIT_V(8); PG8_WAIT_L(0); PG8_BAR; PG8_MMA(1, 0, At, B0); PG8_MMA(1, 1, At, B1); PG8_BAR; PG8_SCHED;
            PG8_LDB(B0, 1, 0); PG8_LDB(B1, 1, 1); PG8_SCHED; PG8_LDA(At, 1, 0); PG8_STAGE(PG8_SA(0, 1), a2 + hstepA, voffA);
            PG8_WAIT_V(8); PG8_WAIT_L(0); PG8_BAR; PG8_MMA(0, 0, At, B0); PG8_MMA(0, 1, At, B1); PG8_BAR; PG8_SCHED;
            PG8_LDA(At, 1, 1); PG8_STAGE(PG8_SB(1, 0), b3, voffB); PG8_STAGE(PG8_SB(1, 1), b3 + hstepB, voffB); PG8_STAGE(PG8_SA(1, 0), a3, voffA);
            PG8_WAIT_V(8); PG8_WAIT_L(0); PG8_BAR; PG8_MMA(1, 0, At, B0); PG8_MMA(1, 1, At, B1); PG8_BAR; PG8_SCHED;
        }
        if (wr == 0) PG8_BAR;
        if constexpr (!is_fused<Epi>::value) E(acc, cur, wr, wc, fr, fq);
        if (!has_next) break;
#pragma unroll
        for (int a = 0; a < 2; ++a)
#pragma unroll
            for (int b = 0; b < 2; ++b)
#pragma unroll
                for (int m = 0; m < 4; ++m)
#pragma unroll
                    for (int n = 0; n < 2; ++n) acc[a][b][m][n] = (f32x4){0.f, 0.f, 0.f, 0.f};
        cur = nxt; cA = nA; cB = nB; ++ui;
        if (wr == 1) PG8_BAR;
    }
    PG8_WAIT_V(0);
    PG8_BAR;
    if constexpr (is_fused<Epi>::value) E.fused(acc, cur, wr, wc, fr, fq, lds, wid, lane);
#undef PG8_SA
#undef PG8_SB
#undef PG8_STAGE
#undef PG8_LDA
#undef PG8_LDB
#undef PG8_MMA
#undef PG8_WAIT_V
#undef PG8_WAIT_L
#undef PG8_BAR
#undef PG8_SCHED
}

typedef f32x4 Acc[2][2][4][2];
#define EPI_LOOP_BEGIN \
    _Pragma("unroll") for (int ai = 0; ai < 2; ++ai) _Pragma("unroll") for (int m = 0; m < 4; ++m) { const int row = u.pm * BM + wr * 64 + fr + ai * HALF + m * 16; \
    _Pragma("unroll") for (int bj = 0; bj < 2; ++bj) { const f32x4 v0 = acc[ai][bj][m][0], v1 = acc[ai][bj][m][1]; const int col = u.pn * BM + bj * HALF + wc * 32 + 8 * fq;
#define EPI_LOOP_END } }
__device__ __forceinline__ u32x4 pack8(const f32x4 a, const f32x4 b) { u32x4 w; w.x = pk2(a[0], a[1]); w.y = pk2(a[2], a[3]); w.z = pk2(b[0], b[1]); w.w = pk2(b[2], b[3]); return w; }

struct EpiProj { bf16_t* O; int ldc;
    __device__ __forceinline__ void operator()(const Acc& acc, const Unit& u, int wr, int wc, int fr, int fq) const {
        EPI_LOOP_BEGIN
            *(u32x4*)(O + (size_t)row * ldc + col) = pack8(v0, v1);
        EPI_LOOP_END
    } };
__device__ __forceinline__ float gelu_tanh(float x) {
    const float z = x * (1.0f + 0.044715f * x * x) * (2.0f * 0.7978845608028654f * LOG2E);
    return x * __builtin_amdgcn_rcpf(1.0f + ex2(-z));
}
struct EpiHid { bf16_t* O; const float* bias;
    __device__ __forceinline__ void operator()(const Acc& acc, const Unit& u, int wr, int wc, int fr, int fq) const {
        EPI_LOOP_BEGIN
            const int c = col - u.pn * BM; const float* bp = bias + u.pn * 256 + c;
            const f32x4 b0 = *(const f32x4*)bp, b1 = *(const f32x4*)(bp + 4);
            f32x4 a = v0 + b0, b = v1 + b1;
#pragma unroll
            for (int j = 0; j < 4; ++j) { a[j] = gelu_tanh(a[j]); b[j] = gelu_tanh(b[j]); }
            *(u32x4*)(O + (size_t)u.pn * 4096 * 256 + (size_t)row * 256 + c) = pack8(a, b);
        EPI_LOOP_END
    } };
struct EpiCmp { bf16_t* O;
    __device__ __forceinline__ void operator()(const Acc& acc, const Unit& u, int wr, int wc, int fr, int fq) const {
        EPI_LOOP_BEGIN
            const int c = col - u.pn * BM;
            if (c < 64) { u32x4 w = pack8(v0, v1); if ((row & 255) == 255) w = (u32x4){0u, 0u, 0u, 0u};
                *(u32x4*)(O + (size_t)u.pn * 4096 * 64 + (size_t)row * 64 + c) = w; }
        EPI_LOOP_END
    } };
template <int ADD> struct EpiMix { bf16_t* mix; const bf16_t* proj; int gcol;
    __device__ __forceinline__ void operator()(const Acc& acc, const Unit& u, int wr, int wc, int fr, int fq) const {
        EPI_LOOP_BEGIN
            const u32x4 gv = *(const u32x4*)(proj + (size_t)row * PP + gcol + col);
            f32x4 a, b;
            a[0] = sigmoidf_(lo_bf(gv.x)) * v0[0]; a[1] = sigmoidf_(hi_bf(gv.x)) * v0[1]; a[2] = sigmoidf_(lo_bf(gv.y)) * v0[2]; a[3] = sigmoidf_(hi_bf(gv.y)) * v0[3];
            b[0] = sigmoidf_(lo_bf(gv.z)) * v1[0]; b[1] = sigmoidf_(hi_bf(gv.z)) * v1[1]; b[2] = sigmoidf_(lo_bf(gv.w)) * v1[2]; b[3] = sigmoidf_(hi_bf(gv.w)) * v1[3];
            bf16_t* mp = mix + (size_t)row * DM + col;
            if (ADD) { const u32x4 pv = *(const u32x4*)mp;
                a[0] += lo_bf(pv.x); a[1] += hi_bf(pv.x); a[2] += lo_bf(pv.y); a[3] += hi_bf(pv.y); b[0] += lo_bf(pv.z); b[1] += hi_bf(pv.z); b[2] += lo_bf(pv.w); b[3] += hi_bf(pv.w); }
            *(u32x4*)mp = pack8(a, b);
        EPI_LOOP_END
    } };
template <int WB> struct EpiRes { const float* base; float* hf; bf16_t* hb; float* part;
    __device__ __forceinline__ void operator()(const Acc& acc, const Unit& u, int wr, int wc, int fr, int fq) const {
#pragma unroll
        for (int ai = 0; ai < 2; ++ai)
#pragma unroll
            for (int m = 0; m < 4; ++m) { const int row = u.pm * BM + wr * 64 + fr + ai * HALF + m * 16; float ss = 0.f;
#pragma unroll
                for (int bj = 0; bj < 2; ++bj) { const int col = u.pn * BM + bj * HALF + wc * 32 + 8 * fq; const size_t off = (size_t)row * DM + col;
                    const f32x4 x0 = *(const f32x4*)(base + off), x1 = *(const f32x4*)(base + off + 4);
                    const f32x4 a = x0 + acc[ai][bj][m][0], b = x1 + acc[ai][bj][m][1];
                    *(f32x4*)(hf + off) = a; *(f32x4*)(hf + off + 4) = b;
                    if (WB) *(u32x4*)(hb + off) = pack8(a, b);
                    ss += (a[0] * a[0] + a[1] * a[1]) + (a[2] * a[2] + a[3] * a[3]) + (b[0] * b[0] + b[1] * b[1]) + (b[2] * b[2] + b[3] * b[3]); }
                ss += __shfl_xor(ss, 16); ss += __shfl_xor(ss, 32);
                if (fq == 0) part[(size_t)row * 16 + u.pn * 4 + wc] = ss; }
    } };
struct EpiUp { bf16_t* act; const float* part;
    __device__ __forceinline__ void operator()(const Acc& acc, const Unit& u, int wr, int wc, int fr, int fq) const {
#pragma unroll
        for (int ai = 0; ai < 2; ++ai)
#pragma unroll
            for (int m = 0; m < 4; ++m) { const int row = u.pm * BM + wr * 64 + fr + ai * HALF + m * 16;
                const f32x4 pp = *(const f32x4*)(part + (size_t)row * 16 + 4 * fq); float ss = (pp[0] + pp[1]) + (pp[2] + pp[3]);
                ss += __shfl_xor(ss, 16); ss += __shfl_xor(ss, 32);
                const float r = __builtin_amdgcn_rsqf(ss * (1.0f / DM) + EPS);
                f32x4 a, b;
#pragma unroll
                for (int j = 0; j < 4; ++j) { const float g0 = acc[ai][0][m][0][j] * r, u0 = acc[ai][1][m][0][j] * r, g1 = acc[ai][0][m][1][j] * r, u1 = acc[ai][1][m][1][j] * r;
                    a[j] = g0 * sigmoidf_(g0) * u0; b[j] = g1 * sigmoidf_(g1) * u1; }
                *(u32x4*)(act + (size_t)row * DFF + u.pn * 128 + wc * 32 + 8 * fq) = pack8(a, b); }
    } };
struct EpiFinal { static constexpr bool FUSED = true;
    const float* base; float* out; const float* gfin; unsigned* xbuf; unsigned* cnt; unsigned* tmo;
    __device__ __forceinline__ void operator()(const Acc&, const Unit&, int, int, int, int) const {}
    __device__ __forceinline__ void fused(f32x4 (&acc)[2][2][4][2], const Unit& u, int wr, int wc, int fr, int fq, LAS unsigned char* lds, int wid, int lane) const {
        LAS float* P = (LAS float*)lds;
        LAS float* S = (LAS float*)(lds + 8192);
        LAS unsigned* flag = (LAS unsigned*)(lds + 8192 + 2048);
#pragma unroll
        for (int ai = 0; ai < 2; ++ai)
#pragma unroll
            for (int m = 0; m < 4; ++m) { const int rl = ai * HALF + wr * 64 + m * 16 + fr; const int row = u.pm * BM + rl; float ss = 0.f;
#pragma unroll
                for (int bj = 0; bj < 2; ++bj) { const int col = u.pn * BM + bj * HALF + wc * 32 + 8 * fq; const size_t off = (size_t)row * DM + col;
                    const f32x4 x0 = *(const f32x4*)(base + off), x1 = *(const f32x4*)(base + off + 4);
                    const f32x4 a = x0 + acc[ai][bj][m][0], b = x1 + acc[ai][bj][m][1]; acc[ai][bj][m][0] = a; acc[ai][bj][m][1] = b;
                    ss += (a[0] * a[0] + a[1] * a[1]) + (a[2] * a[2] + a[3] * a[3]) + (b[0] * b[0] + b[1] * b[1]) + (b[2] * b[2] + b[3] * b[3]); }
                ss += __shfl_xor(ss, 16); ss += __shfl_xor(ss, 32);
                if (fq == 0) P[rl * 4 + wc] = ss; }
        asm volatile("s_waitcnt lgkmcnt(0)" ::: "memory"); __builtin_amdgcn_s_barrier(); asm volatile("" ::: "memory");
        const int rl = wid * 32 + (lane & 31);
        if (lane < 32) { const float tot = (P[rl * 4 + 0] + P[rl * 4 + 1]) + (P[rl * 4 + 2] + P[rl * 4 + 3]);
            __hip_atomic_store(xbuf + ((size_t)(u.pm * BM + rl) * 4 + u.pn), __float_as_uint(tot), __ATOMIC_RELAXED, __HIP_MEMORY_SCOPE_AGENT); }
        asm volatile("s_waitcnt vmcnt(0)" ::: "memory");
        if (lane == 0) __hip_atomic_fetch_add(cnt + 64 * u.pm, 1u, __ATOMIC_RELAXED, __HIP_MEMORY_SCOPE_AGENT);
        if (wid == 0) {
            unsigned sp = 0u;
            for (;;) {
                if ((unsigned)__builtin_amdgcn_readfirstlane(__hip_atomic_load(cnt + 64 * u.pm, __ATOMIC_RELAXED, __HIP_MEMORY_SCOPE_AGENT)) >= 32u) break;
                __builtin_amdgcn_s_sleep(2);
                if (++sp > (1u << 20)) { if (lane == 0) __hip_atomic_store(tmo, 1u, __ATOMIC_RELAXED, __HIP_MEMORY_SCOPE_AGENT); break; }
            }
            __builtin_amdgcn_fence(__ATOMIC_ACQUIRE, "agent");
            if (lane == 0) flag[0] = 1u;
        }
        asm volatile("s_waitcnt vmcnt(0) lgkmcnt(0)" ::: "memory"); __builtin_amdgcn_s_barrier(); asm volatile("" ::: "memory");
        if (lane < 32) { const unsigned* sl = xbuf + (size_t)(u.pm * BM + rl) * 4; float tot = 0.f;
#pragma unroll
            for (int t = 0; t < 4; ++t) tot += __uint_as_float(__hip_atomic_load(sl + t, __ATOMIC_RELAXED, __HIP_MEMORY_SCOPE_AGENT));
            S[rl] = __builtin_amdgcn_rsqf(tot * (1.0f / DM) + EPS); }
        asm volatile("s_waitcnt lgkmcnt(0)" ::: "memory"); __builtin_amdgcn_s_barrier(); asm volatile("" ::: "memory");
#pragma unroll
        for (int bj = 0; bj < 2; ++bj) { const int col = u.pn * BM + bj * HALF + wc * 32 + 8 * fq;
            const f32x4 g0 = *(const f32x4*)(gfin + col), g1 = *(const f32x4*)(gfin + col + 4);
#pragma unroll
            for (int ai = 0; ai < 2; ++ai)
#pragma unroll
                for (int m = 0; m < 4; ++m) { const int rl2 = ai * HALF + wr * 64 + m * 16 + fr; const float rs = S[rl2]; const size_t off = (size_t)(u.pm * BM + rl2) * DM + col;
                    *(f32x4*)(out + off) = acc[ai][bj][m][0] * rs * g0; *(f32x4*)(out + off + 4) = acc[ai][bj][m][1] * rs * g1; } }
    } };
}

namespace att {
constexpr int KB0 = 0, VB0 = 24576, IMP = 49152, IMPW = 65, SELM = IMP + 4 * 64 * IMPW * 4, WMASK = SELM + 512, WSF = WMASK + 64, STEPS = WSF + 8 * 32 * 4, CMPX = STEPS + 8 * 128, ATT_LDS = CMPX + 16384;
static_assert(ATT_LDS <= 143360, "attention LDS");
#define MFMA32(a, b, c) __builtin_amdgcn_mfma_f32_32x32x16_bf16((a), (b), (c), 0, 0, 0)
__device__ __forceinline__ int crow(int r, int hi) { return (r & 3) + 8 * (r >> 2) + 4 * hi; }
typedef short v4i16_t __attribute__((ext_vector_type(4)));
__device__ __forceinline__ s16x4 vtr(LAS const unsigned char* p) { return __builtin_bit_cast(s16x4, __builtin_amdgcn_ds_read_tr16_b64_v4i16((LAS v4i16_t*)p)); }

struct St { float m, l; f32x16 o0, o1; };

__device__ __forceinline__ void qk_tile(f32x16& p0, f32x16& p1, LAS const unsigned char* kb, const bf16x8* qf, int r, int h) {
    bf16x8 k0[4], k1[4], qv[4];
#pragma unroll
    for (int d0 = 0; d0 < 4; ++d0) { k0[d0] = *(const LAS bf16x8*)(kb + (2 * d0 + h) * 1024 + r * 16); k1[d0] = *(const LAS bf16x8*)(kb + (2 * d0 + h) * 1024 + 512 + r * 16);
        qv[d0] = qf[d0]; }
#pragma unroll
    for (int i = 0; i < 16; ++i) { p0[i] = 0.f; p1[i] = 0.f; }
    __builtin_amdgcn_sched_barrier(0);
#pragma unroll
    for (int d0 = 0; d0 < 4; ++d0) { p0 = MFMA32(k0[d0], qv[d0], p0); p1 = MFMA32(k1[d0], qv[d0], p1); }
}
__device__ __forceinline__ void apply_mask(f32x16& p0, f32x16& p1, unsigned long long allow, int h) {
    if (__all(allow == ~0ull)) return;
    const unsigned long long a = allow >> (4 * h); const unsigned lo = (unsigned)a, hi = (unsigned)(a >> 32);
#pragma unroll
    for (int i = 0; i < 16; ++i) { const int cb = (i & 3) + 8 * (i >> 2);
        p0[i] = ((lo >> cb) & 1u) ? p0[i] : -INFINITY; p1[i] = ((hi >> cb) & 1u) ? p1[i] : -INFINITY; }
}
__device__ __forceinline__ float rowmax32(const f32x16& p0, const f32x16& p1) {
    float a = fmaxf(p0[0], p1[0]);
#pragma unroll
    for (int i = 1; i < 16; ++i) a = fmaxf(a, fmaxf(p0[i], p1[i]));
    return fmaxf(a, __shfl_xor(a, 32));
}
__device__ __forceinline__ void pv_tile(f32x16& o0, f32x16& o1, LAS const unsigned char* vb, const f32x16& p0, const f32x16& p1, int lane, int h) {
    bf16x8 pa[4];
#pragma unroll
    for (int s = 0; s < 4; ++s) { u32x4 w;
#pragma unroll
        for (int j = 0; j < 4; ++j) { const int i0 = 8 * (s & 1) + 2 * j; w[j] = (s < 2) ? pk2(p0[i0], p0[i0 + 1]) : pk2(p1[i0], p1[i0 + 1]); }
        pa[s] = __builtin_bit_cast(bf16x8, w); }
    LAS const unsigned char* vp = vb + ((lane >> 4) & 1) * 32 + (lane & 3) * 8 + (4 * h + ((lane & 15) >> 2)) * 64;
    s16x4 l0[4], h0[4], l1[4], h1[4];
#pragma unroll
    for (int s = 0; s < 4; ++s) { l0[s] = vtr(vp + s * 1024); h0[s] = vtr(vp + s * 1024 + 512); l1[s] = vtr(vp + 4096 + s * 1024); h1[s] = vtr(vp + 4096 + s * 1024 + 512); }
    __builtin_amdgcn_sched_barrier(0);
#pragma unroll
    for (int s = 0; s < 4; ++s) {
        const bf16x8 v0 = (bf16x8){l0[s][0], l0[s][1], l0[s][2], l0[s][3], h0[s][0], h0[s][1], h0[s][2], h0[s][3]};
        const bf16x8 v1 = (bf16x8){l1[s][0], l1[s][1], l1[s][2], l1[s][3], h1[s][0], h1[s][1], h1[s][2], h1[s][3]};
        o0 = MFMA32(pa[s], v0, o0); o1 = MFMA32(pa[s], v1, o1);
    }
}
__device__ __forceinline__ void tile_online(St& st, LAS const unsigned char* kb, LAS const unsigned char* vb, const bf16x8* qr, unsigned long long allow,
                                            LAS float* wsf, int lane, int r, int h) {
    f32x16 p0, p1; qk_tile(p0, p1, kb, qr, r, h); __builtin_amdgcn_sched_barrier(0); apply_mask(p0, p1, allow, h);
    const float rm = rowmax32(p0, p1), mnew = fmaxf(st.m, rm), f = ex2(st.m - mnew); st.m = mnew;
    float ls = 0.f;
#pragma unroll
    for (int i = 0; i < 16; ++i) { p0[i] = ex2(p0[i] - mnew); p1[i] = ex2(p1[i] - mnew); ls += p0[i] + p1[i]; }
    st.l = st.l * f + ls;
    if (__any(f != 1.0f)) {
        if (h == 0) wsf[r] = f;
#pragma unroll
        for (int i = 0; i < 16; ++i) { const float fi = wsf[crow(i, h)]; st.o0[i] *= fi; st.o1[i] *= fi; }
    }
    pv_tile(st.o0, st.o1, vb, p0, p1, lane, h);
}
__device__ __forceinline__ void tile_stats(float& m, float& l, LAS const unsigned char* kb, const bf16x8* qr, unsigned long long allow, int r, int h) {
    f32x16 p0, p1; qk_tile(p0, p1, kb, qr, r, h); __builtin_amdgcn_sched_barrier(0); apply_mask(p0, p1, allow, h);
    const float rm = rowmax32(p0, p1), mnew = fmaxf(m, rm), f = ex2(m - mnew); m = mnew;
    float ls = 0.f;
#pragma unroll
    for (int i = 0; i < 16; ++i) ls += ex2(p0[i] - mnew) + ex2(p1[i] - mnew);
    l = l * f + ls;
}
__device__ __forceinline__ void tile_exact(f32x16& o0, f32x16& o1, float m, float invl, LAS const unsigned char* kb, LAS const unsigned char* vb, const bf16x8* qr,
                                           unsigned long long allow, LAS float* impw  , float& carry, int j, int lane, int r, int h) {
    f32x16 p0, p1; qk_tile(p0, p1, kb, qr, r, h); __builtin_amdgcn_sched_barrier(0); apply_mask(p0, p1, allow, h);
#pragma unroll
    for (int i = 0; i < 16; ++i) { p0[i] = ex2(p0[i] - m) * invl; p1[i] = ex2(p1[i] - m) * invl; }
#pragma unroll
    for (int pos = 0; pos < 8; ++pos) {
        const int half = pos >> 2, r4 = pos & 3;
        const float P0 = half ? p1[4 * r4] : p0[4 * r4], P1 = half ? p1[4 * r4 + 1] : p0[4 * r4 + 1], P2 = half ? p1[4 * r4 + 2] : p0[4 * r4 + 2], P3 = half ? p1[4 * r4 + 3] : p0[4 * r4 + 3];
        const float a = (P0 + P1) + (P2 + 0.5f * P3), b = 0.5f * P3;
        const float bx = __shfl_xor(b, 32);
        const float add = h ? bx : carry;
        impw[16 * j + 2 * pos + h] = a + add;
        carry = bx;
    }
    pv_tile(o0, o1, vb, p0, p1, lane, h);
}

__device__ __forceinline__ void qk_tile_c(f32x16& p0, f32x16& p1, LAS const unsigned char* kb, const bf16x8* qf, const f32x16& c, int r, int h) {
    bf16x8 k0[4], k1[4], qv[4];
#pragma unroll
    for (int d0 = 0; d0 < 4; ++d0) { k0[d0] = *(const LAS bf16x8*)(kb + (2 * d0 + h) * 1024 + r * 16); k1[d0] = *(const LAS bf16x8*)(kb + (2 * d0 + h) * 1024 + 512 + r * 16);
        qv[d0] = qf[d0]; }
    __builtin_amdgcn_sched_barrier(0);
    p0 = MFMA32(k0[0], qv[0], c); p1 = MFMA32(k1[0], qv[0], c);
#pragma unroll
    for (int d0 = 1; d0 < 4; ++d0) { p0 = MFMA32(k0[d0], qv[d0], p0); p1 = MFMA32(k1[d0], qv[d0], p1); }
}
__device__ __forceinline__ unsigned long long lowmask(int n);
__device__ __forceinline__ void soft_pv(St& st, f32x16& x0, f32x16& x1, float cx, LAS const unsigned char* vb, bool first, int kind, int tq,
                                        LAS float* wsf, int lane, int r, int h) {
    if (first) st.m = cx;
    else { const float d = st.m - cx;
        if (__any(d != 0.f)) {
#pragma unroll
            for (int i = 0; i < 16; ++i) { x0[i] -= d; x1[i] -= d; } } }
    if (kind) apply_mask(x0, x1, kind == 1 ? lowmask(tq + 1) : ~lowmask(tq + 1), h);
    const float rm = rowmax32(x0, x1);
    if (first) {
        const float dl = (rm > -INFINITY) ? rm : 0.f; st.m += dl;
#pragma unroll
        for (int i = 0; i < 16; ++i) { x0[i] -= dl; x1[i] -= dl; }
    } else if (__any(rm > 8.0f)) {
        const float dl = fmaxf(rm, 0.f), f = ex2(-dl); st.m += dl; st.l *= f;
        if (h == 0) wsf[r] = f;
#pragma unroll
        for (int i = 0; i < 16; ++i) { x0[i] -= dl; x1[i] -= dl; }
#pragma unroll
        for (int i = 0; i < 16; ++i) { const float fi = wsf[crow(i, h)]; st.o0[i] *= fi; st.o1[i] *= fi; }
    }
    float ls = 0.f;
#pragma unroll
    for (int i = 0; i < 16; ++i) { x0[i] = ex2(x0[i]); x1[i] = ex2(x1[i]); ls += x0[i] + x1[i]; }
    st.l += ls;
    pv_tile(st.o0, st.o1, vb, x0, x1, lane, h);
}
__device__ __forceinline__ unsigned long long lowmask(int n) { return n >= 64 ? ~0ull : ((1ull << n) - 1ull); }

typedef LAS const char* lds_cptr;
__device__ __forceinline__ void hs_glds16(const void* gsrc, unsigned lds_dst) { unsigned keep;
    asm volatile("s_mov_b32 %0, m0\n\ts_mov_b32 m0, %2\n\ts_nop 0\n\tglobal_load_lds_dwordx4 %1, off\n\ts_mov_b32 m0, %0" : "=&s"(keep) : "v"(gsrc), "s"(lds_dst) : "memory"); }
__device__ __forceinline__ float hs_max3f(float a, float b, float c) { float r; asm("v_max3_f32 %0, %1, %2, %3" : "=v"(r) : "v"(a), "v"(b), "v"(c)); return r; }
__device__ __forceinline__ float hs_max2f(float a, float b) { float r; asm("v_max_f32_e32 %0, %1, %2" : "=v"(r) : "v"(a), "v"(b)); return r; }
__device__ __forceinline__ float hs_fadd(float a, float b) { float r; asm("v_add_f32_e32 %0, %1, %2" : "=v"(r) : "v"(a), "v"(b)); return r; }
__device__ __forceinline__ float hs_fsub(float a, float b) { float r; asm("v_sub_f32_e32 %0, %1, %2" : "=v"(r) : "v"(a), "v"(b)); return r; }
#define HS_SBAR() __builtin_amdgcn_sched_barrier(0)
#define HS_WAIT_BAR(N) asm volatile("s_waitcnt vmcnt(" #N ") lgkmcnt(0)\n\ts_barrier" ::: "memory")
__device__ __forceinline__ void hs_qkt(f32x16& p0, f32x16& p1, const char* Kslot, const bf16x8* qr, const f32x16& negm, int r32, int hi) {
    const char* kb = Kslot + hi * 1024 + r32 * 16;
#pragma unroll
    for (int d0 = 0; d0 < 4; ++d0) {
        const bf16x8 b0 = *reinterpret_cast<const bf16x8*>(kb + d0 * 2048);
        const bf16x8 b1 = *reinterpret_cast<const bf16x8*>(kb + d0 * 2048 + 512);
        if (d0 == 0) { p0 = MFMA32(b0, qr[0], negm); p1 = MFMA32(b1, qr[0], negm); }
        else { p0 = MFMA32(b0, qr[d0], p0); p1 = MFMA32(b1, qr[d0], p1); } }
}
__device__ __forceinline__ void hs_kload8(bf16x8* kf, lds_cptr kp) {
    kf[0] = *(const LAS bf16x8*)(kp);        kf[1] = *(const LAS bf16x8*)(kp + 512);
    kf[2] = *(const LAS bf16x8*)(kp + 2048); kf[3] = *(const LAS bf16x8*)(kp + 2560);
    kf[4] = *(const LAS bf16x8*)(kp + 4096); kf[5] = *(const LAS bf16x8*)(kp + 4608);
    kf[6] = *(const LAS bf16x8*)(kp + 6144); kf[7] = *(const LAS bf16x8*)(kp + 6656);
}
__device__ __forceinline__ void hs_kload2(bf16x8* kf, lds_cptr kp, int j) { kf[2 * j] = *(const LAS bf16x8*)(kp + j * 2048); kf[2 * j + 1] = *(const LAS bf16x8*)(kp + j * 2048 + 512); }
__device__ __forceinline__ s16x4 hs_vtr(lds_cptr p) { return __builtin_bit_cast(s16x4, __builtin_amdgcn_ds_read_tr16_b64_v4i16((LAS v4i16_t*)p)); }
__device__ __forceinline__ float hs_rowmax(const f32x16& p0, const f32x16& p1) {
    float a = hs_max3f(p0[0], p0[1], p1[0]), b = hs_max3f(p0[2], p0[3], p1[1]); a = hs_max3f(a, p1[2], p1[3]);
#pragma unroll
    for (int r = 4; r < 16; r += 4) { a = hs_max3f(a, p0[r], p0[r + 1]); b = hs_max3f(b, p0[r + 2], p0[r + 3]); a = hs_max3f(a, p1[r], p1[r + 1]); b = hs_max3f(b, p1[r + 2], p1[r + 3]); }
    const float m = hs_max2f(a, b);
    auto rr = __builtin_amdgcn_permlane32_swap(__float_as_uint(m), __float_as_uint(m), false, false);
    return hs_max2f(__uint_as_float(rr[0]), __uint_as_float(rr[1]));
}
__device__ __forceinline__ void hs_pv(f32x16* o, int vb, bf16x8 pa0, bf16x8 pa1, bf16x8 pa2, bf16x8 pa3) {
#pragma unroll
    for (int d0 = 0; d0 < 2; ++d0) { s16x4 lo[4], hi[4];
#pragma unroll
        for (int ks = 0; ks < 4; ++ks) {
            asm volatile("ds_read_b64_tr_b16 %0,%1 offset:%c2" : "=&v"(lo[ks]) : "v"(vb), "i"(d0 * 4096 + ks * 1024) : "memory");
            asm volatile("ds_read_b64_tr_b16 %0,%1 offset:%c2" : "=&v"(hi[ks]) : "v"(vb), "i"(d0 * 4096 + ks * 1024 + 512) : "memory"); }
        asm volatile("s_waitcnt lgkmcnt(0)" ::: "memory"); HS_SBAR();
#define HS_PK(k) (bf16x8){lo[k][0], lo[k][1], lo[k][2], lo[k][3], hi[k][0], hi[k][1], hi[k][2], hi[k][3]}
        o[d0] = MFMA32(pa0, HS_PK(0), o[d0]); o[d0] = MFMA32(pa1, HS_PK(1), o[d0]); o[d0] = MFMA32(pa2, HS_PK(2), o[d0]); o[d0] = MFMA32(pa3, HS_PK(3), o[d0]);
#undef HS_PK
    }
}
template <int THRL, bool DIS> __device__ __forceinline__ void run_branch(char* shm, const bf16x8* qr, const bf16_t* ksb, LAS const unsigned char* steps, const int NT,
                                                               const int qb, f32x16* o, float& l_out, const int wid, const int lane) {
    constexpr int SLOTB = 8192, NSLOT = 3;
    { unsigned long long p_ = (unsigned long long)ksb; asm volatile("" : "+s"(p_)); ksb = (const bf16_t*)p_; }
    const int r32 = lane & 31, hi = lane >> 5, tq = (wid & 1) * 32 + r32;
    const unsigned lds0 = (unsigned)(uintptr_t)shm;
    const unsigned long long mysel = *((LAS const unsigned long long*)((lds_cptr)shm + SELM) + tq);
    const int vcodes = (int)steps[lane];
    float* wsf = (float*)(shm + WSF) + wid * 32;
    const size_t koff = (size_t)lane * PP + wid * 8, voff = (size_t)(16 * (wid & 3) + (lane >> 2)) * PP + (wid >> 2) * 32 + (lane & 3) * 8 + (C_VS - C_KS);
    const unsigned kdst = lds0 + KB0 + wid * 1024, vdst = lds0 + VB0 + wid * 1024;
#define HS_CODE(t) ((int)__builtin_amdgcn_readlane(vcodes, (t)))
#define HS_SRC(c) (ksb + (size_t)(((c) & 0x80) ? (C_KW - C_KS) : 0) + (size_t)(((c) == 0x7f) ? 0 : ((c) & 0x7f)) * 64 * PP)
#define DMA_K(t, slot) do { const int c_ = HS_CODE(t); hs_glds16(HS_SRC(c_) + koff, (unsigned)__builtin_amdgcn_readfirstlane(kdst + (slot))); } while (0)
#define DMA_V(t, slot) do { const int c_ = HS_CODE(t); hs_glds16(HS_SRC(c_) + voff, (unsigned)__builtin_amdgcn_readfirstlane(vdst + (slot))); } while (0)
    const int vb0 = (int)(lds0 + VB0) + ((lane >> 4) & 1) * 32 + (lane & 3) * 8 + (4 * hi + ((lane & 15) >> 2)) * 64;
    const char* Kbase = shm + KB0; bf16x8 kf[8];
    const lds_cptr shm3 = (lds_cptr)shm; const lds_cptr kp0 = shm3 + KB0 + hi * 1024 + r32 * 16; const lds_cptr vp0 = shm3 + VB0 + ((lane >> 4) & 1) * 32 + (lane & 3) * 8 + (4 * hi + ((lane & 15) >> 2)) * 64;
    DMA_K(0, 0); DMA_V(0, 0); DMA_K(1, SLOTB);
    float mhat = 0.f, l_reg = 0.f; f32x16 negm;
    { float z = 0.f; asm volatile("" : "+v"(z));
#pragma unroll
      for (int i = 0; i < 16; ++i) { o[0][i] = z; o[1][i] = z; negm[i] = z; } }
    asm volatile("" : "+v"(negm));
#define CMASK(P0, P1, t) do { const int c_ = HS_CODE(t); const bool isw_ = (c_ & 0x80) != 0; const int jj_ = c_ & 0x7f; \
        if (!DIS && c_ == 0x7f) { _Pragma("unroll") for (int r = 0; r < 16; ++r) { P0[r] = -INFINITY; P1[r] = -INFINITY; } } \
        int kind_ = 0; if (c_ != 0x7f) { if (jj_ == qb) kind_ = 1; else if (isw_ && jj_ == qb - 8) kind_ = 2; } \
        if (kind_) apply_mask(P0, P1, kind_ == 1 ? lowmask(tq + 1) : ~lowmask(tq + 1), hi); } while (0)
    bool resc = false;
#define START(P0, P1) do { const float rm = hs_rowmax(P0, P1); resc = false; \
        { const float dl = (rm > -INFINITY) ? rm : 0.f; mhat = hs_fadd(mhat, dl); \
          _Pragma("unroll") for (int r = 0; r < 16; ++r) { P0[r] = hs_fsub(P0[r], dl); P1[r] = hs_fsub(P1[r], dl); } \
          _Pragma("unroll") for (int r = 0; r < 16; ++r) negm[r] = -mhat; asm volatile("" : "+v"(negm)); } \
        _Pragma("unroll") for (int r = 0; r < 16; ++r) P0[r] = __builtin_amdgcn_exp2f(P0[r]); } while (0)
#define RESC() do { if (resc) { asm volatile("s_waitcnt lgkmcnt(0)" ::: "memory"); \
        _Pragma("unroll") for (int d_ = 0; d_ < 2; ++d_) _Pragma("unroll") for (int r = 0; r < 16; ++r) o[d_][r] *= wsf[crow(r, hi)]; } } while (0)
    f32x16 pA0, pA1, pB0, pB1;
    int sl_prev = 0, sl_cur = 0, sl_next = SLOTB;
#define ROT() do { sl_prev = sl_cur; sl_cur = sl_next; sl_next = (sl_next == (NSLOT - 1) * SLOTB) ? 0 : sl_next + SLOTB; } while (0)
    DMA_K(2, 2 * SLOTB);
    HS_WAIT_BAR(3);
    hs_qkt(pA0, pA1, Kbase, qr, negm, r32, hi); asm volatile("s_nop 15\n\ts_nop 7" : "+v"(pA0), "+v"(pA1)); CMASK(pA0, pA1, 0);
    START(pA0, pA1);
    _Pragma("unroll") for (int r = 0; r < 16; ++r) pA1[r] = __builtin_amdgcn_exp2f(pA1[r]);
    HS_WAIT_BAR(0);
    DMA_K(3, 0); DMA_V(1, SLOTB);
    ROT();
    hs_kload8(kf, kp0 + sl_cur);
    HS_WAIT_BAR(2);
    s16x4 vlo[8], vhi[8]; u32x4 pw0, pw1, pw2, pw3;
#define PKW(P, B) pk2(P[B], P[B + 1])
#define PAF(k) __builtin_bit_cast(bf16x8, pw##k)
#define VFR(i) (bf16x8){vlo[i][0], vlo[i][1], vlo[i][2], vlo[i][3], vhi[i][0], vhi[i][1], vhi[i][2], vhi[i][3]}
#define PIN(x) asm volatile("" : "+v"(x))
#define MX3(a, b, c) __builtin_fmaxf(__builtin_fmaxf((a), (b)), (c))
#define GAPA(MF, A0, A1, A2, A3, W0, W1, PW) do { MF; sacc += A0; sacc += A1; sacc += A2; sacc += A3; PIN(sacc); W0; W1; PIN(PW); HS_SBAR(); } while (0)
#define EX(v) __builtin_amdgcn_exp2f(v)
#define GAPB(MF, X, B) do { MF; X[B] = EX(X[B]); X[B + 1] = EX(X[B + 1]); X[B + 2] = EX(X[B + 2]); X[B + 3] = EX(X[B + 3]); PIN(X); HS_SBAR(); } while (0)
#define VRD(i) do { vlo[i] = hs_vtr(vp_ + (((i) >> 2) * 4096 + ((i) & 3) * 1024)); vhi[i] = hs_vtr(vp_ + (((i) >> 2) * 4096 + ((i) & 3) * 1024 + 512)); } while (0)
#define KRD(G, j) do { if (G) { hs_kload2(kf, kp0 + sl_next, j); HS_SBAR(); } } while (0)
#define STEP(C0, C1, P0, P1, t, GK, GV, GL) do { HS_SBAR(); \
        f32x16 cct; \
        if (DIS) { const int c0_ = HS_CODE(t); const bool en0_ = (c0_ != 0x7f) && (((mysel >> (c0_ & 63)) & 1ull) != 0ull);     \
            _Pragma("unroll") for (int r = 0; r < 16; ++r) cct[r] = en0_ ? negm[r] : -INFINITY; PIN(cct); HS_SBAR(); } \
        const lds_cptr vp_ = vp0 + sl_prev; \
        VRD(0); HS_SBAR(); float sacc = (P0[0] + P0[1]); \
        GAPA(C0 = MFMA32(kf[0], qr[0], (DIS ? cct : negm)), P0[2], P0[3], P0[4], P0[5],     pw0[0] = PKW(P0, 0), pw0[1] = PKW(P0, 2), pw0); \
        VRD(4); HS_SBAR(); GAPA(C1 = MFMA32(kf[1], qr[0], (DIS ? cct : negm)), P0[6], P0[7], P0[8], P0[9],     pw0[2] = PKW(P0, 4), pw0[3] = PKW(P0, 6), pw0); \
        VRD(1); HS_SBAR(); GAPA(C0 = MFMA32(kf[2], qr[1], C0),   P0[10], P0[11], P0[12], P0[13], pw1[0] = PKW(P0, 8), pw1[1] = PKW(P0, 10), pw1); \
        VRD(5); HS_SBAR(); GAPA(C1 = MFMA32(kf[3], qr[1], C1),   P0[14], P0[15], P1[0], P1[1],   pw1[2] = PKW(P0, 12), pw1[3] = PKW(P0, 14), pw1); \
        VRD(2); HS_SBAR(); GAPA(C0 = MFMA32(kf[4], qr[2], C0),   P1[2], P1[3], P1[4], P1[5],     pw2[0] = PKW(P1, 0), pw2[1] = PKW(P1, 2), pw2); \
        VRD(6); HS_SBAR(); GAPA(C1 = MFMA32(kf[5], qr[2], C1),   P1[6], P1[7], P1[8], P1[9],     pw2[2] = PKW(P1, 4), pw2[3] = PKW(P1, 6), pw2); \
        VRD(3); HS_SBAR(); GAPA(C0 = MFMA32(kf[6], qr[3], C0),   P1[10], P1[11], P1[12], P1[13], pw3[0] = PKW(P1, 8), pw3[1] = PKW(P1, 10), pw3); \
        VRD(7); HS_SBAR(); GAPA(C1 = MFMA32(kf[7], qr[3], C1),   P1[14], P1[15], 0.f, 0.f,       pw3[2] = PKW(P1, 12), pw3[3] = PKW(P1, 14), pw3); \
        l_reg += sacc; \
        if (GK) { DMA_K((t) + 3, sl_cur); } if (GV) { DMA_V((t) + 1, sl_next); } \
        CMASK(C0, C1, t); \
        { float a = MX3(C0[0], C0[1], C1[0]), b = MX3(C0[2], C0[3], C1[1]); a = MX3(a, C1[2], C1[3]); \
          _Pragma("unroll") for (int r = 4; r < 16; r += 4) { a = MX3(a, C0[r], C0[r + 1]); b = MX3(b, C0[r + 2], C0[r + 3]); a = MX3(a, C1[r], C1[r + 1]); b = MX3(b, C1[r + 2], C1[r + 3]); } \
          float rm = __builtin_fmaxf(a, b); { auto rr = __builtin_amdgcn_permlane32_swap(__float_as_uint(rm), __float_as_uint(rm), false, false); rm = __builtin_fmaxf(__uint_as_float(rr[0]), __uint_as_float(rr[1])); } \
          resc = false; \
          if (__builtin_expect(__any(rm > (float)THRL), 0)) { const float dl = __builtin_fmaxf(rm, 0.f); mhat += dl; \
            _Pragma("unroll") for (int r = 0; r < 16; ++r) { C0[r] -= dl; C1[r] -= dl; } \
            _Pragma("unroll") for (int r = 0; r < 16; ++r) negm[r] = -mhat; asm volatile("" : "+v"(negm)); \
            const float f = __builtin_amdgcn_exp2f(-dl); l_reg *= f; if (hi == 0) wsf[r32] = f; resc = true; } } \
        HS_SBAR(); \
        GAPB(o[0] = MFMA32(PAF(0), VFR(0), o[0]), C0, 0); \
        GAPB(o[1] = MFMA32(PAF(0), VFR(4), o[1]), C0, 4); \
        KRD(GL, 0); GAPB(o[0] = MFMA32(PAF(1), VFR(1), o[0]), C0, 8); \
        KRD(GL, 1); GAPB(o[1] = MFMA32(PAF(1), VFR(5), o[1]), C0, 12); \
        KRD(GL, 2); GAPB(o[0] = MFMA32(PAF(2), VFR(2), o[0]), C1, 0); \
        KRD(GL, 3); GAPB(o[1] = MFMA32(PAF(2), VFR(6), o[1]), C1, 4); \
        GAPB(o[0] = MFMA32(PAF(3), VFR(3), o[0]), C1, 8); \
        GAPB(o[1] = MFMA32(PAF(3), VFR(7), o[1]), C1, 12); \
    } while (0)
    int t = 1;
    for (; t + 5 < NT; t += 2) {
        STEP(pB0, pB1, pA0, pA1, t, true, true, true);     HS_WAIT_BAR(2); RESC(); ROT();
        STEP(pA0, pA1, pB0, pB1, t + 1, true, true, true); HS_WAIT_BAR(2); RESC(); ROT();
    }
#define ENDW(tt) do { if ((tt) + 3 < NT) { HS_WAIT_BAR(2); } else if ((tt) + 2 < NT) { HS_WAIT_BAR(1); } else { HS_WAIT_BAR(0); } } while (0)
    for (; t + 1 < NT; t += 2) {
        STEP(pB0, pB1, pA0, pA1, t, (t + 3 < NT), (t + 1 < NT), (t + 1 < NT));         ENDW(t);     RESC(); ROT();
        STEP(pA0, pA1, pB0, pB1, t + 1, (t + 4 < NT), (t + 2 < NT), (t + 2 < NT));     ENDW(t + 1); RESC(); ROT();
    }
#define DRAIN(PX0, PX1, SL) do { float sacc = PX0[0] + PX0[1]; _Pragma("unroll") for (int r = 2; r < 16; ++r) sacc += PX0[r]; _Pragma("unroll") for (int r = 0; r < 16; ++r) sacc += PX1[r]; l_reg += sacc; \
      pw0 = (u32x4){PKW(PX0, 0), PKW(PX0, 2), PKW(PX0, 4), PKW(PX0, 6)}; pw1 = (u32x4){PKW(PX0, 8), PKW(PX0, 10), PKW(PX0, 12), PKW(PX0, 14)}; \
      pw2 = (u32x4){PKW(PX1, 0), PKW(PX1, 2), PKW(PX1, 4), PKW(PX1, 6)}; pw3 = (u32x4){PKW(PX1, 8), PKW(PX1, 10), PKW(PX1, 12), PKW(PX1, 14)}; \
      HS_SBAR(); hs_pv(o, vb0 + (SL), PAF(0), PAF(1), PAF(2), PAF(3)); } while (0)
    if (NT & 1) {
        DRAIN(pA0, pA1, sl_prev);
    } else {
        STEP(pB0, pB1, pA0, pA1, NT - 1, false, false, false); RESC();
        DRAIN(pB0, pB1, sl_cur);
    }
#undef DRAIN
    { auto rr = __builtin_amdgcn_permlane32_swap(__float_as_uint(l_reg), __float_as_uint(l_reg), false, false); l_out = __uint_as_float(rr[0]) + __uint_as_float(rr[1]); }
    asm volatile("s_waitcnt lgkmcnt(0)\n\ts_barrier" ::: "memory");
#undef PKW
#undef PAF
#undef VFR
#undef PIN
#undef MX3
#undef GAPA
#undef GAPB
#undef EX
#undef VRD
#undef KRD
#undef STEP
#undef ENDW
#undef DMA_K
#undef DMA_V
#undef CMASK
#undef START
#undef RESC
#undef ROT
#undef HS_CODE
#undef HS_SRC
}
__device__ __forceinline__ void attn_unit(LAS unsigned char* lds, bf16_t* proj, const bf16_t* kcmp, const bf16_t* vcmp, int bh, int qb, int skipw) {
    int tid_ = threadIdx.x; asm volatile("" : "+v"(tid_));
    const int tid = tid_, lane = tid & 63, r = lane & 31, h = lane >> 5, wid = __builtin_amdgcn_readfirstlane(tid >> 6);
    const int b = bh >> 2, hk = bh & 3, g = wid >> 1, tq = (wid & 1) * 32 + r;
    const size_t row = (size_t)b * SEQ + (size_t)qb * 64 + tq;
    const int t = qb * 64 + tq;
    bf16_t* qp = proj + row * PP + C_Q + (hk * 4 + g) * 64;
    bf16x8 qreg[4];
#pragma unroll
    for (int d0 = 0; d0 < 4; ++d0) qreg[d0] = *(const bf16x8*)(qp + d0 * 16 + h * 8);
    const bf16x8* qr = qreg;
    float gate[3];
#pragma unroll
    for (int c = 0; c < 3; ++c) gate[c] = sigmoidf_(bf2f(proj[row * PP + C_GBR + c * 16 + hk * 4 + g]));
#ifdef GATE2X
    if (GATE2X & 1) gate[0] *= 2.f; if (GATE2X & 2) gate[1] *= 2.f; if (GATE2X & 4) gate[2] *= 2.f;
#endif
#ifdef GATEZ
    if (GATEZ & 1) gate[0] = 0.f; if (GATEZ & 2) gate[1] = 0.f; if (GATEZ & 4) gate[2] = 0.f;
#endif
    LAS float* wsf = (LAS float*)(lds + WSF) + wid * 32;
    LAS float* impw = (LAS float*)(lds + IMP) + (g * 64 + tq) * IMPW;
    const size_t krow = lane, kcol = wid * 8;
    const size_t vrow = 16 * (wid & 3) + (lane >> 2), vcol = 32 * (wid >> 2) + 8 * (lane & 3);
    LAS unsigned char* kst = lds + KB0 + wid * 1024 + lane * 16;
    LAS unsigned char* vst = lds + VB0 + wid * 1024 + lane * 16;
    u32x4 kreg, vreg;
    LAS float* osl = (LAS float*)(lds + IMP + wid * (32 * IMPW * 4)) + lane;
#define LDK(base, pitch) kreg = *(const u32x4*)((base) + krow * (size_t)(pitch) + kcol)
#define LDV(base, pitch) vreg = *(const u32x4*)((base) + vrow * (size_t)(pitch) + vcol)
#define STK(buf) *(LAS u32x4*)(kst + (buf) * 8192) = kreg
#define STV(buf) *(LAS u32x4*)(vst + (buf) * 8192) = vreg
#define KBUF(buf) (lds + KB0 + (buf) * 8192)
#define VBUF(buf) (lds + VB0 + (buf) * 8192)
#define ACCUM_OUT(scale_expr, FIRST) do { if (h == 0) wsf[r] = (scale_expr); \
        _Pragma("unroll") for (int i = 0; i < 16; ++i) { const float sc = wsf[crow(i, h)]; \
            if (FIRST) { osl[(i * 2) * 64] = st.o0[i] * sc; osl[(i * 2 + 1) * 64] = st.o1[i] * sc; } \
            else { osl[(i * 2) * 64] += st.o0[i] * sc; osl[(i * 2 + 1) * 64] += st.o1[i] * sc; } } } while (0)

    St st;
    const bf16_t* kc = kcmp + (size_t)bh * 256 * 64; const bf16_t* vc = vcmp + (size_t)bh * 256 * 64;
    const int nmax = (t >= 31) ? ((t - 31) >> 4) : -1;
#define CMP_KT(j) (lds + (j) * 8192)
#define CMP_VT(j) ((j) < 2 ? lds + 32768 + (j) * 8192 : lds + CMPX + ((j) - 2) * 8192)
    {
        u32x4 kr4[4], vr4[4];
#pragma unroll
        for (int j = 0; j < 4; ++j) { kr4[j] = *(const u32x4*)(kc + (size_t)j * 4096 + krow * 64 + kcol); vr4[j] = *(const u32x4*)(vc + (size_t)j * 4096 + vrow * 64 + vcol); }
#pragma unroll
        for (int j = 0; j < 4; ++j) { *(LAS u32x4*)(CMP_KT(j) + wid * 1024 + lane * 16) = kr4[j]; *(LAS u32x4*)(CMP_VT(j) + wid * 1024 + lane * 16) = vr4[j]; }
    }
    __syncthreads();
    float carry = 0.f;
    float m1 = -1e30f, l1 = 0.f;
#pragma unroll 1
    for (int j = 0; j < 4; ++j) {
        const int cnt = nmax - 64 * j + 1; const unsigned long long allow = cnt <= 0 ? 0ull : lowmask(cnt);
        tile_stats(m1, l1, CMP_KT(j), qr, allow, r, h);
    }
    l1 += __shfl_xor(l1, 32);
    const float invl = __builtin_amdgcn_rcpf(fmaxf(l1, 1e-30f));
#pragma unroll
    for (int i = 0; i < 16; ++i) { st.o0[i] = 0.f; st.o1[i] = 0.f; }
#pragma unroll 1
    for (int j = 0; j < 4; ++j) {
        const int cnt = nmax - 64 * j + 1; const unsigned long long allow = cnt <= 0 ? 0ull : lowmask(cnt);
        tile_exact(st.o0, st.o1, m1, invl, CMP_KT(j), CMP_VT(j), qr, allow, impw, carry, j, lane, r, h);
    }
    __syncthreads();
#undef CMP_KT
#undef CMP_VT
    {
        unsigned long long wor = 0ull;
        const unsigned long long valid = lowmask(qb + 1);
        LAS const float* ib = (LAS const float*)(lds + IMP);
        unsigned key[8], T[8];
#pragma unroll
        for (int i = 0; i < 8; ++i) { const int q = wid * 8 + i;
            float v = ((ib[(0 * 64 + q) * IMPW + lane] + ib[(1 * 64 + q) * IMPW + lane]) + ib[(2 * 64 + q) * IMPW + lane]) + ib[(3 * 64 + q) * IMPW + lane];
            if (lane == 0 || lane == qb || lane == qb - 1) v = INFINITY;
            key[i] = (lane <= qb) ? __float_as_uint(fmaxf(v, 0.f)) : 0u; T[i] = 0u; }
#pragma unroll 1
        for (int bb = 30; bb >= 0; --bb) {
#pragma unroll
            for (int i = 0; i < 8; ++i) { const unsigned cand = T[i] | (1u << bb);
                const int c = __popcll(__ballot(key[i] >= cand) & valid); T[i] = (c >= 16) ? cand : T[i]; }
        }
#pragma unroll
        for (int i = 0; i < 8; ++i) { const int q = wid * 8 + i;
            const unsigned long long gt = __ballot(key[i] > T[i]) & valid, eq = __ballot(key[i] == T[i]) & valid;
            const int need = 16 - __popcll(gt);
            const bool pick = ((eq >> lane) & 1ull) && (__popcll(eq & lowmask(lane)) < need);
            const unsigned long long msk = gt | __ballot(pick);
            if (lane == 0) *(LAS unsigned long long*)(lds + SELM + q * 8) = msk;
            wor |= msk; }
        if (lane == 0) *(LAS unsigned long long*)(lds + WMASK + wid * 8) = wor;
    }
    __syncthreads();
    unsigned long long un = 0ull;
#pragma unroll
    for (int w = 0; w < 8; ++w) un |= *(LAS const unsigned long long*)(lds + WMASK + w * 8);
    { const unsigned ulo = __builtin_amdgcn_readfirstlane((unsigned)un), uhi = __builtin_amdgcn_readfirstlane((unsigned)(un >> 32)); un = ((unsigned long long)uhi << 32) | ulo; }
    ACCUM_OUT(gate[0], true);
    {
        LAS unsigned char* steps = lds + STEPS + wid * 128;
        const int nsel = __popcll(un), j0w = qb >= 8 ? qb - 8 : 0, nwin = qb - j0w + 1;
        const int NTs = nsel < 4 ? 4 : nsel, NTw = nwin < 4 ? 4 : nwin;
        if ((un >> lane) & 1ull) steps[__popcll(un & lowmask(lane))] = (unsigned char)lane;
        if (lane >= nsel && lane < NTs) steps[lane] = (unsigned char)0x7f;
        if (lane < NTw) steps[64 + lane] = (unsigned char)(lane < nwin ? (0x80 | (j0w + lane)) : 0x7f);
        const bf16_t* ksb = proj + (size_t)b * SEQ * PP + C_KS + hk * 64;
        char* shm = (char*)lds;
        f32x16 ob[2]; float lt;
        run_branch<8, true>(shm, qr, ksb, steps, NTs, qb, ob, lt, wid, lane);
        {
            int t2 = threadIdx.x; asm volatile("" : "+v"(t2));
            const int lane2 = t2 & 63, r2 = lane2 & 31, h2 = lane2 >> 5, wid2 = __builtin_amdgcn_readfirstlane(t2 >> 6), g2 = wid2 >> 1, tq2 = (wid2 & 1) * 32 + r2;
            LAS float* wsf2 = (LAS float*)(lds + WSF) + wid2 * 32; LAS float* osl2 = (LAS float*)(lds + IMP + wid2 * (32 * IMPW * 4)) + lane2;
            const float g1 = sigmoidf_(bf2f(proj[((size_t)b * SEQ + (size_t)qb * 64 + tq2) * PP + C_GBR + 1 * 16 + hk * 4 + g2]));
            if (h2 == 0) wsf2[r2] = g1 * __builtin_amdgcn_rcpf(fmaxf(lt, 1e-30f));
#pragma unroll
            for (int i = 0; i < 16; ++i) { const float sc = wsf2[crow(i, h2)]; osl2[(i * 2) * 64] += ob[0][i] * sc; osl2[(i * 2 + 1) * 64] += ob[1][i] * sc; }
        }
        {
            int t3 = threadIdx.x; asm volatile("" : "+v"(t3));
            run_branch<8, false>(shm, qr, ksb, steps + 64, NTw, qb, ob, lt, __builtin_amdgcn_readfirstlane(t3 >> 6), t3 & 63);
        }
        st.o0 = ob[0]; st.o1 = ob[1]; st.l = lt;
    }
    {
        int t2 = threadIdx.x; asm volatile("" : "+v"(t2));
        const int lane2 = t2 & 63, r2 = lane2 & 31, h2 = lane2 >> 5, wid2 = __builtin_amdgcn_readfirstlane(t2 >> 6), g2 = wid2 >> 1, tq2 = (wid2 & 1) * 32 + r2;
        LAS float* wsf2 = (LAS float*)(lds + WSF) + wid2 * 32; LAS float* osl2 = (LAS float*)(lds + IMP + wid2 * (32 * IMPW * 4)) + lane2;
        const float g3 = sigmoidf_(bf2f(proj[((size_t)b * SEQ + (size_t)qb * 64 + tq2) * PP + C_GBR + 2 * 16 + hk * 4 + g2]));
        if (h2 == 0) wsf2[r2] = g3 * __builtin_amdgcn_rcpf(fmaxf(st.l, 1e-30f));
        bf16_t* ob2 = proj + ((size_t)b * SEQ + (size_t)qb * 64 + (wid2 & 1) * 32) * PP + C_Q + (hk * 4 + g2) * 64;
        if (!skipw)
#pragma unroll
        for (int i = 0; i < 16; ++i) { const int q = crow(i, h2); const float sc = wsf2[q];
            const float f0 = osl2[(i * 2) * 64] + st.o0[i] * sc, f1 = osl2[(i * 2 + 1) * 64] + st.o1[i] * sc;
            ob2[(size_t)q * PP + r2] = (bf16_t)(pk2(f0, 0.f) & 0xffffu); ob2[(size_t)q * PP + 32 + r2] = (bf16_t)(pk2(f1, 0.f) & 0xffffu); }
    }
#undef LDK
#undef LDV
#undef STK
#undef STV
#undef KBUF
#undef VBUF
#undef ACCUM_OUT
}
}

__device__ __forceinline__ float wave_sum(float v) {
#pragma unroll
    for (int o = 1; o < 64; o <<= 1) v += __shfl_xor(v, o);
    return v;
}
__device__ __forceinline__ void transpose_item(const float* W, int K, int N, bf16_t* WT, int ldt, int k0, int n0, int drow0, const float* kscale, float cscale, LAS float* scr, int lane) {
#pragma unroll 8
    for (int i = 0; i < 32; ++i) { const int kk = 2 * i + (lane >> 5); const int n = n0 + (lane & 31);
        float v = (n < N) ? W[(size_t)(k0 + kk) * N + n] : 0.f;
        if (kscale) v *= kscale[k0 + kk];
        scr[kk * 33 + (lane & 31)] = v * cscale; }
    asm volatile("s_waitcnt lgkmcnt(0)" ::: "memory");
    const int c = lane & 7;
#pragma unroll
    for (int j = 0; j < 4; ++j) { const int n = (lane >> 3) + 8 * j; const LAS float* s = scr + (8 * c) * 33 + n;
        u32x4 o; o.x = pk2(s[0 * 33], s[1 * 33]); o.y = pk2(s[2 * 33], s[3 * 33]); o.z = pk2(s[4 * 33], s[5 * 33]); o.w = pk2(s[6 * 33], s[7 * 33]);
        *(u32x4*)(WT + (size_t)(drow0 + n) * ldt + k0 + 8 * c) = o; }
    asm volatile("s_waitcnt lgkmcnt(0)" ::: "memory");
}

#define XB_TMO      128
#define XB_XCNT(j)  (256  + 64 * (j))
#define XB_XSUB(j)  (1280 + 64 * (j))
#define XB_XGEN(j)  (2304 + 64 * (j))
#define XB_TOP      3328
#define XB_TOPGEN   3392
#define XCD_BAR_WORDS 3456
#define XB_SPIN_CAP (1u << 18)
__device__ __forceinline__ unsigned xb_ld(unsigned* p)              { return __hip_atomic_load(p, __ATOMIC_RELAXED, __HIP_MEMORY_SCOPE_AGENT); }
__device__ __forceinline__ unsigned xb_add(unsigned* p, unsigned v) { return __hip_atomic_fetch_add(p, v, __ATOMIC_RELAXED, __HIP_MEMORY_SCOPE_AGENT); }
__device__ __forceinline__ unsigned xb_xcc_id() { return (unsigned)__builtin_amdgcn_s_getreg((3 << 11) | 20) & 0xFu; }
#define XB_SPIN(cond, bar) do { unsigned _sp = 0; while (cond) { __builtin_amdgcn_s_sleep(1); \
    if ((++_sp & 255u) == 0u) { if (xb_ld(&(bar)[XB_TMO])) break; if (_sp > XB_SPIN_CAP) { atomicAdd(&(bar)[XB_TMO], 1u); break; } } } } while (0)
struct XcdBarrier { unsigned* bar; unsigned x; volatile LAS unsigned* st; };
__device__ __forceinline__ XcdBarrier xcd_barrier_post(unsigned* bar, volatile LAS unsigned* st) {
    XcdBarrier b; b.bar = bar; b.x = xb_xcc_id(); b.st = st;
    if (threadIdx.x == 0) (void)xb_add(&bar[XB_XCNT(b.x)], 1u);
    return b;
}
__device__ __forceinline__ void xcd_barrier_complete(unsigned* bar, unsigned x, unsigned& nloc, unsigned& nx) {
    const unsigned G = gridDim.x * gridDim.y * gridDim.z;
    unsigned sum, cnt, mine, sp = 0u;
    for (;;) {
        sum = 0u; cnt = 0u; mine = 0u;
#pragma unroll
        for (unsigned j = 0; j < 16; ++j) { const unsigned c = xb_ld(&bar[XB_XCNT(j)]); sum += c; cnt += (c > 0u) ? 1u : 0u; mine = (j == x) ? c : mine; }
        if (sum == G) break;
        __builtin_amdgcn_s_sleep(1);
        if ((++sp & 255u) == 0u) { if (xb_ld(&bar[XB_TMO])) break; if (sp > XB_SPIN_CAP) { atomicAdd(&bar[XB_TMO], 1u); break; } }
    }
    nloc = mine > 0u ? mine : 1u; nx = cnt > 0u ? cnt : 1u;
}
__device__ __forceinline__ void xcd_barrier(const XcdBarrier& b) {
    asm volatile("s_waitcnt vmcnt(0)" ::: "memory");
    __syncthreads();
    if (threadIdx.x == 0) {
        unsigned* bar = b.bar;
        __builtin_amdgcn_s_waitcnt(0);
        unsigned nloc = b.st[0], nx = b.st[1];
        if (nloc == 0u) { xcd_barrier_complete(bar, b.x, nloc, nx); b.st[0] = nloc; b.st[1] = nx; }
        const unsigned old = xb_add(&bar[XB_XSUB(b.x)], 1u);
        const unsigned gen = old / nloc;
        if (old + 1u == (gen + 1u) * nloc) {
            __builtin_amdgcn_fence(__ATOMIC_RELEASE, "agent");
            asm volatile("s_waitcnt vmcnt(0)" ::: "memory");
            const unsigned og = xb_add(&bar[XB_TOP], 1u);
            const unsigned tg = og / nx;
            if (og + 1u == (tg + 1u) * nx) xb_add(&bar[XB_TOPGEN], 1u);
            else XB_SPIN(xb_ld(&bar[XB_TOPGEN]) == tg, bar);
            __builtin_amdgcn_fence(__ATOMIC_ACQUIRE, "agent");
            xb_add(&bar[XB_XGEN(b.x)], 1u);
            asm volatile("s_waitcnt vmcnt(0)" ::: "memory");
        } else {
            XB_SPIN(xb_ld(&bar[XB_XGEN(b.x)]) == gen, bar);
            __builtin_amdgcn_fence(__ATOMIC_ACQUIRE, "agent");
            asm volatile("s_waitcnt vmcnt(0)" ::: "memory");
        }
    }
    __syncthreads();
}

struct Args {
    const float *x, *w_in, *conv_w, *w_conv_out, *pos_k, *w1_k, *w2_k, *pos_v, *w1_v, *w2_v, *w_attn_out, *w_o, *g_mix, *g_ffn, *w_gate, *w_up, *w_down, *g_final;
    float* out; unsigned char* ws; int probe; int pad;
};

__global__ void __launch_bounds__(512, 2) nsa_fwd(Args a) {
    extern __shared__ __attribute__((aligned(16))) unsigned char lds_raw[];
    LAS unsigned char* lds = (LAS unsigned char*)lds_raw;
    cg::grid_group grid = cg::this_grid();
    const int tid = threadIdx.x, lane = tid & 63, wave = __builtin_amdgcn_readfirstlane(tid >> 6);
    const int G = gridDim.x, bx = blockIdx.x;
    const int vcu = (G % 8 == 0) ? (bx % 8) * (G / 8) + bx / 8 : bx;
    unsigned char* ws = a.ws;
    volatile LAS unsigned* bst = (volatile LAS unsigned*)(lds + 143360);
    if (tid < 2) bst[tid] = 0u;
    __syncthreads();
    const XcdBarrier gbar = xcd_barrier_post((unsigned*)(ws + WS_BAR), bst);
#define SEAM() xcd_barrier(gbar)
    float* part1 = (float*)(ws + WS_PART1); float* part2 = (float*)(ws + WS_PART2); float* cbias = (float*)(ws + WS_BIAS);
    bf16_t* Win = (bf16_t*)(ws + WS_WIN); bf16_t* Wconv = (bf16_t*)(ws + WS_WCONV); bf16_t* Wattn = (bf16_t*)(ws + WS_WATTN); bf16_t* Wo = (bf16_t*)(ws + WS_WO);
    bf16_t* Wup = (bf16_t*)(ws + WS_WUP); bf16_t* Wdown = (bf16_t*)(ws + WS_WDOWN); bf16_t* W1 = (bf16_t*)(ws + WS_W1); bf16_t* W2 = (bf16_t*)(ws + WS_W2);
    bf16_t* hid = (bf16_t*)(ws + WS_HID); bf16_t* kcmp = (bf16_t*)(ws + WS_KCMP); bf16_t* proj = (bf16_t*)(ws + WS_PROJ);
    float* h1f = (float*)(ws + WS_H1F); bf16_t* h1b = (bf16_t*)(ws + WS_H1B); bf16_t* act = (bf16_t*)(ws + WS_ACT);
    bf16_t* nb = (bf16_t*)a.out; bf16_t* mix = (bf16_t*)a.out; bf16_t* bc = (bf16_t*)((unsigned char*)a.out + OUT_BC);

    {
        LAS float* scr = (LAS float*)(lds + wave * 16384);
        const int gw = vcu * 8 + wave, NGW = G * 8;
        constexpr int I_IN = 16 * 194, I_CONV = 8 * 32, I_ATT = 16 * 32, I_O = 16 * 32, I_G = 16 * 88, I_U = 16 * 88, I_D = 44 * 32, I_1 = 32 * 8, I_2 = 4 * 2;
        constexpr int NITEMS = I_IN + I_CONV + I_ATT + I_O + 2 * I_1 + 2 * I_2;
        for (int it = gw; it < NITEMS; it += NGW) {
            int q = it;
            if (q < I_IN) { const int kb = q / 194, nbk = q % 194, n0 = 32 * nbk; const float cs = (n0 >= C_Q && n0 < C_KC) ? QSCALE : 1.0f;
                transpose_item(a.w_in, 1024, INCOLS, Win, 1024, 64 * kb, n0, n0, a.g_mix, cs, scr, lane); continue; } q -= I_IN;
            if (q < I_CONV) { const int kb = q / 32, nbk = q % 32; transpose_item(a.w_conv_out, 512, 1024, Wconv, 512, 64 * kb, 32 * nbk, 32 * nbk, nullptr, 1.f, scr, lane); continue; } q -= I_CONV;
            if (q < I_ATT) { const int kb = q / 32, nbk = q % 32; transpose_item(a.w_attn_out, 1024, 1024, Wattn, 1024, 64 * kb, 32 * nbk, 32 * nbk, nullptr, 1.f, scr, lane); continue; } q -= I_ATT;
            if (q < I_O) { const int kb = q / 32, nbk = q % 32; transpose_item(a.w_o, 1024, 1024, Wo, 1024, 64 * kb, 32 * nbk, 32 * nbk, nullptr, 1.f, scr, lane); continue; } q -= I_O;
            if (q < I_1) { const int kb = q / 8, nbk = q % 8; transpose_item(a.w1_k, 2048, 256, W1, 2048, 64 * kb, 32 * nbk, 32 * nbk, nullptr, 1.f, scr, lane); continue; } q -= I_1;
            if (q < I_1) { const int kb = q / 8, nbk = q % 8; transpose_item(a.w1_v, 2048, 256, W1, 2048, 64 * kb, 32 * nbk, 256 + 32 * nbk, nullptr, 1.f, scr, lane); continue; } q -= I_1;
            if (q < I_2) { const int kb = q / 2, nbk = q % 2; transpose_item(a.w2_k, 256, 64, W2, 256, 64 * kb, 32 * nbk, 32 * nbk, nullptr, 1.f, scr, lane); continue; } q -= I_2;
            { const int kb = q / 2, nbk = q % 2; transpose_item(a.w2_v, 256, 64, W2, 256, 64 * kb, 32 * nbk, 256 + 32 * nbk, nullptr, 1.f, scr, lane); }
        }
        const int gt = vcu * 512 + tid, NGT = G * 512;
        for (int i = gt; i < 192 * 1024 / 8; i += NGT) *(u32x4*)(Win + (size_t)6208 * 1024 + (size_t)i * 8) = (u32x4){0u, 0u, 0u, 0u};
        for (int i = gt; i < 2 * 192 * 256 / 8; i += NGT) { const int half = i / (192 * 256 / 8), o = i % (192 * 256 / 8);
            *(u32x4*)(W2 + (size_t)(half * 256 + 64) * 256 + (size_t)o * 8) = (u32x4){0u, 0u, 0u, 0u}; }
        for (int m = gw; m < MTOK; m += NGW) {
            const f32x4* xr = (const f32x4*)(a.x + (size_t)m * DM) + lane; f32x4 v[4]; float s = 0.f;
#pragma unroll
            for (int j = 0; j < 4; ++j) { v[j] = xr[64 * j]; s += (v[j][0] * v[j][0] + v[j][1] * v[j][1]) + (v[j][2] * v[j][2] + v[j][3] * v[j][3]); }
            const float rstd = __builtin_amdgcn_rsqf(wave_sum(s) * (1.0f / DM) + EPS);
            u32x2* o8 = (u32x2*)(nb + (size_t)m * DM) + lane;
#pragma unroll
            for (int j = 0; j < 4; ++j) { u32x2 w; w.x = pk2(v[j][0] * rstd, v[j][1] * rstd); w.y = pk2(v[j][2] * rstd, v[j][3] * rstd); o8[64 * j] = w; }
        }
        if (bx < 2) {
            const float* pos = bx ? a.pos_v : a.pos_k; const float* w1 = bx ? a.w1_v : a.w1_k;
            const int j = tid & 255, part = tid >> 8; float s = 0.f;
            for (int k = part * 1024; k < part * 1024 + 1024; ++k) s += pos[k] * w1[(size_t)k * 256 + j];
            LAS float* red = (LAS float*)(lds + 8 * 16384);
            if (part == 1) red[j] = s;
            __syncthreads();
            if (part == 0) cbias[bx * 256 + j] = s + red[j];
        }
    }
    if (a.probe == 0x7fffffff) grid.sync();
    SEAM();
    {
        const int ncols1 = (G > 64) ? 6144 : PP;
        pg8::Gemm g{nb, Win, MTOK, ncols1, DM, DM, 128, 0}; pg8::StaticOrder S; S.init(MTOK, ncols1, G, bx);
        pg8::EpiProj E{proj, PP};
        pg8::gemm_phase(lds, g, S, E);
    }
    SEAM();
    {
        {
            pg8::Gemm g{proj + C_KC, W1, 4096, 512, 2048, 16 * PP, PP * 2, 1}; pg8::StaticOrder S; S.init(4096, 512, G, bx);
            pg8::EpiHid E{hid, cbias};
            pg8::gemm_phase(lds, g, S, E);
        }
        int wb = bx, wn = G; if (G > 64) { wb = bx - 32; wn = G - 32; }
        if (wb >= 0) {
            for (int it = wb * 512 + tid; it < MTOK * 64; it += wn * 512) {
                const int row = it >> 6, ch = (it & 63) * 8, t = row & (SEQ - 1);
                const bf16_t* pr = proj + (size_t)row * PP;
                float accv[8];
#pragma unroll
                for (int j = 0; j < 8; ++j) accv[j] = 0.f;
#pragma unroll
                for (int k = 0; k < 3; ++k) { const int dt = 2 - k;
                    if (t - dt >= 0) { const u32x4 cv = *(const u32x4*)(pr - (size_t)dt * PP + C_C + ch), hv = *(const u32x4*)(pr - (size_t)dt * PP + C_H + ch);
                        const f32x4 w0 = *(const f32x4*)(a.conv_w + k * 512 + ch), w1 = *(const f32x4*)(a.conv_w + k * 512 + ch + 4);
                        accv[0] += w0[0] * lo_bf(cv.x) * lo_bf(hv.x); accv[1] += w0[1] * hi_bf(cv.x) * hi_bf(hv.x); accv[2] += w0[2] * lo_bf(cv.y) * lo_bf(hv.y); accv[3] += w0[3] * hi_bf(cv.y) * hi_bf(hv.y);
                        accv[4] += w1[0] * lo_bf(cv.z) * lo_bf(hv.z); accv[5] += w1[1] * hi_bf(cv.z) * hi_bf(hv.z); accv[6] += w1[2] * lo_bf(cv.w) * lo_bf(hv.w); accv[7] += w1[3] * hi_bf(cv.w) * hi_bf(hv.w); } }
                const u32x4 bv = *(const u32x4*)(pr + C_B + ch);
                u32x4 o; o.x = pk2(accv[0] * lo_bf(bv.x), accv[1] * hi_bf(bv.x)); o.y = pk2(accv[2] * lo_bf(bv.y), accv[3] * hi_bf(bv.y));
                o.z = pk2(accv[4] * lo_bf(bv.z), accv[5] * hi_bf(bv.z)); o.w = pk2(accv[6] * lo_bf(bv.w), accv[7] * hi_bf(bv.w));
                *(u32x4*)(bc + (size_t)row * 512 + ch) = o;
            }
        }
        if (G > 64 && wb >= 0) {
            { pg8::Gemm g{nb, Win + (size_t)6144 * 1024, MTOK, 256, DM, DM, 128, 0}; pg8::StaticOrder S; S.init(MTOK, 256, wn, wb);
              pg8::EpiProj E{proj + 6144, PP}; pg8::gemm_phase(lds, g, S, E); }
            __syncthreads();
            LAS float* scr = (LAS float*)(lds + wave * 16384);
            constexpr int I_G = 16 * 88, I_U = 16 * 88, I_D = 44 * 32;
            for (int it = wb * 8 + wave; it < I_G + I_U + I_D; it += wn * 8) {
                int q = it;
                if (q < I_G) { const int kb = q / 88, nbk = q % 88, n0 = 32 * nbk; transpose_item(a.w_gate, 1024, DFF, Wup, 1024, 64 * kb, n0, (n0 / 128) * 256 + (n0 % 128), a.g_ffn, 1.f, scr, lane); continue; } q -= I_G;
                if (q < I_U) { const int kb = q / 88, nbk = q % 88, n0 = 32 * nbk; transpose_item(a.w_up, 1024, DFF, Wup, 1024, 64 * kb, n0, (n0 / 128) * 256 + 128 + (n0 % 128), a.g_ffn, 1.f, scr, lane); continue; } q -= I_U;
                { const int kb = q / 32, nbk = q % 32; transpose_item(a.w_down, DFF, 1024, Wdown, DFF, 64 * kb, 32 * nbk, 32 * nbk, nullptr, 1.f, scr, lane); }
            }
        }
    }
    {
        pg8::Gemm g{hid, W2, 4096, 512, 256, 256, 128, 2}; pg8::StaticOrder S; S.init(4096, 512, G, bx);
        pg8::EpiCmp E{kcmp};
        pg8::gemm_phase(lds, g, S, E);
    }
    SEAM();
    {
        for (int v = vcu; v < 256; v += G) {
            const int bh = v >> 4, s = v & 15;
#pragma unroll 1
            for (int i = 0; i < 4; ++i) { const int qb = (i == 0) ? 63 - s : (i == 1) ? 32 + s : (i == 2) ? 31 - s : s;
#if defined(PROBE_ATT2) || defined(PROBE_NOLD)
                att::attn_unit(lds, proj, kcmp, kcmp + 4096 * 64, bh, qb, a.probe);
#endif
                att::attn_unit(lds, proj, kcmp, kcmp + 4096 * 64, bh, qb, 0);
            }
        }
    }
    SEAM();
    {
        { pg8::Gemm g{bc, Wconv, MTOK, DM, 512, 512, 128, 0}; pg8::StaticOrder S; S.init(MTOK, DM, G, bx);
          pg8::EpiMix<0> E{mix, proj, C_GCONV}; pg8::gemm_phase(lds, g, S, E); }
        { pg8::Gemm g{proj + C_Q, Wattn, MTOK, DM, DM, PP, 128, 0}; pg8::StaticOrder S; S.init(MTOK, DM, G, bx);
          pg8::EpiMix<1> E{mix, proj, C_GATTN}; pg8::gemm_phase(lds, g, S, E); }
    }
    SEAM();
    {
        pg8::Gemm g{mix, Wo, MTOK, DM, DM, DM, 128, 0}; pg8::StaticOrder S; S.init(MTOK, DM, G, bx);
        pg8::EpiRes<1> E{a.x, h1f, h1b, part1}; pg8::gemm_phase(lds, g, S, E);
    }
    SEAM();
    {
        pg8::Gemm g{h1b, Wup, MTOK, 2 * DFF, DM, DM, 128, 0}; pg8::StaticOrder S; S.init(MTOK, 2 * DFF, G, bx);
        pg8::EpiUp E{act, part1}; pg8::gemm_phase(lds, g, S, E);
    }
    SEAM();
    if (G == 256) {
        pg8::Gemm g{act, Wdown, MTOK, DM, DFF, DFF, 128, 0}; pg8::StaticOrder S; S.init(MTOK, DM, G, bx);
        pg8::EpiFinal E{h1f, a.out, a.g_final, (unsigned*)part2, (unsigned*)(ws + WS_BAR) + 4096, (unsigned*)(ws + WS_BAR) + XB_TMO};
        pg8::gemm_phase(lds, g, S, E);
        return;
    }
    {
        pg8::Gemm g{act, Wdown, MTOK, DM, DFF, DFF, 128, 0}; pg8::StaticOrder S; S.init(MTOK, DM, G, bx);
        pg8::EpiRes<0> E{h1f, a.out, nullptr, part2}; pg8::gemm_phase(lds, g, S, E);
    }
    SEAM();
    {
        for (int it = bx * 512 + tid; it < MTOK * 256; it += G * 512) {
            const int row = it >> 8, c4 = (it & 255) * 4;
            const f32x4* pp = (const f32x4*)(part2 + (size_t)row * 16); float ss = 0.f;
#pragma unroll
            for (int j = 0; j < 4; ++j) { const f32x4 p = pp[j]; ss += (p[0] + p[1]) + (p[2] + p[3]); }
            const float r = __builtin_amdgcn_rsqf(ss * (1.0f / DM) + EPS);
            f32x4 v = *(f32x4*)(a.out + (size_t)row * DM + c4); const f32x4 gf = *(const f32x4*)(a.g_final + c4);
            v = v * r * gf; *(f32x4*)(a.out + (size_t)row * DM + c4) = v;
        }
    }
}

extern "C" void kernel_launch(void* const* d_in, const int* in_sizes, int n_in, void* d_out, int out_size, void* d_ws, size_t ws_size, hipStream_t stream) {
    static int grid = 0;
    if (grid == 0) {
        if (n_in != 18 || out_size != MTOK * DM || ws_size < WS_NEED) { fprintf(stderr, "kernel_launch: unexpected shapes (n_in %d out %d ws %zu)\n", n_in, out_size, ws_size); grid = -1; return; }
        int dev = 0, cus = 0, per_cu = 0;
        (void)hipGetDevice(&dev);
        (void)hipDeviceGetAttribute(&cus, hipDeviceAttributeMultiprocessorCount, dev);
        (void)hipFuncSetAttribute((const void*)nsa_fwd, hipFuncAttributeMaxDynamicSharedMemorySize, LDS_BYTES);
        (void)hipOccupancyMaxActiveBlocksPerMultiprocessor(&per_cu, (const void*)nsa_fwd, 512, LDS_BYTES);
        if (per_cu < 1) { fprintf(stderr, "kernel_launch: occupancy query says %d blocks/CU\n", per_cu); grid = -1; return; }
        grid = cus;
    }
    if (grid < 0) return;
    (void)hipMemsetAsync((unsigned char*)d_ws + WS_BAR, 0, 32768, stream);
    Args a{};
    a.x = (const float*)d_in[0]; a.w_in = (const float*)d_in[1]; a.conv_w = (const float*)d_in[2]; a.w_conv_out = (const float*)d_in[3];
    a.pos_k = (const float*)d_in[4]; a.w1_k = (const float*)d_in[5]; a.w2_k = (const float*)d_in[6];
    a.pos_v = (const float*)d_in[7]; a.w1_v = (const float*)d_in[8]; a.w2_v = (const float*)d_in[9];
    a.w_attn_out = (const float*)d_in[10]; a.w_o = (const float*)d_in[11]; a.g_mix = (const float*)d_in[12]; a.g_ffn = (const float*)d_in[13];
    a.w_gate = (const float*)d_in[14]; a.w_up = (const float*)d_in[15]; a.w_down = (const float*)d_in[16]; a.g_final = (const float*)d_in[17];
    a.out = (float*)d_out; a.ws = (unsigned char*)d_ws; a.probe = 1; a.pad = 0;
    void* args[] = {&a};
    hipError_t e = hipLaunchCooperativeKernel((void*)nsa_fwd, dim3(grid), dim3(512), args, LDS_BYTES, stream);
    if (e != hipSuccess) fprintf(stderr, "kernel_launch: cooperative launch failed: %s (grid %d)\n", hipGetErrorString(e), grid);
}
```

```cpp
#include <hip/hip_runtime.h>
#include <hip/hip_cooperative_groups.h>
#include <cstdio>
#include <cstdint>
namespace cg = cooperative_groups;

#define LAS __attribute__((address_space(3)))
typedef unsigned short bf16_t;
typedef short bf16x8 __attribute__((ext_vector_type(8)));
typedef short s16x4 __attribute__((ext_vector_type(4)));
typedef float f32x4 __attribute__((ext_vector_type(4)));
typedef float f32x16 __attribute__((ext_vector_type(16)));
typedef unsigned u32x4 __attribute__((ext_vector_type(4)));
typedef unsigned u32x2 __attribute__((ext_vector_type(2)));
typedef float f32x2_t __attribute__((ext_vector_type(2)));
typedef __bf16 bf16x2_t __attribute__((ext_vector_type(2)));

constexpr int MTOK = 16384, DM = 1024, SEQ = 4096, NB = 4;
constexpr int PP = 6400;
constexpr int INCOLS = 6192;
constexpr int C_B = 0, C_C = 512, C_H = 1024, C_Q = 1536, C_KC = 2560, C_VC = 2816, C_KS = 3072, C_VS = 3328, C_KW = 3584, C_VW = 3840,
              C_GBR = 4096, C_GCONV = 4144, C_GATTN = 5168;
constexpr int DFF = 2816;
constexpr float EPS = 1e-6f;
constexpr float LOG2E = 1.4426950408889634f;
constexpr float QSCALE = 0.125f * LOG2E;

constexpr size_t MiB = 1u << 20;
constexpr size_t WS_PART1 = 0;
constexpr size_t WS_PART2 = 1 * MiB;
constexpr size_t WS_BIAS = 2 * MiB;
constexpr size_t WS_BAR = 2 * MiB + 65536;
constexpr size_t WS_WIN = 3 * MiB;
constexpr size_t WS_WCONV = 16 * MiB;
constexpr size_t WS_WATTN = 17 * MiB;
constexpr size_t WS_WO = 19 * MiB;
constexpr size_t WS_WUP = 21 * MiB;
constexpr size_t WS_WDOWN = 32 * MiB;
constexpr size_t WS_W1 = 38 * MiB;
constexpr size_t WS_W2 = 40 * MiB;
constexpr size_t WS_HID = 41 * MiB;
constexpr size_t WS_KCMP = 45 * MiB;
constexpr size_t WS_PROJ = 46 * MiB;
constexpr size_t WS_H1F = 46 * MiB;
constexpr size_t WS_H1B = 110 * MiB;
constexpr size_t WS_ACT = 142 * MiB;
constexpr size_t WS_NEED = 246 * MiB;
constexpr size_t OUT_BC = 32 * MiB;

constexpr int LDS_BYTES = 147456;

__device__ __forceinline__ float bf2f(unsigned short v) { return __uint_as_float(((unsigned)v) << 16); }
__device__ __forceinline__ unsigned pk2(float lo, float hi) { f32x2_t v = {lo, hi}; bf16x2_t b = __builtin_convertvector(v, bf16x2_t); return __builtin_bit_cast(unsigned, b); }
__device__ __forceinline__ float ex2(float x) { return __builtin_amdgcn_exp2f(x); }
__device__ __forceinline__ float sigmoidf_(float x) { return __builtin_amdgcn_rcpf(1.0f + ex2(-x * LOG2E)); }
__device__ __forceinline__ float lo_bf(unsigned w) { return __uint_as_float(w << 16); }
__device__ __forceinline__ float hi_bf(unsigned w) { return __uint_as_float(w & 0xffff0000u); }

namespace pg8 {
constexpr int BM = 256, BK = 64, HALF = 128, HTB = HALF * BK * 2, STAGE_BYTES = 8 * HTB, NXCD = 8, WGM = 8;
__host__ __device__ __forceinline__ int lds_byte(int r, int c) { const int st = (r >> 4) * 2 + (c >> 5), rr = r & 15, cc = c & 31, ob = rr * 64 + cc * 2; return st * 1024 + (ob ^ (((ob >> 9) & 1) << 5)); }
__host__ __device__ __forceinline__ void stage_rc(int b, int& R, int& C) { const int st = b / 1024, sb = b % 1024, swz = sb ^ (((sb >> 9) & 1) << 5); R = (st >> 1) * 16 + swz / 64; C = (st & 1) * 32 + (swz % 64) / 2; }
__host__ __device__ __forceinline__ int perm32(int rho) { const int n = rho >> 4, i = rho & 15; return 8 * (i >> 2) + 4 * n + (i & 3); }

struct Unit { int pm, pn; };
struct Gemm { const bf16_t* A; const bf16_t* Bt; int M, N, K; int lda; int a_kstep; int amode; };

struct StaticOrder {
    int nM, nN, nwg, G, c;
    __host__ __device__ void init(int M, int N, int G_, int c_) { nM = M / BM; nN = N / BM; nwg = nM * nN; G = G_; c = c_; }
    __host__ __device__ bool next(int i, Unit& u) const {
        const long L = (long)i * G + c; if (L >= nwg) return false;
        int wgid = (int)L; { const int q = nwg / NXCD, r = nwg % NXCD, xcd = wgid % NXCD, off = wgid / NXCD; wgid = (xcd < r ? xcd * (q + 1) : r * (q + 1) + (xcd - r) * q) + off; }
        const int nig = WGM * nN, gid = wgid / nig, fm = gid * WGM, gsz = (nM - fm) < WGM ? (nM - fm) : WGM;
        u.pm = fm + ((wgid % nig) % gsz); u.pn = (wgid % nig) / gsz; return true;
    }
};

__device__ __forceinline__ const char* a_tile(const Gemm& g, const Unit& u) {
    if (g.amode == 1) return (const char*)g.A + ((size_t)(u.pm >> 2) * SEQ * PP + (size_t)u.pn * 256 + (size_t)(u.pm & 3) * 64) * 2;
    if (g.amode == 2) return (const char*)g.A + ((size_t)u.pn * 4096 * 256 + (size_t)u.pm * 256 * 256) * 2;
    return (const char*)g.A + (size_t)u.pm * 256 * (size_t)g.lda * 2;
}

template <class T, class = void> struct is_fused { static constexpr bool value = false; };
template <class T> struct is_fused<T, decltype((void)T::FUSED)> { static constexpr bool value = true; };
template <class Epi>
__device__ __forceinline__ void gemm_phase(LAS unsigned char* lds, const Gemm g, const StaticOrder& S, const Epi& E) {
#ifdef NO_GEMM
    return;
#endif
    int tid_ = threadIdx.x; asm volatile("" : "+v"(tid_));
    const int tid = tid_, wid = __builtin_amdgcn_readfirstlane(tid >> 6), lane = tid & 63, wr = wid >> 2, wc = wid & 3, fr = lane & 15, fq = lane >> 4;
    const int K = g.K, nt = K / BK;
    unsigned voffA[2], voffB[2];
#pragma unroll
    for (int i = 0; i < 2; ++i) { int R, C; stage_rc(tid * 16 + i * 8192, R, C); const int Rb = (R & ~31) + perm32(R & 31);
        voffA[i] = (unsigned)(R * g.lda + C) * 2u; voffB[i] = (unsigned)(Rb * K + C) * 2u; }
    const size_t kstepA = (size_t)g.a_kstep, kstepB = (size_t)(BK * 2);
    const size_t hstepA = (size_t)HALF * g.lda * 2, hstepB = (size_t)HALF * K * 2;
    const size_t tstepB = 2 * hstepB;
    const unsigned ldsw = (unsigned)wid * 1024u;
    const int aoff = lds_byte(wr * 64 + fr, fq * 8), boff = lds_byte(wc * 32 + fr, fq * 8);
#define PG8_SA(b, h) (((b) * 2 + (h)) * HTB)
#define PG8_SB(b, h) ((4 + (b) * 2 + (h)) * HTB)
#define PG8_STAGE(bufoff, gbase, voff) do { _Pragma("unroll") for (int _i = 0; _i < 2; ++_i) \
        __builtin_amdgcn_global_load_lds((const unsigned*)((const char*)(gbase) + (voff)[_i]), (LAS unsigned*)(lds + (bufoff) + ldsw + _i * 8192), 16, 0, 0); } while (0)
#define PG8_LDA(dst, b, h) do { _Pragma("unroll") for (int m = 0; m < 4; ++m) _Pragma("unroll") for (int k = 0; k < 2; ++k) dst[m][k] = *(const LAS bf16x8*)(lds + PG8_SA(b, h) + aoff + m * 2048 + k * 1024); } while (0)
#define PG8_LDB(dst, b, h) do { _Pragma("unroll") for (int n = 0; n < 2; ++n) _Pragma("unroll") for (int k = 0; k < 2; ++k) dst[n][k] = *(const LAS bf16x8*)(lds + PG8_SB(b, h) + boff + n * 2048 + k * 1024); } while (0)
#define PG8_MMA(ai, bj, At, Bt) do { __builtin_amdgcn_s_setprio(1); _Pragma("unroll") for (int m = 0; m < 4; ++m) _Pragma("unroll") for (int n = 0; n < 2; ++n) _Pragma("unroll") for (int k = 0; k < 2; ++k) \
        acc[ai][bj][m][n] = __builtin_amdgcn_mfma_f32_16x16x32_bf16(Bt[n][k], At[m][k], acc[ai][bj][m][n], 0, 0, 0); __builtin_amdgcn_s_setprio(0); } while (0)
#define PG8_WAIT_V(n) asm volatile("s_waitcnt vmcnt(" #n ")" ::: "memory")
#define PG8_WAIT_L(n) asm volatile("s_waitcnt lgkmcnt(" #n ")" ::: "memory")
#define PG8_BAR __builtin_amdgcn_s_barrier()
#define PG8_SCHED __builtin_amdgcn_sched_barrier(0)
    Unit cur, nxt; int ui = 0;
    if (!S.next(0, cur)) return;
    f32x4 acc[2][2][4][2];
#pragma unroll
    for (int a = 0; a < 2; ++a)
#pragma unroll
        for (int b = 0; b < 2; ++b)
#pragma unroll
            for (int m = 0; m < 4; ++m)
#pragma unroll
                for (int n = 0; n < 2; ++n) acc[a][b][m][n] = (f32x4){0.f, 0.f, 0.f, 0.f};
    bf16x8 At[4][2], B0[2][2], B1[2][2];
    const char* cA = a_tile(g, cur); const char* cB = (const char*)g.Bt + (size_t)cur.pn * tstepB;
    PG8_STAGE(PG8_SB(0, 0), cB, voffB); PG8_STAGE(PG8_SB(0, 1), cB + hstepB, voffB); PG8_STAGE(PG8_SA(0, 0), cA, voffA); PG8_STAGE(PG8_SA(0, 1), cA + hstepA, voffA);
    if (wr == 1) PG8_BAR;
    PG8_WAIT_V(2); PG8_BAR;
    PG8_STAGE(PG8_SB(1, 0), cB + kstepB, voffB); PG8_STAGE(PG8_SA(1, 0), cA + kstepA, voffA); PG8_STAGE(PG8_SB(1, 1), cB + hstepB + kstepB, voffB);
    PG8_WAIT_V(6); PG8_BAR;
    for (;;) {
        const bool has_next = S.next(ui + 1, nxt);
        const char* nA = has_next ? a_tile(g, nxt) : cA; const char* nB = has_next ? (const char*)g.Bt + (size_t)nxt.pn * tstepB : cB;
        for (int t = 0; t < nt; t += 2) {
            const bool last = (t == nt - 2);
            const char* a1 = cA + (size_t)(t + 1) * kstepA;
            const char* a2 = last ? nA : cA + (size_t)(t + 2) * kstepA; const char* b2 = last ? nB : cB + (size_t)(t + 2) * kstepB;
            const char* a3 = a2 + kstepA; const char* b3 = b2 + kstepB;
            PG8_LDB(B0, 0, 0); PG8_LDB(B1, 0, 1); PG8_SCHED; PG8_LDA(At, 0, 0); PG8_STAGE(PG8_SA(1, 1), a1 + hstepA, voffA);
            PG8_WAIT_V(8); PG8_WAIT_L(0); PG8_BAR; PG8_MMA(0, 0, At, B0); PG8_MMA(0, 1, At, B1); PG8_BAR; PG8_SCHED;
            PG8_LDA(At, 0, 1); PG8_STAGE(PG8_SB(0, 0), b2, voffB); PG8_STAGE(PG8_SB(0, 1), b2 + hstepB, voffB); PG8_STAGE(PG8_SA(0, 0), a2, voffA);
            PG8_WAIT_V(8); PG8_WAIT_L(0); PG8_BAR; PG8_MMA(1, 0, At, B0); PG8_MMA(1, 1, At, B1); PG8_BAR; PG8_SCHED;
            PG8_LDB(B0, 1, 0); PG8_LDB(B1, 1, 1); PG8_SCHED; PG8_LDA(At, 1, 0); PG8_STAGE(PG8_SA(0, 1), a2 + hstepA, voffA);
            PG8_WAIT_V(8); PG8_WAIT_L(0); PG8_BAR; PG8_MMA(0, 0, At, B0); PG8_MMA(0, 1, At, B1); PG8_BAR; PG8_SCHED;
            PG8_LDA(At, 1, 1); PG8_STAGE(PG8_SB(1, 0), b3, voffB); PG8_STAGE(PG8_SB(1, 1), b3 + hstepB, voffB); PG8_STAGE(PG8_SA(1, 0), a3, voffA);
            PG8_WAIT_V(8); PG8_WAIT_L(0); PG8_BAR; PG8_MMA(1, 0, At, B0); PG8_MMA(1, 1, At, B1); PG8_BAR; PG8_SCHED;
        }
        if (wr == 0) PG8_BAR;
        if constexpr (!is_fused<Epi>::value) E(acc, cur, wr, wc, fr, fq);
        if (!has_next) break;
#pragma unroll
        for (int a = 0; a < 2; ++a)
#pragma unroll
            for (int b = 0; b < 2; ++b)
#pragma unroll
                for (int m = 0; m < 4; ++m)
#pragma unroll
                    for (int n = 0; n < 2; ++n) acc[a][b][m][n] = (f32x4){0.f, 0.f, 0.f, 0.f};
        cur = nxt; cA = nA; cB = nB; ++ui;
        if (wr == 1) PG8_BAR;
    }
    PG8_WAIT_V(0);
    PG8_BAR;
    if constexpr (is_fused<Epi>::value) E.fused(acc, cur, wr, wc, fr, fq, lds, wid, lane);
#undef PG8_SA
#undef PG8_SB
#undef PG8_STAGE
#undef PG8_LDA
#undef PG8_LDB
#undef PG8_MMA
#undef PG8_WAIT_V
#undef PG8_WAIT_L
#undef PG8_BAR
#undef PG8_SCHED
}

typedef f32x4 Acc[2][2][4][2];
#define EPI_LOOP_BEGIN \
    _Pragma("unroll") for (int ai = 0; ai < 2; ++ai) _Pragma("unroll") for (int m = 0; m < 4; ++m) { const int row = u.pm * BM + wr * 64 + fr + ai * HALF + m * 16; \
    _Pragma("unroll") for (int bj = 0; bj < 2; ++bj) { const f32x4 v0 = acc[ai][bj][m][0], v1 = acc[ai][bj][m][1]; const int col = u.pn * BM + bj * HALF + wc * 32 + 8 * fq;
#define EPI_LOOP_END } }
__device__ __forceinline__ u32x4 pack8(const f32x4 a, const f32x4 b) { u32x4 w; w.x = pk2(a[0], a[1]); w.y = pk2(a[2], a[3]); w.z = pk2(b[0], b[1]); w.w = pk2(b[2], b[3]); return w; }

struct EpiProj { bf16_t* O; int ldc;
    __device__ __forceinline__ void operator()(const Acc& acc, const Unit& u, int wr, int wc, int fr, int fq) const {
        EPI_LOOP_BEGIN
            *(u32x4*)(O + (size_t)row * ldc + col) = pack8(v0, v1);
        EPI_LOOP_END
    } };
__device__ __forceinline__ float gelu_tanh(float x) {
    const float z = x * (1.0f + 0.044715f * x * x) * (2.0f * 0.7978845608028654f * LOG2E);
    return x * __builtin_amdgcn_rcpf(1.0f + ex2(-z));
}
struct EpiHid { bf16_t* O; const float* bias;
    __device__ __forceinline__ void operator()(const Acc& acc, const Unit& u, int wr, int wc, int fr, int fq) const {
        EPI_LOOP_BEGIN
            const int c = col - u.pn * BM; const float* bp = bias + u.pn * 256 + c;
            const f32x4 b0 = *(const f32x4*)bp, b1 = *(const f32x4*)(bp + 4);
            f32x4 a = v0 + b0, b = v1 + b1;
#pragma unroll
            for (int j = 0; j < 4; ++j) { a[j] = gelu_tanh(a[j]); b[j] = gelu_tanh(b[j]); }
            *(u32x4*)(O + (size_t)u.pn * 4096 * 256 + (size_t)row * 256 + c) = pack8(a, b);
        EPI_LOOP_END
    } };
struct EpiCmp { bf16_t* O;
    __device__ __forceinline__ void operator()(const Acc& acc, const Unit& u, int wr, int wc, int fr, int fq) const {
        EPI_LOOP_BEGIN
            const int c = col - u.pn * BM;
            if (c < 64) { u32x4 w = pack8(v0, v1); if ((row & 255) == 255) w = (u32x4){0u, 0u, 0u, 0u};
                *(u32x4*)(O + (size_t)u.pn * 4096 * 64 + (size_t)row * 64 + c) = w; }
        EPI_LOOP_END
    } };
template <int ADD> struct EpiMix { bf16_t* mix; const bf16_t* proj; int gcol;
    __device__ __forceinline__ void operator()(const Acc& acc, const Unit& u, int wr, int wc, int fr, int fq) const {
        EPI_LOOP_BEGIN
            const u32x4 gv = *(const u32x4*)(proj + (size_t)row * PP + gcol + col);
            f32x4 a, b;
            a[0] = sigmoidf_(lo_bf(gv.x)) * v0[0]; a[1] = sigmoidf_(hi_bf(gv.x)) * v0[1]; a[2] = sigmoidf_(lo_bf(gv.y)) * v0[2]; a[3] = sigmoidf_(hi_bf(gv.y)) * v0[3];
            b[0] = sigmoidf_(lo_bf(gv.z)) * v1[0]; b[1] = sigmoidf_(hi_bf(gv.z)) * v1[1]; b[2] = sigmoidf_(lo_bf(gv.w)) * v1[2]; b[3] = sigmoidf_(hi_bf(gv.w)) * v1[3];
            bf16_t* mp = mix + (size_t)row * DM + col;
            if (ADD) { const u32x4 pv = *(const u32x4*)mp;
                a[0] += lo_bf(pv.x); a[1] += hi_bf(pv.x); a[2] += lo_bf(pv.y); a[3] += hi_bf(pv.y); b[0] += lo_bf(pv.z); b[1] += hi_bf(pv.z); b[2] += lo_bf(pv.w); b[3] += hi_bf(pv.w); }
            *(u32x4*)mp = pack8(a, b);
        EPI_LOOP_END
    } };
template <int WB> struct EpiRes { const float* base; float* hf; bf16_t* hb; float* part;
    __device__ __forceinline__ void operator()(const Acc& acc, const Unit& u, int wr, int wc, int fr, int fq) const {
#pragma unroll
        for (int ai = 0; ai < 2; ++ai)
#pragma unroll
            for (int m = 0; m < 4; ++m) { const int row = u.pm * BM + wr * 64 + fr + ai * HALF + m * 16; float ss = 0.f;
#pragma unroll
                for (int bj = 0; bj < 2; ++bj) { const int col = u.pn * BM + bj * HALF + wc * 32 + 8 * fq; const size_t off = (size_t)row * DM + col;
                    const f32x4 x0 = *(const f32x4*)(base + off), x1 = *(const f32x4*)(base + off + 4);
                    const f32x4 a = x0 + acc[ai][bj][m][0], b = x1 + acc[ai][bj][m][1];
                    *(f32x4*)(hf + off) = a; *(f32x4*)(hf + off + 4) = b;
                    if (WB) *(u32x4*)(hb + off) = pack8(a, b);
                    ss += (a[0] * a[0] + a[1] * a[1]) + (a[2] * a[2] + a[3] * a[3]) + (b[0] * b[0] + b[1] * b[1]) + (b[2] * b[2] + b[3] * b[3]); }
                ss += __shfl_xor(ss, 16); ss += __shfl_xor(ss, 32);
                if (fq == 0) part[(size_t)row * 16 + u.pn * 4 + wc] = ss; }
    } };
struct EpiUp { bf16_t* act; const float* part;
    __device__ __forceinline__ void operator()(const Acc& acc, const Unit& u, int wr, int wc, int fr, int fq) const {
#pragma unroll
        for (int ai = 0; ai < 2; ++ai)
#pragma unroll
            for (int m = 0; m < 4; ++m) { const int row = u.pm * BM + wr * 64 + fr + ai * HALF + m * 16;
                const f32x4 pp = *(const f32x4*)(part + (size_t)row * 16 + 4 * fq); float ss = (pp[0] + pp[1]) + (pp[2] + pp[3]);
                ss += __shfl_xor(ss, 16); ss += __shfl_xor(ss, 32);
                const float r = __builtin_amdgcn_rsqf(ss * (1.0f / DM) + EPS);
                f32x4 a, b;
#pragma unroll
                for (int j = 0; j < 4; ++j) { const float g0 = acc[ai][0][m][0][j] * r, u0 = acc[ai][1][m][0][j] * r, g1 = acc[ai][0][m][1][j] * r, u1 = acc[ai][1][m][1][j] * r;
                    a[j] = g0 * sigmoidf_(g0) * u0; b[j] = g1 * sigmoidf_(g1) * u1; }
                *(u32x4*)(act + (size_t)row * DFF + u.pn * 128 + wc * 32 + 8 * fq) = pack8(a, b); }
    } };
struct EpiFinal { static constexpr bool FUSED = true;
    const float* base; float* out; const float* gfin; unsigned* xbuf; unsigned* cnt; unsigned* tmo;
    __device__ __forceinline__ void operator()(const Acc&, const Unit&, int, int, int, int) const {}
    __device__ __forceinline__ void fused(f32x4 (&acc)[2][2][4][2], const Unit& u, int wr, int wc, int fr, int fq, LAS unsigned char* lds, int wid, int lane) const {
        LAS float* P = (LAS float*)lds;
        LAS float* S = (LAS float*)(lds + 8192);
        LAS unsigned* flag = (LAS unsigned*)(lds + 8192 + 2048);
#pragma unroll
        for (int ai = 0; ai < 2; ++ai)
#pragma unroll
            for (int m = 0; m < 4; ++m) { const int rl = ai * HALF + wr * 64 + m * 16 + fr; const int row = u.pm * BM + rl; float ss = 0.f;
#pragma unroll
                for (int bj = 0; bj < 2; ++bj) { const int col = u.pn * BM + bj * HALF + wc * 32 + 8 * fq; const size_t off = (size_t)row * DM + col;
                    const f32x4 x0 = *(const f32x4*)(base + off), x1 = *(const f32x4*)(base + off + 4);
                    const f32x4 a = x0 + acc[ai][bj][m][0], b = x1 + acc[ai][bj][m][1]; acc[ai][bj][m][0] = a; acc[ai][bj][m][1] = b;
                    ss += (a[0] * a[0] + a[1] * a[1]) + (a[2] * a[2] + a[3] * a[3]) + (b[0] * b[0] + b[1] * b[1]) + (b[2] * b[2] + b[3] * b[3]); }
                ss += __shfl_xor(ss, 16); ss += __shfl_xor(ss, 32);
                if (fq == 0) P[rl * 4 + wc] = ss; }
        asm volatile("s_waitcnt lgkmcnt(0)" ::: "memory"); __builtin_amdgcn_s_barrier(); asm volatile("" ::: "memory");
        const int rl = wid * 32 + (lane & 31);
        if (lane < 32) { const float tot = (P[rl * 4 + 0] + P[rl * 4 + 1]) + (P[rl * 4 + 2] + P[rl * 4 + 3]);
            __hip_atomic_store(xbuf + ((size_t)(u.pm * BM + rl) * 4 + u.pn), __float_as_uint(tot), __ATOMIC_RELAXED, __HIP_MEMORY_SCOPE_AGENT); }
        asm volatile("s_waitcnt vmcnt(0)" ::: "memory");
        if (lane == 0) __hip_atomic_fetch_add(cnt + 64 * u.pm, 1u, __ATOMIC_RELAXED, __HIP_MEMORY_SCOPE_AGENT);
        if (wid == 0) {
            unsigned sp = 0u;
            for (;;) {
                if ((unsigned)__builtin_amdgcn_readfirstlane(__hip_atomic_load(cnt + 64 * u.pm, __ATOMIC_RELAXED, __HIP_MEMORY_SCOPE_AGENT)) >= 32u) break;
                __builtin_amdgcn_s_sleep(2);
                if (++sp > (1u << 20)) { if (lane == 0) __hip_atomic_store(tmo, 1u, __ATOMIC_RELAXED, __HIP_MEMORY_SCOPE_AGENT); break; }
            }
            __builtin_amdgcn_fence(__ATOMIC_ACQUIRE, "agent");
            if (lane == 0) flag[0] = 1u;
        }
        asm volatile("s_waitcnt vmcnt(0) lgkmcnt(0)" ::: "memory"); __builtin_amdgcn_s_barrier(); asm volatile("" ::: "memory");
        if (lane < 32) { const unsigned* sl = xbuf + (size_t)(u.pm * BM + rl) * 4; float tot = 0.f;
#pragma unroll
            for (int t = 0; t < 4; ++t) tot += __uint_as_float(__hip_atomic_load(sl + t, __ATOMIC_RELAXED, __HIP_MEMORY_SCOPE_AGENT));
            S[rl] = __builtin_amdgcn_rsqf(tot * (1.0f / DM) + EPS); }
        asm volatile("s_waitcnt lgkmcnt(0)" ::: "memory"); __builtin_amdgcn_s_barrier(); asm volatile("" ::: "memory");
#pragma unroll
        for (int bj = 0; bj < 2; ++bj) { const int col = u.pn * BM + bj * HALF + wc * 32 + 8 * fq;
            const f32x4 g0 = *(const f32x4*)(gfin + col), g1 = *(const f32x4*)(gfin + col + 4);
#pragma unroll
            for (int ai = 0; ai < 2; ++ai)
#pragma unroll
                for (int m = 0; m < 4; ++m) { const int rl2 = ai * HALF + wr * 64 + m * 16 + fr; const float rs = S[rl2]; const size_t off = (size_t)(u.pm * BM + rl2) * DM + col;
                    *(f32x4*)(out + off) = acc[ai][bj][m][0] * rs * g0; *(f32x4*)(out + off + 4) = acc[ai][bj][m][1] * rs * g1; } }
    } };
}

namespace att {
constexpr int KB0 = 0, VB0 = 24576, IMP = 49152, IMPW = 65, SELM = IMP + 4 * 64 * IMPW * 4, WMASK = SELM + 512, WSF = WMASK + 64, STEPS = WSF + 8 * 32 * 4, CMPX = STEPS + 8 * 128, ATT_LDS = CMPX + 16384;
static_assert(ATT_LDS <= 143360, "attention LDS");
#define MFMA32(a, b, c) __builtin_amdgcn_mfma_f32_32x32x16_bf16((a), (b), (c), 0, 0, 0)
__device__ __forceinline__ int crow(int r, int hi) { return (r & 3) + 8 * (r >> 2) + 4 * hi; }
typedef short v4i16_t __attribute__((ext_vector_type(4)));
__device__ __forceinline__ s16x4 vtr(LAS const unsigned char* p) { return __builtin_bit_cast(s16x4, __builtin_amdgcn_ds_read_tr16_b64_v4i16((LAS v4i16_t*)p)); }

struct St { float m, l; f32x16 o0, o1; };

__device__ __forceinline__ void qk_tile(f32x16& p0, f32x16& p1, LAS const unsigned char* kb, const bf16x8* qf, int r, int h) {
    bf16x8 k0[4], k1[4], qv[4];
#pragma unroll
    for (int d0 = 0; d0 < 4; ++d0) { k0[d0] = *(const LAS bf16x8*)(kb + (2 * d0 + h) * 1024 + r * 16); k1[d0] = *(const LAS bf16x8*)(kb + (2 * d0 + h) * 1024 + 512 + r * 16);
        qv[d0] = qf[d0]; }
#pragma unroll
    for (int i = 0; i < 16; ++i) { p0[i] = 0.f; p1[i] = 0.f; }
    __builtin_amdgcn_sched_barrier(0);
#pragma unroll
    for (int d0 = 0; d0 < 4; ++d0) { p0 = MFMA32(k0[d0], qv[d0], p0); p1 = MFMA32(k1[d0], qv[d0], p1); }
}
__device__ __forceinline__ void apply_mask(f32x16& p0, f32x16& p1, unsigned long long allow, int h) {
    if (__all(allow == ~0ull)) return;
    const unsigned long long a = allow >> (4 * h); const unsigned lo = (unsigned)a, hi = (unsigned)(a >> 32);
#pragma unroll
    for (int i = 0; i < 16; ++i) { const int cb = (i & 3) + 8 * (i >> 2);
        p0[i] = ((lo >> cb) & 1u) ? p0[i] : -INFINITY; p1[i] = ((hi >> cb) & 1u) ? p1[i] : -INFINITY; }
}
__device__ __forceinline__ float rowmax32(const f32x16& p0, const f32x16& p1) {
    float a = fmaxf(p0[0], p1[0]);
#pragma unroll
    for (int i = 1; i < 16; ++i) a = fmaxf(a, fmaxf(p0[i], p1[i]));
    return fmaxf(a, __shfl_xor(a, 32));
}
__device__ __forceinline__ void pv_tile(f32x16& o0, f32x16& o1, LAS const unsigned char* vb, const f32x16& p0, const f32x16& p1, int lane, int h) {
    bf16x8 pa[4];
#pragma unroll
    for (int s = 0; s < 4; ++s) { u32x4 w;
#pragma unroll
        for (int j = 0; j < 4; ++j) { const int i0 = 8 * (s & 1) + 2 * j; w[j] = (s < 2) ? pk2(p0[i0], p0[i0 + 1]) : pk2(p1[i0], p1[i0 + 1]); }
        pa[s] = __builtin_bit_cast(bf16x8, w); }
    LAS const unsigned char* vp = vb + ((lane >> 4) & 1) * 32 + (lane & 3) * 8 + (4 * h + ((lane & 15) >> 2)) * 64;
    s16x4 l0[4], h0[4], l1[4], h1[4];
#pragma unroll
    for (int s = 0; s < 4; ++s) { l0[s] = vtr(vp + s * 1024); h0[s] = vtr(vp + s * 1024 + 512); l1[s] = vtr(vp + 4096 + s * 1024); h1[s] = vtr(vp + 4096 + s * 1024 + 512); }
    __builtin_amdgcn_sched_barrier(0);
#pragma unroll
    for (int s = 0; s < 4; ++s) {
        const bf16x8 v0 = (bf16x8){l0[s][0], l0[s][1], l0[s][2], l0[s][3], h0[s][0], h0[s][1], h0[s][2], h0[s][3]};
        const bf16x8 v1 = (bf16x8){l1[s][0], l1[s][1], l1[s][2], l1[s][3], h1[s][0], h1[s][1], h1[s][2], h1[s][3]};
        o0 = MFMA32(pa[s], v0, o0); o1 = MFMA32(pa[s], v1, o1);
    }
}
__device__ __forceinline__ void tile_online(St& st, LAS const unsigned char* kb, LAS const unsigned char* vb, const bf16x8* qr, unsigned long long allow,
                                            LAS float* wsf, int lane, int r, int h) {
    f32x16 p0, p1; qk_tile(p0, p1, kb, qr, r, h); __builtin_amdgcn_sched_barrier(0); apply_mask(p0, p1, allow, h);
    const float rm = rowmax32(p0, p1), mnew = fmaxf(st.m, rm), f = ex2(st.m - mnew); st.m = mnew;
    float ls = 0.f;
#pragma unroll
    for (int i = 0; i < 16; ++i) { p0[i] = ex2(p0[i] - mnew); p1[i] = ex2(p1[i] - mnew); ls += p0[i] + p1[i]; }
    st.l = st.l * f + ls;
    if (__any(f != 1.0f)) {
        if (h == 0) wsf[r] = f;
#pragma unroll
        for (int i = 0; i < 16; ++i) { const float fi = wsf[crow(i, h)]; st.o0[i] *= fi; st.o1[i] *= fi; }
    }
    pv_tile(st.o0, st.o1, vb, p0, p1, lane, h);
}
__device__ __forceinline__ void tile_stats(float& m, float& l, LAS const unsigned char* kb, const bf16x8* qr, unsigned long long allow, int r, int h) {
    f32x16 p0, p1; qk_tile(p0, p1, kb, qr, r, h); __builtin_amdgcn_sched_barrier(0); apply_mask(p0, p1, allow, h);
    const float rm = rowmax32(p0, p1), mnew = fmaxf(m, rm), f = ex2(m - mnew); m = mnew;
    float ls = 0.f;
#pragma unroll
    for (int i = 0; i < 16; ++i) ls += ex2(p0[i] - mnew) + ex2(p1[i] - mnew);
    l = l * f + ls;
}
__device__ __forceinline__ void tile_exact(f32x16& o0, f32x16& o1, float m, float invl, LAS const unsigned char* kb, LAS const unsigned char* vb, const bf16x8* qr,
                                           unsigned long long allow, LAS float* impw  , float& carry, int j, int lane, int r, int h) {
    f32x16 p0, p1; qk_tile(p0, p1, kb, qr, r, h); __builtin_amdgcn_sched_barrier(0); apply_mask(p0, p1, allow, h);
#pragma unroll
    for (int i = 0; i < 16; ++i) { p0[i] = ex2(p0[i] - m) * invl; p1[i] = ex2(p1[i] - m) * invl; }
#pragma unroll
    for (int pos = 0; pos < 8; ++pos) {
        const int half = pos >> 2, r4 = pos & 3;
        const float P0 = half ? p1[4 * r4] : p0[4 * r4], P1 = half ? p1[4 * r4 + 1] : p0[4 * r4 + 1], P2 = half ? p1[4 * r4 + 2] : p0[4 * r4 + 2], P3 = half ? p1[4 * r4 + 3] : p0[4 * r4 + 3];
        const float a = (P0 + P1) + (P2 + 0.5f * P3), b = 0.5f * P3;
        const float bx = __shfl_xor(b, 32);
        const float add = h ? bx : carry;
        impw[16 * j + 2 * pos + h] = a + add;
        carry = bx;
    }
    pv_tile(o0, o1, vb, p0, p1, lane, h);
}

__device__ __forceinline__ void qk_tile_c(f32x16& p0, f32x16& p1, LAS const unsigned char* kb, const bf16x8* qf, const f32x16& c, int r, int h) {
    bf16x8 k0[4], k1[4], qv[4];
#pragma unroll
    for (int d0 = 0; d0 < 4; ++d0) { k0[d0] = *(const LAS bf16x8*)(kb + (2 * d0 + h) * 1024 + r * 16); k1[d0] = *(const LAS bf16x8*)(kb + (2 * d0 + h) * 1024 + 512 + r * 16);
        qv[d0] = qf[d0]; }
    __builtin_amdgcn_sched_barrier(0);
    p0 = MFMA32(k0[0], qv[0], c); p1 = MFMA32(k1[0], qv[0], c);
#pragma unroll
    for (int d0 = 1; d0 < 4; ++d0) { p0 = MFMA32(k0[d0], qv[d0], p0); p1 = MFMA32(k1[d0], qv[d0], p1); }
}
__device__ __forceinline__ unsigned long long lowmask(int n);
__device__ __forceinline__ void soft_pv(St& st, f32x16& x0, f32x16& x1, float cx, LAS const unsigned char* vb, bool first, int kind, int tq,
                                        LAS float* wsf, int lane, int r, int h) {
    if (first) st.m = cx;
    else { const float d = st.m - cx;
        if (__any(d != 0.f)) {
#pragma unroll
            for (int i = 0; i < 16; ++i) { x0[i] -= d; x1[i] -= d; } } }
    if (kind) apply_mask(x0, x1, kind == 1 ? lowmask(tq + 1) : ~lowmask(tq + 1), h);
    const float rm = rowmax32(x0, x1);
    if (first) {
        const float dl = (rm > -INFINITY) ? rm : 0.f; st.m += dl;
#pragma unroll
        for (int i = 0; i < 16; ++i) { x0[i] -= dl; x1[i] -= dl; }
    } else if (__any(rm > 8.0f)) {
        const float dl = fmaxf(rm, 0.f), f = ex2(-dl); st.m += dl; st.l *= f;
        if (h == 0) wsf[r] = f;
#pragma unroll
        for (int i = 0; i < 16; ++i) { x0[i] -= dl; x1[i] -= dl; }
#pragma unroll
        for (int i = 0; i < 16; ++i) { const float fi = wsf[crow(i, h)]; st.o0[i] *= fi; st.o1[i] *= fi; }
    }
    float ls = 0.f;
#pragma unroll
    for (int i = 0; i < 16; ++i) { x0[i] = ex2(x0[i]); x1[i] = ex2(x1[i]); ls += x0[i] + x1[i]; }
    st.l += ls;
    pv_tile(st.o0, st.o1, vb, x0, x1, lane, h);
}
__device__ __forceinline__ unsigned long long lowmask(int n) { return n >= 64 ? ~0ull : ((1ull << n) - 1ull); }

typedef LAS const char* lds_cptr;
__device__ __forceinline__ void hs_glds16(const void* gsrc, unsigned lds_dst) { unsigned keep;
    asm volatile("s_mov_b32 %0, m0\n\ts_mov_b32 m0, %2\n\ts_nop 0\n\tglobal_load_lds_dwordx4 %1, off\n\ts_mov_b32 m0, %0" : "=&s"(keep) : "v"(gsrc), "s"(lds_dst) : "memory"); }
__device__ __forceinline__ float hs_max3f(float a, float b, float c) { float r; asm("v_max3_f32 %0, %1, %2, %3" : "=v"(r) : "v"(a), "v"(b), "v"(c)); return r; }
__device__ __forceinline__ float hs_max2f(float a, float b) { float r; asm("v_max_f32_e32 %0, %1, %2" : "=v"(r) : "v"(a), "v"(b)); return r; }
__device__ __forceinline__ float hs_fadd(float a, float b) { float r; asm("v_add_f32_e32 %0, %1, %2" : "=v"(r) : "v"(a), "v"(b)); return r; }
__device__ __forceinline__ float hs_fsub(float a, float b) { float r; asm("v_sub_f32_e32 %0, %1, %2" : "=v"(r) : "v"(a), "v"(b)); return r; }
#define HS_SBAR() __builtin_amdgcn_sched_barrier(0)
#define HS_WAIT_BAR(N) asm volatile("s_waitcnt vmcnt(" #N ") lgkmcnt(0)\n\ts_barrier" ::: "memory")
__device__ __forceinline__ void hs_qkt(f32x16& p0, f32x16& p1, const char* Kslot, const bf16x8* qr, const f32x16& negm, int r32, int hi) {
    const char* kb = Kslot + hi * 1024 + r32 * 16;
#pragma unroll
    for (int d0 = 0; d0 < 4; ++d0) {
        const bf16x8 b0 = *reinterpret_cast<const bf16x8*>(kb + d0 * 2048);
        const bf16x8 b1 = *reinterpret_cast<const bf16x8*>(kb + d0 * 2048 + 512);
        if (d0 == 0) { p0 = MFMA32(b0, qr[0], negm); p1 = MFMA32(b1, qr[0], negm); }
        else { p0 = MFMA32(b0, qr[d0], p0); p1 = MFMA32(b1, qr[d0], p1); } }
}
__device__ __forceinline__ void hs_kload8(bf16x8* kf, lds_cptr kp) {
    kf[0] = *(const LAS bf16x8*)(kp);        kf[1] = *(const LAS bf16x8*)(kp + 512);
    kf[2] = *(const LAS bf16x8*)(kp + 2048); kf[3] = *(const LAS bf16x8*)(kp + 2560);
    kf[4] = *(const LAS bf16x8*)(kp + 4096); kf[5] = *(const LAS bf16x8*)(kp + 4608);
    kf[6] = *(const LAS bf16x8*)(kp + 6144); kf[7] = *(const LAS bf16x8*)(kp + 6656);
}
__device__ __forceinline__ void hs_kload2(bf16x8* kf, lds_cptr kp, int j) { kf[2 * j] = *(const LAS bf16x8*)(kp + j * 2048); kf[2 * j + 1] = *(const LAS bf16x8*)(kp + j * 2048 + 512); }
__device__ __forceinline__ s16x4 hs_vtr(lds_cptr p) { return __builtin_bit_cast(s16x4, __builtin_amdgcn_ds_read_tr16_b64_v4i16((LAS v4i16_t*)p)); }
__device__ __forceinline__ float hs_rowmax(const f32x16& p0, const f32x16& p1) {
    float a = hs_max3f(p0[0], p0[1], p1[0]), b = hs_max3f(p0[2], p0[3], p1[1]); a = hs_max3f(a, p1[2], p1[3]);
#pragma unroll
    for (int r = 4; r < 16; r += 4) { a = hs_max3f(a, p0[r], p0[r + 1]); b = hs_max3f(b, p0[r + 2], p0[r + 3]); a = hs_max3f(a, p1[r], p1[r + 1]); b = hs_max3f(b, p1[r + 2], p1[r + 3]); }
    const float m = hs_max2f(a, b);
    auto rr = __builtin_amdgcn_permlane32_swap(__float_as_uint(m), __float_as_uint(m), false, false);
    return hs_max2f(__uint_as_float(rr[0]), __uint_as_float(rr[1]));
}
__device__ __forceinline__ void hs_pv(f32x16* o, int vb, bf16x8 pa0, bf16x8 pa1, bf16x8 pa2, bf16x8 pa3) {
#pragma unroll
    for (int d0 = 0; d0 < 2; ++d0) { s16x4 lo[4], hi[4];
#pragma unroll
        for (int ks = 0; ks < 4; ++ks) {
            asm volatile("ds_read_b64_tr_b16 %0,%1 offset:%c2" : "=&v"(lo[ks]) : "v"(vb), "i"(d0 * 4096 + ks * 1024) : "memory");
            asm volatile("ds_read_b64_tr_b16 %0,%1 offset:%c2" : "=&v"(hi[ks]) : "v"(vb), "i"(d0 * 4096 + ks * 1024 + 512) : "memory"); }
        asm volatile("s_waitcnt lgkmcnt(0)" ::: "memory"); HS_SBAR();
#define HS_PK(k) (bf16x8){lo[k][0], lo[k][1], lo[k][2], lo[k][3], hi[k][0], hi[k][1], hi[k][2], hi[k][3]}
        o[d0] = MFMA32(pa0, HS_PK(0), o[d0]); o[d0] = MFMA32(pa1, HS_PK(1), o[d0]); o[d0] = MFMA32(pa2, HS_PK(2), o[d0]); o[d0] = MFMA32(pa3, HS_PK(3), o[d0]);
#undef HS_PK
    }
}
__device__ __forceinline__ void hs_pre_dma(char* shm, const bf16_t* ksb, int c0, int c1, int c2, int wid, int lane) {
    const unsigned lds0 = (unsigned)(uintptr_t)shm;
    const size_t koff = (size_t)lane * PP + wid * 8, voff = (size_t)(16 * (wid & 3) + (lane >> 2)) * PP + (wid >> 2) * 32 + (lane & 3) * 8 + (C_VS - C_KS);
    const unsigned kdst = lds0 + KB0 + wid * 1024, vdst = lds0 + VB0 + wid * 1024;
#define HS_SRC0(c) (ksb + (size_t)(((c) & 0x80) ? (C_KW - C_KS) : 0) + (size_t)(((c) == 0x7f) ? 0 : ((c) & 0x7f)) * 64 * PP)
    hs_glds16(HS_SRC0(c0) + koff, (unsigned)__builtin_amdgcn_readfirstlane(kdst));
    hs_glds16(HS_SRC0(c0) + voff, (unsigned)__builtin_amdgcn_readfirstlane(vdst));
    hs_glds16(HS_SRC0(c1) + koff, (unsigned)__builtin_amdgcn_readfirstlane(kdst + 8192));
    hs_glds16(HS_SRC0(c2) + koff, (unsigned)__builtin_amdgcn_readfirstlane(kdst + 16384));
#undef HS_SRC0
}
template <int THRL, bool DIS, bool PRE> __device__ __forceinline__ void run_branch(char* shm, const bf16x8* qr, const bf16_t* ksb, LAS const unsigned char* steps, const int NT,
                                                               const int qb, f32x16* o, float& l_out, const int wid, const int lane) {
    constexpr int SLOTB = 8192, NSLOT = 3;
    { unsigned long long p_ = (unsigned long long)ksb; asm volatile("" : "+s"(p_)); ksb = (const bf16_t*)p_; }
    const int r32 = lane & 31, hi = lane >> 5, tq = (wid & 1) * 32 + r32;
    const unsigned lds0 = (unsigned)(uintptr_t)shm;
    const unsigned long long mysel = *((LAS const unsigned long long*)((lds_cptr)shm + SELM) + tq);
    const int vcodes = (int)steps[lane];
    float* wsf = (float*)(shm + WSF) + wid * 32;
    const size_t koff = (size_t)lane * PP + wid * 8, voff = (size_t)(16 * (wid & 3) + (lane >> 2)) * PP + (wid >> 2) * 32 + (lane & 3) * 8 + (C_VS - C_KS);
    const unsigned kdst = lds0 + KB0 + wid * 1024, vdst = lds0 + VB0 + wid * 1024;
#define HS_CODE(t) ((int)__builtin_amdgcn_readlane(vcodes, (t)))
#define HS_SRC(c) (ksb + (size_t)(((c) & 0x80) ? (C_KW - C_KS) : 0) + (size_t)(((c) == 0x7f) ? 0 : ((c) & 0x7f)) * 64 * PP)
#define DMA_K(t, slot) do { const int c_ = HS_CODE(t); hs_glds16(HS_SRC(c_) + koff, (unsigned)__builtin_amdgcn_readfirstlane(kdst + (slot))); } while (0)
#define DMA_V(t, slot) do { const int c_ = HS_CODE(t); hs_glds16(HS_SRC(c_) + voff, (unsigned)__builtin_amdgcn_readfirstlane(vdst + (slot))); } while (0)
    const int vb0 = (int)(lds0 + VB0) + ((lane >> 4) & 1) * 32 + (lane & 3) * 8 + (4 * hi + ((lane & 15) >> 2)) * 64;
    const char* Kbase = shm + KB0; bf16x8 kf[8];
    const lds_cptr shm3 = (lds_cptr)shm; const lds_cptr kp0 = shm3 + KB0 + hi * 1024 + r32 * 16; const lds_cptr vp0 = shm3 + VB0 + ((lane >> 4) & 1) * 32 + (lane & 3) * 8 + (4 * hi + ((lane & 15) >> 2)) * 64;
    if (!PRE) { DMA_K(0, 0); DMA_V(0, 0); DMA_K(1, SLOTB); }
    float mhat = 0.f, l_reg = 0.f; f32x16 negm;
    { float z = 0.f; asm volatile("" : "+v"(z));
#pragma unroll
      for (int i = 0; i < 16; ++i) { o[0][i] = z; o[1][i] = z; negm[i] = z; } }
    asm volatile("" : "+v"(negm));
#define CMASK(P0, P1, t) do { const int c_ = HS_CODE(t); const bool isw_ = (c_ & 0x80) != 0; const int jj_ = c_ & 0x7f; \
        if (!DIS && c_ == 0x7f) { _Pragma("unroll") for (int r = 0; r < 16; ++r) { P0[r] = -INFINITY; P1[r] = -INFINITY; } } \
        int kind_ = 0; if (c_ != 0x7f) { if (jj_ == qb) kind_ = 1; else if (isw_ && jj_ == qb - 8) kind_ = 2; } \
        if (kind_) apply_mask(P0, P1, kind_ == 1 ? lowmask(tq + 1) : ~lowmask(tq + 1), hi); } while (0)
    bool resc = false;
#define START(P0, P1) do { const float rm = hs_rowmax(P0, P1); resc = false; \
        { const float dl = (rm > -INFINITY) ? rm : 0.f; mhat = hs_fadd(mhat, dl); \
          _Pragma("unroll") for (int r = 0; r < 16; ++r) { P0[r] = hs_fsub(P0[r], dl); P1[r] = hs_fsub(P1[r], dl); } \
          _Pragma("unroll") for (int r = 0; r < 16; ++r) negm[r] = -mhat; asm volatile("" : "+v"(negm)); } \
        _Pragma("unroll") for (int r = 0; r < 16; ++r) P0[r] = __builtin_amdgcn_exp2f(P0[r]); } while (0)
#define RESC() do { if (resc) { asm volatile("s_waitcnt lgkmcnt(0)" ::: "memory"); \
        _Pragma("unroll") for (int d_ = 0; d_ < 2; ++d_) _Pragma("unroll") for (int r = 0; r < 16; ++r) o[d_][r] *= wsf[crow(r, hi)]; } } while (0)
    f32x16 pA0, pA1, pB0, pB1;
    int sl_prev = 0, sl_cur = 0, sl_next = SLOTB;
#define ROT() do { sl_prev = sl_cur; sl_cur = sl_next; sl_next = (sl_next == (NSLOT - 1) * SLOTB) ? 0 : sl_next + SLOTB; } while (0)
    if (!PRE) DMA_K(2, 2 * SLOTB);
    HS_WAIT_BAR(3);
    hs_qkt(pA0, pA1, Kbase, qr, negm, r32, hi); asm volatile("s_nop 15\n\ts_nop 7" : "+v"(pA0), "+v"(pA1)); CMASK(pA0, pA1, 0);
    START(pA0, pA1);
    _Pragma("unroll") for (int r = 0; r < 16; ++r) pA1[r] = __builtin_amdgcn_exp2f(pA1[r]);
    HS_WAIT_BAR(0);
    DMA_K(3, 0); DMA_V(1, SLOTB);
    ROT();
    hs_kload8(kf, kp0 + sl_cur);
    HS_WAIT_BAR(2);
    s16x4 vlo[8], vhi[8]; u32x4 pw0, pw1, pw2, pw3;
#define PKW(P, B) pk2(P[B], P[B + 1])
#define PAF(k) __builtin_bit_cast(bf16x8, pw##k)
#define VFR(i) (bf16x8){vlo[i][0], vlo[i][1], vlo[i][2], vlo[i][3], vhi[i][0], vhi[i][1], vhi[i][2], vhi[i][3]}
#define PIN(x) asm volatile("" : "+v"(x))
#define MX3(a, b, c) __builtin_fmaxf(__builtin_fmaxf((a), (b)), (c))
#define GAPA(MF, A0, A1, A2, A3, W0, W1, PW) do { MF; sacc += A0; sacc += A1; sacc += A2; sacc += A3; PIN(sacc); W0; W1; PIN(PW); HS_SBAR(); } while (0)
#define EX(v) __builtin_amdgcn_exp2f(v)
#define GAPB(MF, X, B) do { MF; X[B] = EX(X[B]); X[B + 1] = EX(X[B + 1]); X[B + 2] = EX(X[B + 2]); X[B + 3] = EX(X[B + 3]); PIN(X); HS_SBAR(); } while (0)
#define VRD(i) do { vlo[i] = hs_vtr(vp_ + (((i) >> 2) * 4096 + ((i) & 3) * 1024)); vhi[i] = hs_vtr(vp_ + (((i) >> 2) * 4096 + ((i) & 3) * 1024 + 512)); } while (0)
#define KRD(G, j) do { if (G) { hs_kload2(kf, kp0 + sl_next, j); HS_SBAR(); } } while (0)
#define STEP(C0, C1, P0, P1, t, GK, GV, GL) do { HS_SBAR(); \
        f32x16 cct; \
        if (DIS) { const int c0_ = HS_CODE(t); const bool en0_ = (c0_ != 0x7f) && (((mysel >> (c0_ & 63)) & 1ull) != 0ull);     \
            _Pragma("unroll") for (int r = 0; r < 16; ++r) cct[r] = en0_ ? negm[r] : -INFINITY; PIN(cct); HS_SBAR(); } \
        const lds_cptr vp_ = vp0 + sl_prev; \
        VRD(0); HS_SBAR(); float sacc = (P0[0] + P0[1]); \
        GAPA(C0 = MFMA32(kf[0], qr[0], (DIS ? cct : negm)), P0[2], P0[3], P0[4], P0[5],     pw0[0] = PKW(P0, 0), pw0[1] = PKW(P0, 2), pw0); \
        VRD(4); HS_SBAR(); GAPA(C1 = MFMA32(kf[1], qr[0], (DIS ? cct : negm)), P0[6], P0[7], P0[8], P0[9],     pw0[2] = PKW(P0, 4), pw0[3] = PKW(P0, 6), pw0); \
        VRD(1); HS_SBAR(); GAPA(C0 = MFMA32(kf[2], qr[1], C0),   P0[10], P0[11], P0[12], P0[13], pw1[0] = PKW(P0, 8), pw1[1] = PKW(P0, 10), pw1); \
        VRD(5); HS_SBAR(); GAPA(C1 = MFMA32(kf[3], qr[1], C1),   P0[14], P0[15], P1[0], P1[1],   pw1[2] = PKW(P0, 12), pw1[3] = PKW(P0, 14), pw1); \
        VRD(2); HS_SBAR(); GAPA(C0 = MFMA32(kf[4], qr[2], C0),   P1[2], P1[3], P1[4], P1[5],     pw2[0] = PKW(P1, 0), pw2[1] = PKW(P1, 2), pw2); \
        VRD(6); HS_SBAR(); GAPA(C1 = MFMA32(kf[5], qr[2], C1),   P1[6], P1[7], P1[8], P1[9],     pw2[2] = PKW(P1, 4), pw2[3] = PKW(P1, 6), pw2); \
        VRD(3); HS_SBAR(); GAPA(C0 = MFMA32(kf[6], qr[3], C0),   P1[10], P1[11], P1[12], P1[13], pw3[0] = PKW(P1, 8), pw3[1] = PKW(P1, 10), pw3); \
        VRD(7); HS_SBAR(); GAPA(C1 = MFMA32(kf[7], qr[3], C1),   P1[14], P1[15], 0.f, 0.f,       pw3[2] = PKW(P1, 12), pw3[3] = PKW(P1, 14), pw3); \
        l_reg += sacc; \
        if (GK) { DMA_K((t) + 3, sl_cur); } if (GV) { DMA_V((t) + 1, sl_next); } \
        CMASK(C0, C1, t); \
        { float a = MX3(C0[0], C0[1], C1[0]), b = MX3(C0[2], C0[3], C1[1]); a = MX3(a, C1[2], C1[3]); \
          _Pragma("unroll") for (int r = 4; r < 16; r += 4) { a = MX3(a, C0[r], C0[r + 1]); b = MX3(b, C0[r + 2], C0[r + 3]); a = MX3(a, C1[r], C1[r + 1]); b = MX3(b, C1[r + 2], C1[r + 3]); } \
          float rm = __builtin_fmaxf(a, b); { auto rr = __builtin_amdgcn_permlane32_swap(__float_as_uint(rm), __float_as_uint(rm), false, false); rm = __builtin_fmaxf(__uint_as_float(rr[0]), __uint_as_float(rr[1])); } \
          resc = false; \
          if (__builtin_expect(__any(rm > (float)THRL), 0)) { const float dl = __builtin_fmaxf(rm, 0.f); mhat += dl; \
            _Pragma("unroll") for (int r = 0; r < 16; ++r) { C0[r] -= dl; C1[r] -= dl; } \
            _Pragma("unroll") for (int r = 0; r < 16; ++r) negm[r] = -mhat; asm volatile("" : "+v"(negm)); \
            const float f = __builtin_amdgcn_exp2f(-dl); l_reg *= f; if (hi == 0) wsf[r32] = f; resc = true; } } \
        HS_SBAR(); \
        GAPB(o[0] = MFMA32(PAF(0), VFR(0), o[0]), C0, 0); \
        GAPB(o[1] = MFMA32(PAF(0), VFR(4), o[1]), C0, 4); \
        KRD(GL, 0); GAPB(o[0] = MFMA32(PAF(1), VFR(1), o[0]), C0, 8); \
        KRD(GL, 1); GAPB(o[1] = MFMA32(PAF(1), VFR(5), o[1]), C0, 12); \
        KRD(GL, 2); GAPB(o[0] = MFMA32(PAF(2), VFR(2), o[0]), C1, 0); \
        KRD(GL, 3); GAPB(o[1] = MFMA32(PAF(2), VFR(6), o[1]), C1, 4); \
        GAPB(o[0] = MFMA32(PAF(3), VFR(3), o[0]), C1, 8); \
        GAPB(o[1] = MFMA32(PAF(3), VFR(7), o[1]), C1, 12); \
    } while (0)
    int t = 1;
    for (; t + 5 < NT; t += 2) {
        STEP(pB0, pB1, pA0, pA1, t, true, true, true);     HS_WAIT_BAR(2); RESC(); ROT();
        STEP(pA0, pA1, pB0, pB1, t + 1, true, true, true); HS_WAIT_BAR(2); RESC(); ROT();
    }
#define ENDW(tt) do { if ((tt) + 3 < NT) { HS_WAIT_BAR(2); } else if ((tt) + 2 < NT) { HS_WAIT_BAR(1); } else { HS_WAIT_BAR(0); } } while (0)
    for (; t + 1 < NT; t += 2) {
        STEP(pB0, pB1, pA0, pA1, t, (t + 3 < NT), (t + 1 < NT), (t + 1 < NT));         ENDW(t);     RESC(); ROT();
        STEP(pA0, pA1, pB0, pB1, t + 1, (t + 4 < NT), (t + 2 < NT), (t + 2 < NT));     ENDW(t + 1); RESC(); ROT();
    }
#define DRAIN(PX0, PX1, SL) do { float sacc = PX0[0] + PX0[1]; _Pragma("unroll") for (int r = 2; r < 16; ++r) sacc += PX0[r]; _Pragma("unroll") for (int r = 0; r < 16; ++r) sacc += PX1[r]; l_reg += sacc; \
      pw0 = (u32x4){PKW(PX0, 0), PKW(PX0, 2), PKW(PX0, 4), PKW(PX0, 6)}; pw1 = (u32x4){PKW(PX0, 8), PKW(PX0, 10), PKW(PX0, 12), PKW(PX0, 14)}; \
      pw2 = (u32x4){PKW(PX1, 0), PKW(PX1, 2), PKW(PX1, 4), PKW(PX1, 6)}; pw3 = (u32x4){PKW(PX1, 8), PKW(PX1, 10), PKW(PX1, 12), PKW(PX1, 14)}; \
      HS_SBAR(); hs_pv(o, vb0 + (SL), PAF(0), PAF(1), PAF(2), PAF(3)); } while (0)
    if (NT & 1) {
        DRAIN(pA0, pA1, sl_prev);
    } else {
        STEP(pB0, pB1, pA0, pA1, NT - 1, false, false, false); RESC();
        DRAIN(pB0, pB1, sl_cur);
    }
#undef DRAIN
    { auto rr = __builtin_amdgcn_permlane32_swap(__float_as_uint(l_reg), __float_as_uint(l_reg), false, false); l_out = __uint_as_float(rr[0]) + __uint_as_float(rr[1]); }
    asm volatile("s_waitcnt lgkmcnt(0)\n\ts_barrier" ::: "memory");
#undef PKW
#undef PAF
#undef VFR
#undef PIN
#undef MX3
#undef GAPA
#undef GAPB
#undef EX
#undef VRD
#undef KRD
#undef STEP
#undef ENDW
#undef DMA_K
#undef DMA_V
#undef CMASK
#undef START
#undef RESC
#undef ROT
#undef HS_CODE
#undef HS_SRC
}
__device__ __forceinline__ void attn_unit(LAS unsigned char* lds, bf16_t* proj, const bf16_t* kcmp, const bf16_t* vcmp, int bh, int qb, int skipw) {
    int tid_ = threadIdx.x; asm volatile("" : "+v"(tid_));
    const int tid = tid_, lane = tid & 63, r = lane & 31, h = lane >> 5, wid = __builtin_amdgcn_readfirstlane(tid >> 6);
    const int b = bh >> 2, hk = bh & 3, g = wid >> 1, tq = (wid & 1) * 32 + r;
    const size_t row = (size_t)b * SEQ + (size_t)qb * 64 + tq;
    const int t = qb * 64 + tq;
    bf16_t* qp = proj + row * PP + C_Q + (hk * 4 + g) * 64;
    bf16x8 qreg[4];
#pragma unroll
    for (int d0 = 0; d0 < 4; ++d0) qreg[d0] = *(const bf16x8*)(qp + d0 * 16 + h * 8);
    const bf16x8* qr = qreg;
    float gate[3];
#pragma unroll
    for (int c = 0; c < 3; ++c) gate[c] = sigmoidf_(bf2f(proj[row * PP + C_GBR + c * 16 + hk * 4 + g]));
#ifdef GATE2X
    if (GATE2X & 1) gate[0] *= 2.f; if (GATE2X & 2) gate[1] *= 2.f; if (GATE2X & 4) gate[2] *= 2.f;
#endif
#ifdef GATEZ
    if (GATEZ & 1) gate[0] = 0.f; if (GATEZ & 2) gate[1] = 0.f; if (GATEZ & 4) gate[2] = 0.f;
#endif
    LAS float* wsf = (LAS float*)(lds + WSF) + wid * 32;
    LAS float* impw = (LAS float*)(lds + IMP) + (g * 64 + tq) * IMPW;
    const size_t krow = lane, kcol = wid * 8;
    const size_t vrow = 16 * (wid & 3) + (lane >> 2), vcol = 32 * (wid >> 2) + 8 * (lane & 3);
    LAS unsigned char* kst = lds + KB0 + wid * 1024 + lane * 16;
    LAS unsigned char* vst = lds + VB0 + wid * 1024 + lane * 16;
    u32x4 kreg, vreg;
    LAS float* osl = (LAS float*)(lds + IMP + wid * (32 * IMPW * 4)) + lane;
#define LDK(base, pitch) kreg = *(const u32x4*)((base) + krow * (size_t)(pitch) + kcol)
#define LDV(base, pitch) vreg = *(const u32x4*)((base) + vrow * (size_t)(pitch) + vcol)
#define STK(buf) *(LAS u32x4*)(kst + (buf) * 8192) = kreg
#define STV(buf) *(LAS u32x4*)(vst + (buf) * 8192) = vreg
#define KBUF(buf) (lds + KB0 + (buf) * 8192)
#define VBUF(buf) (lds + VB0 + (buf) * 8192)
#define ACCUM_OUT(scale_expr, FIRST) do { if (h == 0) wsf[r] = (scale_expr); \
        _Pragma("unroll") for (int i = 0; i < 16; ++i) { const float sc = wsf[crow(i, h)]; \
            if (FIRST) { osl[(i * 2) * 64] = st.o0[i] * sc; osl[(i * 2 + 1) * 64] = st.o1[i] * sc; } \
            else { osl[(i * 2) * 64] += st.o0[i] * sc; osl[(i * 2 + 1) * 64] += st.o1[i] * sc; } } } while (0)

    St st;
    const bf16_t* kc = kcmp + (size_t)bh * 256 * 64; const bf16_t* vc = vcmp + (size_t)bh * 256 * 64;
    const int nmax = (t >= 31) ? ((t - 31) >> 4) : -1;
#define CMP_KT(j) (lds + (j) * 8192)
#define CMP_VT(j) ((j) < 2 ? lds + 32768 + (j) * 8192 : lds + CMPX + ((j) - 2) * 8192)
    {
        u32x4 kr4[4], vr4[4];
#pragma unroll
        for (int j = 0; j < 4; ++j) { kr4[j] = *(const u32x4*)(kc + (size_t)j * 4096 + krow * 64 + kcol); vr4[j] = *(const u32x4*)(vc + (size_t)j * 4096 + vrow * 64 + vcol); }
#pragma unroll
        for (int j = 0; j < 4; ++j) { *(LAS u32x4*)(CMP_KT(j) + wid * 1024 + lane * 16) = kr4[j]; *(LAS u32x4*)(CMP_VT(j) + wid * 1024 + lane * 16) = vr4[j]; }
    }
    __syncthreads();
    float carry = 0.f;
    float m1 = -1e30f, l1 = 0.f;
#pragma unroll 1
    for (int j = 0; j < 4; ++j) {
        const int cnt = nmax - 64 * j + 1; const unsigned long long allow = cnt <= 0 ? 0ull : lowmask(cnt);
        tile_stats(m1, l1, CMP_KT(j), qr, allow, r, h);
    }
    l1 += __shfl_xor(l1, 32);
    const float invl = __builtin_amdgcn_rcpf(fmaxf(l1, 1e-30f));
#pragma unroll
    for (int i = 0; i < 16; ++i) { st.o0[i] = 0.f; st.o1[i] = 0.f; }
#pragma unroll 1
    for (int j = 0; j < 4; ++j) {
        const int cnt = nmax - 64 * j + 1; const unsigned long long allow = cnt <= 0 ? 0ull : lowmask(cnt);
        tile_exact(st.o0, st.o1, m1, invl, CMP_KT(j), CMP_VT(j), qr, allow, impw, carry, j, lane, r, h);
    }
    __syncthreads();
    hs_pre_dma((char*)lds, proj + (size_t)b * SEQ * PP + C_KS + hk * 64, 0, qb > 0 ? qb : 0x7f, qb > 1 ? qb - 1 : 0x7f, wid, lane);
#undef CMP_KT
#undef CMP_VT
    {
        unsigned long long wor = 0ull;
        const unsigned long long valid = lowmask(qb + 1);
        LAS const float* ib = (LAS const float*)(lds + IMP);
        unsigned key[8], T[8];
#pragma unroll
        for (int i = 0; i < 8; ++i) { const int q = wid * 8 + i;
            float v = ((ib[(0 * 64 + q) * IMPW + lane] + ib[(1 * 64 + q) * IMPW + lane]) + ib[(2 * 64 + q) * IMPW + lane]) + ib[(3 * 64 + q) * IMPW + lane];
            if (lane == 0 || lane == qb || lane == qb - 1) v = INFINITY;
            key[i] = (lane <= qb) ? __float_as_uint(fmaxf(v, 0.f)) : 0u; T[i] = 0u; }
#pragma unroll 1
        for (int bb = 30; bb >= 0; --bb) {
#pragma unroll
            for (int i = 0; i < 8; ++i) { const unsigned cand = T[i] | (1u << bb);
                const int c = __popcll(__ballot(key[i] >= cand) & valid); T[i] = (c >= 16) ? cand : T[i]; }
        }
#pragma unroll
        for (int i = 0; i < 8; ++i) { const int q = wid * 8 + i;
            const unsigned long long gt = __ballot(key[i] > T[i]) & valid, eq = __ballot(key[i] == T[i]) & valid;
            const int need = 16 - __popcll(gt);
            const bool pick = ((eq >> lane) & 1ull) && (__popcll(eq & lowmask(lane)) < need);
            const unsigned long long msk = gt | __ballot(pick);
            if (lane == 0) *(LAS unsigned long long*)(lds + SELM + q * 8) = msk;
            wor |= msk; }
        if (lane == 0) *(LAS unsigned long long*)(lds + WMASK + wid * 8) = wor;
    }
    __syncthreads();
    unsigned long long un = 0ull;
#pragma unroll
    for (int w = 0; w < 8; ++w) un |= *(LAS const unsigned long long*)(lds + WMASK + w * 8);
    { const unsigned ulo = __builtin_amdgcn_readfirstlane((unsigned)un), uhi = __builtin_amdgcn_readfirstlane((unsigned)(un >> 32)); un = ((unsigned long long)uhi << 32) | ulo; }
    ACCUM_OUT(gate[0], true);
    {
        LAS unsigned char* steps = lds + STEPS + wid * 128;
        const int nsel = __popcll(un), j0w = qb >= 8 ? qb - 8 : 0, nwin = qb - j0w + 1;
        const int NTs = nsel < 4 ? 4 : nsel, NTw = nwin < 4 ? 4 : nwin;
        {
            const unsigned long long F = 1ull | (1ull << qb) | (qb > 0 ? (1ull << (qb - 1)) : 0ull), rest = un & ~F; const int nF = __popcll(F);
            if (lane == 0) { steps[0] = 0; if (qb > 0) steps[1] = (unsigned char)qb; if (qb > 1) steps[2] = (unsigned char)(qb - 1); }
            if ((rest >> lane) & 1ull) steps[nF + __popcll(rest & lowmask(lane))] = (unsigned char)lane;
        }
        if (lane >= nsel && lane < NTs) steps[lane] = (unsigned char)0x7f;
        if (lane < NTw) steps[64 + lane] = (unsigned char)(lane < nwin ? (0x80 | (j0w + lane)) : 0x7f);
        const bf16_t* ksb = proj + (size_t)b * SEQ * PP + C_KS + hk * 64;
        char* shm = (char*)lds;
        f32x16 ob[2]; float lt;
        run_branch<8, true, true>(shm, qr, ksb, steps, NTs, qb, ob, lt, wid, lane);
        {
            int t2 = threadIdx.x; asm volatile("" : "+v"(t2));
            const int lane2 = t2 & 63, r2 = lane2 & 31, h2 = lane2 >> 5, wid2 = __builtin_amdgcn_readfirstlane(t2 >> 6), g2 = wid2 >> 1, tq2 = (wid2 & 1) * 32 + r2;
            LAS float* wsf2 = (LAS float*)(lds + WSF) + wid2 * 32; LAS float* osl2 = (LAS float*)(lds + IMP + wid2 * (32 * IMPW * 4)) + lane2;
            const float g1 = sigmoidf_(bf2f(proj[((size_t)b * SEQ + (size_t)qb * 64 + tq2) * PP + C_GBR + 1 * 16 + hk * 4 + g2]));
            if (h2 == 0) wsf2[r2] = g1 * __builtin_amdgcn_rcpf(fmaxf(lt, 1e-30f));
#pragma unroll
            for (int i = 0; i < 16; ++i) { const float sc = wsf2[crow(i, h2)]; osl2[(i * 2) * 64] += ob[0][i] * sc; osl2[(i * 2 + 1) * 64] += ob[1][i] * sc; }
        }
        {
            int t3 = threadIdx.x; asm volatile("" : "+v"(t3));
            run_branch<8, false, false>(shm, qr, ksb, steps + 64, NTw, qb, ob, lt, __builtin_amdgcn_readfirstlane(t3 >> 6), t3 & 63);
        }
        st.o0 = ob[0]; st.o1 = ob[1]; st.l = lt;
    }
    {
        int t2 = threadIdx.x; asm volatile("" : "+v"(t2));
        const int lane2 = t2 & 63, r2 = lane2 & 31, h2 = lane2 >> 5, wid2 = __builtin_amdgcn_readfirstlane(t2 >> 6), g2 = wid2 >> 1, tq2 = (wid2 & 1) * 32 + r2;
        LAS float* wsf2 = (LAS float*)(lds + WSF) + wid2 * 32; LAS float* osl2 = (LAS float*)(lds + IMP + wid2 * (32 * IMPW * 4)) + lane2;
        const float g3 = sigmoidf_(bf2f(proj[((size_t)b * SEQ + (size_t)qb * 64 + tq2) * PP + C_GBR + 2 * 16 + hk * 4 + g2]));
        if (h2 == 0) wsf2[r2] = g3 * __builtin_amdgcn_rcpf(fmaxf(st.l, 1e-30f));
        bf16_t* ob2 = proj + ((size_t)b * SEQ + (size_t)qb * 64 + (wid2 & 1) * 32) * PP + C_Q + (hk * 4 + g2) * 64;
        if (!skipw)
#pragma unroll
        for (int i = 0; i < 16; ++i) { const int q = crow(i, h2); const float sc = wsf2[q];
            const float f0 = osl2[(i * 2) * 64] + st.o0[i] * sc, f1 = osl2[(i * 2 + 1) * 64] + st.o1[i] * sc;
            ob2[(size_t)q * PP + r2] = (bf16_t)(pk2(f0, 0.f) & 0xffffu); ob2[(size_t)q * PP + 32 + r2] = (bf16_t)(pk2(f1, 0.f) & 0xffffu); }
    }
#undef LDK
#undef LDV
#undef STK
#undef STV
#undef KBUF
#undef VBUF
#undef ACCUM_OUT
}
}

__device__ __forceinline__ float wave_sum(float v) {
#pragma unroll
    for (int o = 1; o < 64; o <<= 1) v += __shfl_xor(v, o);
    return v;
}
__device__ __forceinline__ void transpose_item(const float* W, int K, int N, bf16_t* WT, int ldt, int k0, int n0, int drow0, const float* kscale, float cscale, LAS float* scr, int lane) {
#pragma unroll 8
    for (int i = 0; i < 32; ++i) { const int kk = 2 * i + (lane >> 5); const int n = n0 + (lane & 31);
        float v = (n < N) ? W[(size_t)(k0 + kk) * N + n] : 0.f;
        if (kscale) v *= kscale[k0 + kk];
        scr[kk * 33 + (lane & 31)] = v * cscale; }
    asm volatile("s_waitcnt lgkmcnt(0)" ::: "memory");
    const int c = lane & 7;
#pragma unroll
    for (int j = 0; j < 4; ++j) { const int n = (lane >> 3) + 8 * j; const LAS float* s = scr + (8 * c) * 33 + n;
        u32x4 o; o.x = pk2(s[0 * 33], s[1 * 33]); o.y = pk2(s[2 * 33], s[3 * 33]); o.z = pk2(s[4 * 33], s[5 * 33]); o.w = pk2(s[6 * 33], s[7 * 33]);
        *(u32x4*)(WT + (size_t)(drow0 + n) * ldt + k0 + 8 * c) = o; }
    asm volatile("s_waitcnt lgkmcnt(0)" ::: "memory");
}

#define XB_TMO      128
#define XB_XCNT(j)  (256  + 64 * (j))
#define XB_XSUB(j)  (1280 + 64 * (j))
#define XB_XGEN(j)  (2304 + 64 * (j))
#define XB_TOP      3328
#define XB_TOPGEN   3392
#define XCD_BAR_WORDS 3456
#define XB_SPIN_CAP (1u << 18)
__device__ __forceinline__ unsigned xb_ld(unsigned* p)              { return __hip_atomic_load(p, __ATOMIC_RELAXED, __HIP_MEMORY_SCOPE_AGENT); }
__device__ __forceinline__ unsigned xb_add(unsigned* p, unsigned v) { return __hip_atomic_fetch_add(p, v, __ATOMIC_RELAXED, __HIP_MEMORY_SCOPE_AGENT); }
__device__ __forceinline__ unsigned xb_xcc_id() { return (unsigned)__builtin_amdgcn_s_getreg((3 << 11) | 20) & 0xFu; }
#define XB_SPIN(cond, bar) do { unsigned _sp = 0; while (cond) { __builtin_amdgcn_s_sleep(1); \
    if ((++_sp & 255u) == 0u) { if (xb_ld(&(bar)[XB_TMO])) break; if (_sp > XB_SPIN_CAP) { atomicAdd(&(bar)[XB_TMO], 1u); break; } } } } while (0)
struct XcdBarrier { unsigned* bar; unsigned x; volatile LAS unsigned* st; };
__device__ __forceinline__ XcdBarrier xcd_barrier_post(unsigned* bar, volatile LAS unsigned* st) {
    XcdBarrier b; b.bar = bar; b.x = xb_xcc_id(); b.st = st;
    if (threadIdx.x == 0) (void)xb_add(&bar[XB_XCNT(b.x)], 1u);
    return b;
}
__device__ __forceinline__ void xcd_barrier_complete(unsigned* bar, unsigned x, unsigned& nloc, unsigned& nx) {
    const unsigned G = gridDim.x * gridDim.y * gridDim.z;
    unsigned sum, cnt, mine, sp = 0u;
    for (;;) {
        sum = 0u; cnt = 0u; mine = 0u;
#pragma unroll
        for (unsigned j = 0; j < 16; ++j) { const unsigned c = xb_ld(&bar[XB_XCNT(j)]); sum += c; cnt += (c > 0u) ? 1u : 0u; mine = (j == x) ? c : mine; }
        if (sum == G) break;
        __builtin_amdgcn_s_sleep(1);
        if ((++sp & 255u) == 0u) { if (xb_ld(&bar[XB_TMO])) break; if (sp > XB_SPIN_CAP) { atomicAdd(&bar[XB_TMO], 1u); break; } }
    }
    nloc = mine > 0u ? mine : 1u; nx = cnt > 0u ? cnt : 1u;
}
__device__ __forceinline__ void xcd_barrier(const XcdBarrier& b) {
    asm volatile("s_waitcnt vmcnt(0)" ::: "memory");
    __syncthreads();
    if (threadIdx.x == 0) {
        unsigned* bar = b.bar;
        __builtin_amdgcn_s_waitcnt(0);
        unsigned nloc = b.st[0], nx = b.st[1];
        if (nloc == 0u) { xcd_barrier_complete(bar, b.x, nloc, nx); b.st[0] = nloc; b.st[1] = nx; }
        const unsigned old = xb_add(&bar[XB_XSUB(b.x)], 1u);
        const unsigned gen = old / nloc;
        if (old + 1u == (gen + 1u) * nloc) {
            __builtin_amdgcn_fence(__ATOMIC_RELEASE, "agent");
            asm volatile("s_waitcnt vmcnt(0)" ::: "memory");
            const unsigned og = xb_add(&bar[XB_TOP], 1u);
            const unsigned tg = og / nx;
            if (og + 1u == (tg + 1u) * nx) xb_add(&bar[XB_TOPGEN], 1u);
            else XB_SPIN(xb_ld(&bar[XB_TOPGEN]) == tg, bar);
            __builtin_amdgcn_fence(__ATOMIC_ACQUIRE, "agent");
            xb_add(&bar[XB_XGEN(b.x)], 1u);
            asm volatile("s_waitcnt vmcnt(0)" ::: "memory");
        } else {
            XB_SPIN(xb_ld(&bar[XB_XGEN(b.x)]) == gen, bar);
            __builtin_amdgcn_fence(__ATOMIC_ACQUIRE, "agent");
            asm volatile("s_waitcnt vmcnt(0)" ::: "memory");
        }
    }
    __syncthreads();
}

struct Args {
    const float *x, *w_in, *conv_w, *w_conv_out, *pos_k, *w1_k, *w2_k, *pos_v, *w1_v, *w2_v, *w_attn_out, *w_o, *g_mix, *g_ffn, *w_gate, *w_up, *w_down, *g_final;
    float* out; unsigned char* ws; int probe; int pad;
};

__global__ void __launch_bounds__(512, 2) nsa_fwd(Args a) {
    extern __shared__ __attribute__((aligned(16))) unsigned char lds_raw[];
    LAS unsigned char* lds = (LAS unsigned char*)lds_raw;
    cg::grid_group grid = cg::this_grid();
    const int tid = threadIdx.x, lane = tid & 63, wave = __builtin_amdgcn_readfirstlane(tid >> 6);
    const int G = gridDim.x, bx = blockIdx.x;
    const int vcu = (G % 8 == 0) ? (bx % 8) * (G / 8) + bx / 8 : bx;
    unsigned char* ws = a.ws;
    volatile LAS unsigned* bst = (volatile LAS unsigned*)(lds + 143360);
    if (tid < 2) bst[tid] = 0u;
    __syncthreads();
    const XcdBarrier gbar = xcd_barrier_post((unsigned*)(ws + WS_BAR), bst);
#define SEAM() xcd_barrier(gbar)
    float* part1 = (float*)(ws + WS_PART1); float* part2 = (float*)(ws + WS_PART2); float* cbias = (float*)(ws + WS_BIAS);
    bf16_t* Win = (bf16_t*)(ws + WS_WIN); bf16_t* Wconv = (bf16_t*)(ws + WS_WCONV); bf16_t* Wattn = (bf16_t*)(ws + WS_WATTN); bf16_t* Wo = (bf16_t*)(ws + WS_WO);
    bf16_t* Wup = (bf16_t*)(ws + WS_WUP); bf16_t* Wdown = (bf16_t*)(ws + WS_WDOWN); bf16_t* W1 = (bf16_t*)(ws + WS_W1); bf16_t* W2 = (bf16_t*)(ws + WS_W2);
    bf16_t* hid = (bf16_t*)(ws + WS_HID); bf16_t* kcmp = (bf16_t*)(ws + WS_KCMP); bf16_t* proj = (bf16_t*)(ws + WS_PROJ);
    float* h1f = (float*)(ws + WS_H1F); bf16_t* h1b = (bf16_t*)(ws + WS_H1B); bf16_t* act = (bf16_t*)(ws + WS_ACT);
    bf16_t* nb = (bf16_t*)a.out; bf16_t* mix = (bf16_t*)a.out; bf16_t* bc = (bf16_t*)((unsigned char*)a.out + OUT_BC);

    {
        LAS float* scr = (LAS float*)(lds + wave * 16384);
        const int gw = vcu * 8 + wave, NGW = G * 8;
        constexpr int I_IN = 16 * 194, I_CONV = 8 * 32, I_ATT = 16 * 32, I_O = 16 * 32, I_G = 16 * 88, I_U = 16 * 88, I_D = 44 * 32, I_1 = 32 * 8, I_2 = 4 * 2;
        constexpr int NITEMS = I_IN + I_CONV + I_ATT + I_O + 2 * I_1 + 2 * I_2;
        for (int it = gw; it < NITEMS; it += NGW) {
            int q = it;
            if (q < I_IN) { const int kb = q / 194, nbk = q % 194, n0 = 32 * nbk; const float cs = (n0 >= C_Q && n0 < C_KC) ? QSCALE : 1.0f;
                transpose_item(a.w_in, 1024, INCOLS, Win, 1024, 64 * kb, n0, n0, a.g_mix, cs, scr, lane); continue; } q -= I_IN;
            if (q < I_CONV) { const int kb = q / 32, nbk = q % 32; transpose_item(a.w_conv_out, 512, 1024, Wconv, 512, 64 * kb, 32 * nbk, 32 * nbk, nullptr, 1.f, scr, lane); continue; } q -= I_CONV;
            if (q < I_ATT) { const int kb = q / 32, nbk = q % 32; transpose_item(a.w_attn_out, 1024, 1024, Wattn, 1024, 64 * kb, 32 * nbk, 32 * nbk, nullptr, 1.f, scr, lane); continue; } q -= I_ATT;
            if (q < I_O) { const int kb = q / 32, nbk = q % 32; transpose_item(a.w_o, 1024, 1024, Wo, 1024, 64 * kb, 32 * nbk, 32 * nbk, nullptr, 1.f, scr, lane); continue; } q -= I_O;
            if (q < I_1) { const int kb = q / 8, nbk = q % 8; transpose_item(a.w1_k, 2048, 256, W1, 2048, 64 * kb, 32 * nbk, 32 * nbk, nullptr, 1.f, scr, lane); continue; } q -= I_1;
            if (q < I_1) { const int kb = q / 8, nbk = q % 8; transpose_item(a.w1_v, 2048, 256, W1, 2048, 64 * kb, 32 * nbk, 256 + 32 * nbk, nullptr, 1.f, scr, lane); continue; } q -= I_1;
            if (q < I_2) { const int kb = q / 2, nbk = q % 2; transpose_item(a.w2_k, 256, 64, W2, 256, 64 * kb, 32 * nbk, 32 * nbk, nullptr, 1.f, scr, lane); continue; } q -= I_2;
            { const int kb = q / 2, nbk = q % 2; transpose_item(a.w2_v, 256, 64, W2, 256, 64 * kb, 32 * nbk, 256 + 32 * nbk, nullptr, 1.f, scr, lane); }
        }
        const int gt = vcu * 512 + tid, NGT = G * 512;
        for (int i = gt; i < 192 * 1024 / 8; i += NGT) *(u32x4*)(Win + (size_t)6208 * 1024 + (size_t)i * 8) = (u32x4){0u, 0u, 0u, 0u};
        for (int i = gt; i < 2 * 192 * 256 / 8; i += NGT) { const int half = i / (192 * 256 / 8), o = i % (192 * 256 / 8);
            *(u32x4*)(W2 + (size_t)(half * 256 + 64) * 256 + (size_t)o * 8) = (u32x4){0u, 0u, 0u, 0u}; }
        for (int m = gw; m < MTOK; m += NGW) {
            const f32x4* xr = (const f32x4*)(a.x + (size_t)m * DM) + lane; f32x4 v[4]; float s = 0.f;
#pragma unroll
            for (int j = 0; j < 4; ++j) { v[j] = xr[64 * j]; s += (v[j][0] * v[j][0] + v[j][1] * v[j][1]) + (v[j][2] * v[j][2] + v[j][3] * v[j][3]); }
            const float rstd = __builtin_amdgcn_rsqf(wave_sum(s) * (1.0f / DM) + EPS);
            u32x2* o8 = (u32x2*)(nb + (size_t)m * DM) + lane;
#pragma unroll
            for (int j = 0; j < 4; ++j) { u32x2 w; w.x = pk2(v[j][0] * rstd, v[j][1] * rstd); w.y = pk2(v[j][2] * rstd, v[j][3] * rstd); o8[64 * j] = w; }
        }
        if (bx < 2) {
            const float* pos = bx ? a.pos_v : a.pos_k; const float* w1 = bx ? a.w1_v : a.w1_k;
            const int j = tid & 255, part = tid >> 8; float s = 0.f;
            for (int k = part * 1024; k < part * 1024 + 1024; ++k) s += pos[k] * w1[(size_t)k * 256 + j];
            LAS float* red = (LAS float*)(lds + 8 * 16384);
            if (part == 1) red[j] = s;
            __syncthreads();
            if (part == 0) cbias[bx * 256 + j] = s + red[j];
        }
    }
    if (a.probe == 0x7fffffff) grid.sync();
    SEAM();
    {
        const int ncols1 = (G > 64) ? 6144 : PP;
        pg8::Gemm g{nb, Win, MTOK, ncols1, DM, DM, 128, 0}; pg8::StaticOrder S; S.init(MTOK, ncols1, G, bx);
        pg8::EpiProj E{proj, PP};
        pg8::gemm_phase(lds, g, S, E);
    }
    SEAM();
    {
        {
            pg8::Gemm g{proj + C_KC, W1, 4096, 512, 2048, 16 * PP, PP * 2, 1}; pg8::StaticOrder S; S.init(4096, 512, G, bx);
            pg8::EpiHid E{hid, cbias};
            pg8::gemm_phase(lds, g, S, E);
        }
        int wb = bx, wn = G; if (G > 64) { wb = bx - 32; wn = G - 32; }
        if (wb >= 0) {
            for (int it = wb * 512 + tid; it < MTOK * 64; it += wn * 512) {
                const int row = it >> 6, ch = (it & 63) * 8, t = row & (SEQ - 1);
                const bf16_t* pr = proj + (size_t)row * PP;
                float accv[8];
#pragma unroll
                for (int j = 0; j < 8; ++j) accv[j] = 0.f;
#pragma unroll
                for (int k = 0; k < 3; ++k) { const int dt = 2 - k;
                    if (t - dt >= 0) { const u32x4 cv = *(const u32x4*)(pr - (size_t)dt * PP + C_C + ch), hv = *(const u32x4*)(pr - (size_t)dt * PP + C_H + ch);
                        const f32x4 w0 = *(const f32x4*)(a.conv_w + k * 512 + ch), w1 = *(const f32x4*)(a.conv_w + k * 512 + ch + 4);
                        accv[0] += w0[0] * lo_bf(cv.x) * lo_bf(hv.x); accv[1] += w0[1] * hi_bf(cv.x) * hi_bf(hv.x); accv[2] += w0[2] * lo_bf(cv.y) * lo_bf(hv.y); accv[3] += w0[3] * hi_bf(cv.y) * hi_bf(hv.y);
                        accv[4] += w1[0] * lo_bf(cv.z) * lo_bf(hv.z); accv[5] += w1[1] * hi_bf(cv.z) * hi_bf(hv.z); accv[6] += w1[2] * lo_bf(cv.w) * lo_bf(hv.w); accv[7] += w1[3] * hi_bf(cv.w) * hi_bf(hv.w); } }
                const u32x4 bv = *(const u32x4*)(pr + C_B + ch);
                u32x4 o; o.x = pk2(accv[0] * lo_bf(bv.x), accv[1] * hi_bf(bv.x)); o.y = pk2(accv[2] * lo_bf(bv.y), accv[3] * hi_bf(bv.y));
                o.z = pk2(accv[4] * lo_bf(bv.z), accv[5] * hi_bf(bv.z)); o.w = pk2(accv[6] * lo_bf(bv.w), accv[7] * hi_bf(bv.w));
                *(u32x4*)(bc + (size_t)row * 512 + ch) = o;
            }
        }
        if (G > 64 && wb >= 0) {
            { pg8::Gemm g{nb, Win + (size_t)6144 * 1024, MTOK, 256, DM, DM, 128, 0}; pg8::StaticOrder S; S.init(MTOK, 256, wn, wb);
              pg8::EpiProj E{proj + 6144, PP}; pg8::gemm_phase(lds, g, S, E); }
            __syncthreads();
            LAS float* scr = (LAS float*)(lds + wave * 16384);
            constexpr int I_G = 16 * 88, I_U = 16 * 88, I_D = 44 * 32;
            for (int it = wb * 8 + wave; it < I_G + I_U + I_D; it += wn * 8) {
                int q = it;
                if (q < I_G) { const int kb = q / 88, nbk = q % 88, n0 = 32 * nbk; transpose_item(a.w_gate, 1024, DFF, Wup, 1024, 64 * kb, n0, (n0 / 128) * 256 + (n0 % 128), a.g_ffn, 1.f, scr, lane); continue; } q -= I_G;
                if (q < I_U) { const int kb = q / 88, nbk = q % 88, n0 = 32 * nbk; transpose_item(a.w_up, 1024, DFF, Wup, 1024, 64 * kb, n0, (n0 / 128) * 256 + 128 + (n0 % 128), a.g_ffn, 1.f, scr, lane); continue; } q -= I_U;
                { const int kb = q / 32, nbk = q % 32; transpose_item(a.w_down, DFF, 1024, Wdown, DFF, 64 * kb, 32 * nbk, 32 * nbk, nullptr, 1.f, scr, lane); }
            }
        }
    }
    {
        pg8::Gemm g{hid, W2, 4096, 512, 256, 256, 128, 2}; pg8::StaticOrder S; S.init(4096, 512, G, bx);
        pg8::EpiCmp E{kcmp};
        pg8::gemm_phase(lds, g, S, E);
    }
    SEAM();
    {
        for (int v = vcu; v < 256; v += G) {
            const int bh = v >> 4, s = v & 15;
#pragma unroll 1
            for (int i = 0; i < 4; ++i) { const int qb = (i == 0) ? 63 - s : (i == 1) ? 32 + s : (i == 2) ? 31 - s : s;
#if defined(PROBE_ATT2) || defined(PROBE_NOLD)
                att::attn_unit(lds, proj, kcmp, kcmp + 4096 * 64, bh, qb, a.probe);
#endif
                att::attn_unit(lds, proj, kcmp, kcmp + 4096 * 64, bh, qb, 0);
            }
        }
    }
    SEAM();
    {
        { pg8::Gemm g{bc, Wconv, MTOK, DM, 512, 512, 128, 0}; pg8::StaticOrder S; S.init(MTOK, DM, G, bx);
          pg8::EpiMix<0> E{mix, proj, C_GCONV}; pg8::gemm_phase(lds, g, S, E); }
        { pg8::Gemm g{proj + C_Q, Wattn, MTOK, DM, DM, PP, 128, 0}; pg8::StaticOrder S; S.init(MTOK, DM, G, bx);
          pg8::EpiMix<1> E{mix, proj, C_GATTN}; pg8::gemm_phase(lds, g, S, E); }
    }
    SEAM();
    {
        pg8::Gemm g{mix, Wo, MTOK, DM, DM, DM, 128, 0}; pg8::StaticOrder S; S.init(MTOK, DM, G, bx);
        pg8::EpiRes<1> E{a.x, h1f, h1b, part1}; pg8::gemm_phase(lds, g, S, E);
    }
    SEAM();
    {
        pg8::Gemm g{h1b, Wup, MTOK, 2 * DFF, DM, DM, 128, 0}; pg8::StaticOrder S; S.init(MTOK, 2 * DFF, G, bx);
        pg8::EpiUp E{act, part1}; pg8::gemm_phase(lds, g, S, E);
    }
    SEAM();
    if (G == 256) {
        pg8::Gemm g{act, Wdown, MTOK, DM, DFF, DFF, 128, 0}; pg8::StaticOrder S; S.init(MTOK, DM, G, bx);
        pg8::EpiFinal E{h1f, a.out, a.g_final, (unsigned*)part2, (unsigned*)(ws + WS_BAR) + 4096, (unsigned*)(ws + WS_BAR) + XB_TMO};
        pg8::gemm_phase(lds, g, S, E);
        return;
    }
    {
        pg8::Gemm g{act, Wdown, MTOK, DM, DFF, DFF, 128, 0}; pg8::StaticOrder S; S.init(MTOK, DM, G, bx);
        pg8::EpiRes<0> E{h1f, a.out, nullptr, part2}; pg8::gemm_phase(lds, g, S, E);
    }
    SEAM();
    {
        for (int it = bx * 512 + tid; it < MTOK * 256; it += G * 512) {
            const int row = it >> 8, c4 = (it & 255) * 4;
            const f32x4* pp = (const f32x4*)(part2 + (size_t)row * 16); float ss = 0.f;
#pragma unroll
            for (int j = 0; j < 4; ++j) { const f32x4 p = pp[j]; ss += (p[0] + p[1]) + (p[2] + p[3]); }
            const float r = __builtin_amdgcn_rsqf(ss * (1.0f / DM) + EPS);
            f32x4 v = *(f32x4*)(a.out + (size_t)row * DM + c4); const f32x4 gf = *(const f32x4*)(a.g_final + c4);
            v = v * r * gf; *(f32x4*)(a.out + (size_t)row * DM + c4) = v;
        }
    }
}

extern "C" void kernel_launch(void* const* d_in, const int* in_sizes, int n_in, void* d_out, int out_size, void* d_ws, size_t ws_size, hipStream_t stream) {
    static int grid = 0;
    if (grid == 0) {
        if (n_in != 18 || out_size != MTOK * DM || ws_size < WS_NEED) { fprintf(stderr, "kernel_launch: unexpected shapes (n_in %d out %d ws %zu)\n", n_in, out_size, ws_size); grid = -1; return; }
        int dev = 0, cus = 0, per_cu = 0;
        (void)hipGetDevice(&dev);
        (void)hipDeviceGetAttribute(&cus, hipDeviceAttributeMultiprocessorCount, dev);
        (void)hipFuncSetAttribute((const void*)nsa_fwd, hipFuncAttributeMaxDynamicSharedMemorySize, LDS_BYTES);
        (void)hipOccupancyMaxActiveBlocksPerMultiprocessor(&per_cu, (const void*)nsa_fwd, 512, LDS_BYTES);
        if (per_cu < 1) { fprintf(stderr, "kernel_launch: occupancy query says %d blocks/CU\n", per_cu); grid = -1; return; }
        grid = cus;
    }
    if (grid < 0) return;
    (void)hipMemsetAsync((unsigned char*)d_ws + WS_BAR, 0, 32768, stream);
    Args a{};
    a.x = (const float*)d_in[0]; a.w_in = (const float*)d_in[1]; a.conv_w = (const float*)d_in[2]; a.w_conv_out = (const float*)d_in[3];
    a.pos_k = (const float*)d_in[4]; a.w1_k = (const float*)d_in[5]; a.w2_k = (const float*)d_in[6];
    a.pos_v = (const float*)d_in[7]; a.w1_v = (const float*)d_in[8]; a.w2_v = (const float*)d_in[9];
    a.w_attn_out = (const float*)d_in[10]; a.w_o = (const float*)d_in[11]; a.g_mix = (const float*)d_in[12]; a.g_ffn = (const float*)d_in[13];
    a.w_gate = (const float*)d_in[14]; a.w_up = (const float*)d_in[15]; a.w_down = (const float*)d_in[16]; a.g_final = (const float*)d_in[17];
    a.out = (float*)d_out; a.ws = (unsigned char*)d_ws; a.probe = 1; a.pad = 0;
    void* args[] = {&a};
    hipError_t e = hipLaunchCooperativeKernel((void*)nsa_fwd, dim3(grid), dim3(512), args, LDS_BYTES, stream);
    if (e != hipSuccess) fprintf(stderr, "kernel_launch: cooperative launch failed: %s (grid %d)\n", hipGetErrorString(e), grid);
}
```

```cpp
#include <hip/hip_runtime.h>
#include <hip/hip_cooperative_groups.h>
#include <cstdio>
#include <cstdint>
namespace cg = cooperative_groups;

#define LAS __attribute__((address_space(3)))
typedef unsigned short bf16_t;
typedef short bf16x8 __attribute__((ext_vector_type(8)));
typedef short s16x4 __attribute__((ext_vector_type(4)));
typedef float f32x4 __attribute__((ext_vector_type(4)));
typedef float f32x16 __attribute__((ext_vector_type(16)));
typedef unsigned u32x4 __attribute__((ext_vector_type(4)));
typedef unsigned u32x2 __attribute__((ext_vector_type(2)));
typedef float f32x2_t __attribute__((ext_vector_type(2)));
typedef __bf16 bf16x2_t __attribute__((ext_vector_type(2)));

constexpr int MTOK = 16384, DM = 1024, SEQ = 4096, NB = 4;
constexpr int PP = 6400;
constexpr int INCOLS = 6192;
constexpr int C_B = 0, C_C = 512, C_H = 1024, C_Q = 1536, C_KC = 2560, C_VC = 2816, C_KS = 3072, C_VS = 3328, C_KW = 3584, C_VW = 3840,
              C_GBR = 4096, C_GCONV = 4144, C_GATTN = 5168;
constexpr int DFF = 2816;
constexpr float EPS = 1e-6f;
constexpr float LOG2E = 1.4426950408889634f;
constexpr float QSCALE = 0.125f * LOG2E;

constexpr size_t MiB = 1u << 20;
constexpr size_t WS_PART1 = 0;
constexpr size_t WS_PART2 = 1 * MiB;
constexpr size_t WS_BIAS = 2 * MiB;
constexpr size_t WS_BAR = 2 * MiB + 65536;
constexpr size_t WS_WIN = 3 * MiB;
constexpr size_t WS_WCONV = 16 * MiB;
constexpr size_t WS_WATTN = 17 * MiB;
constexpr size_t WS_WO = 19 * MiB;
constexpr size_t WS_WUP = 21 * MiB;
constexpr size_t WS_WDOWN = 32 * MiB;
constexpr size_t WS_W1 = 38 * MiB;
constexpr size_t WS_W2 = 40 * MiB;
constexpr size_t WS_HID = 41 * MiB;
constexpr size_t WS_KCMP = 45 * MiB;
constexpr size_t WS_PROJ = 46 * MiB;
constexpr size_t WS_H1F = 46 * MiB;
constexpr size_t WS_H1B = 110 * MiB;
constexpr size_t WS_ACT = 142 * MiB;
constexpr size_t WS_NEED = 246 * MiB;
constexpr size_t OUT_BC = 32 * MiB;

constexpr int LDS_BYTES = 147456;

__device__ __forceinline__ float bf2f(unsigned short v) { return __uint_as_float(((unsigned)v) << 16); }
__device__ __forceinline__ unsigned pk2(float lo, float hi) { f32x2_t v = {lo, hi}; bf16x2_t b = __builtin_convertvector(v, bf16x2_t); return __builtin_bit_cast(unsigned, b); }
__device__ __forceinline__ float ex2(float x) { return __builtin_amdgcn_exp2f(x); }
__device__ __forceinline__ float sigmoidf_(float x) { return __builtin_amdgcn_rcpf(1.0f + ex2(-x * LOG2E)); }
__device__ __forceinline__ float lo_bf(unsigned w) { return __uint_as_float(w << 16); }
__device__ __forceinline__ float hi_bf(unsigned w) { return __uint_as_float(w & 0xffff0000u); }

namespace pg8 {
constexpr int BM = 256, BK = 64, HALF = 128, HTB = HALF * BK * 2, STAGE_BYTES = 8 * HTB, NXCD = 8, WGM = 8;
__host__ __device__ __forceinline__ int lds_byte(int r, int c) { const int st = (r >> 4) * 2 + (c >> 5), rr = r & 15, cc = c & 31, ob = rr * 64 + cc * 2; return st * 1024 + (ob ^ (((ob >> 9) & 1) << 5)); }
__host__ __device__ __forceinline__ void stage_rc(int b, int& R, int& C) { const int st = b / 1024, sb = b % 1024, swz = sb ^ (((sb >> 9) & 1) << 5); R = (st >> 1) * 16 + swz / 64; C = (st & 1) * 32 + (swz % 64) / 2; }
__host__ __device__ __forceinline__ int perm32(int rho) { const int n = rho >> 4, i = rho & 15; return 8 * (i >> 2) + 4 * n + (i & 3); }

struct Unit { int pm, pn; };
struct Gemm { const bf16_t* A; const bf16_t* Bt; int M, N, K; int lda; int a_kstep; int amode; };

struct StaticOrder {
    int nM, nN, nwg, G, c;
    __host__ __device__ void init(int M, int N, int G_, int c_) { nM = M / BM; nN = N / BM; nwg = nM * nN; G = G_; c = c_; }
    __host__ __device__ bool next(int i, Unit& u) const {
        const long L = (long)i * G + c; if (L >= nwg) return false;
        int wgid = (int)L; { const int q = nwg / NXCD, r = nwg % NXCD, xcd = wgid % NXCD, off = wgid / NXCD; wgid = (xcd < r ? xcd * (q + 1) : r * (q + 1) + (xcd - r) * q) + off; }
        const int nig = WGM * nN, gid = wgid / nig, fm = gid * WGM, gsz = (nM - fm) < WGM ? (nM - fm) : WGM;
        u.pm = fm + ((wgid % nig) % gsz); u.pn = (wgid % nig) / gsz; return true;
    }
};

__device__ __forceinline__ const char* a_tile(const Gemm& g, const Unit& u) {
    if (g.amode == 1) return (const char*)g.A + ((size_t)(u.pm >> 2) * SEQ * PP + (size_t)u.pn * 256 + (size_t)(u.pm & 3) * 64) * 2;
    if (g.amode == 2) return (const char*)g.A + ((size_t)u.pn * 4096 * 256 + (size_t)u.pm * 256 * 256) * 2;
    return (const char*)g.A + (size_t)u.pm * 256 * (size_t)g.lda * 2;
}

template <class T, class = void> struct is_fused { static constexpr bool value = false; };
template <class T> struct is_fused<T, decltype((void)T::FUSED)> { static constexpr bool value = true; };
template <class Epi>
__device__ __forceinline__ void gemm_phase(LAS unsigned char* lds, const Gemm g, const StaticOrder& S, const Epi& E) {
#ifdef NO_GEMM
    return;
#endif
    int tid_ = threadIdx.x; asm volatile("" : "+v"(tid_));
    const int tid = tid_, wid = __builtin_amdgcn_readfirstlane(tid >> 6), lane = tid & 63, wr = wid >> 2, wc = wid & 3, fr = lane & 15, fq = lane >> 4;
    const int K = g.K, nt = K / BK;
    unsigned voffA[2], voffB[2];
#pragma unroll
    for (int i = 0; i < 2; ++i) { int R, C; stage_rc(tid * 16 + i * 8192, R, C); const int Rb = (R & ~31) + perm32(R & 31);
        voffA[i] = (unsigned)(R * g.lda + C) * 2u; voffB[i] = (unsigned)(Rb * K + C) * 2u; }
    const size_t kstepA = (size_t)g.a_kstep, kstepB = (size_t)(BK * 2);
    const size_t hstepA = (size_t)HALF * g.lda * 2, hstepB = (size_t)HALF * K * 2;
    const size_t tstepB = 2 * hstepB;
    const unsigned ldsw = (unsigned)wid * 1024u;
    const int aoff = lds_byte(wr * 64 + fr, fq * 8), boff = lds_byte(wc * 32 + fr, fq * 8);
#define PG8_SA(b, h) (((b) * 2 + (h)) * HTB)
#define PG8_SB(b, h) ((4 + (b) * 2 + (h)) * HTB)
#define PG8_STAGE(bufoff, gbase, voff) do { _Pragma("unroll") for (int _i = 0; _i < 2; ++_i) \
        __builtin_amdgcn_global_load_lds((const unsigned*)((const char*)(gbase) + (voff)[_i]), (LAS unsigned*)(lds + (bufoff) + ldsw + _i * 8192), 16, 0, 0); } while (0)
#define PG8_LDA(dst, b, h) do { _Pragma("unroll") for (int m = 0; m < 4; ++m) _Pragma("unroll") for (int k = 0; k < 2; ++k) dst[m][k] = *(const LAS bf16x8*)(lds + PG8_SA(b, h) + aoff + m * 2048 + k * 1024); } while (0)
#define PG8_LDB(dst, b, h) do { _Pragma("unroll") for (int n = 0; n < 2; ++n) _Pragma("unroll") for (int k = 0; k < 2; ++k) dst[n][k] = *(const LAS bf16x8*)(lds + PG8_SB(b, h) + boff + n * 2048 + k * 1024); } while (0)
#define PG8_MMA(ai, bj, At, Bt) do { __builtin_amdgcn_s_setprio(1); _Pragma("unroll") for (int m = 0; m < 4; ++m) _Pragma("unroll") for (int n = 0; n < 2; ++n) _Pragma("unroll") for (int k = 0; k < 2; ++k) \
        acc[ai][bj][m][n] = __builtin_amdgcn_mfma_f32_16x16x32_bf16(Bt[n][k], At[m][k], acc[ai][bj][m][n], 0, 0, 0); __builtin_amdgcn_s_setprio(0); } while (0)
#define PG8_WAIT_V(n) asm volatile("s_waitcnt vmcnt(" #n ")" ::: "memory")
#define PG8_WAIT_L(n) asm volatile("s_waitcnt lgkmcnt(" #n ")" ::: "memory")
#define PG8_BAR __builtin_amdgcn_s_barrier()
#define PG8_SCHED __builtin_amdgcn_sched_barrier(0)
    Unit cur, nxt; int ui = 0;
    if (!S.next(0, cur)) return;
    f32x4 acc[2][2][4][2];
#pragma unroll
    for (int a = 0; a < 2; ++a)
#pragma unroll
        for (int b = 0; b < 2; ++b)
#pragma unroll
            for (int m = 0; m < 4; ++m)
#pragma unroll
                for (int n = 0; n < 2; ++n) acc[a][b][m][n] = (f32x4){0.f, 0.f, 0.f, 0.f};
    bf16x8 At[4][2], B0[2][2], B1[2][2];
    const char* cA = a_tile(g, cur); const char* cB = (const char*)g.Bt + (size_t)cur.pn * tstepB;
    PG8_STAGE(PG8_SB(0, 0), cB, voffB); PG8_STAGE(PG8_SB(0, 1), cB + hstepB, voffB); PG8_STAGE(PG8_SA(0, 0), cA, voffA); PG8_STAGE(PG8_SA(0, 1), cA + hstepA, voffA);
    if (wr == 1) PG8_BAR;
    PG8_WAIT_V(2); PG8_BAR;
    PG8_STAGE(PG8_SB(1, 0), cB + kstepB, voffB); PG8_STAGE(PG8_SA(1, 0), cA + kstepA, voffA); PG8_STAGE(PG8_SB(1, 1), cB + hstepB + kstepB, voffB);
    PG8_WAIT_V(6); PG8_BAR;
    for (;;) {
        const bool has_next = S.next(ui + 1, nxt);
        const char* nA = has_next ? a_tile(g, nxt) : cA; const char* nB = has_next ? (const char*)g.Bt + (size_t)nxt.pn * tstepB : cB;
        for (int t = 0; t < nt; t += 2) {
            const bool last = (t == nt - 2);
            const char* a1 = cA + (size_t)(t + 1) * kstepA;
            const char* a2 = last ? nA : cA + (size_t)(t + 2) * kstepA; const char* b2 = last ? nB : cB + (size_t)(t + 2) * kstepB;
            const char* a3 = a2 + kstepA; const char* b3 = b2 + kstepB;
            PG8_LDB(B0, 0, 0); PG8_LDB(B1, 0, 1); PG8_SCHED; PG8_LDA(At, 0, 0); PG8_STAGE(PG8_SA(1, 1), a1 + hstepA, voffA);
            PG8_WAIT_V(8); PG8_WAIT_L(0); PG8_BAR; PG8_MMA(0, 0, At, B0); PG8_MMA(0, 1, At, B1); PG8_BAR; PG8_SCHED;
            PG8_LDA(At, 0, 1); PG8_STAGE(PG8_SB(0, 0), b2, voffB); PG8_STAGE(PG8_SB(0, 1), b2 + hstepB, voffB); PG8_STAGE(PG8_SA(0, 0), a2, voffA);
            PG8_WAIT_V(8); PG8_WAIT_L(0); PG8_BAR; PG8_MMA(1, 0, At, B0); PG8_MMA(1, 1, At, B1); PG8_BAR; PG8_SCHED;
            PG8_LDB(B0, 1, 0); PG8_LDB(B1, 1, 1); PG8_SCHED; PG8_LDA(At, 1, 0); PG8_STAGE(PG8_SA(0, 1), a2 + hstepA, voffA);
            PG8_WAIT_V(8); PG8_WAIT_L(0); PG8_BAR; PG8_MMA(0, 0, At, B0); PG8_MMA(0, 1, At, B1); PG8_BAR; PG8_SCHED;
            PG8_LDA(At, 1, 1); PG8_STAGE(PG8_SB(1, 0), b3, voffB); PG8_STAGE(PG8_SB(1, 1), b3 + hstepB, voffB); PG8_STAGE(PG8_SA(1, 0), a3, voffA);
            PG8_WAIT_V(8); PG8_WAIT_L(0); PG8_BAR; PG8_MMA(1, 0, At, B0); PG8_MMA(1, 1, At, B1); PG8_BAR; PG8_SCHED;
        }
        if (wr == 0) PG8_BAR;
        if constexpr (!is_fused<Epi>::value) E(acc, cur, wr, wc, fr, fq);
        if (!has_next) break;
#pragma unroll
        for (int a = 0; a < 2; ++a)
#pragma unroll
            for (int b = 0; b < 2; ++b)
#pragma unroll
                for (int m = 0; m < 4; ++m)
#pragma unroll
                    for (int n = 0; n < 2; ++n) acc[a][b][m][n] = (f32x4){0.f, 0.f, 0.f, 0.f};
        cur = nxt; cA = nA; cB = nB; ++ui;
        if (wr == 1) PG8_BAR;
    }
    PG8_WAIT_V(0);
    PG8_BAR;
    if constexpr (is_fused<Epi>::value) E.fused(acc, cur, wr, wc, fr, fq, lds, wid, lane);
#undef PG8_SA
#undef PG8_SB
#undef PG8_STAGE
#undef PG8_LDA
#undef PG8_LDB
#undef PG8_MMA
#undef PG8_WAIT_V
#undef PG8_WAIT_L
#undef PG8_BAR
#undef PG8_SCHED
}

typedef f32x4 Acc[2][2][4][2];
#define EPI_LOOP_BEGIN \
    _Pragma("unroll") for (int ai = 0; ai < 2; ++ai) _Pragma("unroll") for (int m = 0; m < 4; ++m) { const int row = u.pm * BM + wr * 64 + fr + ai * HALF + m * 16; \
    _Pragma("unroll") for (int bj = 0; bj < 2; ++bj) { const f32x4 v0 = acc[ai][bj][m][0], v1 = acc[ai][bj][m][1]; const int col = u.pn * BM + bj * HALF + wc * 32 + 8 * fq;
#define EPI_LOOP_END } }
__device__ __forceinline__ u32x4 pack8(const f32x4 a, const f32x4 b) { u32x4 w; w.x = pk2(a[0], a[1]); w.y = pk2(a[2], a[3]); w.z = pk2(b[0], b[1]); w.w = pk2(b[2], b[3]); return w; }

struct EpiProj { bf16_t* O; int ldc;
    __device__ __forceinline__ void operator()(const Acc& acc, const Unit& u, int wr, int wc, int fr, int fq) const {
        EPI_LOOP_BEGIN
            *(u32x4*)(O + (size_t)row * ldc + col) = pack8(v0, v1);
        EPI_LOOP_END
    } };
__device__ __forceinline__ float gelu_tanh(float x) {
    const float z = x * (1.0f + 0.044715f * x * x) * (2.0f * 0.7978845608028654f * LOG2E);
    return x * __builtin_amdgcn_rcpf(1.0f + ex2(-z));
}
struct EpiHid { bf16_t* O; const float* bias;
    __device__ __forceinline__ void operator()(const Acc& acc, const Unit& u, int wr, int wc, int fr, int fq) const {
        EPI_LOOP_BEGIN
            const int c = col - u.pn * BM; const float* bp = bias + u.pn * 256 + c;
            const f32x4 b0 = *(const f32x4*)bp, b1 = *(const f32x4*)(bp + 4);
            f32x4 a = v0 + b0, b = v1 + b1;
#pragma unroll
            for (int j = 0; j < 4; ++j) { a[j] = gelu_tanh(a[j]); b[j] = gelu_tanh(b[j]); }
            *(u32x4*)(O + (size_t)u.pn * 4096 * 256 + (size_t)row * 256 + c) = pack8(a, b);
        EPI_LOOP_END
    } };
struct EpiCmp { bf16_t* O;
    __device__ __forceinline__ void operator()(const Acc& acc, const Unit& u, int wr, int wc, int fr, int fq) const {
        EPI_LOOP_BEGIN
            const int c = col - u.pn * BM;
            if (c < 64) { u32x4 w = pack8(v0, v1); if ((row & 255) == 255) w = (u32x4){0u, 0u, 0u, 0u};
                *(u32x4*)(O + (size_t)u.pn * 4096 * 64 + (size_t)row * 64 + c) = w; }
        EPI_LOOP_END
    } };
template <int ADD> struct EpiMix { bf16_t* mix; const bf16_t* proj; int gcol;
    __device__ __forceinline__ void operator()(const Acc& acc, const Unit& u, int wr, int wc, int fr, int fq) const {
        EPI_LOOP_BEGIN
            const u32x4 gv = *(const u32x4*)(proj + (size_t)row * PP + gcol + col);
            f32x4 a, b;
            a[0] = sigmoidf_(lo_bf(gv.x)) * v0[0]; a[1] = sigmoidf_(hi_bf(gv.x)) * v0[1]; a[2] = sigmoidf_(lo_bf(gv.y)) * v0[2]; a[3] = sigmoidf_(hi_bf(gv.y)) * v0[3];
            b[0] = sigmoidf_(lo_bf(gv.z)) * v1[0]; b[1] = sigmoidf_(hi_bf(gv.z)) * v1[1]; b[2] = sigmoidf_(lo_bf(gv.w)) * v1[2]; b[3] = sigmoidf_(hi_bf(gv.w)) * v1[3];
            bf16_t* mp = mix + (size_t)row * DM + col;
            if (ADD) { const u32x4 pv = *(const u32x4*)mp;
                a[0] += lo_bf(pv.x); a[1] += hi_bf(pv.x); a[2] += lo_bf(pv.y); a[3] += hi_bf(pv.y); b[0] += lo_bf(pv.z); b[1] += hi_bf(pv.z); b[2] += lo_bf(pv.w); b[3] += hi_bf(pv.w); }
            *(u32x4*)mp = pack8(a, b);
        EPI_LOOP_END
    } };
template <int WB> struct EpiRes { const float* base; float* hf; bf16_t* hb; float* part;
    __device__ __forceinline__ void operator()(const Acc& acc, const Unit& u, int wr, int wc, int fr, int fq) const {
#pragma unroll
        for (int ai = 0; ai < 2; ++ai)
#pragma unroll
            for (int m = 0; m < 4; ++m) { const int row = u.pm * BM + wr * 64 + fr + ai * HALF + m * 16; float ss = 0.f;
#pragma unroll
                for (int bj = 0; bj < 2; ++bj) { const int col = u.pn * BM + bj * HALF + wc * 32 + 8 * fq; const size_t off = (size_t)row * DM + col;
                    const f32x4 x0 = *(const f32x4*)(base + off), x1 = *(const f32x4*)(base + off + 4);
                    const f32x4 a = x0 + acc[ai][bj][m][0], b = x1 + acc[ai][bj][m][1];
                    *(f32x4*)(hf + off) = a; *(f32x4*)(hf + off + 4) = b;
                    if (WB) *(u32x4*)(hb + off) = pack8(a, b);
                    ss += (a[0] * a[0] + a[1] * a[1]) + (a[2] * a[2] + a[3] * a[3]) + (b[0] * b[0] + b[1] * b[1]) + (b[2] * b[2] + b[3] * b[3]); }
                ss += __shfl_xor(ss, 16); ss += __shfl_xor(ss, 32);
                if (fq == 0) part[(size_t)row * 16 + u.pn * 4 + wc] = ss; }
    } };
struct EpiUp { bf16_t* act; const float* part;
    __device__ __forceinline__ void operator()(const Acc& acc, const Unit& u, int wr, int wc, int fr, int fq) const {
#pragma unroll
        for (int ai = 0; ai < 2; ++ai)
#pragma unroll
            for (int m = 0; m < 4; ++m) { const int row = u.pm * BM + wr * 64 + fr + ai * HALF + m * 16;
                const f32x4 pp = *(const f32x4*)(part + (size_t)row * 16 + 4 * fq); float ss = (pp[0] + pp[1]) + (pp[2] + pp[3]);
                ss += __shfl_xor(ss, 16); ss += __shfl_xor(ss, 32);
                const float r = __builtin_amdgcn_rsqf(ss * (1.0f / DM) + EPS);
                f32x4 a, b;
#pragma unroll
                for (int j = 0; j < 4; ++j) { const float g0 = acc[ai][0][m][0][j] * r, u0 = acc[ai][1][m][0][j] * r, g1 = acc[ai][0][m][1][j] * r, u1 = acc[ai][1][m][1][j] * r;
                    a[j] = g0 * sigmoidf_(g0) * u0; b[j] = g1 * sigmoidf_(g1) * u1; }
                *(u32x4*)(act + (size_t)row * DFF + u.pn * 128 + wc * 32 + 8 * fq) = pack8(a, b); }
    } };
struct EpiFinal { static constexpr bool FUSED = true;
    const float* base; float* out; const float* gfin; unsigned* xbuf; unsigned* cnt; unsigned* tmo;
    __device__ __forceinline__ void operator()(const Acc&, const Unit&, int, int, int, int) const {}
    __device__ __forceinline__ void fused(f32x4 (&acc)[2][2][4][2], const Unit& u, int wr, int wc, int fr, int fq, LAS unsigned char* lds, int wid, int lane) const {
        LAS float* P = (LAS float*)lds;
        LAS float* S = (LAS float*)(lds + 8192);
        LAS unsigned* flag = (LAS unsigned*)(lds + 8192 + 2048);
#pragma unroll
        for (int ai = 0; ai < 2; ++ai)
#pragma unroll
            for (int m = 0; m < 4; ++m) { const int rl = ai * HALF + wr * 64 + m * 16 + fr; const int row = u.pm * BM + rl; float ss = 0.f;
#pragma unroll
                for (int bj = 0; bj < 2; ++bj) { const int col = u.pn * BM + bj * HALF + wc * 32 + 8 * fq; const size_t off = (size_t)row * DM + col;
                    const f32x4 x0 = *(const f32x4*)(base + off), x1 = *(const f32x4*)(base + off + 4);
                    const f32x4 a = x0 + acc[ai][bj][m][0], b = x1 + acc[ai][bj][m][1]; acc[ai][bj][m][0] = a; acc[ai][bj][m][1] = b;
                    ss += (a[0] * a[0] + a[1] * a[1]) + (a[2] * a[2] + a[3] * a[3]) + (b[0] * b[0] + b[1] * b[1]) + (b[2] * b[2] + b[3] * b[3]); }
                ss += __shfl_xor(ss, 16); ss += __shfl_xor(ss, 32);
                if (fq == 0) P[rl * 4 + wc] = ss; }
        asm volatile("s_waitcnt lgkmcnt(0)" ::: "memory"); __builtin_amdgcn_s_barrier(); asm volatile("" ::: "memory");
        const int rl = wid * 32 + (lane & 31);
        if (lane < 32) { const float tot = (P[rl * 4 + 0] + P[rl * 4 + 1]) + (P[rl * 4 + 2] + P[rl * 4 + 3]);
            __hip_atomic_store(xbuf + ((size_t)(u.pm * BM + rl) * 4 + u.pn), __float_as_uint(tot), __ATOMIC_RELAXED, __HIP_MEMORY_SCOPE_AGENT); }
        asm volatile("s_waitcnt vmcnt(0)" ::: "memory");
        if (lane == 0) __hip_atomic_fetch_add(cnt + 64 * u.pm, 1u, __ATOMIC_RELAXED, __HIP_MEMORY_SCOPE_AGENT);
        if (wid == 0) {
            unsigned sp = 0u;
            for (;;) {
                if ((unsigned)__builtin_amdgcn_readfirstlane(__hip_atomic_load(cnt + 64 * u.pm, __ATOMIC_RELAXED, __HIP_MEMORY_SCOPE_AGENT)) >= 32u) break;
                __builtin_amdgcn_s_sleep(2);
                if (++sp > (1u << 20)) { if (lane == 0) __hip_atomic_store(tmo, 1u, __ATOMIC_RELAXED, __HIP_MEMORY_SCOPE_AGENT); break; }
            }
            __builtin_amdgcn_fence(__ATOMIC_ACQUIRE, "agent");
            if (lane == 0) flag[0] = 1u;
        }
        asm volatile("s_waitcnt vmcnt(0) lgkmcnt(0)" ::: "memory"); __builtin_amdgcn_s_barrier(); asm volatile("" ::: "memory");
        if (lane < 32) { const unsigned* sl = xbuf + (size_t)(u.pm * BM + rl) * 4; float tot = 0.f;
#pragma unroll
            for (int t = 0; t < 4; ++t) tot += __uint_as_float(__hip_atomic_load(sl + t, __ATOMIC_RELAXED, __HIP_MEMORY_SCOPE_AGENT));
            S[rl] = __builtin_amdgcn_rsqf(tot * (1.0f / DM) + EPS); }
        asm volatile("s_waitcnt lgkmcnt(0)" ::: "memory"); __builtin_amdgcn_s_barrier(); asm volatile("" ::: "memory");
#pragma unroll
        for (int bj = 0; bj < 2; ++bj) { const int col = u.pn * BM + bj * HALF + wc * 32 + 8 * fq;
            const f32x4 g0 = *(const f32x4*)(gfin + col), g1 = *(const f32x4*)(gfin + col + 4);
#pragma unroll
            for (int ai = 0; ai < 2; ++ai)
#pragma unroll
                for (int m = 0; m < 4; ++m) { const int rl2 = ai * HALF + wr * 64 + m * 16 + fr; const float rs = S[rl2]; const size_t off = (size_t)(u.pm * BM + rl2) * DM + col;
                    *(f32x4*)(out + off) = acc[ai][bj][m][0] * rs * g0; *(f32x4*)(out + off + 4) = acc[ai][bj][m][1] * rs * g1; } }
    } };
}

namespace att {
constexpr int KB0 = 0, VB0 = 24576, IMP = 49152, IMPW = 65, SELM = IMP + 4 * 64 * IMPW * 4, WMASK = SELM + 512, WSF = WMASK + 64, STEPS = WSF + 8 * 32 * 4, CMPX = STEPS + 8 * 128, ATT_LDS = CMPX + 16384;
static_assert(ATT_LDS <= 143360, "attention LDS");
#define MFMA32(a, b, c) __builtin_amdgcn_mfma_f32_32x32x16_bf16((a), (b), (c), 0, 0, 0)
__device__ __forceinline__ int crow(int r, int hi) { return (r & 3) + 8 * (r >> 2) + 4 * hi; }
typedef short v4i16_t __attribute__((ext_vector_type(4)));
__device__ __forceinline__ s16x4 vtr(LAS const unsigned char* p) { return __builtin_bit_cast(s16x4, __builtin_amdgcn_ds_read_tr16_b64_v4i16((LAS v4i16_t*)p)); }

struct St { float m, l; f32x16 o0, o1; };

__device__ __forceinline__ void qk_tile(f32x16& p0, f32x16& p1, LAS const unsigned char* kb, const bf16x8* qf, int r, int h) {
    bf16x8 k0[4], k1[4], qv[4];
#pragma unroll
    for (int d0 = 0; d0 < 4; ++d0) { k0[d0] = *(const LAS bf16x8*)(kb + (2 * d0 + h) * 1024 + r * 16); k1[d0] = *(const LAS bf16x8*)(kb + (2 * d0 + h) * 1024 + 512 + r * 16);
        qv[d0] = qf[d0]; }
#pragma unroll
    for (int i = 0; i < 16; ++i) { p0[i] = 0.f; p1[i] = 0.f; }
    __builtin_amdgcn_sched_barrier(0);
#pragma unroll
    for (int d0 = 0; d0 < 4; ++d0) { p0 = MFMA32(k0[d0], qv[d0], p0); p1 = MFMA32(k1[d0], qv[d0], p1); }
}
__device__ __forceinline__ void apply_mask(f32x16& p0, f32x16& p1, unsigned long long allow, int h) {
    if (__all(allow == ~0ull)) return;
    const unsigned long long a = allow >> (4 * h); const unsigned lo = (unsigned)a, hi = (unsigned)(a >> 32);
#pragma unroll
    for (int i = 0; i < 16; ++i) { const int cb = (i & 3) + 8 * (i >> 2);
        p0[i] = ((lo >> cb) & 1u) ? p0[i] : -INFINITY; p1[i] = ((hi >> cb) & 1u) ? p1[i] : -INFINITY; }
}
__device__ __forceinline__ float rowmax32(const f32x16& p0, const f32x16& p1) {
    float a = fmaxf(p0[0], p1[0]);
#pragma unroll
    for (int i = 1; i < 16; ++i) a = fmaxf(a, fmaxf(p0[i], p1[i]));
    return fmaxf(a, __shfl_xor(a, 32));
}
__device__ __forceinline__ void pv_tile(f32x16& o0, f32x16& o1, LAS const unsigned char* vb, const f32x16& p0, const f32x16& p1, int lane, int h) {
    bf16x8 pa[4];
#pragma unroll
    for (int s = 0; s < 4; ++s) { u32x4 w;
#pragma unroll
        for (int j = 0; j < 4; ++j) { const int i0 = 8 * (s & 1) + 2 * j; w[j] = (s < 2) ? pk2(p0[i0], p0[i0 + 1]) : pk2(p1[i0], p1[i0 + 1]); }
        pa[s] = __builtin_bit_cast(bf16x8, w); }
    LAS const unsigned char* vp = vb + ((lane >> 4) & 1) * 32 + (lane & 3) * 8 + (4 * h + ((lane & 15) >> 2)) * 64;
    s16x4 l0[4], h0[4], l1[4], h1[4];
#pragma unroll
    for (int s = 0; s < 4; ++s) { l0[s] = vtr(vp + s * 1024); h0[s] = vtr(vp + s * 1024 + 512); l1[s] = vtr(vp + 4096 + s * 1024); h1[s] = vtr(vp + 4096 + s * 1024 + 512); }
    __builtin_amdgcn_sched_barrier(0);
#pragma unroll
    for (int s = 0; s < 4; ++s) {
        const bf16x8 v0 = (bf16x8){l0[s][0], l0[s][1], l0[s][2], l0[s][3], h0[s][0], h0[s][1], h0[s][2], h0[s][3]};
        const bf16x8 v1 = (bf16x8){l1[s][0], l1[s][1], l1[s][2], l1[s][3], h1[s][0], h1[s][1], h1[s][2], h1[s][3]};
        o0 = MFMA32(pa[s], v0, o0); o1 = MFMA32(pa[s], v1, o1);
    }
}
__device__ __forceinline__ void tile_online(St& st, LAS const unsigned char* kb, LAS const unsigned char* vb, const bf16x8* qr, unsigned long long allow,
                                            LAS float* wsf, int lane, int r, int h) {
    f32x16 p0, p1; qk_tile(p0, p1, kb, qr, r, h); __builtin_amdgcn_sched_barrier(0); apply_mask(p0, p1, allow, h);
    const float rm = rowmax32(p0, p1), mnew = fmaxf(st.m, rm), f = ex2(st.m - mnew); st.m = mnew;
    float ls = 0.f;
#pragma unroll
    for (int i = 0; i < 16; ++i) { p0[i] = ex2(p0[i] - mnew); p1[i] = ex2(p1[i] - mnew); ls += p0[i] + p1[i]; }
    st.l = st.l * f + ls;
    if (__any(f != 1.0f)) {
        if (h == 0) wsf[r] = f;
#pragma unroll
        for (int i = 0; i < 16; ++i) { const float fi = wsf[crow(i, h)]; st.o0[i] *= fi; st.o1[i] *= fi; }
    }
    pv_tile(st.o0, st.o1, vb, p0, p1, lane, h);
}
__device__ __forceinline__ void tile_stats(float& m, float& l, LAS const unsigned char* kb, const bf16x8* qr, unsigned long long allow, int r, int h) {
    f32x16 p0, p1; qk_tile(p0, p1, kb, qr, r, h); __builtin_amdgcn_sched_barrier(0); apply_mask(p0, p1, allow, h);
    const float rm = rowmax32(p0, p1), mnew = fmaxf(m, rm), f = ex2(m - mnew); m = mnew;
    float ls = 0.f;
#pragma unroll
    for (int i = 0; i < 16; ++i) ls += ex2(p0[i] - mnew) + ex2(p1[i] - mnew);
    l = l * f + ls;
}
__device__ __forceinline__ void tile_exact(f32x16& o0, f32x16& o1, float m, float invl, LAS const unsigned char* kb, LAS const unsigned char* vb, const bf16x8* qr,
                                           unsigned long long allow, LAS float* impw  , float& carry, int j, int lane, int r, int h) {
    f32x16 p0, p1; qk_tile(p0, p1, kb, qr, r, h); __builtin_amdgcn_sched_barrier(0); apply_mask(p0, p1, allow, h);
#pragma unroll
    for (int i = 0; i < 16; ++i) { p0[i] = ex2(p0[i] - m) * invl; p1[i] = ex2(p1[i] - m) * invl; }
#pragma unroll
    for (int pos = 0; pos < 8; ++pos) {
        const int half = pos >> 2, r4 = pos & 3;
        const float P0 = half ? p1[4 * r4] : p0[4 * r4], P1 = half ? p1[4 * r4 + 1] : p0[4 * r4 + 1], P2 = half ? p1[4 * r4 + 2] : p0[4 * r4 + 2], P3 = half ? p1[4 * r4 + 3] : p0[4 * r4 + 3];
        const float a = (P0 + P1) + (P2 + 0.5f * P3), b = 0.5f * P3;
        const float bx = __shfl_xor(b, 32);
        const float add = h ? bx : carry;
        impw[16 * j + 2 * pos + h] = a + add;
        carry = bx;
    }
    pv_tile(o0, o1, vb, p0, p1, lane, h);
}

__device__ __forceinline__ void qk_tile_c(f32x16& p0, f32x16& p1, LAS const unsigned char* kb, const bf16x8* qf, const f32x16& c, int r, int h) {
    bf16x8 k0[4], k1[4], qv[4];
#pragma unroll
    for (int d0 = 0; d0 < 4; ++d0) { k0[d0] = *(const LAS bf16x8*)(kb + (2 * d0 + h) * 1024 + r * 16); k1[d0] = *(const LAS bf16x8*)(kb + (2 * d0 + h) * 1024 + 512 + r * 16);
        qv[d0] = qf[d0]; }
    __builtin_amdgcn_sched_barrier(0);
    p0 = MFMA32(k0[0], qv[0], c); p1 = MFMA32(k1[0], qv[0], c);
#pragma unroll
    for (int d0 = 1; d0 < 4; ++d0) { p0 = MFMA32(k0[d0], qv[d0], p0); p1 = MFMA32(k1[d0], qv[d0], p1); }
}
__device__ __forceinline__ unsigned long long lowmask(int n);
__device__ __forceinline__ void soft_pv(St& st, f32x16& x0, f32x16& x1, float cx, LAS const unsigned char* vb, bool first, int kind, int tq,
                                        LAS float* wsf, int lane, int r, int h) {
    if (first) st.m = cx;
    else { const float d = st.m - cx;
        if (__any(d != 0.f)) {
#pragma unroll
            for (int i = 0; i < 16; ++i) { x0[i] -= d; x1[i] -= d; } } }
    if (kind) apply_mask(x0, x1, kind == 1 ? lowmask(tq + 1) : ~lowmask(tq + 1), h);
    const float rm = rowmax32(x0, x1);
    if (first) {
        const float dl = (rm > -INFINITY) ? rm : 0.f; st.m += dl;
#pragma unroll
        for (int i = 0; i < 16; ++i) { x0[i] -= dl; x1[i] -= dl; }
    } else if (__any(rm > 8.0f)) {
        const float dl = fmaxf(rm, 0.f), f = ex2(-dl); st.m += dl; st.l *= f;
        if (h == 0) wsf[r] = f;
#pragma unroll
        for (int i = 0; i < 16; ++i) { x0[i] -= dl; x1[i] -= dl; }
#pragma unroll
        for (int i = 0; i < 16; ++i) { const float fi = wsf[crow(i, h)]; st.o0[i] *= fi; st.o1[i] *= fi; }
    }
    float ls = 0.f;
#pragma unroll
    for (int i = 0; i < 16; ++i) { x0[i] = ex2(x0[i]); x1[i] = ex2(x1[i]); ls += x0[i] + x1[i]; }
    st.l += ls;
    pv_tile(st.o0, st.o1, vb, x0, x1, lane, h);
}
__device__ __forceinline__ unsigned long long lowmask(int n) { return n >= 64 ? ~0ull : ((1ull << n) - 1ull); }

typedef LAS const char* lds_cptr;
__device__ __forceinline__ void hs_glds16(const void* gsrc, unsigned lds_dst) { unsigned keep;
    asm volatile("s_mov_b32 %0, m0\n\ts_mov_b32 m0, %2\n\ts_nop 0\n\tglobal_load_lds_dwordx4 %1, off\n\ts_mov_b32 m0, %0" : "=&s"(keep) : "v"(gsrc), "s"(lds_dst) : "memory"); }
__device__ __forceinline__ float hs_max3f(float a, float b, float c) { float r; asm("v_max3_f32 %0, %1, %2, %3" : "=v"(r) : "v"(a), "v"(b), "v"(c)); return r; }
__device__ __forceinline__ float hs_max2f(float a, float b) { float r; asm("v_max_f32_e32 %0, %1, %2" : "=v"(r) : "v"(a), "v"(b)); return r; }
__device__ __forceinline__ float hs_fadd(float a, float b) { float r; asm("v_add_f32_e32 %0, %1, %2" : "=v"(r) : "v"(a), "v"(b)); return r; }
__device__ __forceinline__ float hs_fsub(float a, float b) { float r; asm("v_sub_f32_e32 %0, %1, %2" : "=v"(r) : "v"(a), "v"(b)); return r; }
#define HS_SBAR() __builtin_amdgcn_sched_barrier(0)
#define HS_WAIT_BAR(N) asm volatile("s_waitcnt vmcnt(" #N ") lgkmcnt(0)\n\ts_barrier" ::: "memory")
__device__ __forceinline__ void hs_qkt(f32x16& p0, f32x16& p1, const char* Kslot, const bf16x8* qr, const f32x16& negm, int r32, int hi) {
    const char* kb = Kslot + hi * 1024 + r32 * 16;
#pragma unroll
    for (int d0 = 0; d0 < 4; ++d0) {
        const bf16x8 b0 = *reinterpret_cast<const bf16x8*>(kb + d0 * 2048);
        const bf16x8 b1 = *reinterpret_cast<const bf16x8*>(kb + d0 * 2048 + 512);
        if (d0 == 0) { p0 = MFMA32(b0, qr[0], negm); p1 = MFMA32(b1, qr[0], negm); }
        else { p0 = MFMA32(b0, qr[d0], p0); p1 = MFMA32(b1, qr[d0], p1); } }
}
__device__ __forceinline__ void hs_kload8(bf16x8* kf, lds_cptr kp) {
    kf[0] = *(const LAS bf16x8*)(kp);        kf[1] = *(const LAS bf16x8*)(kp + 512);
    kf[2] = *(const LAS bf16x8*)(kp + 2048); kf[3] = *(const LAS bf16x8*)(kp + 2560);
    kf[4] = *(const LAS bf16x8*)(kp + 4096); kf[5] = *(const LAS bf16x8*)(kp + 4608);
    kf[6] = *(const LAS bf16x8*)(kp + 6144); kf[7] = *(const LAS bf16x8*)(kp + 6656);
}
__device__ __forceinline__ void hs_kload2(bf16x8* kf, lds_cptr kp, int j) { kf[2 * j] = *(const LAS bf16x8*)(kp + j * 2048); kf[2 * j + 1] = *(const LAS bf16x8*)(kp + j * 2048 + 512); }
__device__ __forceinline__ s16x4 hs_vtr(lds_cptr p) { return __builtin_bit_cast(s16x4, __builtin_amdgcn_ds_read_tr16_b64_v4i16((LAS v4i16_t*)p)); }
__device__ __forceinline__ float hs_rowmax(const f32x16& p0, const f32x16& p1) {
    float a = hs_max3f(p0[0], p0[1], p1[0]), b = hs_max3f(p0[2], p0[3], p1[1]); a = hs_max3f(a, p1[2], p1[3]);
#pragma unroll
    for (int r = 4; r < 16; r += 4) { a = hs_max3f(a, p0[r], p0[r + 1]); b = hs_max3f(b, p0[r + 2], p0[r + 3]); a = hs_max3f(a, p1[r], p1[r + 1]); b = hs_max3f(b, p1[r + 2], p1[r + 3]); }
    const float m = hs_max2f(a, b);
    auto rr = __builtin_amdgcn_permlane32_swap(__float_as_uint(m), __float_as_uint(m), false, false);
    return hs_max2f(__uint_as_float(rr[0]), __uint_as_float(rr[1]));
}
__device__ __forceinline__ void hs_pv(f32x16* o, int vb, bf16x8 pa0, bf16x8 pa1, bf16x8 pa2, bf16x8 pa3) {
#pragma unroll
    for (int d0 = 0; d0 < 2; ++d0) { s16x4 lo[4], hi[4];
#pragma unroll
        for (int ks = 0; ks < 4; ++ks) {
            asm volatile("ds_read_b64_tr_b16 %0,%1 offset:%c2" : "=&v"(lo[ks]) : "v"(vb), "i"(d0 * 4096 + ks * 1024) : "memory");
            asm volatile("ds_read_b64_tr_b16 %0,%1 offset:%c2" : "=&v"(hi[ks]) : "v"(vb), "i"(d0 * 4096 + ks * 1024 + 512) : "memory"); }
        asm volatile("s_waitcnt lgkmcnt(0)" ::: "memory"); HS_SBAR();
#define HS_PK(k) (bf16x8){lo[k][0], lo[k][1], lo[k][2], lo[k][3], hi[k][0], hi[k][1], hi[k][2], hi[k][3]}
        o[d0] = MFMA32(pa0, HS_PK(0), o[d0]); o[d0] = MFMA32(pa1, HS_PK(1), o[d0]); o[d0] = MFMA32(pa2, HS_PK(2), o[d0]); o[d0] = MFMA32(pa3, HS_PK(3), o[d0]);
#undef HS_PK
    }
}
__device__ __forceinline__ void hs_pre_dma(char* shm, const bf16_t* ksb, int c0, int c1, int c2, int wid, int lane) {
    const unsigned lds0 = (unsigned)(uintptr_t)shm;
    const size_t koff = (size_t)lane * PP + wid * 8, voff = (size_t)(16 * (wid & 3) + (lane >> 2)) * PP + (wid >> 2) * 32 + (lane & 3) * 8 + (C_VS - C_KS);
    const unsigned kdst = lds0 + KB0 + wid * 1024, vdst = lds0 + VB0 + wid * 1024;
#define HS_SRC0(c) (ksb + (size_t)(((c) & 0x80) ? (C_KW - C_KS) : 0) + (size_t)(((c) == 0x7f) ? 0 : ((c) & 0x7f)) * 64 * PP)
    hs_glds16(HS_SRC0(c0) + koff, (unsigned)__builtin_amdgcn_readfirstlane(kdst));
    hs_glds16(HS_SRC0(c0) + voff, (unsigned)__builtin_amdgcn_readfirstlane(vdst));
    hs_glds16(HS_SRC0(c1) + koff, (unsigned)__builtin_amdgcn_readfirstlane(kdst + 8192));
    hs_glds16(HS_SRC0(c2) + koff, (unsigned)__builtin_amdgcn_readfirstlane(kdst + 16384));
#undef HS_SRC0
}
template <int THRL, bool DIS, bool PRE> __device__ __forceinline__ void run_branch(char* shm, const bf16x8* qr, const bf16_t* ksb, LAS const unsigned char* steps, const int NT,
                                                               const int qb, f32x16* o, float& l_out, const int wid, const int lane) {
    constexpr int SLOTB = 8192, NSLOT = 3;
    { unsigned long long p_ = (unsigned long long)ksb; asm volatile("" : "+s"(p_)); ksb = (const bf16_t*)p_; }
    const int r32 = lane & 31, hi = lane >> 5, tq = (wid & 1) * 32 + r32;
    const unsigned lds0 = (unsigned)(uintptr_t)shm;
    const unsigned long long mysel = *((LAS const unsigned long long*)((lds_cptr)shm + SELM) + tq);
    const int vcodes = (int)steps[lane];
    float* wsf = (float*)(shm + WSF) + wid * 32;
    const size_t koff = (size_t)lane * PP + wid * 8, voff = (size_t)(16 * (wid & 3) + (lane >> 2)) * PP + (wid >> 2) * 32 + (lane & 3) * 8 + (C_VS - C_KS);
    const unsigned kdst = lds0 + KB0 + wid * 1024, vdst = lds0 + VB0 + wid * 1024;
#define HS_CODE(t) ((int)__builtin_amdgcn_readlane(vcodes, (t)))
#define HS_SRC(c) (ksb + (size_t)(((c) & 0x80) ? (C_KW - C_KS) : 0) + (size_t)(((c) == 0x7f) ? 0 : ((c) & 0x7f)) * 64 * PP)
#define DMA_K(t, slot) do { const int c_ = HS_CODE(t); hs_glds16(HS_SRC(c_) + koff, (unsigned)__builtin_amdgcn_readfirstlane(kdst + (slot))); } while (0)
#define DMA_V(t, slot) do { const int c_ = HS_CODE(t); hs_glds16(HS_SRC(c_) + voff, (unsigned)__builtin_amdgcn_readfirstlane(vdst + (slot))); } while (0)
    const int vb0 = (int)(lds0 + VB0) + ((lane >> 4) & 1) * 32 + (lane & 3) * 8 + (4 * hi + ((lane & 15) >> 2)) * 64;
    const char* Kbase = shm + KB0; bf16x8 kf[8];
    const lds_cptr shm3 = (lds_cptr)shm; const lds_cptr kp0 = shm3 + KB0 + hi * 1024 + r32 * 16; const lds_cptr vp0 = shm3 + VB0 + ((lane >> 4) & 1) * 32 + (lane & 3) * 8 + (4 * hi + ((lane & 15) >> 2)) * 64;
    if (!PRE) { DMA_K(0, 0); DMA_V(0, 0); DMA_K(1, SLOTB); }
    float mhat = 0.f, l_reg = 0.f; f32x16 negm;
    { float z = 0.f; asm volatile("" : "+v"(z));
#pragma unroll
      for (int i = 0; i < 16; ++i) { o[0][i] = z; o[1][i] = z; negm[i] = z; } }
    asm volatile("" : "+v"(negm));
#define CMASK(P0, P1, t) do { const int c_ = HS_CODE(t); const bool isw_ = (c_ & 0x80) != 0; const int jj_ = c_ & 0x7f; \
        if (!DIS && c_ == 0x7f) { _Pragma("unroll") for (int r = 0; r < 16; ++r) { P0[r] = -INFINITY; P1[r] = -INFINITY; } } \
        int kind_ = 0; if (c_ != 0x7f) { if (jj_ == qb) kind_ = 1; else if (isw_ && jj_ == qb - 8) kind_ = 2; } \
        if (kind_) apply_mask(P0, P1, kind_ == 1 ? lowmask(tq + 1) : ~lowmask(tq + 1), hi); } while (0)
    bool resc = false;
#define START(P0, P1) do { const float rm = hs_rowmax(P0, P1); resc = false; \
        { const float dl = (rm > -INFINITY) ? rm : 0.f; mhat = hs_fadd(mhat, dl); \
          _Pragma("unroll") for (int r = 0; r < 16; ++r) { P0[r] = hs_fsub(P0[r], dl); P1[r] = hs_fsub(P1[r], dl); } \
          _Pragma("unroll") for (int r = 0; r < 16; ++r) negm[r] = -mhat; asm volatile("" : "+v"(negm)); } \
        _Pragma("unroll") for (int r = 0; r < 16; ++r) P0[r] = __builtin_amdgcn_exp2f(P0[r]); } while (0)
#define RESC() do { if (resc) { asm volatile("s_waitcnt lgkmcnt(0)" ::: "memory"); \
        _Pragma("unroll") for (int d_ = 0; d_ < 2; ++d_) _Pragma("unroll") for (int r = 0; r < 16; ++r) o[d_][r] *= wsf[crow(r, hi)]; } } while (0)
    f32x16 pA0, pA1, pB0, pB1;
    int sl_prev = 0, sl_cur = 0, sl_next = SLOTB;
#define ROT() do { sl_prev = sl_cur; sl_cur = sl_next; sl_next = (sl_next == (NSLOT - 1) * SLOTB) ? 0 : sl_next + SLOTB; } while (0)
    if (!PRE) DMA_K(2, 2 * SLOTB);
    HS_WAIT_BAR(3);
    hs_qkt(pA0, pA1, Kbase, qr, negm, r32, hi); asm volatile("s_nop 15\n\ts_nop 7" : "+v"(pA0), "+v"(pA1)); CMASK(pA0, pA1, 0);
    START(pA0, pA1);
    _Pragma("unroll") for (int r = 0; r < 16; ++r) pA1[r] = __builtin_amdgcn_exp2f(pA1[r]);
    HS_WAIT_BAR(0);
    DMA_K(3, 0); DMA_V(1, SLOTB);
    ROT();
    hs_kload8(kf, kp0 + sl_cur);
    HS_WAIT_BAR(2);
    s16x4 vlo[8], vhi[8]; u32x4 pw0, pw1, pw2, pw3;
#define PKW(P, B) pk2(P[B], P[B + 1])
#define PAF(k) __builtin_bit_cast(bf16x8, pw##k)
#define VFR(i) (bf16x8){vlo[i][0], vlo[i][1], vlo[i][2], vlo[i][3], vhi[i][0], vhi[i][1], vhi[i][2], vhi[i][3]}
#define PIN(x) asm volatile("" : "+v"(x))
#define MX3(a, b, c) __builtin_fmaxf(__builtin_fmaxf((a), (b)), (c))
#define GAPA(MF, A0, A1, A2, A3, W0, W1, PW) do { MF; sacc += A0; sacc += A1; sacc += A2; sacc += A3; PIN(sacc); W0; W1; PIN(PW); HS_SBAR(); } while (0)
#define EX(v) __builtin_amdgcn_exp2f(v)
#define GAPB(MF, X, B) do { MF; X[B] = EX(X[B]); X[B + 1] = EX(X[B + 1]); X[B + 2] = EX(X[B + 2]); X[B + 3] = EX(X[B + 3]); PIN(X); HS_SBAR(); } while (0)
#define VRD(i) do { vlo[i] = hs_vtr(vp_ + (((i) >> 2) * 4096 + ((i) & 3) * 1024)); vhi[i] = hs_vtr(vp_ + (((i) >> 2) * 4096 + ((i) & 3) * 1024 + 512)); } while (0)
#define KRD(G, j) do { if (G) { hs_kload2(kf, kp0 + sl_next, j); HS_SBAR(); } } while (0)
#define STEP(C0, C1, P0, P1, t, GK, GV, GL) do { HS_SBAR(); \
        f32x16 cct; \
        if (DIS) { const int c0_ = HS_CODE(t); const bool en0_ = (c0_ != 0x7f) && (((mysel >> (c0_ & 63)) & 1ull) != 0ull);     \
            _Pragma("unroll") for (int r = 0; r < 16; ++r) cct[r] = en0_ ? negm[r] : -INFINITY; PIN(cct); HS_SBAR(); } \
        const lds_cptr vp_ = vp0 + sl_prev; \
        VRD(0); HS_SBAR(); float sacc = (P0[0] + P0[1]); \
        GAPA(C0 = MFMA32(kf[0], qr[0], (DIS ? cct : negm)), P0[2], P0[3], P0[4], P0[5],     pw0[0] = PKW(P0, 0), pw0[1] = PKW(P0, 2), pw0); \
        VRD(4); HS_SBAR(); GAPA(C1 = MFMA32(kf[1], qr[0], (DIS ? cct : negm)), P0[6], P0[7], P0[8], P0[9],     pw0[2] = PKW(P0, 4), pw0[3] = PKW(P0, 6), pw0); \
        VRD(1); HS_SBAR(); GAPA(C0 = MFMA32(kf[2], qr[1], C0),   P0[10], P0[11], P0[12], P0[13], pw1[0] = PKW(P0, 8), pw1[1] = PKW(P0, 10), pw1); \
        VRD(5); HS_SBAR(); GAPA(C1 = MFMA32(kf[3], qr[1], C1),   P0[14], P0[15], P1[0], P1[1],   pw1[2] = PKW(P0, 12), pw1[3] = PKW(P0, 14), pw1); \
        VRD(2); HS_SBAR(); GAPA(C0 = MFMA32(kf[4], qr[2], C0),   P1[2], P1[3], P1[4], P1[5],     pw2[0] = PKW(P1, 0), pw2[1] = PKW(P1, 2), pw2); \
        VRD(6); HS_SBAR(); GAPA(C1 = MFMA32(kf[5], qr[2], C1),   P1[6], P1[7], P1[8], P1[9],     pw2[2] = PKW(P1, 4), pw2[3] = PKW(P1, 6), pw2); \
        VRD(3); HS_SBAR(); GAPA(C0 = MFMA32(kf[6], qr[3], C0),   P1[10], P1[11], P1[12], P1[13], pw3[0] = PKW(P1, 8), pw3[1] = PKW(P1, 10), pw3); \
        VRD(7); HS_SBAR(); GAPA(C1 = MFMA32(kf[7], qr[3], C1),   P1[14], P1[15], 0.f, 0.f,       pw3[2] = PKW(P1, 12), pw3[3] = PKW(P1, 14), pw3); \
        l_reg += sacc; \
        if (GK) { DMA_K((t) + 3, sl_cur); } if (GV) { DMA_V((t) + 1, sl_next); } \
        CMASK(C0, C1, t); \
        { float a = MX3(C0[0], C0[1], C1[0]), b = MX3(C0[2], C0[3], C1[1]); a = MX3(a, C1[2], C1[3]); \
          _Pragma("unroll") for (int r = 4; r < 16; r += 4) { a = MX3(a, C0[r], C0[r + 1]); b = MX3(b, C0[r + 2], C0[r + 3]); a = MX3(a, C1[r], C1[r + 1]); b = MX3(b, C1[r + 2], C1[r + 3]); } \
          float rm = __builtin_fmaxf(a, b); { auto rr = __builtin_amdgcn_permlane32_swap(__float_as_uint(rm), __float_as_uint(rm), false, false); rm = __builtin_fmaxf(__uint_as_float(rr[0]), __uint_as_float(rr[1])); } \
          resc = false; \
          if (__builtin_expect(__any(rm > (float)THRL), 0)) { const float dl = __builtin_fmaxf(rm, 0.f); mhat += dl; \
            _Pragma("unroll") for (int r = 0; r < 16; ++r) { C0[r] -= dl; C1[r] -= dl; } \
            _Pragma("unroll") for (int r = 0; r < 16; ++r) negm[r] = -mhat; asm volatile("" : "+v"(negm)); \
            const float f = __builtin_amdgcn_exp2f(-dl); l_reg *= f; if (hi == 0) wsf[r32] = f; resc = true; } } \
        HS_SBAR(); \
        GAPB(o[0] = MFMA32(PAF(0), VFR(0), o[0]), C0, 0); \
        GAPB(o[1] = MFMA32(PAF(0), VFR(4), o[1]), C0, 4); \
        KRD(GL, 0); GAPB(o[0] = MFMA32(PAF(1), VFR(1), o[0]), C0, 8); \
        KRD(GL, 1); GAPB(o[1] = MFMA32(PAF(1), VFR(5), o[1]), C0, 12); \
        KRD(GL, 2); GAPB(o[0] = MFMA32(PAF(2), VFR(2), o[0]), C1, 0); \
        KRD(GL, 3); GAPB(o[1] = MFMA32(PAF(2), VFR(6), o[1]), C1, 4); \
        GAPB(o[0] = MFMA32(PAF(3), VFR(3), o[0]), C1, 8); \
        GAPB(o[1] = MFMA32(PAF(3), VFR(7), o[1]), C1, 12); \
    } while (0)
    int t = 1;
    for (; t + 5 < NT; t += 2) {
        STEP(pB0, pB1, pA0, pA1, t, true, true, true);     HS_WAIT_BAR(2); RESC(); ROT();
        STEP(pA0, pA1, pB0, pB1, t + 1, true, true, true); HS_WAIT_BAR(2); RESC(); ROT();
    }
#define ENDW(tt) do { if ((tt) + 3 < NT) { HS_WAIT_BAR(2); } else if ((tt) + 2 < NT) { HS_WAIT_BAR(1); } else { HS_WAIT_BAR(0); } } while (0)
    for (; t + 1 < NT; t += 2) {
        STEP(pB0, pB1, pA0, pA1, t, (t + 3 < NT), (t + 1 < NT), (t + 1 < NT));         ENDW(t);     RESC(); ROT();
        STEP(pA0, pA1, pB0, pB1, t + 1, (t + 4 < NT), (t + 2 < NT), (t + 2 < NT));     ENDW(t + 1); RESC(); ROT();
    }
#define DRAIN(PX0, PX1, SL) do { float sacc = PX0[0] + PX0[1]; _Pragma("unroll") for (int r = 2; r < 16; ++r) sacc += PX0[r]; _Pragma("unroll") for (int r = 0; r < 16; ++r) sacc += PX1[r]; l_reg += sacc; \
      pw0 = (u32x4){PKW(PX0, 0), PKW(PX0, 2), PKW(PX0, 4), PKW(PX0, 6)}; pw1 = (u32x4){PKW(PX0, 8), PKW(PX0, 10), PKW(PX0, 12), PKW(PX0, 14)}; \
      pw2 = (u32x4){PKW(PX1, 0), PKW(PX1, 2), PKW(PX1, 4), PKW(PX1, 6)}; pw3 = (u32x4){PKW(PX1, 8), PKW(PX1, 10), PKW(PX1, 12), PKW(PX1, 14)}; \
      HS_SBAR(); hs_pv(o, vb0 + (SL), PAF(0), PAF(1), PAF(2), PAF(3)); } while (0)
    if (NT & 1) {
        DRAIN(pA0, pA1, sl_prev);
    } else {
        STEP(pB0, pB1, pA0, pA1, NT - 1, false, false, false); RESC();
        DRAIN(pB0, pB1, sl_cur);
    }
#undef DRAIN
    { auto rr = __builtin_amdgcn_permlane32_swap(__float_as_uint(l_reg), __float_as_uint(l_reg), false, false); l_out = __uint_as_float(rr[0]) + __uint_as_float(rr[1]); }
    asm volatile("s_waitcnt lgkmcnt(0)\n\ts_barrier" ::: "memory");
#undef PKW
#undef PAF
#undef VFR
#undef PIN
#undef MX3
#undef GAPA
#undef GAPB
#undef EX
#undef VRD
#undef KRD
#undef STEP
#undef ENDW
#undef DMA_K
#undef DMA_V
#undef CMASK
#undef START
#undef RESC
#undef ROT
#undef HS_CODE
#undef HS_SRC
}
__device__ __forceinline__ void attn_unit(LAS unsigned char* lds, bf16_t* proj, const bf16_t* kcmp, const bf16_t* vcmp, int bh, int qb, int skipw) {
    int tid_ = threadIdx.x; asm volatile("" : "+v"(tid_));
    const int tid = tid_, lane = tid & 63, r = lane & 31, h = lane >> 5, wid = __builtin_amdgcn_readfirstlane(tid >> 6);
    const int b = bh >> 2, hk = bh & 3, g = wid >> 1, tq = (wid & 1) * 32 + r;
    const size_t row = (size_t)b * SEQ + (size_t)qb * 64 + tq;
    const int t = qb * 64 + tq;
    bf16_t* qp = proj + row * PP + C_Q + (hk * 4 + g) * 64;
    bf16x8 qreg[4];
#pragma unroll
    for (int d0 = 0; d0 < 4; ++d0) qreg[d0] = *(const bf16x8*)(qp + d0 * 16 + h * 8);
    const bf16x8* qr = qreg;
    float gate[3];
#pragma unroll
    for (int c = 0; c < 3; ++c) gate[c] = sigmoidf_(bf2f(proj[row * PP + C_GBR + c * 16 + hk * 4 + g]));
#ifdef GATE2X
    if (GATE2X & 1) gate[0] *= 2.f; if (GATE2X & 2) gate[1] *= 2.f; if (GATE2X & 4) gate[2] *= 2.f;
#endif
#ifdef GATEZ
    if (GATEZ & 1) gate[0] = 0.f; if (GATEZ & 2) gate[1] = 0.f; if (GATEZ & 4) gate[2] = 0.f;
#endif
    LAS float* wsf = (LAS float*)(lds + WSF) + wid * 32;
    LAS float* impw = (LAS float*)(lds + IMP) + (g * 64 + tq) * IMPW;
    const size_t krow = lane, kcol = wid * 8;
    const size_t vrow = 16 * (wid & 3) + (lane >> 2), vcol = 32 * (wid >> 2) + 8 * (lane & 3);
    LAS unsigned char* kst = lds + KB0 + wid * 1024 + lane * 16;
    LAS unsigned char* vst = lds + VB0 + wid * 1024 + lane * 16;
    u32x4 kreg, vreg;
    LAS float* osl = (LAS float*)(lds + IMP + wid * (32 * IMPW * 4)) + lane;
#define LDK(base, pitch) kreg = *(const u32x4*)((base) + krow * (size_t)(pitch) + kcol)
#define LDV(base, pitch) vreg = *(const u32x4*)((base) + vrow * (size_t)(pitch) + vcol)
#define STK(buf) *(LAS u32x4*)(kst + (buf) * 8192) = kreg
#define STV(buf) *(LAS u32x4*)(vst + (buf) * 8192) = vreg
#define KBUF(buf) (lds + KB0 + (buf) * 8192)
#define VBUF(buf) (lds + VB0 + (buf) * 8192)
#define ACCUM_OUT(scale_expr, FIRST) do { if (h == 0) wsf[r] = (scale_expr); \
        _Pragma("unroll") for (int i = 0; i < 16; ++i) { const float sc = wsf[crow(i, h)]; \
            if (FIRST) { osl[(i * 2) * 64] = st.o0[i] * sc; osl[(i * 2 + 1) * 64] = st.o1[i] * sc; } \
            else { osl[(i * 2) * 64] += st.o0[i] * sc; osl[(i * 2 + 1) * 64] += st.o1[i] * sc; } } } while (0)

    St st;
    const bf16_t* kc = kcmp + (size_t)bh * 256 * 64; const bf16_t* vc = vcmp + (size_t)bh * 256 * 64;
    const int nmax = (t >= 31) ? ((t - 31) >> 4) : -1;
#define CMP_KT(j) (lds + (j) * 8192)
#define CMP_VT(j) ((j) < 2 ? lds + 32768 + (j) * 8192 : lds + CMPX + ((j) - 2) * 8192)
    {
        u32x4 kr4[4], vr4[4];
#pragma unroll
        for (int j = 0; j < 4; ++j) { kr4[j] = *(const u32x4*)(kc + (size_t)j * 4096 + krow * 64 + kcol); vr4[j] = *(const u32x4*)(vc + (size_t)j * 4096 + vrow * 64 + vcol); }
#pragma unroll
        for (int j = 0; j < 4; ++j) { *(LAS u32x4*)(CMP_KT(j) + wid * 1024 + lane * 16) = kr4[j]; *(LAS u32x4*)(CMP_VT(j) + wid * 1024 + lane * 16) = vr4[j]; }
    }
    __syncthreads();
    float carry = 0.f;
    float m1 = -1e30f, l1 = 0.f;
#pragma unroll 1
    for (int j = 0; j < 4; ++j) {
        const int cnt = nmax - 64 * j + 1; const unsigned long long allow = cnt <= 0 ? 0ull : lowmask(cnt);
        if (__all(allow == 0ull)) continue;
        tile_stats(m1, l1, CMP_KT(j), qr, allow, r, h);
    }
    l1 += __shfl_xor(l1, 32);
    const float invl = __builtin_amdgcn_rcpf(fmaxf(l1, 1e-30f));
#pragma unroll
    for (int i = 0; i < 16; ++i) { st.o0[i] = 0.f; st.o1[i] = 0.f; }
#pragma unroll 1
    for (int j = 0; j < 4; ++j) {
        const int cnt = nmax - 64 * j + 1; const unsigned long long allow = cnt <= 0 ? 0ull : lowmask(cnt);
        if (__all(allow == 0ull)) {
#pragma unroll
            for (int pos = 0; pos < 8; ++pos) impw[16 * j + 2 * pos + h] = (pos == 0 && h == 0) ? carry : 0.f;
            carry = 0.f; continue; }
        tile_exact(st.o0, st.o1, m1, invl, CMP_KT(j), CMP_VT(j), qr, allow, impw, carry, j, lane, r, h);
    }
    __syncthreads();
    hs_pre_dma((char*)lds, proj + (size_t)b * SEQ * PP + C_KS + hk * 64, 0, qb > 0 ? qb : 0x7f, qb > 1 ? qb - 1 : 0x7f, wid, lane);
#undef CMP_KT
#undef CMP_VT
    {
        unsigned long long wor = 0ull;
        const unsigned long long valid = lowmask(qb + 1);
        LAS const float* ib = (LAS const float*)(lds + IMP);
        unsigned key[8], T[8];
#pragma unroll
        for (int i = 0; i < 8; ++i) { const int q = wid * 8 + i;
            float v = ((ib[(0 * 64 + q) * IMPW + lane] + ib[(1 * 64 + q) * IMPW + lane]) + ib[(2 * 64 + q) * IMPW + lane]) + ib[(3 * 64 + q) * IMPW + lane];
            if (lane == 0 || lane == qb || lane == qb - 1) v = INFINITY;
            key[i] = (lane <= qb) ? __float_as_uint(fmaxf(v, 0.f)) : 0u; T[i] = 0u; }
        if (qb >= 16)
#pragma unroll 1
        for (int bb = 30; bb >= 0; --bb) {
#pragma unroll
            for (int i = 0; i < 8; ++i) { const unsigned cand = T[i] | (1u << bb);
                const int c = __popcll(__ballot(key[i] >= cand) & valid); T[i] = (c >= 16) ? cand : T[i]; }
        }
#pragma unroll
        for (int i = 0; i < 8; ++i) { const int q = wid * 8 + i;
            const unsigned long long gt = __ballot(key[i] > T[i]) & valid, eq = __ballot(key[i] == T[i]) & valid;
            const int need = 16 - __popcll(gt);
            const bool pick = ((eq >> lane) & 1ull) && (__popcll(eq & lowmask(lane)) < need);
            const unsigned long long msk = gt | __ballot(pick);
            if (lane == 0) *(LAS unsigned long long*)(lds + SELM + q * 8) = msk;
            wor |= msk; }
        if (lane == 0) *(LAS unsigned long long*)(lds + WMASK + wid * 8) = wor;
    }
    __syncthreads();
    unsigned long long un = 0ull;
#pragma unroll
    for (int w = 0; w < 8; ++w) un |= *(LAS const unsigned long long*)(lds + WMASK + w * 8);
    { const unsigned ulo = __builtin_amdgcn_readfirstlane((unsigned)un), uhi = __builtin_amdgcn_readfirstlane((unsigned)(un >> 32)); un = ((unsigned long long)uhi << 32) | ulo; }
    ACCUM_OUT(gate[0], true);
    {
        LAS unsigned char* steps = lds + STEPS + wid * 128;
        const int nsel = __popcll(un), j0w = qb >= 8 ? qb - 8 : 0, nwin = qb - j0w + 1;
        const int NTs = nsel < 4 ? 4 : nsel, NTw = nwin < 4 ? 4 : nwin;
        {
            const unsigned long long F = 1ull | (1ull << qb) | (qb > 0 ? (1ull << (qb - 1)) : 0ull), rest = un & ~F; const int nF = __popcll(F);
            if (lane == 0) { steps[0] = 0; if (qb > 0) steps[1] = (unsigned char)qb; if (qb > 1) steps[2] = (unsigned char)(qb - 1); }
            if ((rest >> lane) & 1ull) steps[nF + __popcll(rest & lowmask(lane))] = (unsigned char)lane;
        }
        if (lane >= nsel && lane < NTs) steps[lane] = (unsigned char)0x7f;
        if (lane < NTw) steps[64 + lane] = (unsigned char)(lane < nwin ? (0x80 | (j0w + lane)) : 0x7f);
        const bf16_t* ksb = proj + (size_t)b * SEQ * PP + C_KS + hk * 64;
        char* shm = (char*)lds;
        f32x16 ob[2]; float lt;
        run_branch<8, true, true>(shm, qr, ksb, steps, NTs, qb, ob, lt, wid, lane);
        {
            int t2 = threadIdx.x; asm volatile("" : "+v"(t2));
            const int lane2 = t2 & 63, r2 = lane2 & 31, h2 = lane2 >> 5, wid2 = __builtin_amdgcn_readfirstlane(t2 >> 6), g2 = wid2 >> 1, tq2 = (wid2 & 1) * 32 + r2;
            LAS float* wsf2 = (LAS float*)(lds + WSF) + wid2 * 32; LAS float* osl2 = (LAS float*)(lds + IMP + wid2 * (32 * IMPW * 4)) + lane2;
            const float g1 = sigmoidf_(bf2f(proj[((size_t)b * SEQ + (size_t)qb * 64 + tq2) * PP + C_GBR + 1 * 16 + hk * 4 + g2]));
            if (h2 == 0) wsf2[r2] = g1 * __builtin_amdgcn_rcpf(fmaxf(lt, 1e-30f));
#pragma unroll
            for (int i = 0; i < 16; ++i) { const float sc = wsf2[crow(i, h2)]; osl2[(i * 2) * 64] += ob[0][i] * sc; osl2[(i * 2 + 1) * 64] += ob[1][i] * sc; }
        }
        {
            int t3 = threadIdx.x; asm volatile("" : "+v"(t3));
            run_branch<8, false, false>(shm, qr, ksb, steps + 64, NTw, qb, ob, lt, __builtin_amdgcn_readfirstlane(t3 >> 6), t3 & 63);
        }
        st.o0 = ob[0]; st.o1 = ob[1]; st.l = lt;
    }
    {
        int t2 = threadIdx.x; asm volatile("" : "+v"(t2));
        const int lane2 = t2 & 63, r2 = lane2 & 31, h2 = lane2 >> 5, wid2 = __builtin_amdgcn_readfirstlane(t2 >> 6), g2 = wid2 >> 1, tq2 = (wid2 & 1) * 32 + r2;
        LAS float* wsf2 = (LAS float*)(lds + WSF) + wid2 * 32; LAS float* osl2 = (LAS float*)(lds + IMP + wid2 * (32 * IMPW * 4)) + lane2;
        const float g3 = sigmoidf_(bf2f(proj[((size_t)b * SEQ + (size_t)qb * 64 + tq2) * PP + C_GBR + 2 * 16 + hk * 4 + g2]));
        if (h2 == 0) wsf2[r2] = g3 * __builtin_amdgcn_rcpf(fmaxf(st.l, 1e-30f));
        bf16_t* ob2 = proj + ((size_t)b * SEQ + (size_t)qb * 64 + (wid2 & 1) * 32) * PP + C_Q + (hk * 4 + g2) * 64;
        if (!skipw)
#pragma unroll
        for (int i = 0; i < 16; ++i) { const int q = crow(i, h2); const float sc = wsf2[q];
            const float f0 = osl2[(i * 2) * 64] + st.o0[i] * sc, f1 = osl2[(i * 2 + 1) * 64] + st.o1[i] * sc;
            ob2[(size_t)q * PP + r2] = (bf16_t)(pk2(f0, 0.f) & 0xffffu); ob2[(size_t)q * PP + 32 + r2] = (bf16_t)(pk2(f1, 0.f) & 0xffffu); }
    }
#undef LDK
#undef LDV
#undef STK
#undef STV
#undef KBUF
#undef VBUF
#undef ACCUM_OUT
}
}

__device__ __forceinline__ float wave_sum(float v) {
#pragma unroll
    for (int o = 1; o < 64; o <<= 1) v += __shfl_xor(v, o);
    return v;
}
__device__ __forceinline__ void transpose_item(const float* W, int K, int N, bf16_t* WT, int ldt, int k0, int n0, int drow0, const float* kscale, float cscale, LAS float* scr, int lane) {
#pragma unroll 8
    for (int i = 0; i < 32; ++i) { const int kk = 2 * i + (lane >> 5); const int n = n0 + (lane & 31);
        float v = (n < N) ? W[(size_t)(k0 + kk) * N + n] : 0.f;
        if (kscale) v *= kscale[k0 + kk];
        scr[kk * 33 + (lane & 31)] = v * cscale; }
    asm volatile("s_waitcnt lgkmcnt(0)" ::: "memory");
    const int c = lane & 7;
#pragma unroll
    for (int j = 0; j < 4; ++j) { const int n = (lane >> 3) + 8 * j; const LAS float* s = scr + (8 * c) * 33 + n;
        u32x4 o; o.x = pk2(s[0 * 33], s[1 * 33]); o.y = pk2(s[2 * 33], s[3 * 33]); o.z = pk2(s[4 * 33], s[5 * 33]); o.w = pk2(s[6 * 33], s[7 * 33]);
        *(u32x4*)(WT + (size_t)(drow0 + n) * ldt + k0 + 8 * c) = o; }
    asm volatile("s_waitcnt lgkmcnt(0)" ::: "memory");
}

#define XB_TMO      128
#define XB_XCNT(j)  (256  + 64 * (j))
#define XB_XSUB(j)  (1280 + 64 * (j))
#define XB_XGEN(j)  (2304 + 64 * (j))
#define XB_TOP      3328
#define XB_TOPGEN   3392
#define XCD_BAR_WORDS 3456
#define XB_SPIN_CAP (1u << 18)
__device__ __forceinline__ unsigned xb_ld(unsigned* p)              { return __hip_atomic_load(p, __ATOMIC_RELAXED, __HIP_MEMORY_SCOPE_AGENT); }
__device__ __forceinline__ unsigned xb_add(unsigned* p, unsigned v) { return __hip_atomic_fetch_add(p, v, __ATOMIC_RELAXED, __HIP_MEMORY_SCOPE_AGENT); }
__device__ __forceinline__ unsigned xb_xcc_id() { return (unsigned)__builtin_amdgcn_s_getreg((3 << 11) | 20) & 0xFu; }
#define XB_SPIN(cond, bar) do { unsigned _sp = 0; while (cond) { __builtin_amdgcn_s_sleep(1); \
    if ((++_sp & 255u) == 0u) { if (xb_ld(&(bar)[XB_TMO])) break; if (_sp > XB_SPIN_CAP) { atomicAdd(&(bar)[XB_TMO], 1u); break; } } } } while (0)
struct XcdBarrier { unsigned* bar; unsigned x; volatile LAS unsigned* st; };
__device__ __forceinline__ XcdBarrier xcd_barrier_post(unsigned* bar, volatile LAS unsigned* st) {
    XcdBarrier b; b.bar = bar; b.x = xb_xcc_id(); b.st = st;
    if (threadIdx.x == 0) (void)xb_add(&bar[XB_XCNT(b.x)], 1u);
    return b;
}
__device__ __forceinline__ void xcd_barrier_complete(unsigned* bar, unsigned x, unsigned& nloc, unsigned& nx) {
    const unsigned G = gridDim.x * gridDim.y * gridDim.z;
    unsigned sum, cnt, mine, sp = 0u;
    for (;;) {
        sum = 0u; cnt = 0u; mine = 0u;
#pragma unroll
        for (unsigned j = 0; j < 16; ++j) { const unsigned c = xb_ld(&bar[XB_XCNT(j)]); sum += c; cnt += (c > 0u) ? 1u : 0u; mine = (j == x) ? c : mine; }
        if (sum == G) break;
        __builtin_amdgcn_s_sleep(1);
        if ((++sp & 255u) == 0u) { if (xb_ld(&bar[XB_TMO])) break; if (sp > XB_SPIN_CAP) { atomicAdd(&bar[XB_TMO], 1u); break; } }
    }
    nloc = mine > 0u ? mine : 1u; nx = cnt > 0u ? cnt : 1u;
}
__device__ __forceinline__ void xcd_barrier(const XcdBarrier& b) {
    asm volatile("s_waitcnt vmcnt(0)" ::: "memory");
    __syncthreads();
    if (threadIdx.x == 0) {
        unsigned* bar = b.bar;
        __builtin_amdgcn_s_waitcnt(0);
        unsigned nloc = b.st[0], nx = b.st[1];
        if (nloc == 0u) { xcd_barrier_complete(bar, b.x, nloc, nx); b.st[0] = nloc; b.st[1] = nx; }
        const unsigned old = xb_add(&bar[XB_XSUB(b.x)], 1u);
        const unsigned gen = old / nloc;
        if (old + 1u == (gen + 1u) * nloc) {
            __builtin_amdgcn_fence(__ATOMIC_RELEASE, "agent");
            asm volatile("s_waitcnt vmcnt(0)" ::: "memory");
            const unsigned og = xb_add(&bar[XB_TOP], 1u);
            const unsigned tg = og / nx;
            if (og + 1u == (tg + 1u) * nx) xb_add(&bar[XB_TOPGEN], 1u);
            else XB_SPIN(xb_ld(&bar[XB_TOPGEN]) == tg, bar);
            __builtin_amdgcn_fence(__ATOMIC_ACQUIRE, "agent");
            xb_add(&bar[XB_XGEN(b.x)], 1u);
            asm volatile("s_waitcnt vmcnt(0)" ::: "memory");
        } else {
            XB_SPIN(xb_ld(&bar[XB_XGEN(b.x)]) == gen, bar);
            __builtin_amdgcn_fence(__ATOMIC_ACQUIRE, "agent");
            asm volatile("s_waitcnt vmcnt(0)" ::: "memory");
        }
    }
    __syncthreads();
}

struct Args {
    const float *x, *w_in, *conv_w, *w_conv_out, *pos_k, *w1_k, *w2_k, *pos_v, *w1_v, *w2_v, *w_attn_out, *w_o, *g_mix, *g_ffn, *w_gate, *w_up, *w_down, *g_final;
    float* out; unsigned char* ws; int probe; int pad;
};

__global__ void __launch_bounds__(512, 2) nsa_fwd(Args a) {
    extern __shared__ __attribute__((aligned(16))) unsigned char lds_raw[];
    LAS unsigned char* lds = (LAS unsigned char*)lds_raw;
    cg::grid_group grid = cg::this_grid();
    const int tid = threadIdx.x, lane = tid & 63, wave = __builtin_amdgcn_readfirstlane(tid >> 6);
    const int G = gridDim.x, bx = blockIdx.x;
    const int vcu = (G % 8 == 0) ? (bx % 8) * (G / 8) + bx / 8 : bx;
    unsigned char* ws = a.ws;
    volatile LAS unsigned* bst = (volatile LAS unsigned*)(lds + 143360);
    if (tid < 2) bst[tid] = 0u;
    __syncthreads();
    const XcdBarrier gbar = xcd_barrier_post((unsigned*)(ws + WS_BAR), bst);
#define SEAM() xcd_barrier(gbar)
    float* part1 = (float*)(ws + WS_PART1); float* part2 = (float*)(ws + WS_PART2); float* cbias = (float*)(ws + WS_BIAS);
    bf16_t* Win = (bf16_t*)(ws + WS_WIN); bf16_t* Wconv = (bf16_t*)(ws + WS_WCONV); bf16_t* Wattn = (bf16_t*)(ws + WS_WATTN); bf16_t* Wo = (bf16_t*)(ws + WS_WO);
    bf16_t* Wup = (bf16_t*)(ws + WS_WUP); bf16_t* Wdown = (bf16_t*)(ws + WS_WDOWN); bf16_t* W1 = (bf16_t*)(ws + WS_W1); bf16_t* W2 = (bf16_t*)(ws + WS_W2);
    bf16_t* hid = (bf16_t*)(ws + WS_HID); bf16_t* kcmp = (bf16_t*)(ws + WS_KCMP); bf16_t* proj = (bf16_t*)(ws + WS_PROJ);
    float* h1f = (float*)(ws + WS_H1F); bf16_t* h1b = (bf16_t*)(ws + WS_H1B); bf16_t* act = (bf16_t*)(ws + WS_ACT);
    bf16_t* nb = (bf16_t*)a.out; bf16_t* mix = (bf16_t*)a.out; bf16_t* bc = (bf16_t*)((unsigned char*)a.out + OUT_BC);

    {
        LAS float* scr = (LAS float*)(lds + wave * 16384);
        const int gw = vcu * 8 + wave, NGW = G * 8;
        constexpr int I_IN = 16 * 194, I_CONV = 8 * 32, I_ATT = 16 * 32, I_O = 16 * 32, I_G = 16 * 88, I_U = 16 * 88, I_D = 44 * 32, I_1 = 32 * 8, I_2 = 4 * 2;
        constexpr int NITEMS = I_IN + I_CONV + I_ATT + I_O + 2 * I_1 + 2 * I_2;
        for (int it = gw; it < NITEMS; it += NGW) {
            int q = it;
            if (q < I_IN) { const int kb = q / 194, nbk = q % 194, n0 = 32 * nbk; const float cs = (n0 >= C_Q && n0 < C_KC) ? QSCALE : 1.0f;
                transpose_item(a.w_in, 1024, INCOLS, Win, 1024, 64 * kb, n0, n0, a.g_mix, cs, scr, lane); continue; } q -= I_IN;
            if (q < I_CONV) { const int kb = q / 32, nbk = q % 32; transpose_item(a.w_conv_out, 512, 1024, Wconv, 512, 64 * kb, 32 * nbk, 32 * nbk, nullptr, 1.f, scr, lane); continue; } q -= I_CONV;
            if (q < I_ATT) { const int kb = q / 32, nbk = q % 32; transpose_item(a.w_attn_out, 1024, 1024, Wattn, 1024, 64 * kb, 32 * nbk, 32 * nbk, nullptr, 1.f, scr, lane); continue; } q -= I_ATT;
            if (q < I_O) { const int kb = q / 32, nbk = q % 32; transpose_item(a.w_o, 1024, 1024, Wo, 1024, 64 * kb, 32 * nbk, 32 * nbk, nullptr, 1.f, scr, lane); continue; } q -= I_O;
            if (q < I_1) { const int kb = q / 8, nbk = q % 8; transpose_item(a.w1_k, 2048, 256, W1, 2048, 64 * kb, 32 * nbk, 32 * nbk, nullptr, 1.f, scr, lane); continue; } q -= I_1;
            if (q < I_1) { const int kb = q / 8, nbk = q % 8; transpose_item(a.w1_v, 2048, 256, W1, 2048, 64 * kb, 32 * nbk, 256 + 32 * nbk, nullptr, 1.f, scr, lane); continue; } q -= I_1;
            if (q < I_2) { const int kb = q / 2, nbk = q % 2; transpose_item(a.w2_k, 256, 64, W2, 256, 64 * kb, 32 * nbk, 32 * nbk, nullptr, 1.f, scr, lane); continue; } q -= I_2;
            { const int kb = q / 2, nbk = q % 2; transpose_item(a.w2_v, 256, 64, W2, 256, 64 * kb, 32 * nbk, 256 + 32 * nbk, nullptr, 1.f, scr, lane); }
        }
        const int gt = vcu * 512 + tid, NGT = G * 512;
        for (int i = gt; i < 192 * 1024 / 8; i += NGT) *(u32x4*)(Win + (size_t)6208 * 1024 + (size_t)i * 8) = (u32x4){0u, 0u, 0u, 0u};
        for (int i = gt; i < 2 * 192 * 256 / 8; i += NGT) { const int half = i / (192 * 256 / 8), o = i % (192 * 256 / 8);
            *(u32x4*)(W2 + (size_t)(half * 256 + 64) * 256 + (size_t)o * 8) = (u32x4){0u, 0u, 0u, 0u}; }
        for (int m = gw; m < MTOK; m += NGW) {
            const f32x4* xr = (const f32x4*)(a.x + (size_t)m * DM) + lane; f32x4 v[4]; float s = 0.f;
#pragma unroll
            for (int j = 0; j < 4; ++j) { v[j] = xr[64 * j]; s += (v[j][0] * v[j][0] + v[j][1] * v[j][1]) + (v[j][2] * v[j][2] + v[j][3] * v[j][3]); }
            const float rstd = __builtin_amdgcn_rsqf(wave_sum(s) * (1.0f / DM) + EPS);
            u32x2* o8 = (u32x2*)(nb + (size_t)m * DM) + lane;
#pragma unroll
            for (int j = 0; j < 4; ++j) { u32x2 w; w.x = pk2(v[j][0] * rstd, v[j][1] * rstd); w.y = pk2(v[j][2] * rstd, v[j][3] * rstd); o8[64 * j] = w; }
        }
        if (bx < 2) {
            const float* pos = bx ? a.pos_v : a.pos_k; const float* w1 = bx ? a.w1_v : a.w1_k;
            const int j = tid & 255, part = tid >> 8; float s = 0.f;
            for (int k = part * 1024; k < part * 1024 + 1024; ++k) s += pos[k] * w1[(size_t)k * 256 + j];
            LAS float* red = (LAS float*)(lds + 8 * 16384);
            if (part == 1) red[j] = s;
            __syncthreads();
            if (part == 0) cbias[bx * 256 + j] = s + red[j];
        }
    }
    if (a.probe == 0x7fffffff) grid.sync();
    SEAM();
    {
        const int ncols1 = (G > 64) ? 6144 : PP;
        pg8::Gemm g{nb, Win, MTOK, ncols1, DM, DM, 128, 0}; pg8::StaticOrder S; S.init(MTOK, ncols1, G, bx);
        pg8::EpiProj E{proj, PP};
        pg8::gemm_phase(lds, g, S, E);
    }
    SEAM();
    {
        {
            pg8::Gemm g{proj + C_KC, W1, 4096, 512, 2048, 16 * PP, PP * 2, 1}; pg8::StaticOrder S; S.init(4096, 512, G, bx);
            pg8::EpiHid E{hid, cbias};
            pg8::gemm_phase(lds, g, S, E);
        }
        int wb = bx, wn = G; if (G > 64) { wb = bx - 32; wn = G - 32; }
        if (wb >= 0) {
            for (int it = wb * 512 + tid; it < MTOK * 64; it += wn * 512) {
                const int row = it >> 6, ch = (it & 63) * 8, t = row & (SEQ - 1);
                const bf16_t* pr = proj + (size_t)row * PP;
                float accv[8];
#pragma unroll
                for (int j = 0; j < 8; ++j) accv[j] = 0.f;
#pragma unroll
                for (int k = 0; k < 3; ++k) { const int dt = 2 - k;
                    if (t - dt >= 0) { const u32x4 cv = *(const u32x4*)(pr - (size_t)dt * PP + C_C + ch), hv = *(const u32x4*)(pr - (size_t)dt * PP + C_H + ch);
                        const f32x4 w0 = *(const f32x4*)(a.conv_w + k * 512 + ch), w1 = *(const f32x4*)(a.conv_w + k * 512 + ch + 4);
                        accv[0] += w0[0] * lo_bf(cv.x) * lo_bf(hv.x); accv[1] += w0[1] * hi_bf(cv.x) * hi_bf(hv.x); accv[2] += w0[2] * lo_bf(cv.y) * lo_bf(hv.y); accv[3] += w0[3] * hi_bf(cv.y) * hi_bf(hv.y);
                        accv[4] += w1[0] * lo_bf(cv.z) * lo_bf(hv.z); accv[5] += w1[1] * hi_bf(cv.z) * hi_bf(hv.z); accv[6] += w1[2] * lo_bf(cv.w) * lo_bf(hv.w); accv[7] += w1[3] * hi_bf(cv.w) * hi_bf(hv.w); } }
                const u32x4 bv = *(const u32x4*)(pr + C_B + ch);
                u32x4 o; o.x = pk2(accv[0] * lo_bf(bv.x), accv[1] * hi_bf(bv.x)); o.y = pk2(accv[2] * lo_bf(bv.y), accv[3] * hi_bf(bv.y));
                o.z = pk2(accv[4] * lo_bf(bv.z), accv[5] * hi_bf(bv.z)); o.w = pk2(accv[6] * lo_bf(bv.w), accv[7] * hi_bf(bv.w));
                *(u32x4*)(bc + (size_t)row * 512 + ch) = o;
            }
        }
        if (G > 64 && wb >= 0) {
            { pg8::Gemm g{nb, Win + (size_t)6144 * 1024, MTOK, 256, DM, DM, 128, 0}; pg8::StaticOrder S; S.init(MTOK, 256, wn, wb);
              pg8::EpiProj E{proj + 6144, PP}; pg8::gemm_phase(lds, g, S, E); }
            __syncthreads();
            LAS float* scr = (LAS float*)(lds + wave * 16384);
            constexpr int I_G = 16 * 88, I_U = 16 * 88, I_D = 44 * 32;
            for (int it = wb * 8 + wave; it < I_G + I_U + I_D; it += wn * 8) {
                int q = it;
                if (q < I_G) { const int kb = q / 88, nbk = q % 88, n0 = 32 * nbk; transpose_item(a.w_gate, 1024, DFF, Wup, 1024, 64 * kb, n0, (n0 / 128) * 256 + (n0 % 128), a.g_ffn, 1.f, scr, lane); continue; } q -= I_G;
                if (q < I_U) { const int kb = q / 88, nbk = q % 88, n0 = 32 * nbk; transpose_item(a.w_up, 1024, DFF, Wup, 1024, 64 * kb, n0, (n0 / 128) * 256 + 128 + (n0 % 128), a.g_ffn, 1.f, scr, lane); continue; } q -= I_U;
                { const int kb = q / 32, nbk = q % 32; transpose_item(a.w_down, DFF, 1024, Wdown, DFF, 64 * kb, 32 * nbk, 32 * nbk, nullptr, 1.f, scr, lane); }
            }
        }
    }
    {
        pg8::Gemm g{hid, W2, 4096, 512, 256, 256, 128, 2}; pg8::StaticOrder S; S.init(4096, 512, G, bx);
        pg8::EpiCmp E{kcmp};
        pg8::gemm_phase(lds, g, S, E);
    }
    SEAM();
    {
        for (int v = vcu; v < 256; v += G) {
            const int bh = v >> 4, s = v & 15;
#pragma unroll 1
            for (int i = 0; i < 4; ++i) { const int qb = (i == 0) ? 63 - s : (i == 1) ? 32 + s : (i == 2) ? 31 - s : s;
#if defined(PROBE_ATT2) || defined(PROBE_NOLD)
                att::attn_unit(lds, proj, kcmp, kcmp + 4096 * 64, bh, qb, a.probe);
#endif
                att::attn_unit(lds, proj, kcmp, kcmp + 4096 * 64, bh, qb, 0);
            }
        }
    }
    SEAM();
    {
        { pg8::Gemm g{bc, Wconv, MTOK, DM, 512, 512, 128, 0}; pg8::StaticOrder S; S.init(MTOK, DM, G, bx);
          pg8::EpiMix<0> E{mix, proj, C_GCONV}; pg8::gemm_phase(lds, g, S, E); }
        { pg8::Gemm g{proj + C_Q, Wattn, MTOK, DM, DM, PP, 128, 0}; pg8::StaticOrder S; S.init(MTOK, DM, G, bx);
          pg8::EpiMix<1> E{mix, proj, C_GATTN}; pg8::gemm_phase(lds, g, S, E); }
    }
    SEAM();
    {
        pg8::Gemm g{mix, Wo, MTOK, DM, DM, DM, 128, 0}; pg8::StaticOrder S; S.init(MTOK, DM, G, bx);
        pg8::EpiRes<1> E{a.x, h1f, h1b, part1}; pg8::gemm_phase(lds, g, S, E);
    }
    SEAM();
    {
        pg8::Gemm g{h1b, Wup, MTOK, 2 * DFF, DM, DM, 128, 0}; pg8::StaticOrder S; S.init(MTOK, 2 * DFF, G, bx);
        pg8::EpiUp E{act, part1}; pg8::gemm_phase(lds, g, S, E);
    }
    SEAM();
    if (G == 256) {
        pg8::Gemm g{act, Wdown, MTOK, DM, DFF, DFF, 128, 0}; pg8::StaticOrder S; S.init(MTOK, DM, G, bx);
        pg8::EpiFinal E{h1f, a.out, a.g_final, (unsigned*)part2, (unsigned*)(ws + WS_BAR) + 4096, (unsigned*)(ws + WS_BAR) + XB_TMO};
        pg8::gemm_phase(lds, g, S, E);
        return;
    }
    {
        pg8::Gemm g{act, Wdown, MTOK, DM, DFF, DFF, 128, 0}; pg8::StaticOrder S; S.init(MTOK, DM, G, bx);
        pg8::EpiRes<0> E{h1f, a.out, nullptr, part2}; pg8::gemm_phase(lds, g, S, E);
    }
    SEAM();
    {
        for (int it = bx * 512 + tid; it < MTOK * 256; it += G * 512) {
            const int row = it >> 8, c4 = (it & 255) * 4;
            const f32x4* pp = (const f32x4*)(part2 + (size_t)row * 16); float ss = 0.f;
#pragma unroll
            for (int j = 0; j < 4; ++j) { const f32x4 p = pp[j]; ss += (p[0] + p[1]) + (p[2] + p[3]); }
            const float r = __builtin_amdgcn_rsqf(ss * (1.0f / DM) + EPS);
            f32x4 v = *(f32x4*)(a.out + (size_t)row * DM + c4); const f32x4 gf = *(const f32x4*)(a.g_final + c4);
            v = v * r * gf; *(f32x4*)(a.out + (size_t)row * DM + c4) = v;
        }
    }
}

extern "C" void kernel_launch(void* const* d_in, const int* in_sizes, int n_in, void* d_out, int out_size, void* d_ws, size_t ws_size, hipStream_t stream) {
    static int grid = 0;
    if (grid == 0) {
        if (n_in != 18 || out_size != MTOK * DM || ws_size < WS_NEED) { fprintf(stderr, "kernel_launch: unexpected shapes (n_in %d out %d ws %zu)\n", n_in, out_size, ws_size); grid = -1; return; }
        int dev = 0, cus = 0, per_cu = 0;
        (void)hipGetDevice(&dev);
        (void)hipDeviceGetAttribute(&cus, hipDeviceAttributeMultiprocessorCount, dev);
        (void)hipFuncSetAttribute((const void*)nsa_fwd, hipFuncAttributeMaxDynamicSharedMemorySize, LDS_BYTES);
        (void)hipOccupancyMaxActiveBlocksPerMultiprocessor(&per_cu, (const void*)nsa_fwd, 512, LDS_BYTES);
        if (per_cu < 1) { fprintf(stderr, "kernel_launch: occupancy query says %d blocks/CU\n", per_cu); grid = -1; return; }
        grid = cus;
    }
    if (grid < 0) return;
    (void)hipMemsetAsync((unsigned char*)d_ws + WS_BAR, 0, 32768, stream);
    Args a{};
    a.x = (const float*)d_in[0]; a.w_in = (const float*)d_in[1]; a.conv_w = (const float*)d_in[2]; a.w_conv_out = (const float*)d_in[3];
    a.pos_k = (const float*)d_in[4]; a.w1_k = (const float*)d_in[5]; a.w2_k = (const float*)d_in[6];
    a.pos_v = (const float*)d_in[7]; a.w1_v = (const float*)d_in[8]; a.w2_v = (const float*)d_in[9];
    a.w_attn_out = (const float*)d_in[10]; a.w_o = (const float*)d_in[11]; a.g_mix = (const float*)d_in[12]; a.g_ffn = (const float*)d_in[13];
    a.w_gate = (const float*)d_in[14]; a.w_up = (const float*)d_in[15]; a.w_down = (const float*)d_in[16]; a.g_final = (const float*)d_in[17];
    a.out = (float*)d_out; a.ws = (unsigned char*)d_ws; a.probe = 1; a.pad = 0;
    void* args[] = {&a};
    hipError_t e = hipLaunchCooperativeKernel((void*)nsa_fwd, dim3(grid), dim3(512), args, LDS_BYTES, stream);
    if (e != hipSuccess) fprintf(stderr, "kernel_launch: cooperative launch failed: %s (grid %d)\n", hipGetErrorString(e), grid);
}
```

```cpp
#include <hip/hip_runtime.h>
#include <hip/hip_cooperative_groups.h>
#include <cstdio>
#include <cstdint>
namespace cg = cooperative_groups;

#define LAS __attribute__((address_space(3)))
typedef unsigned short bf16_t;
typedef short bf16x8 __attribute__((ext_vector_type(8)));
typedef short s16x4 __attribute__((ext_vector_type(4)));
typedef float f32x4 __attribute__((ext_vector_type(4)));
typedef float f32x16 __attribute__((ext_vector_type(16)));
typedef unsigned u32x4 __attribute__((ext_vector_type(4)));
typedef unsigned u32x2 __attribute__((ext_vector_type(2)));
typedef float f32x2_t __attribute__((ext_vector_type(2)));
typedef __bf16 bf16x2_t __attribute__((ext_vector_type(2)));

constexpr int MTOK = 16384, DM = 1024, SEQ = 4096, NB = 4;
constexpr int WPAD = 6400;
constexpr int PP = 4864;
constexpr int TENS = 16 * 4096 * 64;
constexpr int INCOLS = 6192;
constexpr int C_B = 0, C_C = 512, C_H = 1024, C_Q = 1536, C_GBR = 2560, C_GCONV = 2608, C_GATTN = 3632;
constexpr int WQ0 = 1536, WQ1 = 2560;
constexpr int DFF = 2816;
constexpr float EPS = 1e-6f;
constexpr float LOG2E = 1.4426950408889634f;
constexpr float QSCALE = 0.125f * LOG2E;

constexpr size_t MiB = 1u << 20;
constexpr size_t WS_PART1 = 0;
constexpr size_t WS_PART2 = 1 * MiB;
constexpr size_t WS_BIAS = 2 * MiB;
constexpr size_t WS_BAR = 2 * MiB + 65536;
constexpr size_t WS_WIN = 3 * MiB;
constexpr size_t WS_WCONV = 16 * MiB;
constexpr size_t WS_WATTN = 17 * MiB;
constexpr size_t WS_WO = 19 * MiB;
constexpr size_t WS_WUP = 21 * MiB;
constexpr size_t WS_WDOWN = 32 * MiB;
constexpr size_t WS_W1 = 38 * MiB;
constexpr size_t WS_W2 = 40 * MiB;
constexpr size_t WS_HID = 41 * MiB;
constexpr size_t WS_KCMP = 45 * MiB;
constexpr size_t WS_PROJ = 46 * MiB;
constexpr size_t WS_KV = 198 * MiB;
constexpr size_t WS_H1F = 46 * MiB;
constexpr size_t WS_H1B = 110 * MiB;
constexpr size_t WS_ACT = 142 * MiB;
constexpr size_t WS_NEED = 246 * MiB;
constexpr size_t OUT_BC = 32 * MiB;

constexpr int LDS_BYTES = 147456;

__device__ __forceinline__ float bf2f(unsigned short v) { return __uint_as_float(((unsigned)v) << 16); }
__device__ __forceinline__ unsigned pk2(float lo, float hi) { f32x2_t v = {lo, hi}; bf16x2_t b = __builtin_convertvector(v, bf16x2_t); return __builtin_bit_cast(unsigned, b); }
__device__ __forceinline__ float ex2(float x) { return __builtin_amdgcn_exp2f(x); }
__device__ __forceinline__ float sigmoidf_(float x) { return __builtin_amdgcn_rcpf(1.0f + ex2(-x * LOG2E)); }
__device__ __forceinline__ float lo_bf(unsigned w) { return __uint_as_float(w << 16); }
__device__ __forceinline__ float hi_bf(unsigned w) { return __uint_as_float(w & 0xffff0000u); }

namespace pg8 {
constexpr int BM = 256, BK = 64, HALF = 128, HTB = HALF * BK * 2, STAGE_BYTES = 8 * HTB, NXCD = 8, WGM = 8;
__host__ __device__ __forceinline__ int lds_byte(int r, int c) { const int st = (r >> 4) * 2 + (c >> 5), rr = r & 15, cc = c & 31, ob = rr * 64 + cc * 2; return st * 1024 + (ob ^ (((ob >> 9) & 1) << 5)); }
__host__ __device__ __forceinline__ void stage_rc(int b, int& R, int& C) { const int st = b / 1024, sb = b % 1024, swz = sb ^ (((sb >> 9) & 1) << 5); R = (st >> 1) * 16 + swz / 64; C = (st & 1) * 32 + (swz % 64) / 2; }
__host__ __device__ __forceinline__ int perm32(int rho) { const int n = rho >> 4, i = rho & 15; return 8 * (i >> 2) + 4 * n + (i & 3); }

struct Unit { int pm, pn; };
struct Gemm { const bf16_t* A; const bf16_t* Bt; int M, N, K; int lda; int a_kstep; int amode; };

struct StaticOrder {
    int nM, nN, nwg, G, c;
    __host__ __device__ void init(int M, int N, int G_, int c_) { nM = M / BM; nN = N / BM; nwg = nM * nN; G = G_; c = c_; }
    __host__ __device__ bool next(int i, Unit& u) const {
        const long L = (long)i * G + c; if (L >= nwg) return false;
        int wgid = (int)L; { const int q = nwg / NXCD, r = nwg % NXCD, xcd = wgid % NXCD, off = wgid / NXCD; wgid = (xcd < r ? xcd * (q + 1) : r * (q + 1) + (xcd - r) * q) + off; }
        const int nig = WGM * nN, gid = wgid / nig, fm = gid * WGM, gsz = (nM - fm) < WGM ? (nM - fm) : WGM;
        u.pm = fm + ((wgid % nig) % gsz); u.pn = (wgid % nig) / gsz; return true;
    }
};

__device__ __forceinline__ const char* a_tile(const Gemm& g, const Unit& u) {
    if (g.amode == 1) return (const char*)g.A + ((size_t)u.pn * TENS + (size_t)u.pm * 4096 * 64) * 2;
    if (g.amode == 2) return (const char*)g.A + ((size_t)u.pn * 4096 * 256 + (size_t)u.pm * 256 * 256) * 2;
    return (const char*)g.A + (size_t)u.pm * 256 * (size_t)g.lda * 2;
}

template <class T, class = void> struct is_fused { static constexpr bool value = false; };
template <class T> struct is_fused<T, decltype((void)T::FUSED)> { static constexpr bool value = true; };
template <class Epi>
__device__ __forceinline__ void gemm_phase(LAS unsigned char* lds, const Gemm g, const StaticOrder& S, const Epi& E) {
#ifdef NO_GEMM
    return;
#endif
    int tid_ = threadIdx.x; asm volatile("" : "+v"(tid_));
    const int tid = tid_, wid = __builtin_amdgcn_readfirstlane(tid >> 6), lane = tid & 63, wr = wid >> 2, wc = wid & 3, fr = lane & 15, fq = lane >> 4;
    const int K = g.K, nt = K / BK;
    unsigned voffA[2], voffB[2];
#pragma unroll
    for (int i = 0; i < 2; ++i) { int R, C; stage_rc(tid * 16 + i * 8192, R, C); const int Rb = (R & ~31) + perm32(R & 31);
        voffA[i] = (unsigned)(R * g.lda + C) * 2u; voffB[i] = (unsigned)(Rb * K + C) * 2u; }
    const size_t kstepA = (size_t)g.a_kstep, kstepB = (size_t)(BK * 2);
    const size_t hstepA = (size_t)HALF * g.lda * 2, hstepB = (size_t)HALF * K * 2;
    const size_t tstepB = 2 * hstepB;
    const unsigned ldsw = (unsigned)wid * 1024u;
    const int aoff = lds_byte(wr * 64 + fr, fq * 8), boff = lds_byte(wc * 32 + fr, fq * 8);
#define PG8_SA(b, h) (((b) * 2 + (h)) * HTB)
#define PG8_SB(b, h) ((4 + (b) * 2 + (h)) * HTB)
#define PG8_STAGE(bufoff, gbase, voff) do { _Pragma("unroll") for (int _i = 0; _i < 2; ++_i) \
        __builtin_amdgcn_global_load_lds((const unsigned*)((const char*)(gbase) + (voff)[_i]), (LAS unsigned*)(lds + (bufoff) + ldsw + _i * 8192), 16, 0, 0); } while (0)
#define PG8_LDA(dst, b, h) do { _Pragma("unroll") for (int m = 0; m < 4; ++m) _Pragma("unroll") for (int k = 0; k < 2; ++k) dst[m][k] = *(const LAS bf16x8*)(lds + PG8_SA(b, h) + aoff + m * 2048 + k * 1024); } while (0)
#define PG8_LDB(dst, b, h) do { _Pragma("unroll") for (int n = 0; n < 2; ++n) _Pragma("unroll") for (int k = 0; k < 2; ++k) dst[n][k] = *(const LAS bf16x8*)(lds + PG8_SB(b, h) + boff + n * 2048 + k * 1024); } while (0)
#define PG8_MMA(ai, bj, At, Bt) do { __builtin_amdgcn_s_setprio(1); _Pragma("unroll") for (int m = 0; m < 4; ++m) _Pragma("unroll") for (int n = 0; n < 2; ++n) _Pragma("unroll") for (int k = 0; k < 2; ++k) \
        acc[ai][bj][m][n] = __builtin_amdgcn_mfma_f32_16x16x32_bf16(Bt[n][k], At[m][k], acc[ai][bj][m][n], 0, 0, 0); __builtin_amdgcn_s_setprio(0); } while (0)
#define PG8_WAIT_V(n) asm volatile("s_waitcnt vmcnt(" #n ")" ::: "memory")
#define PG8_WAIT_L(n) asm volatile("s_waitcnt lgkmcnt(" #n ")" ::: "memory")
#define PG8_BAR __builtin_amdgcn_s_barrier()
#define PG8_SCHED __builtin_amdgcn_sched_barrier(0)
    Unit cur, nxt; int ui = 0;
    if (!S.next(0, cur)) return;
    f32x4 acc[2][2][4][2];
#pragma unroll
    for (int a = 0; a < 2; ++a)
#pragma unroll
        for (int b = 0; b < 2; ++b)
#pragma unroll
            for (int m = 0; m < 4; ++m)
#pragma unroll
                for (int n = 0; n < 2; ++n) acc[a][b][m][n] = (f32x4){0.f, 0.f, 0.f, 0.f};
    bf16x8 At[4][2], B0[2][2], B1[2][2];
    const char* cA = a_tile(g, cur); const char* cB = (const char*)g.Bt + (size_t)cur.pn * tstepB;
    PG8_STAGE(PG8_SB(0, 0), cB, voffB); PG8_STAGE(PG8_SB(0, 1), cB + hstepB, voffB); PG8_STAGE(PG8_SA(0, 0), cA, voffA); PG8_STAGE(PG8_SA(0, 1), cA + hstepA, voffA);
    if (wr == 1) PG8_BAR;
    PG8_WAIT_V(2); PG8_BAR;
    PG8_STAGE(PG8_SB(1, 0), cB + kstepB, voffB); PG8_STAGE(PG8_SA(1, 0), cA + kstepA, voffA); PG8_STAGE(PG8_SB(1, 1), cB + hstepB + kstepB, voffB);
    PG8_WAIT_V(6); PG8_BAR;
    for (;;) {
        const bool has_next = S.next(ui + 1, nxt);
        const char* nA = has_next ? a_tile(g, nxt) : cA; const char* nB = has_next ? (const char*)g.Bt + (size_t)nxt.pn * tstepB : cB;
        for (int t = 0; t < nt; t += 2) {
            const bool last = (t == nt - 2);
            const char* a1 = cA + (size_t)(t + 1) * kstepA;
            const char* a2 = last ? nA : cA + (size_t)(t + 2) * kstepA; const char* b2 = last ? nB : cB + (size_t)(t + 2) * kstepB;
            const char* a3 = a2 + kstepA; const char* b3 = b2 + kstepB;
            PG8_LDB(B0, 0, 0); PG8_LDB(B1, 0, 1); PG8_SCHED; PG8_LDA(At, 0, 0); PG8_STAGE(PG8_SA(1, 1), a1 + hstepA, voffA);
            PG8_WAIT_V(8); PG8_WAIT_L(0); PG8_BAR; PG8_MMA(0, 0, At, B0); PG8_MMA(0, 1, At, B1); PG8_BAR; PG8_SCHED;
            PG8_LDA(At, 0, 1); PG8_STAGE(PG8_SB(0, 0), b2, voffB); PG8_STAGE(PG8_SB(0, 1), b2 + hstepB, voffB); PG8_STAGE(PG8_SA(0, 0), a2, voffA);
            PG8_WAIT_V(8); PG8_WAIT_L(0); PG8_BAR; PG8_MMA(1, 0, At, B0); PG8_MMA(1, 1, At, B1); PG8_BAR; PG8_SCHED;
            PG8_LDB(B0, 1, 0); PG8_LDB(B1, 1, 1); PG8_SCHED; PG8_LDA(At, 1, 0); PG8_STAGE(PG8_SA(0, 1), a2 + hstepA, voffA);
            PG8_WAIT_V(8); PG8_WAIT_L(0); PG8_BAR; PG8_MMA(0, 0, At, B0); PG8_MMA(0, 1, At, B1); PG8_BAR; PG8_SCHED;
            PG8_LDA(At, 1, 1); PG8_STAGE(PG8_SB(1, 0), b3, voffB); PG8_STAGE(PG8_SB(1, 1), b3 + hstepB, voffB); PG8_STAGE(PG8_SA(1, 0), a3, voffA);
            PG8_WAIT_V(8); PG8_WAIT_L(0); PG8_BAR; PG8_MMA(1, 0, At, B0); PG8_MMA(1, 1, At, B1); PG8_BAR; PG8_SCHED;
        }
        if (wr == 0) PG8_BAR;
        if constexpr (!is_fused<Epi>::value) E(acc, cur, wr, wc, fr, fq);
        if (!has_next) break;
#pragma unroll
        for (int a = 0; a < 2; ++a)
#pragma unroll
            for (int b = 0; b < 2; ++b)
#pragma unroll
                for (int m = 0; m < 4; ++m)
#pragma unroll
                    for (int n = 0; n < 2; ++n) acc[a][b][m][n] = (f32x4){0.f, 0.f, 0.f, 0.f};
        cur = nxt; cA = nA; cB = nB; ++ui;
        if (wr == 1) PG8_BAR;
    }
    PG8_WAIT_V(0);
    PG8_BAR;
    if constexpr (is_fused<Epi>::value) E.fused(acc, cur, wr, wc, fr, fq, lds, wid, lane);
#undef PG8_SA
#undef PG8_SB
#undef PG8_STAGE
#undef PG8_LDA
#undef PG8_LDB
#undef PG8_MMA
#undef PG8_WAIT_V
#undef PG8_WAIT_L
#undef PG8_BAR
#undef PG8_SCHED
}

typedef f32x4 Acc[2][2][4][2];
#define EPI_LOOP_BEGIN \
    _Pragma("unroll") for (int ai = 0; ai < 2; ++ai) _Pragma("unroll") for (int m = 0; m < 4; ++m) { const int row = u.pm * BM + wr * 64 + fr + ai * HALF + m * 16; \
    _Pragma("unroll") for (int bj = 0; bj < 2; ++bj) { const f32x4 v0 = acc[ai][bj][m][0], v1 = acc[ai][bj][m][1]; const int col = u.pn * BM + bj * HALF + wc * 32 + 8 * fq;
#define EPI_LOOP_END } }
__device__ __forceinline__ u32x4 pack8(const f32x4 a, const f32x4 b) { u32x4 w; w.x = pk2(a[0], a[1]); w.y = pk2(a[2], a[3]); w.z = pk2(b[0], b[1]); w.w = pk2(b[2], b[3]); return w; }

struct EpiProj { bf16_t* O; int ldc; bf16_t* kv;
    __device__ __forceinline__ void operator()(const Acc& acc, const Unit& u, int wr, int wc, int fr, int fq) const {
        if (kv && u.pn >= 10 && u.pn < 16) {
            bf16_t* base = kv + (size_t)(u.pn - 10) * TENS;
            EPI_LOOP_BEGIN
                const int c = col - u.pn * BM, hk = c >> 6, d = c & 63, bb = row >> 12, tt = row & 4095;
                *(u32x4*)(base + ((size_t)(bb * 4 + hk) * 4096 + tt) * 64 + d) = pack8(v0, v1);
            EPI_LOOP_END
        } else {
            const int shift = (kv && u.pn >= 16) ? 1536 : 0;
            EPI_LOOP_BEGIN
                *(u32x4*)(O + (size_t)row * ldc + col - shift) = pack8(v0, v1);
            EPI_LOOP_END
        }
    } };
__device__ __forceinline__ float gelu_tanh(float x) {
    const float z = x * (1.0f + 0.044715f * x * x) * (2.0f * 0.7978845608028654f * LOG2E);
    return x * __builtin_amdgcn_rcpf(1.0f + ex2(-z));
}
struct EpiHid { bf16_t* O; const float* bias;
    __device__ __forceinline__ void operator()(const Acc& acc, const Unit& u, int wr, int wc, int fr, int fq) const {
        EPI_LOOP_BEGIN
            const int c = col - u.pn * BM; const float* bp = bias + u.pn * 256 + c;
            const f32x4 b0 = *(const f32x4*)bp, b1 = *(const f32x4*)(bp + 4);
            f32x4 a = v0 + b0, b = v1 + b1;
#pragma unroll
            for (int j = 0; j < 4; ++j) { a[j] = gelu_tanh(a[j]); b[j] = gelu_tanh(b[j]); }
            *(u32x4*)(O + (size_t)u.pn * 4096 * 256 + (size_t)row * 256 + c) = pack8(a, b);
        EPI_LOOP_END
    } };
struct EpiCmp { bf16_t* O;
    __device__ __forceinline__ void operator()(const Acc& acc, const Unit& u, int wr, int wc, int fr, int fq) const {
        EPI_LOOP_BEGIN
            const int c = col - u.pn * BM;
            if (c < 64) { u32x4 w = pack8(v0, v1); if ((row & 255) == 255) w = (u32x4){0u, 0u, 0u, 0u};
                *(u32x4*)(O + (size_t)u.pn * 4096 * 64 + (size_t)row * 64 + c) = w; }
        EPI_LOOP_END
    } };
template <int ADD> struct EpiMix { bf16_t* mix; const bf16_t* proj; int gcol;
    __device__ __forceinline__ void operator()(const Acc& acc, const Unit& u, int wr, int wc, int fr, int fq) const {
        EPI_LOOP_BEGIN
            const u32x4 gv = *(const u32x4*)(proj + (size_t)row * PP + gcol + col);
            f32x4 a, b;
            a[0] = sigmoidf_(lo_bf(gv.x)) * v0[0]; a[1] = sigmoidf_(hi_bf(gv.x)) * v0[1]; a[2] = sigmoidf_(lo_bf(gv.y)) * v0[2]; a[3] = sigmoidf_(hi_bf(gv.y)) * v0[3];
            b[0] = sigmoidf_(lo_bf(gv.z)) * v1[0]; b[1] = sigmoidf_(hi_bf(gv.z)) * v1[1]; b[2] = sigmoidf_(lo_bf(gv.w)) * v1[2]; b[3] = sigmoidf_(hi_bf(gv.w)) * v1[3];
            bf16_t* mp = mix + (size_t)row * DM + col;
            if (ADD) { const u32x4 pv = *(const u32x4*)mp;
                a[0] += lo_bf(pv.x); a[1] += hi_bf(pv.x); a[2] += lo_bf(pv.y); a[3] += hi_bf(pv.y); b[0] += lo_bf(pv.z); b[1] += hi_bf(pv.z); b[2] += lo_bf(pv.w); b[3] += hi_bf(pv.w); }
            *(u32x4*)mp = pack8(a, b);
        EPI_LOOP_END
    } };
template <int WB> struct EpiRes { const float* base; float* hf; bf16_t* hb; float* part;
    __device__ __forceinline__ void operator()(const Acc& acc, const Unit& u, int wr, int wc, int fr, int fq) const {
#pragma unroll
        for (int ai = 0; ai < 2; ++ai)
#pragma unroll
            for (int m = 0; m < 4; ++m) { const int row = u.pm * BM + wr * 64 + fr + ai * HALF + m * 16; float ss = 0.f;
#pragma unroll
                for (int bj = 0; bj < 2; ++bj) { const int col = u.pn * BM + bj * HALF + wc * 32 + 8 * fq; const size_t off = (size_t)row * DM + col;
                    const f32x4 x0 = *(const f32x4*)(base + off), x1 = *(const f32x4*)(base + off + 4);
                    const f32x4 a = x0 + acc[ai][bj][m][0], b = x1 + acc[ai][bj][m][1];
                    *(f32x4*)(hf + off) = a; *(f32x4*)(hf + off + 4) = b;
                    if (WB) *(u32x4*)(hb + off) = pack8(a, b);
                    ss += (a[0] * a[0] + a[1] * a[1]) + (a[2] * a[2] + a[3] * a[3]) + (b[0] * b[0] + b[1] * b[1]) + (b[2] * b[2] + b[3] * b[3]); }
                ss += __shfl_xor(ss, 16); ss += __shfl_xor(ss, 32);
                if (fq == 0) part[(size_t)row * 16 + u.pn * 4 + wc] = ss; }
    } };
struct EpiUp { bf16_t* act; const float* part;
    __device__ __forceinline__ void operator()(const Acc& acc, const Unit& u, int wr, int wc, int fr, int fq) const {
#pragma unroll
        for (int ai = 0; ai < 2; ++ai)
#pragma unroll
            for (int m = 0; m < 4; ++m) { const int row = u.pm * BM + wr * 64 + fr + ai * HALF + m * 16;
                const f32x4 pp = *(const f32x4*)(part + (size_t)row * 16 + 4 * fq); float ss = (pp[0] + pp[1]) + (pp[2] + pp[3]);
                ss += __shfl_xor(ss, 16); ss += __shfl_xor(ss, 32);
                const float r = __builtin_amdgcn_rsqf(ss * (1.0f / DM) + EPS);
                f32x4 a, b;
#pragma unroll
                for (int j = 0; j < 4; ++j) { const float g0 = acc[ai][0][m][0][j] * r, u0 = acc[ai][1][m][0][j] * r, g1 = acc[ai][0][m][1][j] * r, u1 = acc[ai][1][m][1][j] * r;
                    a[j] = g0 * sigmoidf_(g0) * u0; b[j] = g1 * sigmoidf_(g1) * u1; }
                *(u32x4*)(act + (size_t)row * DFF + u.pn * 128 + wc * 32 + 8 * fq) = pack8(a, b); }
    } };
struct EpiFinal { static constexpr bool FUSED = true;
    const float* base; float* out; const float* gfin; unsigned* xbuf; unsigned* cnt; unsigned* tmo;
    __device__ __forceinline__ void operator()(const Acc&, const Unit&, int, int, int, int) const {}
    __device__ __forceinline__ void fused(f32x4 (&acc)[2][2][4][2], const Unit& u, int wr, int wc, int fr, int fq, LAS unsigned char* lds, int wid, int lane) const {
        LAS float* P = (LAS float*)lds;
        LAS float* S = (LAS float*)(lds + 8192);
        LAS unsigned* flag = (LAS unsigned*)(lds + 8192 + 2048);
#pragma unroll
        for (int ai = 0; ai < 2; ++ai)
#pragma unroll
            for (int m = 0; m < 4; ++m) { const int rl = ai * HALF + wr * 64 + m * 16 + fr; const int row = u.pm * BM + rl; float ss = 0.f;
#pragma unroll
                for (int bj = 0; bj < 2; ++bj) { const int col = u.pn * BM + bj * HALF + wc * 32 + 8 * fq; const size_t off = (size_t)row * DM + col;
                    const f32x4 x0 = *(const f32x4*)(base + off), x1 = *(const f32x4*)(base + off + 4);
                    const f32x4 a = x0 + acc[ai][bj][m][0], b = x1 + acc[ai][bj][m][1]; acc[ai][bj][m][0] = a; acc[ai][bj][m][1] = b;
                    ss += (a[0] * a[0] + a[1] * a[1]) + (a[2] * a[2] + a[3] * a[3]) + (b[0] * b[0] + b[1] * b[1]) + (b[2] * b[2] + b[3] * b[3]); }
                ss += __shfl_xor(ss, 16); ss += __shfl_xor(ss, 32);
                if (fq == 0) P[rl * 4 + wc] = ss; }
        asm volatile("s_waitcnt lgkmcnt(0)" ::: "memory"); __builtin_amdgcn_s_barrier(); asm volatile("" ::: "memory");
        const int rl = wid * 32 + (lane & 31);
        if (lane < 32) { const float tot = (P[rl * 4 + 0] + P[rl * 4 + 1]) + (P[rl * 4 + 2] + P[rl * 4 + 3]);
            __hip_atomic_store(xbuf + ((size_t)(u.pm * BM + rl) * 4 + u.pn), __float_as_uint(tot), __ATOMIC_RELAXED, __HIP_MEMORY_SCOPE_AGENT); }
        asm volatile("s_waitcnt vmcnt(0)" ::: "memory");
        if (lane == 0) __hip_atomic_fetch_add(cnt + 64 * u.pm, 1u, __ATOMIC_RELAXED, __HIP_MEMORY_SCOPE_AGENT);
        if (wid == 0) {
            unsigned sp = 0u;
            for (;;) {
                if ((unsigned)__builtin_amdgcn_readfirstlane(__hip_atomic_load(cnt + 64 * u.pm, __ATOMIC_RELAXED, __HIP_MEMORY_SCOPE_AGENT)) >= 32u) break;
                __builtin_amdgcn_s_sleep(2);
                if (++sp > (1u << 20)) { if (lane == 0) __hip_atomic_store(tmo, 1u, __ATOMIC_RELAXED, __HIP_MEMORY_SCOPE_AGENT); break; }
            }
            __builtin_amdgcn_fence(__ATOMIC_ACQUIRE, "agent");
            if (lane == 0) flag[0] = 1u;
        }
        asm volatile("s_waitcnt vmcnt(0) lgkmcnt(0)" ::: "memory"); __builtin_amdgcn_s_barrier(); asm volatile("" ::: "memory");
        if (lane < 32) { const unsigned* sl = xbuf + (size_t)(u.pm * BM + rl) * 4; float tot = 0.f;
#pragma unroll
            for (int t = 0; t < 4; ++t) tot += __uint_as_float(__hip_atomic_load(sl + t, __ATOMIC_RELAXED, __HIP_MEMORY_SCOPE_AGENT));
            S[rl] = __builtin_amdgcn_rsqf(tot * (1.0f / DM) + EPS); }
        asm volatile("s_waitcnt lgkmcnt(0)" ::: "memory"); __builtin_amdgcn_s_barrier(); asm volatile("" ::: "memory");
#pragma unroll
        for (int bj = 0; bj < 2; ++bj) { const int col = u.pn * BM + bj * HALF + wc * 32 + 8 * fq;
            const f32x4 g0 = *(const f32x4*)(gfin + col), g1 = *(const f32x4*)(gfin + col + 4);
#pragma unroll
            for (int ai = 0; ai < 2; ++ai)
#pragma unroll
                for (int m = 0; m < 4; ++m) { const int rl2 = ai * HALF + wr * 64 + m * 16 + fr; const float rs = S[rl2]; const size_t off = (size_t)(u.pm * BM + rl2) * DM + col;
                    *(f32x4*)(out + off) = acc[ai][bj][m][0] * rs * g0; *(f32x4*)(out + off + 4) = acc[ai][bj][m][1] * rs * g1; } }
    } };
}

namespace att {
constexpr int KB0 = 0, VB0 = 24576, IMP = 49152, IMPW = 65, SELM = IMP + 4 * 64 * IMPW * 4, WMASK = SELM + 512, WSF = WMASK + 64, STEPS = WSF + 8 * 32 * 4, CMPX = STEPS + 8 * 128, ATT_LDS = CMPX + 16384;
static_assert(ATT_LDS <= 143360, "attention LDS");
#define MFMA32(a, b, c) __builtin_amdgcn_mfma_f32_32x32x16_bf16((a), (b), (c), 0, 0, 0)
__device__ __forceinline__ int crow(int r, int hi) { return (r & 3) + 8 * (r >> 2) + 4 * hi; }
typedef short v4i16_t __attribute__((ext_vector_type(4)));
__device__ __forceinline__ s16x4 vtr(LAS const unsigned char* p) { return __builtin_bit_cast(s16x4, __builtin_amdgcn_ds_read_tr16_b64_v4i16((LAS v4i16_t*)p)); }

struct St { float m, l; f32x16 o0, o1; };

__device__ __forceinline__ void qk_tile(f32x16& p0, f32x16& p1, LAS const unsigned char* kb, const bf16x8* qf, int r, int h) {
    bf16x8 k0[4], k1[4], qv[4];
#pragma unroll
    for (int d0 = 0; d0 < 4; ++d0) { k0[d0] = *(const LAS bf16x8*)(kb + (2 * d0 + h) * 1024 + r * 16); k1[d0] = *(const LAS bf16x8*)(kb + (2 * d0 + h) * 1024 + 512 + r * 16);
        qv[d0] = qf[d0]; }
#pragma unroll
    for (int i = 0; i < 16; ++i) { p0[i] = 0.f; p1[i] = 0.f; }
    __builtin_amdgcn_sched_barrier(0);
#pragma unroll
    for (int d0 = 0; d0 < 4; ++d0) { p0 = MFMA32(k0[d0], qv[d0], p0); p1 = MFMA32(k1[d0], qv[d0], p1); }
}
__device__ __forceinline__ void apply_mask(f32x16& p0, f32x16& p1, unsigned long long allow, int h) {
    if (__all(allow == ~0ull)) return;
    const unsigned long long a = allow >> (4 * h); const unsigned lo = (unsigned)a, hi = (unsigned)(a >> 32);
#pragma unroll
    for (int i = 0; i < 16; ++i) { const int cb = (i & 3) + 8 * (i >> 2);
        p0[i] = ((lo >> cb) & 1u) ? p0[i] : -INFINITY; p1[i] = ((hi >> cb) & 1u) ? p1[i] : -INFINITY; }
}
__device__ __forceinline__ float rowmax32(const f32x16& p0, const f32x16& p1) {
    float a = fmaxf(p0[0], p1[0]);
#pragma unroll
    for (int i = 1; i < 16; ++i) a = fmaxf(a, fmaxf(p0[i], p1[i]));
    return fmaxf(a, __shfl_xor(a, 32));
}
__device__ __forceinline__ void pv_tile(f32x16& o0, f32x16& o1, LAS const unsigned char* vb, const f32x16& p0, const f32x16& p1, int lane, int h) {
    bf16x8 pa[4];
#pragma unroll
    for (int s = 0; s < 4; ++s) { u32x4 w;
#pragma unroll
        for (int j = 0; j < 4; ++j) { const int i0 = 8 * (s & 1) + 2 * j; w[j] = (s < 2) ? pk2(p0[i0], p0[i0 + 1]) : pk2(p1[i0], p1[i0 + 1]); }
        pa[s] = __builtin_bit_cast(bf16x8, w); }
    LAS const unsigned char* vp = vb + ((lane >> 4) & 1) * 32 + (lane & 3) * 8 + (4 * h + ((lane & 15) >> 2)) * 64;
    s16x4 l0[4], h0[4], l1[4], h1[4];
#pragma unroll
    for (int s = 0; s < 4; ++s) { l0[s] = vtr(vp + s * 1024); h0[s] = vtr(vp + s * 1024 + 512); l1[s] = vtr(vp + 4096 + s * 1024); h1[s] = vtr(vp + 4096 + s * 1024 + 512); }
    __builtin_amdgcn_sched_barrier(0);
#pragma unroll
    for (int s = 0; s < 4; ++s) {
        const bf16x8 v0 = (bf16x8){l0[s][0], l0[s][1], l0[s][2], l0[s][3], h0[s][0], h0[s][1], h0[s][2], h0[s][3]};
        const bf16x8 v1 = (bf16x8){l1[s][0], l1[s][1], l1[s][2], l1[s][3], h1[s][0], h1[s][1], h1[s][2], h1[s][3]};
        o0 = MFMA32(pa[s], v0, o0); o1 = MFMA32(pa[s], v1, o1);
    }
}
__device__ __forceinline__ void tile_online(St& st, LAS const unsigned char* kb, LAS const unsigned char* vb, const bf16x8* qr, unsigned long long allow,
                                            LAS float* wsf, int lane, int r, int h) {
    f32x16 p0, p1; qk_tile(p0, p1, kb, qr, r, h); __builtin_amdgcn_sched_barrier(0); apply_mask(p0, p1, allow, h);
    const float rm = rowmax32(p0, p1), mnew = fmaxf(st.m, rm), f = ex2(st.m - mnew); st.m = mnew;
    float ls = 0.f;
#pragma unroll
    for (int i = 0; i < 16; ++i) { p0[i] = ex2(p0[i] - mnew); p1[i] = ex2(p1[i] - mnew); ls += p0[i] + p1[i]; }
    st.l = st.l * f + ls;
    if (__any(f != 1.0f)) {
        if (h == 0) wsf[r] = f;
#pragma unroll
        for (int i = 0; i < 16; ++i) { const float fi = wsf[crow(i, h)]; st.o0[i] *= fi; st.o1[i] *= fi; }
    }
    pv_tile(st.o0, st.o1, vb, p0, p1, lane, h);
}
__device__ __forceinline__ void tile_stats(float& m, float& l, LAS const unsigned char* kb, const bf16x8* qr, unsigned long long allow, int r, int h) {
    f32x16 p0, p1; qk_tile(p0, p1, kb, qr, r, h); __builtin_amdgcn_sched_barrier(0); apply_mask(p0, p1, allow, h);
    const float rm = rowmax32(p0, p1), mnew = fmaxf(m, rm), f = ex2(m - mnew); m = mnew;
    float ls = 0.f;
#pragma unroll
    for (int i = 0; i < 16; ++i) ls += ex2(p0[i] - mnew) + ex2(p1[i] - mnew);
    l = l * f + ls;
}
__device__ __forceinline__ void tile_exact(f32x16& o0, f32x16& o1, float m, float invl, LAS const unsigned char* kb, LAS const unsigned char* vb, const bf16x8* qr,
                                           unsigned long long allow, LAS float* impw  , float& carry, int j, int lane, int r, int h) {
    f32x16 p0, p1; qk_tile(p0, p1, kb, qr, r, h); __builtin_amdgcn_sched_barrier(0); apply_mask(p0, p1, allow, h);
#pragma unroll
    for (int i = 0; i < 16; ++i) { p0[i] = ex2(p0[i] - m) * invl; p1[i] = ex2(p1[i] - m) * invl; }
#pragma unroll
    for (int pos = 0; pos < 8; ++pos) {
        const int half = pos >> 2, r4 = pos & 3;
        const float P0 = half ? p1[4 * r4] : p0[4 * r4], P1 = half ? p1[4 * r4 + 1] : p0[4 * r4 + 1], P2 = half ? p1[4 * r4 + 2] : p0[4 * r4 + 2], P3 = half ? p1[4 * r4 + 3] : p0[4 * r4 + 3];
        const float a = (P0 + P1) + (P2 + 0.5f * P3), b = 0.5f * P3;
        const float bx = __shfl_xor(b, 32);
        const float add = h ? bx : carry;
        impw[16 * j + 2 * pos + h] = a + add;
        carry = bx;
    }
    pv_tile(o0, o1, vb, p0, p1, lane, h);
}

__device__ __forceinline__ void qk_tile_c(f32x16& p0, f32x16& p1, LAS const unsigned char* kb, const bf16x8* qf, const f32x16& c, int r, int h) {
    bf16x8 k0[4], k1[4], qv[4];
#pragma unroll
    for (int d0 = 0; d0 < 4; ++d0) { k0[d0] = *(const LAS bf16x8*)(kb + (2 * d0 + h) * 1024 + r * 16); k1[d0] = *(const LAS bf16x8*)(kb + (2 * d0 + h) * 1024 + 512 + r * 16);
        qv[d0] = qf[d0]; }
    __builtin_amdgcn_sched_barrier(0);
    p0 = MFMA32(k0[0], qv[0], c); p1 = MFMA32(k1[0], qv[0], c);
#pragma unroll
    for (int d0 = 1; d0 < 4; ++d0) { p0 = MFMA32(k0[d0], qv[d0], p0); p1 = MFMA32(k1[d0], qv[d0], p1); }
}
__device__ __forceinline__ unsigned long long lowmask(int n);
__device__ __forceinline__ void soft_pv(St& st, f32x16& x0, f32x16& x1, float cx, LAS const unsigned char* vb, bool first, int kind, int tq,
                                        LAS float* wsf, int lane, int r, int h) {
    if (first) st.m = cx;
    else { const float d = st.m - cx;
        if (__any(d != 0.f)) {
#pragma unroll
            for (int i = 0; i < 16; ++i) { x0[i] -= d; x1[i] -= d; } } }
    if (kind) apply_mask(x0, x1, kind == 1 ? lowmask(tq + 1) : ~lowmask(tq + 1), h);
    const float rm = rowmax32(x0, x1);
    if (first) {
        const float dl = (rm > -INFINITY) ? rm : 0.f; st.m += dl;
#pragma unroll
        for (int i = 0; i < 16; ++i) { x0[i] -= dl; x1[i] -= dl; }
    } else if (__any(rm > 8.0f)) {
        const float dl = fmaxf(rm, 0.f), f = ex2(-dl); st.m += dl; st.l *= f;
        if (h == 0) wsf[r] = f;
#pragma unroll
        for (int i = 0; i < 16; ++i) { x0[i] -= dl; x1[i] -= dl; }
#pragma unroll
        for (int i = 0; i < 16; ++i) { const float fi = wsf[crow(i, h)]; st.o0[i] *= fi; st.o1[i] *= fi; }
    }
    float ls = 0.f;
#pragma unroll
    for (int i = 0; i < 16; ++i) { x0[i] = ex2(x0[i]); x1[i] = ex2(x1[i]); ls += x0[i] + x1[i]; }
    st.l += ls;
    pv_tile(st.o0, st.o1, vb, x0, x1, lane, h);
}
__device__ __forceinline__ unsigned long long lowmask(int n) { return n >= 64 ? ~0ull : ((1ull << n) - 1ull); }

typedef LAS const char* lds_cptr;
__device__ __forceinline__ void hs_glds16(const void* gsrc, unsigned lds_dst) { unsigned keep;
    asm volatile("s_mov_b32 %0, m0\n\ts_mov_b32 m0, %2\n\ts_nop 0\n\tglobal_load_lds_dwordx4 %1, off\n\ts_mov_b32 m0, %0" : "=&s"(keep) : "v"(gsrc), "s"(lds_dst) : "memory"); }
__device__ __forceinline__ float hs_max3f(float a, float b, float c) { float r; asm("v_max3_f32 %0, %1, %2, %3" : "=v"(r) : "v"(a), "v"(b), "v"(c)); return r; }
__device__ __forceinline__ float hs_max2f(float a, float b) { float r; asm("v_max_f32_e32 %0, %1, %2" : "=v"(r) : "v"(a), "v"(b)); return r; }
__device__ __forceinline__ float hs_fadd(float a, float b) { float r; asm("v_add_f32_e32 %0, %1, %2" : "=v"(r) : "v"(a), "v"(b)); return r; }
__device__ __forceinline__ float hs_fsub(float a, float b) { float r; asm("v_sub_f32_e32 %0, %1, %2" : "=v"(r) : "v"(a), "v"(b)); return r; }
#define HS_SBAR() __builtin_amdgcn_sched_barrier(0)
#define HS_WAIT_BAR(N) asm volatile("s_waitcnt vmcnt(" #N ") lgkmcnt(0)\n\ts_barrier" ::: "memory")
__device__ __forceinline__ void hs_qkt(f32x16& p0, f32x16& p1, const char* Kslot, const bf16x8* qr, const f32x16& negm, int r32, int hi) {
    const char* kb = Kslot + hi * 1024 + r32 * 16;
#pragma unroll
    for (int d0 = 0; d0 < 4; ++d0) {
        const bf16x8 b0 = *reinterpret_cast<const bf16x8*>(kb + d0 * 2048);
        const bf16x8 b1 = *reinterpret_cast<const bf16x8*>(kb + d0 * 2048 + 512);
        if (d0 == 0) { p0 = MFMA32(b0, qr[0], negm); p1 = MFMA32(b1, qr[0], negm); }
        else { p0 = MFMA32(b0, qr[d0], p0); p1 = MFMA32(b1, qr[d0], p1); } }
}
__device__ __forceinline__ void hs_kload8(bf16x8* kf, lds_cptr kp) {
    kf[0] = *(const LAS bf16x8*)(kp);        kf[1] = *(const LAS bf16x8*)(kp + 512);
    kf[2] = *(const LAS bf16x8*)(kp + 2048); kf[3] = *(const LAS bf16x8*)(kp + 2560);
    kf[4] = *(const LAS bf16x8*)(kp + 4096); kf[5] = *(const LAS bf16x8*)(kp + 4608);
    kf[6] = *(const LAS bf16x8*)(kp + 6144); kf[7] = *(const LAS bf16x8*)(kp + 6656);
}
__device__ __forceinline__ void hs_kload2(bf16x8* kf, lds_cptr kp, int j) { kf[2 * j] = *(const LAS bf16x8*)(kp + j * 2048); kf[2 * j + 1] = *(const LAS bf16x8*)(kp + j * 2048 + 512); }
__device__ __forceinline__ s16x4 hs_vtr(lds_cptr p) { return __builtin_bit_cast(s16x4, __builtin_amdgcn_ds_read_tr16_b64_v4i16((LAS v4i16_t*)p)); }
__device__ __forceinline__ float hs_rowmax(const f32x16& p0, const f32x16& p1) {
    float a = hs_max3f(p0[0], p0[1], p1[0]), b = hs_max3f(p0[2], p0[3], p1[1]); a = hs_max3f(a, p1[2], p1[3]);
#pragma unroll
    for (int r = 4; r < 16; r += 4) { a = hs_max3f(a, p0[r], p0[r + 1]); b = hs_max3f(b, p0[r + 2], p0[r + 3]); a = hs_max3f(a, p1[r], p1[r + 1]); b = hs_max3f(b, p1[r + 2], p1[r + 3]); }
    const float m = hs_max2f(a, b);
    auto rr = __builtin_amdgcn_permlane32_swap(__float_as_uint(m), __float_as_uint(m), false, false);
    return hs_max2f(__uint_as_float(rr[0]), __uint_as_float(rr[1]));
}
__device__ __forceinline__ void hs_pv(f32x16* o, int vb, bf16x8 pa0, bf16x8 pa1, bf16x8 pa2, bf16x8 pa3) {
#pragma unroll
    for (int d0 = 0; d0 < 2; ++d0) { s16x4 lo[4], hi[4];
#pragma unroll
        for (int ks = 0; ks < 4; ++ks) {
            asm volatile("ds_read_b64_tr_b16 %0,%1 offset:%c2" : "=&v"(lo[ks]) : "v"(vb), "i"(d0 * 4096 + ks * 1024) : "memory");
            asm volatile("ds_read_b64_tr_b16 %0,%1 offset:%c2" : "=&v"(hi[ks]) : "v"(vb), "i"(d0 * 4096 + ks * 1024 + 512) : "memory"); }
        asm volatile("s_waitcnt lgkmcnt(0)" ::: "memory"); HS_SBAR();
#define HS_PK(k) (bf16x8){lo[k][0], lo[k][1], lo[k][2], lo[k][3], hi[k][0], hi[k][1], hi[k][2], hi[k][3]}
        o[d0] = MFMA32(pa0, HS_PK(0), o[d0]); o[d0] = MFMA32(pa1, HS_PK(1), o[d0]); o[d0] = MFMA32(pa2, HS_PK(2), o[d0]); o[d0] = MFMA32(pa3, HS_PK(3), o[d0]);
#undef HS_PK
    }
}
__device__ __forceinline__ void hs_pre_dma(char* shm, const bf16_t* ksb, int c0, int c1, int c2, int wid, int lane) {
    const unsigned lds0 = (unsigned)(uintptr_t)shm;
    const size_t koff = (size_t)lane * 64 + wid * 8, voff = (size_t)(16 * (wid & 3) + (lane >> 2)) * 64 + (wid >> 2) * 32 + (lane & 3) * 8 + (size_t)TENS;
    const unsigned kdst = lds0 + KB0 + wid * 1024, vdst = lds0 + VB0 + wid * 1024;
#define HS_SRC0(c) (ksb + (((c) & 0x80) ? (size_t)2 * TENS : (size_t)0) + (size_t)(((c) == 0x7f) ? 0 : ((c) & 0x7f)) * 4096)
    hs_glds16(HS_SRC0(c0) + koff, (unsigned)__builtin_amdgcn_readfirstlane(kdst));
    hs_glds16(HS_SRC0(c0) + voff, (unsigned)__builtin_amdgcn_readfirstlane(vdst));
    hs_glds16(HS_SRC0(c1) + koff, (unsigned)__builtin_amdgcn_readfirstlane(kdst + 8192));
    hs_glds16(HS_SRC0(c2) + koff, (unsigned)__builtin_amdgcn_readfirstlane(kdst + 16384));
#undef HS_SRC0
}
template <int THRL, bool DIS, bool PRE> __device__ __forceinline__ void run_branch(char* shm, const bf16x8* qr, const bf16_t* ksb, LAS const unsigned char* steps, const int NT,
                                                               const int qb, f32x16* o, float& l_out, const int wid, const int lane) {
    constexpr int SLOTB = 8192, NSLOT = 3;
    { unsigned long long p_ = (unsigned long long)ksb; asm volatile("" : "+s"(p_)); ksb = (const bf16_t*)p_; }
    const int r32 = lane & 31, hi = lane >> 5, tq = (wid & 1) * 32 + r32;
    const unsigned lds0 = (unsigned)(uintptr_t)shm;
    const unsigned long long mysel = *((LAS const unsigned long long*)((lds_cptr)shm + SELM) + tq);
    const int vcodes = (int)steps[lane];
    float* wsf = (float*)(shm + WSF) + wid * 32;
    const size_t koff = (size_t)lane * 64 + wid * 8, voff = (size_t)(16 * (wid & 3) + (lane >> 2)) * 64 + (wid >> 2) * 32 + (lane & 3) * 8 + (size_t)TENS;
    const unsigned kdst = lds0 + KB0 + wid * 1024, vdst = lds0 + VB0 + wid * 1024;
#define HS_CODE(t) ((int)__builtin_amdgcn_readlane(vcodes, (t)))
#define HS_SRC(c) (ksb + (((c) & 0x80) ? (size_t)2 * TENS : (size_t)0) + (size_t)(((c) == 0x7f) ? 0 : ((c) & 0x7f)) * 4096)
#define DMA_K(t, slot) do { const int c_ = HS_CODE(t); hs_glds16(HS_SRC(c_) + koff, (unsigned)__builtin_amdgcn_readfirstlane(kdst + (slot))); } while (0)
#define DMA_V(t, slot) do { const int c_ = HS_CODE(t); hs_glds16(HS_SRC(c_) + voff, (unsigned)__builtin_amdgcn_readfirstlane(vdst + (slot))); } while (0)
    const int vb0 = (int)(lds0 + VB0) + ((lane >> 4) & 1) * 32 + (lane & 3) * 8 + (4 * hi + ((lane & 15) >> 2)) * 64;
    const char* Kbase = shm + KB0; bf16x8 kf[8];
    const lds_cptr shm3 = (lds_cptr)shm; const lds_cptr kp0 = shm3 + KB0 + hi * 1024 + r32 * 16; const lds_cptr vp0 = shm3 + VB0 + ((lane >> 4) & 1) * 32 + (lane & 3) * 8 + (4 * hi + ((lane & 15) >> 2)) * 64;
    if (!PRE) { DMA_K(0, 0); DMA_V(0, 0); DMA_K(1, SLOTB); }
    float mhat = 0.f, l_reg = 0.f; f32x16 negm;
    { float z = 0.f; asm volatile("" : "+v"(z));
#pragma unroll
      for (int i = 0; i < 16; ++i) { o[0][i] = z; o[1][i] = z; negm[i] = z; } }
    asm volatile("" : "+v"(negm));
#define CMASK(P0, P1, t) do { const int c_ = HS_CODE(t); const bool isw_ = (c_ & 0x80) != 0; const int jj_ = c_ & 0x7f; \
        if (!DIS && c_ == 0x7f) { _Pragma("unroll") for (int r = 0; r < 16; ++r) { P0[r] = -INFINITY; P1[r] = -INFINITY; } } \
        int kind_ = 0; if (c_ != 0x7f) { if (jj_ == qb) kind_ = 1; else if (isw_ && jj_ == qb - 8) kind_ = 2; } \
        if (kind_) apply_mask(P0, P1, kind_ == 1 ? lowmask(tq + 1) : ~lowmask(tq + 1), hi); } while (0)
    bool resc = false;
#define START(P0, P1) do { const float rm = hs_rowmax(P0, P1); resc = false; \
        { const float dl = (rm > -INFINITY) ? rm : 0.f; mhat = hs_fadd(mhat, dl); \
          _Pragma("unroll") for (int r = 0; r < 16; ++r) { P0[r] = hs_fsub(P0[r], dl); P1[r] = hs_fsub(P1[r], dl); } \
          _Pragma("unroll") for (int r = 0; r < 16; ++r) negm[r] = -mhat; asm volatile("" : "+v"(negm)); } \
        _Pragma("unroll") for (int r = 0; r < 16; ++r) P0[r] = __builtin_amdgcn_exp2f(P0[r]); } while (0)
#define RESC() do { if (resc) { asm volatile("s_waitcnt lgkmcnt(0)" ::: "memory"); \
        _Pragma("unroll") for (int d_ = 0; d_ < 2; ++d_) _Pragma("unroll") for (int r = 0; r < 16; ++r) o[d_][r] *= wsf[crow(r, hi)]; } } while (0)
    f32x16 pA0, pA1, pB0, pB1;
    int sl_prev = 0, sl_cur = 0, sl_next = SLOTB;
#define ROT() do { sl_prev = sl_cur; sl_cur = sl_next; sl_next = (sl_next == (NSLOT - 1) * SLOTB) ? 0 : sl_next + SLOTB; } while (0)
    if (!PRE) DMA_K(2, 2 * SLOTB);
    HS_WAIT_BAR(3);
    hs_qkt(pA0, pA1, Kbase, qr, negm, r32, hi); asm volatile("s_nop 15\n\ts_nop 7" : "+v"(pA0), "+v"(pA1)); CMASK(pA0, pA1, 0);
    START(pA0, pA1);
    _Pragma("unroll") for (int r = 0; r < 16; ++r) pA1[r] = __builtin_amdgcn_exp2f(pA1[r]);
    HS_WAIT_BAR(0);
    DMA_K(3, 0); DMA_V(1, SLOTB);
    ROT();
    hs_kload8(kf, kp0 + sl_cur);
    HS_WAIT_BAR(2);
    s16x4 vlo[8], vhi[8]; u32x4 pw0, pw1, pw2, pw3;
#define PKW(P, B) pk2(P[B], P[B + 1])
#define PAF(k) __builtin_bit_cast(bf16x8, pw##k)
#define VFR(i) (bf16x8){vlo[i][0], vlo[i][1], vlo[i][2], vlo[i][3], vhi[i][0], vhi[i][1], vhi[i][2], vhi[i][3]}
#define PIN(x) asm volatile("" : "+v"(x))
#define MX3(a, b, c) __builtin_fmaxf(__builtin_fmaxf((a), (b)), (c))
#define GAPA(MF, A0, A1, A2, A3, W0, W1, PW) do { MF; sacc += A0; sacc += A1; sacc += A2; sacc += A3; PIN(sacc); W0; W1; PIN(PW); HS_SBAR(); } while (0)
#define EX(v) __builtin_amdgcn_exp2f(v)
#define GAPB(MF, X, B) do { MF; X[B] = EX(X[B]); X[B + 1] = EX(X[B + 1]); X[B + 2] = EX(X[B + 2]); X[B + 3] = EX(X[B + 3]); PIN(X); HS_SBAR(); } while (0)
#define VRD(i) do { vlo[i] = hs_vtr(vp_ + (((i) >> 2) * 4096 + ((i) & 3) * 1024)); vhi[i] = hs_vtr(vp_ + (((i) >> 2) * 4096 + ((i) & 3) * 1024 + 512)); } while (0)
#define KRD(G, j) do { if (G) { hs_kload2(kf, kp0 + sl_next, j); HS_SBAR(); } } while (0)
#define STEP(C0, C1, P0, P1, t, GK, GV, GL) do { HS_SBAR(); \
        f32x16 cct; \
        if (DIS) { const int c0_ = HS_CODE(t); const bool en0_ = (c0_ != 0x7f) && (((mysel >> (c0_ & 63)) & 1ull) != 0ull);     \
            _Pragma("unroll") for (int r = 0; r < 16; ++r) cct[r] = en0_ ? negm[r] : -INFINITY; PIN(cct); HS_SBAR(); } \
        const lds_cptr vp_ = vp0 + sl_prev; \
        VRD(0); HS_SBAR(); float sacc = (P0[0] + P0[1]); \
        GAPA(C0 = MFMA32(kf[0], qr[0], (DIS ? cct : negm)), P0[2], P0[3], P0[4], P0[5],     pw0[0] = PKW(P0, 0), pw0[1] = PKW(P0, 2), pw0); \
        VRD(4); HS_SBAR(); GAPA(C1 = MFMA32(kf[1], qr[0], (DIS ? cct : negm)), P0[6], P0[7], P0[8], P0[9],     pw0[2] = PKW(P0, 4), pw0[3] = PKW(P0, 6), pw0); \
        VRD(1); HS_SBAR(); GAPA(C0 = MFMA32(kf[2], qr[1], C0),   P0[10], P0[11], P0[12], P0[13], pw1[0] = PKW(P0, 8), pw1[1] = PKW(P0, 10), pw1); \
        VRD(5); HS_SBAR(); GAPA(C1 = MFMA32(kf[3], qr[1], C1),   P0[14], P0[15], P1[0], P1[1],   pw1[2] = PKW(P0, 12), pw1[3] = PKW(P0, 14), pw1); \
        VRD(2); HS_SBAR(); GAPA(C0 = MFMA32(kf[4], qr[2], C0),   P1[2], P1[3], P1[4], P1[5],     pw2[0] = PKW(P1, 0), pw2[1] = PKW(P1, 2), pw2); \
        VRD(6); HS_SBAR(); GAPA(C1 = MFMA32(kf[5], qr[2], C1),   P1[6], P1[7], P1[8], P1[9],     pw2[2] = PKW(P1, 4), pw2[3] = PKW(P1, 6), pw2); \
        VRD(3); HS_SBAR(); GAPA(C0 = MFMA32(kf[6], qr[3], C0),   P1[10], P1[11], P1[12], P1[13], pw3[0] = PKW(P1, 8), pw3[1] = PKW(P1, 10), pw3); \
        VRD(7); HS_SBAR(); GAPA(C1 = MFMA32(kf[7], qr[3], C1),   P1[14], P1[15], 0.f, 0.f,       pw3[2] = PKW(P1, 12), pw3[3] = PKW(P1, 14), pw3); \
        l_reg += sacc; \
        if (GK) { DMA_K((t) + 3, sl_cur); } if (GV) { DMA_V((t) + 1, sl_next); } \
        CMASK(C0, C1, t); \
        { float a = MX3(C0[0], C0[1], C1[0]), b = MX3(C0[2], C0[3], C1[1]); a = MX3(a, C1[2], C1[3]); \
          _Pragma("unroll") for (int r = 4; r < 16; r += 4) { a = MX3(a, C0[r], C0[r + 1]); b = MX3(b, C0[r + 2], C0[r + 3]); a = MX3(a, C1[r], C1[r + 1]); b = MX3(b, C1[r + 2], C1[r + 3]); } \
          float rm = __builtin_fmaxf(a, b); { auto rr = __builtin_amdgcn_permlane32_swap(__float_as_uint(rm), __float_as_uint(rm), false, false); rm = __builtin_fmaxf(__uint_as_float(rr[0]), __uint_as_float(rr[1])); } \
          resc = false; \
          if (__builtin_expect(__any(rm > (float)THRL), 0)) { const float dl = __builtin_fmaxf(rm, 0.f); mhat += dl; \
            _Pragma("unroll") for (int r = 0; r < 16; ++r) { C0[r] -= dl; C1[r] -= dl; } \
            _Pragma("unroll") for (int r = 0; r < 16; ++r) negm[r] = -mhat; asm volatile("" : "+v"(negm)); \
            const float f = __builtin_amdgcn_exp2f(-dl); l_reg *= f; if (hi == 0) wsf[r32] = f; resc = true; } } \
        HS_SBAR(); \
        GAPB(o[0] = MFMA32(PAF(0), VFR(0), o[0]), C0, 0); \
        GAPB(o[1] = MFMA32(PAF(0), VFR(4), o[1]), C0, 4); \
        KRD(GL, 0); GAPB(o[0] = MFMA32(PAF(1), VFR(1), o[0]), C0, 8); \
        KRD(GL, 1); GAPB(o[1] = MFMA32(PAF(1), VFR(5), o[1]), C0, 12); \
        KRD(GL, 2); GAPB(o[0] = MFMA32(PAF(2), VFR(2), o[0]), C1, 0); \
        KRD(GL, 3); GAPB(o[1] = MFMA32(PAF(2), VFR(6), o[1]), C1, 4); \
        GAPB(o[0] = MFMA32(PAF(3), VFR(3), o[0]), C1, 8); \
        GAPB(o[1] = MFMA32(PAF(3), VFR(7), o[1]), C1, 12); \
    } while (0)
    int t = 1;
    for (; t + 5 < NT; t += 2) {
        STEP(pB0, pB1, pA0, pA1, t, true, true, true);     HS_WAIT_BAR(2); RESC(); ROT();
        STEP(pA0, pA1, pB0, pB1, t + 1, true, true, true); HS_WAIT_BAR(2); RESC(); ROT();
    }
#define ENDW(tt) do { if ((tt) + 3 < NT) { HS_WAIT_BAR(2); } else if ((tt) + 2 < NT) { HS_WAIT_BAR(1); } else { HS_WAIT_BAR(0); } } while (0)
    for (; t + 1 < NT; t += 2) {
        STEP(pB0, pB1, pA0, pA1, t, (t + 3 < NT), (t + 1 < NT), (t + 1 < NT));         ENDW(t);     RESC(); ROT();
        STEP(pA0, pA1, pB0, pB1, t + 1, (t + 4 < NT), (t + 2 < NT), (t + 2 < NT));     ENDW(t + 1); RESC(); ROT();
    }
#define DRAIN(PX0, PX1, SL) do { float sacc = PX0[0] + PX0[1]; _Pragma("unroll") for (int r = 2; r < 16; ++r) sacc += PX0[r]; _Pragma("unroll") for (int r = 0; r < 16; ++r) sacc += PX1[r]; l_reg += sacc; \
      pw0 = (u32x4){PKW(PX0, 0), PKW(PX0, 2), PKW(PX0, 4), PKW(PX0, 6)}; pw1 = (u32x4){PKW(PX0, 8), PKW(PX0, 10), PKW(PX0, 12), PKW(PX0, 14)}; \
      pw2 = (u32x4){PKW(PX1, 0), PKW(PX1, 2), PKW(PX1, 4), PKW(PX1, 6)}; pw3 = (u32x4){PKW(PX1, 8), PKW(PX1, 10), PKW(PX1, 12), PKW(PX1, 14)}; \
      HS_SBAR(); hs_pv(o, vb0 + (SL), PAF(0), PAF(1), PAF(2), PAF(3)); } while (0)
    if (NT & 1) {
        DRAIN(pA0, pA1, sl_prev);
    } else {
        STEP(pB0, pB1, pA0, pA1, NT - 1, false, false, false); RESC();
        DRAIN(pB0, pB1, sl_cur);
    }
#undef DRAIN
    { auto rr = __builtin_amdgcn_permlane32_swap(__float_as_uint(l_reg), __float_as_uint(l_reg), false, false); l_out = __uint_as_float(rr[0]) + __uint_as_float(rr[1]); }
    asm volatile("s_waitcnt lgkmcnt(0)\n\ts_barrier" ::: "memory");
#undef PKW
#undef PAF
#undef VFR
#undef PIN
#undef MX3
#undef GAPA
#undef GAPB
#undef EX
#undef VRD
#undef KRD
#undef STEP
#undef ENDW
#undef DMA_K
#undef DMA_V
#undef CMASK
#undef START
#undef RESC
#undef ROT
#undef HS_CODE
#undef HS_SRC
}
__device__ __forceinline__ void attn_unit(LAS unsigned char* lds, bf16_t* proj, const bf16_t* kvb, const bf16_t* kcmp, const bf16_t* vcmp, int bh, int qb, int skipw) {
    int tid_ = threadIdx.x; asm volatile("" : "+v"(tid_));
    const int tid = tid_, lane = tid & 63, r = lane & 31, h = lane >> 5, wid = __builtin_amdgcn_readfirstlane(tid >> 6);
    const int b = bh >> 2, hk = bh & 3, g = wid >> 1, tq = (wid & 1) * 32 + r;
    const size_t row = (size_t)b * SEQ + (size_t)qb * 64 + tq;
    const int t = qb * 64 + tq;
    bf16_t* qp = proj + row * PP + C_Q + (hk * 4 + g) * 64;
    bf16x8 qreg[4];
#pragma unroll
    for (int d0 = 0; d0 < 4; ++d0) qreg[d0] = *(const bf16x8*)(qp + d0 * 16 + h * 8);
    const bf16x8* qr = qreg;
    float gate[3];
#pragma unroll
    for (int c = 0; c < 3; ++c) gate[c] = sigmoidf_(bf2f(proj[row * PP + C_GBR + c * 16 + hk * 4 + g]));
#ifdef GATE2X
    if (GATE2X & 1) gate[0] *= 2.f; if (GATE2X & 2) gate[1] *= 2.f; if (GATE2X & 4) gate[2] *= 2.f;
#endif
#ifdef GATEZ
    if (GATEZ & 1) gate[0] = 0.f; if (GATEZ & 2) gate[1] = 0.f; if (GATEZ & 4) gate[2] = 0.f;
#endif
    LAS float* wsf = (LAS float*)(lds + WSF) + wid * 32;
    LAS float* impw = (LAS float*)(lds + IMP) + (g * 64 + tq) * IMPW;
    const size_t krow = lane, kcol = wid * 8;
    const size_t vrow = 16 * (wid & 3) + (lane >> 2), vcol = 32 * (wid >> 2) + 8 * (lane & 3);
    LAS unsigned char* kst = lds + KB0 + wid * 1024 + lane * 16;
    LAS unsigned char* vst = lds + VB0 + wid * 1024 + lane * 16;
    u32x4 kreg, vreg;
    LAS float* osl = (LAS float*)(lds + IMP + wid * (32 * IMPW * 4)) + lane;
#define LDK(base, pitch) kreg = *(const u32x4*)((base) + krow * (size_t)(pitch) + kcol)
#define LDV(base, pitch) vreg = *(const u32x4*)((base) + vrow * (size_t)(pitch) + vcol)
#define STK(buf) *(LAS u32x4*)(kst + (buf) * 8192) = kreg
#define STV(buf) *(LAS u32x4*)(vst + (buf) * 8192) = vreg
#define KBUF(buf) (lds + KB0 + (buf) * 8192)
#define VBUF(buf) (lds + VB0 + (buf) * 8192)
#define ACCUM_OUT(scale_expr, FIRST) do { if (h == 0) wsf[r] = (scale_expr); \
        _Pragma("unroll") for (int i = 0; i < 16; ++i) { const float sc = wsf[crow(i, h)]; \
            if (FIRST) { osl[(i * 2) * 64] = st.o0[i] * sc; osl[(i * 2 + 1) * 64] = st.o1[i] * sc; } \
            else { osl[(i * 2) * 64] += st.o0[i] * sc; osl[(i * 2 + 1) * 64] += st.o1[i] * sc; } } } while (0)

    St st;
    const bf16_t* kc = kcmp + (size_t)bh * 256 * 64; const bf16_t* vc = vcmp + (size_t)bh * 256 * 64;
    const int nmax = (t >= 31) ? ((t - 31) >> 4) : -1;
#define CMP_KT(j) (lds + (j) * 8192)
#define CMP_VT(j) ((j) < 2 ? lds + 32768 + (j) * 8192 : lds + CMPX + ((j) - 2) * 8192)
    {
        u32x4 kr4[4], vr4[4];
#pragma unroll
        for (int j = 0; j < 4; ++j) { kr4[j] = *(const u32x4*)(kc + (size_t)j * 4096 + krow * 64 + kcol); vr4[j] = *(const u32x4*)(vc + (size_t)j * 4096 + vrow * 64 + vcol); }
#pragma unroll
        for (int j = 0; j < 4; ++j) { *(LAS u32x4*)(CMP_KT(j) + wid * 1024 + lane * 16) = kr4[j]; *(LAS u32x4*)(CMP_VT(j) + wid * 1024 + lane * 16) = vr4[j]; }
    }
    __syncthreads();
    float carry = 0.f;
    float m1 = -1e30f, l1 = 0.f;
#pragma unroll 1
    for (int j = 0; j < 4; ++j) {
        const int cnt = nmax - 64 * j + 1; const unsigned long long allow = cnt <= 0 ? 0ull : lowmask(cnt);
        if (__all(allow == 0ull)) continue;
        tile_stats(m1, l1, CMP_KT(j), qr, allow, r, h);
    }
    l1 += __shfl_xor(l1, 32);
    const float invl = __builtin_amdgcn_rcpf(fmaxf(l1, 1e-30f));
#pragma unroll
    for (int i = 0; i < 16; ++i) { st.o0[i] = 0.f; st.o1[i] = 0.f; }
#pragma unroll 1
    for (int j = 0; j < 4; ++j) {
        const int cnt = nmax - 64 * j + 1; const unsigned long long allow = cnt <= 0 ? 0ull : lowmask(cnt);
        if (__all(allow == 0ull)) {
#pragma unroll
            for (int pos = 0; pos < 8; ++pos) impw[16 * j + 2 * pos + h] = (pos == 0 && h == 0) ? carry : 0.f;
            carry = 0.f; continue; }
        tile_exact(st.o0, st.o1, m1, invl, CMP_KT(j), CMP_VT(j), qr, allow, impw, carry, j, lane, r, h);
    }
    __syncthreads();
    hs_pre_dma((char*)lds, kvb + (size_t)2 * TENS + (size_t)bh * 4096 * 64, 0, qb > 0 ? qb : 0x7f, qb > 1 ? qb - 1 : 0x7f, wid, lane);
#undef CMP_KT
#undef CMP_VT
    {
        unsigned long long wor = 0ull;
        const unsigned long long valid = lowmask(qb + 1);
        LAS const float* ib = (LAS const float*)(lds + IMP);
        unsigned key[8], T[8];
#pragma unroll
        for (int i = 0; i < 8; ++i) { const int q = wid * 8 + i;
            float v = ((ib[(0 * 64 + q) * IMPW + lane] + ib[(1 * 64 + q) * IMPW + lane]) + ib[(2 * 64 + q) * IMPW + lane]) + ib[(3 * 64 + q) * IMPW + lane];
            if (lane == 0 || lane == qb || lane == qb - 1) v = INFINITY;
            key[i] = (lane <= qb) ? __float_as_uint(fmaxf(v, 0.f)) : 0u; T[i] = 0u; }
        if (qb >= 16)
#pragma unroll 1
        for (int bb = 30; bb >= 0; --bb) {
#pragma unroll
            for (int i = 0; i < 8; ++i) { const unsigned cand = T[i] | (1u << bb);
                const int c = __popcll(__ballot(key[i] >= cand) & valid); T[i] = (c >= 16) ? cand : T[i]; }
        }
#pragma unroll
        for (int i = 0; i < 8; ++i) { const int q = wid * 8 + i;
            const unsigned long long gt = __ballot(key[i] > T[i]) & valid, eq = __ballot(key[i] == T[i]) & valid;
            const int need = 16 - __popcll(gt);
            const bool pick = ((eq >> lane) & 1ull) && (__popcll(eq & lowmask(lane)) < need);
            const unsigned long long msk = gt | __ballot(pick);
            if (lane == 0) *(LAS unsigned long long*)(lds + SELM + q * 8) = msk;
            wor |= msk; }
        if (lane == 0) *(LAS unsigned long long*)(lds + WMASK + wid * 8) = wor;
    }
    __syncthreads();
    unsigned long long un = 0ull;
#pragma unroll
    for (int w = 0; w < 8; ++w) un |= *(LAS const unsigned long long*)(lds + WMASK + w * 8);
    { const unsigned ulo = __builtin_amdgcn_readfirstlane((unsigned)un), uhi = __builtin_amdgcn_readfirstlane((unsigned)(un >> 32)); un = ((unsigned long long)uhi << 32) | ulo; }
    ACCUM_OUT(gate[0], true);
    {
        LAS unsigned char* steps = lds + STEPS + wid * 128;
        const int nsel = __popcll(un), j0w = qb >= 8 ? qb - 8 : 0, nwin = qb - j0w + 1;
        const int NTs = nsel < 4 ? 4 : nsel, NTw = nwin < 4 ? 4 : nwin;
        {
            const unsigned long long F = 1ull | (1ull << qb) | (qb > 0 ? (1ull << (qb - 1)) : 0ull), rest = un & ~F; const int nF = __popcll(F);
            if (lane == 0) { steps[0] = 0; if (qb > 0) steps[1] = (unsigned char)qb; if (qb > 1) steps[2] = (unsigned char)(qb - 1); }
            if ((rest >> lane) & 1ull) steps[nF + __popcll(rest & lowmask(lane))] = (unsigned char)lane;
        }
        if (lane >= nsel && lane < NTs) steps[lane] = (unsigned char)0x7f;
        if (lane < NTw) steps[64 + lane] = (unsigned char)(lane < nwin ? (0x80 | (j0w + lane)) : 0x7f);
        const bf16_t* ksb = kvb + (size_t)2 * TENS + (size_t)bh * 4096 * 64;
        char* shm = (char*)lds;
        f32x16 ob[2]; float lt;
        run_branch<8, true, true>(shm, qr, ksb, steps, NTs, qb, ob, lt, wid, lane);
        {
            int t2 = threadIdx.x; asm volatile("" : "+v"(t2));
            const int lane2 = t2 & 63, r2 = lane2 & 31, h2 = lane2 >> 5, wid2 = __builtin_amdgcn_readfirstlane(t2 >> 6), g2 = wid2 >> 1, tq2 = (wid2 & 1) * 32 + r2;
            LAS float* wsf2 = (LAS float*)(lds + WSF) + wid2 * 32; LAS float* osl2 = (LAS float*)(lds + IMP + wid2 * (32 * IMPW * 4)) + lane2;
            const float g1 = sigmoidf_(bf2f(proj[((size_t)b * SEQ + (size_t)qb * 64 + tq2) * PP + C_GBR + 1 * 16 + hk * 4 + g2]));
            if (h2 == 0) wsf2[r2] = g1 * __builtin_amdgcn_rcpf(fmaxf(lt, 1e-30f));
#pragma unroll
            for (int i = 0; i < 16; ++i) { const float sc = wsf2[crow(i, h2)]; osl2[(i * 2) * 64] += ob[0][i] * sc; osl2[(i * 2 + 1) * 64] += ob[1][i] * sc; }
        }
        {
            int t3 = threadIdx.x; asm volatile("" : "+v"(t3));
            run_branch<8, false, false>(shm, qr, ksb, steps + 64, NTw, qb, ob, lt, __builtin_amdgcn_readfirstlane(t3 >> 6), t3 & 63);
        }
        st.o0 = ob[0]; st.o1 = ob[1]; st.l = lt;
    }
    {
        int t2 = threadIdx.x; asm volatile("" : "+v"(t2));
        const int lane2 = t2 & 63, r2 = lane2 & 31, h2 = lane2 >> 5, wid2 = __builtin_amdgcn_readfirstlane(t2 >> 6), g2 = wid2 >> 1, tq2 = (wid2 & 1) * 32 + r2;
        LAS float* wsf2 = (LAS float*)(lds + WSF) + wid2 * 32; LAS float* osl2 = (LAS float*)(lds + IMP + wid2 * (32 * IMPW * 4)) + lane2;
        const float g3 = sigmoidf_(bf2f(proj[((size_t)b * SEQ + (size_t)qb * 64 + tq2) * PP + C_GBR + 2 * 16 + hk * 4 + g2]));
        if (h2 == 0) wsf2[r2] = g3 * __builtin_amdgcn_rcpf(fmaxf(st.l, 1e-30f));
        bf16_t* ob2 = proj + ((size_t)b * SEQ + (size_t)qb * 64 + (wid2 & 1) * 32) * PP + C_Q + (hk * 4 + g2) * 64;
        if (!skipw)
#pragma unroll
        for (int i = 0; i < 16; ++i) { const int q = crow(i, h2); const float sc = wsf2[q];
            const float f0 = osl2[(i * 2) * 64] + st.o0[i] * sc, f1 = osl2[(i * 2 + 1) * 64] + st.o1[i] * sc;
            ob2[(size_t)q * PP + r2] = (bf16_t)(pk2(f0, 0.f) & 0xffffu); ob2[(size_t)q * PP + 32 + r2] = (bf16_t)(pk2(f1, 0.f) & 0xffffu); }
    }
#undef LDK
#undef LDV
#undef STK
#undef STV
#undef KBUF
#undef VBUF
#undef ACCUM_OUT
}
}

__device__ __forceinline__ float wave_sum(float v) {
#pragma unroll
    for (int o = 1; o < 64; o <<= 1) v += __shfl_xor(v, o);
    return v;
}
__device__ __forceinline__ void transpose_item(const float* W, int K, int N, bf16_t* WT, int ldt, int k0, int n0, int drow0, const float* kscale, float cscale, LAS float* scr, int lane) {
#pragma unroll 8
    for (int i = 0; i < 32; ++i) { const int kk = 2 * i + (lane >> 5); const int n = n0 + (lane & 31);
        float v = (n < N) ? W[(size_t)(k0 + kk) * N + n] : 0.f;
        if (kscale) v *= kscale[k0 + kk];
        scr[kk * 33 + (lane & 31)] = v * cscale; }
    asm volatile("s_waitcnt lgkmcnt(0)" ::: "memory");
    const int c = lane & 7;
#pragma unroll
    for (int j = 0; j < 4; ++j) { const int n = (lane >> 3) + 8 * j; const LAS float* s = scr + (8 * c) * 33 + n;
        u32x4 o; o.x = pk2(s[0 * 33], s[1 * 33]); o.y = pk2(s[2 * 33], s[3 * 33]); o.z = pk2(s[4 * 33], s[5 * 33]); o.w = pk2(s[6 * 33], s[7 * 33]);
        *(u32x4*)(WT + (size_t)(drow0 + n) * ldt + k0 + 8 * c) = o; }
    asm volatile("s_waitcnt lgkmcnt(0)" ::: "memory");
}

#define XB_TMO      128
#define XB_XCNT(j)  (256  + 64 * (j))
#define XB_XSUB(j)  (1280 + 64 * (j))
#define XB_XGEN(j)  (2304 + 64 * (j))
#define XB_TOP      3328
#define XB_TOPGEN   3392
#define XCD_BAR_WORDS 3456
#define XB_SPIN_CAP (1u << 18)
__device__ __forceinline__ unsigned xb_ld(unsigned* p)              { return __hip_atomic_load(p, __ATOMIC_RELAXED, __HIP_MEMORY_SCOPE_AGENT); }
__device__ __forceinline__ unsigned xb_add(unsigned* p, unsigned v) { return __hip_atomic_fetch_add(p, v, __ATOMIC_RELAXED, __HIP_MEMORY_SCOPE_AGENT); }
__device__ __forceinline__ unsigned xb_xcc_id() { return (unsigned)__builtin_amdgcn_s_getreg((3 << 11) | 20) & 0xFu; }
#define XB_SPIN(cond, bar) do { unsigned _sp = 0; while (cond) { __builtin_amdgcn_s_sleep(1); \
    if ((++_sp & 255u) == 0u) { if (xb_ld(&(bar)[XB_TMO])) break; if (_sp > XB_SPIN_CAP) { atomicAdd(&(bar)[XB_TMO], 1u); break; } } } } while (0)
struct XcdBarrier { unsigned* bar; unsigned x; volatile LAS unsigned* st; };
__device__ __forceinline__ XcdBarrier xcd_barrier_post(unsigned* bar, volatile LAS unsigned* st) {
    XcdBarrier b; b.bar = bar; b.x = xb_xcc_id(); b.st = st;
    if (threadIdx.x == 0) (void)xb_add(&bar[XB_XCNT(b.x)], 1u);
    return b;
}
__device__ __forceinline__ void xcd_barrier_complete(unsigned* bar, unsigned x, unsigned& nloc, unsigned& nx) {
    const unsigned G = gridDim.x * gridDim.y * gridDim.z;
    unsigned sum, cnt, mine, sp = 0u;
    for (;;) {
        sum = 0u; cnt = 0u; mine = 0u;
#pragma unroll
        for (unsigned j = 0; j < 16; ++j) { const unsigned c = xb_ld(&bar[XB_XCNT(j)]); sum += c; cnt += (c > 0u) ? 1u : 0u; mine = (j == x) ? c : mine; }
        if (sum == G) break;
        __builtin_amdgcn_s_sleep(1);
        if ((++sp & 255u) == 0u) { if (xb_ld(&bar[XB_TMO])) break; if (sp > XB_SPIN_CAP) { atomicAdd(&bar[XB_TMO], 1u); break; } }
    }
    nloc = mine > 0u ? mine : 1u; nx = cnt > 0u ? cnt : 1u;
}
__device__ __forceinline__ void xcd_barrier(const XcdBarrier& b) {
    asm volatile("s_waitcnt vmcnt(0)" ::: "memory");
    __syncthreads();
    if (threadIdx.x == 0) {
        unsigned* bar = b.bar;
        __builtin_amdgcn_s_waitcnt(0);
        unsigned nloc = b.st[0], nx = b.st[1];
        if (nloc == 0u) { xcd_barrier_complete(bar, b.x, nloc, nx); b.st[0] = nloc; b.st[1] = nx; }
        const unsigned old = xb_add(&bar[XB_XSUB(b.x)], 1u);
        const unsigned gen = old / nloc;
        if (old + 1u == (gen + 1u) * nloc) {
            __builtin_amdgcn_fence(__ATOMIC_RELEASE, "agent");
            asm volatile("s_waitcnt vmcnt(0)" ::: "memory");
            const unsigned og = xb_add(&bar[XB_TOP], 1u);
            const unsigned tg = og / nx;
            if (og + 1u == (tg + 1u) * nx) xb_add(&bar[XB_TOPGEN], 1u);
            else XB_SPIN(xb_ld(&bar[XB_TOPGEN]) == tg, bar);
            __builtin_amdgcn_fence(__ATOMIC_ACQUIRE, "agent");
            xb_add(&bar[XB_XGEN(b.x)], 1u);
            asm volatile("s_waitcnt vmcnt(0)" ::: "memory");
        } else {
            XB_SPIN(xb_ld(&bar[XB_XGEN(b.x)]) == gen, bar);
            __builtin_amdgcn_fence(__ATOMIC_ACQUIRE, "agent");
            asm volatile("s_waitcnt vmcnt(0)" ::: "memory");
        }
    }
    __syncthreads();
}

struct Args {
    const float *x, *w_in, *conv_w, *w_conv_out, *pos_k, *w1_k, *w2_k, *pos_v, *w1_v, *w2_v, *w_attn_out, *w_o, *g_mix, *g_ffn, *w_gate, *w_up, *w_down, *g_final;
    float* out; unsigned char* ws; int probe; int pad;
};

__global__ void __launch_bounds__(512, 2) nsa_fwd(Args a) {
    extern __shared__ __attribute__((aligned(16))) unsigned char lds_raw[];
    LAS unsigned char* lds = (LAS unsigned char*)lds_raw;
    cg::grid_group grid = cg::this_grid();
    const int tid = threadIdx.x, lane = tid & 63, wave = __builtin_amdgcn_readfirstlane(tid >> 6);
    const int G = gridDim.x, bx = blockIdx.x;
    const int vcu = (G % 8 == 0) ? (bx % 8) * (G / 8) + bx / 8 : bx;
    unsigned char* ws = a.ws;
    volatile LAS unsigned* bst = (volatile LAS unsigned*)(lds + 143360);
    if (tid < 2) bst[tid] = 0u;
    __syncthreads();
    const XcdBarrier gbar = xcd_barrier_post((unsigned*)(ws + WS_BAR), bst);
#define SEAM() xcd_barrier(gbar)
    float* part1 = (float*)(ws + WS_PART1); float* part2 = (float*)(ws + WS_PART2); float* cbias = (float*)(ws + WS_BIAS);
    bf16_t* Win = (bf16_t*)(ws + WS_WIN); bf16_t* Wconv = (bf16_t*)(ws + WS_WCONV); bf16_t* Wattn = (bf16_t*)(ws + WS_WATTN); bf16_t* Wo = (bf16_t*)(ws + WS_WO);
    bf16_t* Wup = (bf16_t*)(ws + WS_WUP); bf16_t* Wdown = (bf16_t*)(ws + WS_WDOWN); bf16_t* W1 = (bf16_t*)(ws + WS_W1); bf16_t* W2 = (bf16_t*)(ws + WS_W2);
    bf16_t* hid = (bf16_t*)(ws + WS_HID); bf16_t* kcmp = (bf16_t*)(ws + WS_KCMP); bf16_t* proj = (bf16_t*)(ws + WS_PROJ); bf16_t* kvbuf = (bf16_t*)(ws + WS_KV);
    float* h1f = (float*)(ws + WS_H1F); bf16_t* h1b = (bf16_t*)(ws + WS_H1B); bf16_t* act = (bf16_t*)(ws + WS_ACT);
    bf16_t* nb = (bf16_t*)a.out; bf16_t* mix = (bf16_t*)a.out; bf16_t* bc = (bf16_t*)((unsigned char*)a.out + OUT_BC);

    {
        LAS float* scr = (LAS float*)(lds + wave * 16384);
        const int gw = vcu * 8 + wave, NGW = G * 8;
        constexpr int I_IN = 16 * 194, I_CONV = 8 * 32, I_ATT = 16 * 32, I_O = 16 * 32, I_G = 16 * 88, I_U = 16 * 88, I_D = 44 * 32, I_1 = 32 * 8, I_2 = 4 * 2;
        constexpr int NITEMS = I_IN + I_CONV + I_ATT + I_O + 2 * I_1 + 2 * I_2;
        for (int it = gw; it < NITEMS; it += NGW) {
            int q = it;
            if (q < I_IN) { const int kb = q / 194, nbk = q % 194, n0 = 32 * nbk; const float cs = (n0 >= WQ0 && n0 < WQ1) ? QSCALE : 1.0f;
                transpose_item(a.w_in, 1024, INCOLS, Win, 1024, 64 * kb, n0, n0, a.g_mix, cs, scr, lane); continue; } q -= I_IN;
            if (q < I_CONV) { const int kb = q / 32, nbk = q % 32; transpose_item(a.w_conv_out, 512, 1024, Wconv, 512, 64 * kb, 32 * nbk, 32 * nbk, nullptr, 1.f, scr, lane); continue; } q -= I_CONV;
            if (q < I_ATT) { const int kb = q / 32, nbk = q % 32; transpose_item(a.w_attn_out, 1024, 1024, Wattn, 1024, 64 * kb, 32 * nbk, 32 * nbk, nullptr, 1.f, scr, lane); continue; } q -= I_ATT;
            if (q < I_O) { const int kb = q / 32, nbk = q % 32; transpose_item(a.w_o, 1024, 1024, Wo, 1024, 64 * kb, 32 * nbk, 32 * nbk, nullptr, 1.f, scr, lane); continue; } q -= I_O;
            if (q < I_1) { const int kb = q / 8, nbk = q % 8; transpose_item(a.w1_k, 2048, 256, W1, 2048, 64 * kb, 32 * nbk, 32 * nbk, nullptr, 1.f, scr, lane); continue; } q -= I_1;
            if (q < I_1) { const int kb = q / 8, nbk = q % 8; transpose_item(a.w1_v, 2048, 256, W1, 2048, 64 * kb, 32 * nbk, 256 + 32 * nbk, nullptr, 1.f, scr, lane); continue; } q -= I_1;
            if (q < I_2) { const int kb = q / 2, nbk = q % 2; transpose_item(a.w2_k, 256, 64, W2, 256, 64 * kb, 32 * nbk, 32 * nbk, nullptr, 1.f, scr, lane); continue; } q -= I_2;
            { const int kb = q / 2, nbk = q % 2; transpose_item(a.w2_v, 256, 64, W2, 256, 64 * kb, 32 * nbk, 256 + 32 * nbk, nullptr, 1.f, scr, lane); }
        }
        const int gt = vcu * 512 + tid, NGT = G * 512;
        for (int i = gt; i < 192 * 1024 / 8; i += NGT) *(u32x4*)(Win + (size_t)6208 * 1024 + (size_t)i * 8) = (u32x4){0u, 0u, 0u, 0u};
        for (int i = gt; i < 2 * 192 * 256 / 8; i += NGT) { const int half = i / (192 * 256 / 8), o = i % (192 * 256 / 8);
            *(u32x4*)(W2 + (size_t)(half * 256 + 64) * 256 + (size_t)o * 8) = (u32x4){0u, 0u, 0u, 0u}; }
        for (int m = gw; m < MTOK; m += NGW) {
            const f32x4* xr = (const f32x4*)(a.x + (size_t)m * DM) + lane; f32x4 v[4]; float s = 0.f;
#pragma unroll
            for (int j = 0; j < 4; ++j) { v[j] = xr[64 * j]; s += (v[j][0] * v[j][0] + v[j][1] * v[j][1]) + (v[j][2] * v[j][2] + v[j][3] * v[j][3]); }
            const float rstd = __builtin_amdgcn_rsqf(wave_sum(s) * (1.0f / DM) + EPS);
            u32x2* o8 = (u32x2*)(nb + (size_t)m * DM) + lane;
#pragma unroll
            for (int j = 0; j < 4; ++j) { u32x2 w; w.x = pk2(v[j][0] * rstd, v[j][1] * rstd); w.y = pk2(v[j][2] * rstd, v[j][3] * rstd); o8[64 * j] = w; }
        }
        if (bx < 2) {
            const float* pos = bx ? a.pos_v : a.pos_k; const float* w1 = bx ? a.w1_v : a.w1_k;
            const int j = tid & 255, part = tid >> 8; float s = 0.f;
            for (int k = part * 1024; k < part * 1024 + 1024; ++k) s += pos[k] * w1[(size_t)k * 256 + j];
            LAS float* red = (LAS float*)(lds + 8 * 16384);
            if (part == 1) red[j] = s;
            __syncthreads();
            if (part == 0) cbias[bx * 256 + j] = s + red[j];
        }
    }
    if (a.probe == 0x7fffffff) grid.sync();
    SEAM();
    {
        const int ncols1 = (G > 64) ? 6144 : WPAD;
        pg8::Gemm g{nb, Win, MTOK, ncols1, DM, DM, 128, 0}; pg8::StaticOrder S; S.init(MTOK, ncols1, G, bx);
        pg8::EpiProj E{proj, PP, kvbuf};
        pg8::gemm_phase(lds, g, S, E);
    }
    SEAM();
    {
        {
            pg8::Gemm g{kvbuf, W1, 4096, 512, 2048, 16 * 64, 128, 1}; pg8::StaticOrder S; S.init(4096, 512, G, bx);
            pg8::EpiHid E{hid, cbias};
            pg8::gemm_phase(lds, g, S, E);
        }
        int wb = bx, wn = G; if (G > 64) { wb = bx - 32; wn = G - 32; }
        if (wb >= 0) {
            for (int it = wb * 512 + tid; it < MTOK * 64; it += wn * 512) {
                const int row = it >> 6, ch = (it & 63) * 8, t = row & (SEQ - 1);
                const bf16_t* pr = proj + (size_t)row * PP;
                float accv[8];
#pragma unroll
                for (int j = 0; j < 8; ++j) accv[j] = 0.f;
#pragma unroll
                for (int k = 0; k < 3; ++k) { const int dt = 2 - k;
                    if (t - dt >= 0) { const u32x4 cv = *(const u32x4*)(pr - (size_t)dt * PP + C_C + ch), hv = *(const u32x4*)(pr - (size_t)dt * PP + C_H + ch);
                        const f32x4 w0 = *(const f32x4*)(a.conv_w + k * 512 + ch), w1 = *(const f32x4*)(a.conv_w + k * 512 + ch + 4);
                        accv[0] += w0[0] * lo_bf(cv.x) * lo_bf(hv.x); accv[1] += w0[1] * hi_bf(cv.x) * hi_bf(hv.x); accv[2] += w0[2] * lo_bf(cv.y) * lo_bf(hv.y); accv[3] += w0[3] * hi_bf(cv.y) * hi_bf(hv.y);
                        accv[4] += w1[0] * lo_bf(cv.z) * lo_bf(hv.z); accv[5] += w1[1] * hi_bf(cv.z) * hi_bf(hv.z); accv[6] += w1[2] * lo_bf(cv.w) * lo_bf(hv.w); accv[7] += w1[3] * hi_bf(cv.w) * hi_bf(hv.w); } }
                const u32x4 bv = *(const u32x4*)(pr + C_B + ch);
                u32x4 o; o.x = pk2(accv[0] * lo_bf(bv.x), accv[1] * hi_bf(bv.x)); o.y = pk2(accv[2] * lo_bf(bv.y), accv[3] * hi_bf(bv.y));
                o.z = pk2(accv[4] * lo_bf(bv.z), accv[5] * hi_bf(bv.z)); o.w = pk2(accv[6] * lo_bf(bv.w), accv[7] * hi_bf(bv.w));
                *(u32x4*)(bc + (size_t)row * 512 + ch) = o;
            }
        }
        if (G > 64 && wb >= 0) {
            { pg8::Gemm g{nb, Win + (size_t)6144 * 1024, MTOK, 256, DM, DM, 128, 0}; pg8::StaticOrder S; S.init(MTOK, 256, wn, wb);
              pg8::EpiProj E{proj + (6144 - 1536), PP, nullptr}; pg8::gemm_phase(lds, g, S, E); }
            __syncthreads();
            LAS float* scr = (LAS float*)(lds + wave * 16384);
            constexpr int I_G = 16 * 88, I_U = 16 * 88, I_D = 44 * 32;
            for (int it = wb * 8 + wave; it < I_G + I_U + I_D; it += wn * 8) {
                int q = it;
                if (q < I_G) { const int kb = q / 88, nbk = q % 88, n0 = 32 * nbk; transpose_item(a.w_gate, 1024, DFF, Wup, 1024, 64 * kb, n0, (n0 / 128) * 256 + (n0 % 128), a.g_ffn, 1.f, scr, lane); continue; } q -= I_G;
                if (q < I_U) { const int kb = q / 88, nbk = q % 88, n0 = 32 * nbk; transpose_item(a.w_up, 1024, DFF, Wup, 1024, 64 * kb, n0, (n0 / 128) * 256 + 128 + (n0 % 128), a.g_ffn, 1.f, scr, lane); continue; } q -= I_U;
                { const int kb = q / 32, nbk = q % 32; transpose_item(a.w_down, DFF, 1024, Wdown, DFF, 64 * kb, 32 * nbk, 32 * nbk, nullptr, 1.f, scr, lane); }
            }
        }
    }
    {
        pg8::Gemm g{hid, W2, 4096, 512, 256, 256, 128, 2}; pg8::StaticOrder S; S.init(4096, 512, G, bx);
        pg8::EpiCmp E{kcmp};
        pg8::gemm_phase(lds, g, S, E);
    }
    SEAM();
    {
        for (int v = vcu; v < 256; v += G) {
            const int bh = v >> 4, s = v & 15;
#pragma unroll 1
            for (int i = 0; i < 4; ++i) { const int qb = (i == 0) ? 63 - s : (i == 1) ? 32 + s : (i == 2) ? 31 - s : s;
#if defined(PROBE_ATT2) || defined(PROBE_NOLD)
                att::attn_unit(lds, proj, kvbuf, kcmp, kcmp + 4096 * 64, bh, qb, a.probe);
#endif
                att::attn_unit(lds, proj, kvbuf, kcmp, kcmp + 4096 * 64, bh, qb, 0);
            }
        }
    }
    SEAM();
    {
        { pg8::Gemm g{bc, Wconv, MTOK, DM, 512, 512, 128, 0}; pg8::StaticOrder S; S.init(MTOK, DM, G, bx);
          pg8::EpiMix<0> E{mix, proj, C_GCONV}; pg8::gemm_phase(lds, g, S, E); }
        { pg8::Gemm g{proj + C_Q, Wattn, MTOK, DM, DM, PP, 128, 0}; pg8::StaticOrder S; S.init(MTOK, DM, G, bx);
          pg8::EpiMix<1> E{mix, proj, C_GATTN}; pg8::gemm_phase(lds, g, S, E); }
    }
    SEAM();
    {
        pg8::Gemm g{mix, Wo, MTOK, DM, DM, DM, 128, 0}; pg8::StaticOrder S; S.init(MTOK, DM, G, bx);
        pg8::EpiRes<1> E{a.x, h1f, h1b, part1}; pg8::gemm_phase(lds, g, S, E);
    }
    SEAM();
    {
        pg8::Gemm g{h1b, Wup, MTOK, 2 * DFF, DM, DM, 128, 0}; pg8::StaticOrder S; S.init(MTOK, 2 * DFF, G, bx);
        pg8::EpiUp E{act, part1}; pg8::gemm_phase(lds, g, S, E);
    }
    SEAM();
    if (G == 256) {
        pg8::Gemm g{act, Wdown, MTOK, DM, DFF, DFF, 128, 0}; pg8::StaticOrder S; S.init(MTOK, DM, G, bx);
        pg8::EpiFinal E{h1f, a.out, a.g_final, (unsigned*)part2, (unsigned*)(ws + WS_BAR) + 4096, (unsigned*)(ws + WS_BAR) + XB_TMO};
        pg8::gemm_phase(lds, g, S, E);
        return;
    }
    {
        pg8::Gemm g{act, Wdown, MTOK, DM, DFF, DFF, 128, 0}; pg8::StaticOrder S; S.init(MTOK, DM, G, bx);
        pg8::EpiRes<0> E{h1f, a.out, nullptr, part2}; pg8::gemm_phase(lds, g, S, E);
    }
    SEAM();
    {
        for (int it = bx * 512 + tid; it < MTOK * 256; it += G * 512) {
            const int row = it >> 8, c4 = (it & 255) * 4;
            const f32x4* pp = (const f32x4*)(part2 + (size_t)row * 16); float ss = 0.f;
#pragma unroll
            for (int j = 0; j < 4; ++j) { const f32x4 p = pp[j]; ss += (p[0] + p[1]) + (p[2] + p[3]); }
            const float r = __builtin_amdgcn_rsqf(ss * (1.0f / DM) + EPS);
            f32x4 v = *(f32x4*)(a.out + (size_t)row * DM + c4); const f32x4 gf = *(const f32x4*)(a.g_final + c4);
            v = v * r * gf; *(f32x4*)(a.out + (size_t)row * DM + c4) = v;
        }
    }
}

extern "C" void kernel_launch(void* const* d_in, const int* in_sizes, int n_in, void* d_out, int out_size, void* d_ws, size_t ws_size, hipStream_t stream) {
    static int grid = 0;
    if (grid == 0) {
        if (n_in != 18 || out_size != MTOK * DM || ws_size < WS_NEED) { fprintf(stderr, "kernel_launch: unexpected shapes (n_in %d out %d ws %zu)\n", n_in, out_size, ws_size); grid = -1; return; }
        int dev = 0, cus = 0, per_cu = 0;
        (void)hipGetDevice(&dev);
        (void)hipDeviceGetAttribute(&cus, hipDeviceAttributeMultiprocessorCount, dev);
        (void)hipFuncSetAttribute((const void*)nsa_fwd, hipFuncAttributeMaxDynamicSharedMemorySize, LDS_BYTES);
        (void)hipOccupancyMaxActiveBlocksPerMultiprocessor(&per_cu, (const void*)nsa_fwd, 512, LDS_BYTES);
        if (per_cu < 1) { fprintf(stderr, "kernel_launch: occupancy query says %d blocks/CU\n", per_cu); grid = -1; return; }
        grid = cus;
    }
    if (grid < 0) return;
    (void)hipMemsetAsync((unsigned char*)d_ws + WS_BAR, 0, 32768, stream);
    Args a{};
    a.x = (const float*)d_in[0]; a.w_in = (const float*)d_in[1]; a.conv_w = (const float*)d_in[2]; a.w_conv_out = (const float*)d_in[3];
    a.pos_k = (const float*)d_in[4]; a.w1_k = (const float*)d_in[5]; a.w2_k = (const float*)d_in[6];
    a.pos_v = (const float*)d_in[7]; a.w1_v = (const float*)d_in[8]; a.w2_v = (const float*)d_in[9];
    a.w_attn_out = (const float*)d_in[10]; a.w_o = (const float*)d_in[11]; a.g_mix = (const float*)d_in[12]; a.g_ffn = (const float*)d_in[13];
    a.w_gate = (const float*)d_in[14]; a.w_up = (const float*)d_in[15]; a.w_down = (const float*)d_in[16]; a.g_final = (const float*)d_in[17];
    a.out = (float*)d_out; a.ws = (unsigned char*)d_ws; a.probe = 1; a.pad = 0;
    void* args[] = {&a};
    hipError_t e = hipLaunchCooperativeKernel((void*)nsa_fwd, dim3(grid), dim3(512), args, LDS_BYTES, stream);
    if (e != hipSuccess) fprintf(stderr, "kernel_launch: cooperative launch failed: %s (grid %d)\n", hipGetErrorString(e), grid);
}
```

```cpp
#include <hip/hip_runtime.h>
#include <hip/hip_cooperative_groups.h>
#include <cstdio>
#include <cstdint>
namespace cg = cooperative_groups;

#define LAS __attribute__((address_space(3)))
typedef unsigned short bf16_t;
typedef short bf16x8 __attribute__((ext_vector_type(8)));
typedef short s16x4 __attribute__((ext_vector_type(4)));
typedef float f32x4 __attribute__((ext_vector_type(4)));
typedef float f32x16 __attribute__((ext_vector_type(16)));
typedef unsigned u32x4 __attribute__((ext_vector_type(4)));
typedef unsigned u32x2 __attribute__((ext_vector_type(2)));
typedef float f32x2_t __attribute__((ext_vector_type(2)));
typedef __bf16 bf16x2_t __attribute__((ext_vector_type(2)));

constexpr int MTOK = 16384, DM = 1024, SEQ = 4096, NB = 4;
constexpr int PP = 6400;
constexpr int INCOLS = 6192;
constexpr int C_B = 0, C_C = 512, C_H = 1024, C_Q = 1536, C_KC = 2560, C_VC = 2816, C_KS = 3072, C_VS = 3328, C_KW = 3584, C_VW = 3840,
              C_GBR = 4096, C_GCONV = 4144, C_GATTN = 5168;
constexpr int DFF = 2816;
constexpr float EPS = 1e-6f;
constexpr float LOG2E = 1.4426950408889634f;
constexpr float QSCALE = 0.125f * LOG2E;

constexpr size_t MiB = 1u << 20;
constexpr size_t WS_PART1 = 0;
constexpr size_t WS_PART2 = 1 * MiB;
constexpr size_t WS_BIAS = 2 * MiB;
constexpr size_t WS_BAR = 2 * MiB + 65536;
constexpr size_t WS_WIN = 3 * MiB;
constexpr size_t WS_WCONV = 16 * MiB;
constexpr size_t WS_WATTN = 17 * MiB;
constexpr size_t WS_WO = 19 * MiB;
constexpr size_t WS_WUP = 21 * MiB;
constexpr size_t WS_WDOWN = 32 * MiB;
constexpr size_t WS_W1 = 38 * MiB;
constexpr size_t WS_W2 = 40 * MiB;
constexpr size_t WS_HID = 41 * MiB;
constexpr size_t WS_KCMP = 45 * MiB;
constexpr size_t WS_PROJ = 46 * MiB;
constexpr size_t WS_H1F = 46 * MiB;
constexpr size_t WS_H1B = 110 * MiB;
constexpr size_t WS_ACT = 142 * MiB;
constexpr size_t WS_NEED = 246 * MiB;
constexpr size_t OUT_BC = 32 * MiB;

constexpr int LDS_BYTES = 147456;

__device__ __forceinline__ float bf2f(unsigned short v) { return __uint_as_float(((unsigned)v) << 16); }
__device__ __forceinline__ unsigned pk2(float lo, float hi) { f32x2_t v = {lo, hi}; bf16x2_t b = __builtin_convertvector(v, bf16x2_t); return __builtin_bit_cast(unsigned, b); }
__device__ __forceinline__ float ex2(float x) { return __builtin_amdgcn_exp2f(x); }
__device__ __forceinline__ float sigmoidf_(float x) { return __builtin_amdgcn_rcpf(1.0f + ex2(-x * LOG2E)); }
__device__ __forceinline__ float lo_bf(unsigned w) { return __uint_as_float(w << 16); }
__device__ __forceinline__ float hi_bf(unsigned w) { return __uint_as_float(w & 0xffff0000u); }

namespace pg8 {
constexpr int BM = 256, BK = 64, HALF = 128, HTB = HALF * BK * 2, STAGE_BYTES = 8 * HTB, NXCD = 8, WGM = 8;
__host__ __device__ __forceinline__ int lds_byte(int r, int c) { const int st = (r >> 4) * 2 + (c >> 5), rr = r & 15, cc = c & 31, ob = rr * 64 + cc * 2; return st * 1024 + (ob ^ (((ob >> 9) & 1) << 5)); }
__host__ __device__ __forceinline__ void stage_rc(int b, int& R, int& C) { const int st = b / 1024, sb = b % 1024, swz = sb ^ (((sb >> 9) & 1) << 5); R = (st >> 1) * 16 + swz / 64; C = (st & 1) * 32 + (swz % 64) / 2; }
__host__ __device__ __forceinline__ int perm32(int rho) { const int n = rho >> 4, i = rho & 15; return 8 * (i >> 2) + 4 * n + (i & 3); }

struct Unit { int pm, pn; };
struct Gemm { const bf16_t* A; const bf16_t* Bt; int M, N, K; int lda; int a_kstep; int amode; };

struct StaticOrder {
    int nM, nN, nwg, G, c;
    __host__ __device__ void init(int M, int N, int G_, int c_) { nM = M / BM; nN = N / BM; nwg = nM * nN; G = G_; c = c_; }
    __host__ __device__ bool next(int i, Unit& u) const {
        const long L = (long)i * G + c; if (L >= nwg) return false;
        int wgid = (int)L; { const int q = nwg / NXCD, r = nwg % NXCD, xcd = wgid % NXCD, off = wgid / NXCD; wgid = (xcd < r ? xcd * (q + 1) : r * (q + 1) + (xcd - r) * q) + off; }
        const int nig = WGM * nN, gid = wgid / nig, fm = gid * WGM, gsz = (nM - fm) < WGM ? (nM - fm) : WGM;
        u.pm = fm + ((wgid % nig) % gsz); u.pn = (wgid % nig) / gsz; return true;
    }
};

__device__ __forceinline__ const char* a_tile(const Gemm& g, const Unit& u) {
    if (g.amode == 1) return (const char*)g.A + ((size_t)(u.pm >> 2) * SEQ * PP + (size_t)u.pn * 256 + (size_t)(u.pm & 3) * 64) * 2;
    if (g.amode == 2) return (const char*)g.A + ((size_t)u.pn * 4096 * 256 + (size_t)u.pm * 256 * 256) * 2;
    return (const char*)g.A + (size_t)u.pm * 256 * (size_t)g.lda * 2;
}

template <class T, class = void> struct is_fused { static constexpr bool value = false; };
template <class T> struct is_fused<T, decltype((void)T::FUSED)> { static constexpr bool value = true; };
template <class Epi>
__device__ __forceinline__ void gemm_phase(LAS unsigned char* lds, const Gemm g, const StaticOrder& S, const Epi& E) {
#ifdef NO_GEMM
    return;
#endif
    int tid_ = threadIdx.x; asm volatile("" : "+v"(tid_));
    const int tid = tid_, wid = __builtin_amdgcn_readfirstlane(tid >> 6), lane = tid & 63, wr = wid >> 2, wc = wid & 3, fr = lane & 15, fq = lane >> 4;
    const int K = g.K, nt = K / BK;
    unsigned voffA[2], voffB[2];
#pragma unroll
    for (int i = 0; i < 2; ++i) { int R, C; stage_rc(tid * 16 + i * 8192, R, C); const int Rb = (R & ~31) + perm32(R & 31);
        voffA[i] = (unsigned)(R * g.lda + C) * 2u; voffB[i] = (unsigned)(Rb * K + C) * 2u; }
    const size_t kstepA = (size_t)g.a_kstep, kstepB = (size_t)(BK * 2);
    const size_t hstepA = (size_t)HALF * g.lda * 2, hstepB = (size_t)HALF * K * 2;
    const size_t tstepB = 2 * hstepB;
    const unsigned ldsw = (unsigned)wid * 1024u;
    const int aoff = lds_byte(wr * 64 + fr, fq * 8), boff = lds_byte(wc * 32 + fr, fq * 8);
#define PG8_SA(b, h) (((b) * 2 + (h)) * HTB)
#define PG8_SB(b, h) ((4 + (b) * 2 + (h)) * HTB)
#define PG8_STAGE(bufoff, gbase, voff) do { _Pragma("unroll") for (int _i = 0; _i < 2; ++_i) \
        __builtin_amdgcn_global_load_lds((const unsigned*)((const char*)(gbase) + (voff)[_i]), (LAS unsigned*)(lds + (bufoff) + ldsw + _i * 8192), 16, 0, 0); } while (0)
#define PG8_LDA(dst, b, h) do { _Pragma("unroll") for (int m = 0; m < 4; ++m) _Pragma("unroll") for (int k = 0; k < 2; ++k) dst[m][k] = *(const LAS bf16x8*)(lds + PG8_SA(b, h) + aoff + m * 2048 + k * 1024); } while (0)
#define PG8_LDB(dst, b, h) do { _Pragma("unroll") for (int n = 0; n < 2; ++n) _Pragma("unroll") for (int k = 0; k < 2; ++k) dst[n][k] = *(const LAS bf16x8*)(lds + PG8_SB(b, h) + boff + n * 2048 + k * 1024); } while (0)
#define PG8_MMA(ai, bj, At, Bt) do { __builtin_amdgcn_s_setprio(1); _Pragma("unroll") for (int m = 0; m < 4; ++m) _Pragma("unroll") for (int n = 0; n < 2; ++n) _Pragma("unroll") for (int k = 0; k < 2; ++k) \
        acc[ai][bj][m][n] = __builtin_amdgcn_mfma_f32_16x16x32_bf16(Bt[n][k], At[m][k], acc[ai][bj][m][n], 0, 0, 0); __builtin_amdgcn_s_setprio(0); } while (0)
#define PG8_WAIT_V(n) asm volatile("s_waitcnt vmcnt(" #n ")" ::: "memory")
#define PG8_WAIT_L(n) asm volatile("s_waitcnt lgkmcnt(" #n ")" ::: "memory")
#define PG8_BAR __builtin_amdgcn_s_barrier()
#define PG8_SCHED __builtin_amdgcn_sched_barrier(0)
    Unit cur, nxt; int ui = 0;
    if (!S.next(0, cur)) return;
    f32x4 acc[2][2][4][2];
#pragma unroll
    for (int a = 0; a < 2; ++a)
#pragma unroll
        for (int b = 0; b < 2; ++b)
#pragma unroll
            for (int m = 0; m < 4; ++m)
#pragma unroll
                for (int n = 0; n < 2; ++n) acc[a][b][m][n] = (f32x4){0.f, 0.f, 0.f, 0.f};
    bf16x8 At[4][2], B0[2][2], B1[2][2];
    const char* cA = a_tile(g, cur); const char* cB = (const char*)g.Bt + (size_t)cur.pn * tstepB;
    PG8_STAGE(PG8_SB(0, 0), cB, voffB); PG8_STAGE(PG8_SB(0, 1), cB + hstepB, voffB); PG8_STAGE(PG8_SA(0, 0), cA, voffA); PG8_STAGE(PG8_SA(0, 1), cA + hstepA, voffA);
    if (wr == 1) PG8_BAR;
    PG8_WAIT_V(2); PG8_BAR;
    PG8_STAGE(PG8_SB(1, 0), cB + kstepB, voffB); PG8_STAGE(PG8_SA(1, 0), cA + kstepA, voffA); PG8_STAGE(PG8_SB(1, 1), cB + hstepB + kstepB, voffB);
    PG8_WAIT_V(6); PG8_BAR;
    for (;;) {
        const bool has_next = S.next(ui + 1, nxt);
        const char* nA = has_next ? a_tile(g, nxt) : cA; const char* nB = has_next ? (const char*)g.Bt + (size_t)nxt.pn * tstepB : cB;
        for (int t = 0; t < nt; t += 2) {
            const bool last = (t == nt - 2);
            const char* a1 = cA + (size_t)(t + 1) * kstepA;
            const char* a2 = last ? nA : cA + (size_t)(t + 2) * kstepA; const char* b2 = last ? nB : cB + (size_t)(t + 2) * kstepB;
            const char* a3 = a2 + kstepA; const char* b3 = b2 + kstepB;
            PG8_LDB(B0, 0, 0); PG8_LDB(B1, 0, 1); PG8_SCHED; PG8_LDA(At, 0, 0); PG8_STAGE(PG8_SA(1, 1), a1 + hstepA, voffA);
            PG8_WAIT_V(8); PG8_WAIT_L(0); PG8_BAR; PG8_MMA(0, 0, At, B0); PG8_MMA(0, 1, At, B1); PG8_BAR; PG8_SCHED;
            PG8_LDA(At, 0, 1); PG8_STAGE(PG8_SB(0, 0), b2, voffB); PG8_STAGE(PG8_SB(0, 1), b2 + hstepB, voffB); PG8_STAGE(PG8_SA(0, 0), a2, voffA);
            PG8_WAIT_V(8); PG8_WAIT_L(0); PG8_BAR; PG8_MMA(1, 0, At, B0); PG8_MMA(1, 1, At, B1); PG8_BAR; PG8_SCHED;
            PG8_LDB(B0, 1, 0); PG8_LDB(B1, 1, 1); PG8_SCHED; PG8_LDA(At, 1, 0); PG8_STAGE(PG8_SA(0, 1), a2 + hstepA, voffA);
            PG8_WAIT_V(8); PG8_WAIT_L(0); PG8_BAR; PG8_MMA(0, 0, At, B0); PG8_MMA(0, 1, At, B1); PG8_BAR; PG8_SCHED;
            PG8_LDA(At, 1, 1); PG8_STAGE(PG8_SB(1, 0), b3, voffB); PG8_STAGE(PG8_SB(1, 1), b3 + hstepB, voffB); PG8_STAGE(PG8_SA(1, 0), a3, voffA);
            PG8_WAIT_V(8); PG8_WAIT_L(0); PG8_BAR; PG8_MMA(1, 0, At, B0); PG8_MMA(1, 1, At, B1); PG8_BAR; PG8_SCHED;
        }
        if (wr == 0) PG8_BAR;
        if constexpr (!is_fused<Epi>::value) E(acc, cur, wr, wc, fr, fq);
        if (!has_next) break;
#pragma unroll
        for (int a = 0; a < 2; ++a)
#pragma unroll
            for (int b = 0; b < 2; ++b)
#pragma unroll
                for (int m = 0; m < 4; ++m)
#pragma unroll
                    for (int n = 0; n < 2; ++n) acc[a][b][m][n] = (f32x4){0.f, 0.f, 0.f, 0.f};
        cur = nxt; cA = nA; cB = nB; ++ui;
        if (wr == 1) PG8_BAR;
    }
    PG8_WAIT_V(0);
    PG8_BAR;
    if constexpr (is_fused<Epi>::value) E.fused(acc, cur, wr, wc, fr, fq, lds, wid, lane);
#undef PG8_SA
#undef PG8_SB
#undef PG8_STAGE
#undef PG8_LDA
#undef PG8_LDB
#undef PG8_MMA
#undef PG8_WAIT_V
#undef PG8_WAIT_L
#undef PG8_BAR
#undef PG8_SCHED
}

typedef f32x4 Acc[2][2][4][2];
#define EPI_LOOP_BEGIN \
    _Pragma("unroll") for (int ai = 0; ai < 2; ++ai) _Pragma("unroll") for (int m = 0; m < 4; ++m) { const int row = u.pm * BM + wr * 64 + fr + ai * HALF + m * 16; \
    _Pragma("unroll") for (int bj = 0; bj < 2; ++bj) { const f32x4 v0 = acc[ai][bj][m][0], v1 = acc[ai][bj][m][1]; const int col = u.pn * BM + bj * HALF + wc * 32 + 8 * fq;
#define EPI_LOOP_END } }
__device__ __forceinline__ u32x4 pack8(const f32x4 a, const f32x4 b) { u32x4 w; w.x = pk2(a[0], a[1]); w.y = pk2(a[2], a[3]); w.z = pk2(b[0], b[1]); w.w = pk2(b[2], b[3]); return w; }

struct EpiProj { bf16_t* O; int ldc;
    __device__ __forceinline__ void operator()(const Acc& acc, const Unit& u, int wr, int wc, int fr, int fq) const {
        EPI_LOOP_BEGIN
            *(u32x4*)(O + (size_t)row * ldc + col) = pack8(v0, v1);
        EPI_LOOP_END
    } };
__device__ __forceinline__ float gelu_tanh(float x) {
    const float z = x * (1.0f + 0.044715f * x * x) * (2.0f * 0.7978845608028654f * LOG2E);
    return x * __builtin_amdgcn_rcpf(1.0f + ex2(-z));
}
struct EpiHid { bf16_t* O; const float* bias;
    __device__ __forceinline__ void operator()(const Acc& acc, const Unit& u, int wr, int wc, int fr, int fq) const {
        EPI_LOOP_BEGIN
            const int c = col - u.pn * BM; const float* bp = bias + u.pn * 256 + c;
            const f32x4 b0 = *(const f32x4*)bp, b1 = *(const f32x4*)(bp + 4);
            f32x4 a = v0 + b0, b = v1 + b1;
#pragma unroll
            for (int j = 0; j < 4; ++j) { a[j] = gelu_tanh(a[j]); b[j] = gelu_tanh(b[j]); }
            *(u32x4*)(O + (size_t)u.pn * 4096 * 256 + (size_t)row * 256 + c) = pack8(a, b);
        EPI_LOOP_END
    } };
struct EpiCmp { bf16_t* O;
    __device__ __forceinline__ void operator()(const Acc& acc, const Unit& u, int wr, int wc, int fr, int fq) const {
        EPI_LOOP_BEGIN
            const int c = col - u.pn * BM;
            if (c < 64) { u32x4 w = pack8(v0, v1); if ((row & 255) == 255) w = (u32x4){0u, 0u, 0u, 0u};
                *(u32x4*)(O + (size_t)u.pn * 4096 * 64 + (size_t)row * 64 + c) = w; }
        EPI_LOOP_END
    } };
template <int ADD> struct EpiMix { bf16_t* mix; const bf16_t* proj; int gcol;
    __device__ __forceinline__ void operator()(const Acc& acc, const Unit& u, int wr, int wc, int fr, int fq) const {
        EPI_LOOP_BEGIN
            const u32x4 gv = *(const u32x4*)(proj + (size_t)row * PP + gcol + col);
            f32x4 a, b;
            a[0] = sigmoidf_(lo_bf(gv.x)) * v0[0]; a[1] = sigmoidf_(hi_bf(gv.x)) * v0[1]; a[2] = sigmoidf_(lo_bf(gv.y)) * v0[2]; a[3] = sigmoidf_(hi_bf(gv.y)) * v0[3];
            b[0] = sigmoidf_(lo_bf(gv.z)) * v1[0]; b[1] = sigmoidf_(hi_bf(gv.z)) * v1[1]; b[2] = sigmoidf_(lo_bf(gv.w)) * v1[2]; b[3] = sigmoidf_(hi_bf(gv.w)) * v1[3];
            bf16_t* mp = mix + (size_t)row * DM + col;
            if (ADD) { const u32x4 pv = *(const u32x4*)mp;
                a[0] += lo_bf(pv.x); a[1] += hi_bf(pv.x); a[2] += lo_bf(pv.y); a[3] += hi_bf(pv.y); b[0] += lo_bf(pv.z); b[1] += hi_bf(pv.z); b[2] += lo_bf(pv.w); b[3] += hi_bf(pv.w); }
            *(u32x4*)mp = pack8(a, b);
        EPI_LOOP_END
    } };
template <int WB> struct EpiRes { const float* base; float* hf; bf16_t* hb; float* part;
    __device__ __forceinline__ void operator()(const Acc& acc, const Unit& u, int wr, int wc, int fr, int fq) const {
#pragma unroll
        for (int ai = 0; ai < 2; ++ai)
#pragma unroll
            for (int m = 0; m < 4; ++m) { const int row = u.pm * BM + wr * 64 + fr + ai * HALF + m * 16; float ss = 0.f;
#pragma unroll
                for (int bj = 0; bj < 2; ++bj) { const int col = u.pn * BM + bj * HALF + wc * 32 + 8 * fq; const size_t off = (size_t)row * DM + col;
                    const f32x4 x0 = *(const f32x4*)(base + off), x1 = *(const f32x4*)(base + off + 4);
                    const f32x4 a = x0 + acc[ai][bj][m][0], b = x1 + acc[ai][bj][m][1];
                    *(f32x4*)(hf + off) = a; *(f32x4*)(hf + off + 4) = b;
                    if (WB) *(u32x4*)(hb + off) = pack8(a, b);
                    ss += (a[0] * a[0] + a[1] * a[1]) + (a[2] * a[2] + a[3] * a[3]) + (b[0] * b[0] + b[1] * b[1]) + (b[2] * b[2] + b[3] * b[3]); }
                ss += __shfl_xor(ss, 16); ss += __shfl_xor(ss, 32);
                if (fq == 0) part[(size_t)row * 16 + u.pn * 4 + wc] = ss; }
    } };
struct EpiUp { bf16_t* act; const float* part;
    __device__ __forceinline__ void operator()(const Acc& acc, const Unit& u, int wr, int wc, int fr, int fq) const {
#pragma unroll
        for (int ai = 0; ai < 2; ++ai)
#pragma unroll
            for (int m = 0; m < 4; ++m) { const int row = u.pm * BM + wr * 64 + fr + ai * HALF + m * 16;
                const f32x4 pp = *(const f32x4*)(part + (size_t)row * 16 + 4 * fq); float ss = (pp[0] + pp[1]) + (pp[2] + pp[3]);
                ss += __shfl_xor(ss, 16); ss += __shfl_xor(ss, 32);
                const float r = __builtin_amdgcn_rsqf(ss * (1.0f / DM) + EPS);
                f32x4 a, b;
#pragma unroll
                for (int j = 0; j < 4; ++j) { const float g0 = acc[ai][0][m][0][j] * r, u0 = acc[ai][1][m][0][j] * r, g1 = acc[ai][0][m][1][j] * r, u1 = acc[ai][1][m][1][j] * r;
                    a[j] = g0 * sigmoidf_(g0) * u0; b[j] = g1 * sigmoidf_(g1) * u1; }
                *(u32x4*)(act + (size_t)row * DFF + u.pn * 128 + wc * 32 + 8 * fq) = pack8(a, b); }
    } };
struct EpiFinal { static constexpr bool FUSED = true;
    const float* base; float* out; const float* gfin; unsigned* xbuf; unsigned* cnt; unsigned* tmo;
    __device__ __forceinline__ void operator()(const Acc&, const Unit&, int, int, int, int) const {}
    __device__ __forceinline__ void fused(f32x4 (&acc)[2][2][4][2], const Unit& u, int wr, int wc, int fr, int fq, LAS unsigned char* lds, int wid, int lane) const {
        LAS float* P = (LAS float*)lds;
        LAS float* S = (LAS float*)(lds + 8192);
        LAS unsigned* flag = (LAS unsigned*)(lds + 8192 + 2048);
#pragma unroll
        for (int ai = 0; ai < 2; ++ai)
#pragma unroll
            for (int m = 0; m < 4; ++m) { const int rl = ai * HALF + wr * 64 + m * 16 + fr; const int row = u.pm * BM + rl; float ss = 0.f;
#pragma unroll
                for (int bj = 0; bj < 2; ++bj) { const int col = u.pn * BM + bj * HALF + wc * 32 + 8 * fq; const size_t off = (size_t)row * DM + col;
                    const f32x4 x0 = *(const f32x4*)(base + off), x1 = *(const f32x4*)(base + off + 4);
                    const f32x4 a = x0 + acc[ai][bj][m][0], b = x1 + acc[ai][bj][m][1]; acc[ai][bj][m][0] = a; acc[ai][bj][m][1] = b;
                    ss += (a[0] * a[0] + a[1] * a[1]) + (a[2] * a[2] + a[3] * a[3]) + (b[0] * b[0] + b[1] * b[1]) + (b[2] * b[2] + b[3] * b[3]); }
                ss += __shfl_xor(ss, 16); ss += __shfl_xor(ss, 32);
                if (fq == 0) P[rl * 4 + wc] = ss; }
        asm volatile("s_waitcnt lgkmcnt(0)" ::: "memory"); __builtin_amdgcn_s_barrier(); asm volatile("" ::: "memory");
        const int rl = wid * 32 + (lane & 31);
        if (lane < 32) { const float tot = (P[rl * 4 + 0] + P[rl * 4 + 1]) + (P[rl * 4 + 2] + P[rl * 4 + 3]);
            __hip_atomic_store(xbuf + ((size_t)(u.pm * BM + rl) * 4 + u.pn), __float_as_uint(tot), __ATOMIC_RELAXED, __HIP_MEMORY_SCOPE_AGENT); }
        asm volatile("s_waitcnt vmcnt(0)" ::: "memory");
        if (lane == 0) __hip_atomic_fetch_add(cnt + 64 * u.pm, 1u, __ATOMIC_RELAXED, __HIP_MEMORY_SCOPE_AGENT);
        if (wid == 0) {
            unsigned sp = 0u;
            for (;;) {
                if ((unsigned)__builtin_amdgcn_readfirstlane(__hip_atomic_load(cnt + 64 * u.pm, __ATOMIC_RELAXED, __HIP_MEMORY_SCOPE_AGENT)) >= 32u) break;
                __builtin_amdgcn_s_sleep(2);
                if (++sp > (1u << 20)) { if (lane == 0) __hip_atomic_store(tmo, 1u, __ATOMIC_RELAXED, __HIP_MEMORY_SCOPE_AGENT); break; }
            }
            __builtin_amdgcn_fence(__ATOMIC_ACQUIRE, "agent");
            if (lane == 0) flag[0] = 1u;
        }
        asm volatile("s_waitcnt vmcnt(0) lgkmcnt(0)" ::: "memory"); __builtin_amdgcn_s_barrier(); asm volatile("" ::: "memory");
        if (lane < 32) { const unsigned* sl = xbuf + (size_t)(u.pm * BM + rl) * 4; float tot = 0.f;
#pragma unroll
            for (int t = 0; t < 4; ++t) tot += __uint_as_float(__hip_atomic_load(sl + t, __ATOMIC_RELAXED, __HIP_MEMORY_SCOPE_AGENT));
            S[rl] = __builtin_amdgcn_rsqf(tot * (1.0f / DM) + EPS); }
        asm volatile("s_waitcnt lgkmcnt(0)" ::: "memory"); __builtin_amdgcn_s_barrier(); asm volatile("" ::: "memory");
#pragma unroll
        for (int bj = 0; bj < 2; ++bj) { const int col = u.pn * BM + bj * HALF + wc * 32 + 8 * fq;
            const f32x4 g0 = *(const f32x4*)(gfin + col), g1 = *(const f32x4*)(gfin + col + 4);
#pragma unroll
            for (int ai = 0; ai < 2; ++ai)
#pragma unroll
                for (int m = 0; m < 4; ++m) { const int rl2 = ai * HALF + wr * 64 + m * 16 + fr; const float rs = S[rl2]; const size_t off = (size_t)(u.pm * BM + rl2) * DM + col;
                    *(f32x4*)(out + off) = acc[ai][bj][m][0] * rs * g0; *(f32x4*)(out + off + 4) = acc[ai][bj][m][1] * rs * g1; } }
    } };
}

namespace att {
constexpr int KB0 = 0, VB0 = 24576, IMP = 49152, IMPW = 65, SELM = IMP + 4 * 64 * IMPW * 4, WMASK = SELM + 512, WSF = WMASK + 64, STEPS = WSF + 8 * 32 * 4, CMPX = STEPS + 8 * 128, ATT_LDS = CMPX + 16384;
static_assert(ATT_LDS <= 143360, "attention LDS");
#define MFMA32(a, b, c) __builtin_amdgcn_mfma_f32_32x32x16_bf16((a), (b), (c), 0, 0, 0)
__device__ __forceinline__ int crow(int r, int hi) { return (r & 3) + 8 * (r >> 2) + 4 * hi; }
typedef short v4i16_t __attribute__((ext_vector_type(4)));
__device__ __forceinline__ s16x4 vtr(LAS const unsigned char* p) { return __builtin_bit_cast(s16x4, __builtin_amdgcn_ds_read_tr16_b64_v4i16((LAS v4i16_t*)p)); }

struct St { float m, l; f32x16 o0, o1; };

__device__ __forceinline__ void qk_tile(f32x16& p0, f32x16& p1, LAS const unsigned char* kb, const bf16x8* qf, int r, int h) {
    bf16x8 k0[4], k1[4], qv[4];
#pragma unroll
    for (int d0 = 0; d0 < 4; ++d0) { k0[d0] = *(const LAS bf16x8*)(kb + (2 * d0 + h) * 1024 + r * 16); k1[d0] = *(const LAS bf16x8*)(kb + (2 * d0 + h) * 1024 + 512 + r * 16);
        qv[d0] = qf[d0]; }
#pragma unroll
    for (int i = 0; i < 16; ++i) { p0[i] = 0.f; p1[i] = 0.f; }
    __builtin_amdgcn_sched_barrier(0);
#pragma unroll
    for (int d0 = 0; d0 < 4; ++d0) { p0 = MFMA32(k0[d0], qv[d0], p0); p1 = MFMA32(k1[d0], qv[d0], p1); }
}
__device__ __forceinline__ void apply_mask(f32x16& p0, f32x16& p1, unsigned long long allow, int h) {
    if (__all(allow == ~0ull)) return;
    const unsigned long long a = allow >> (4 * h); const unsigned lo = (unsigned)a, hi = (unsigned)(a >> 32);
#pragma unroll
    for (int i = 0; i < 16; ++i) { const int cb = (i & 3) + 8 * (i >> 2);
        p0[i] = ((lo >> cb) & 1u) ? p0[i] : -INFINITY; p1[i] = ((hi >> cb) & 1u) ? p1[i] : -INFINITY; }
}
__device__ __forceinline__ float rowmax32(const f32x16& p0, const f32x16& p1) {
    float a = fmaxf(p0[0], p1[0]);
#pragma unroll
    for (int i = 1; i < 16; ++i) a = fmaxf(a, fmaxf(p0[i], p1[i]));
    return fmaxf(a, __shfl_xor(a, 32));
}
__device__ __forceinline__ void pv_tile(f32x16& o0, f32x16& o1, LAS const unsigned char* vb, const f32x16& p0, const f32x16& p1, int lane, int h) {
    bf16x8 pa[4];
#pragma unroll
    for (int s = 0; s < 4; ++s) { u32x4 w;
#pragma unroll
        for (int j = 0; j < 4; ++j) { const int i0 = 8 * (s & 1) + 2 * j; w[j] = (s < 2) ? pk2(p0[i0], p0[i0 + 1]) : pk2(p1[i0], p1[i0 + 1]); }
        pa[s] = __builtin_bit_cast(bf16x8, w); }
    LAS const unsigned char* vp = vb + ((lane >> 4) & 1) * 32 + (lane & 3) * 8 + (4 * h + ((lane & 15) >> 2)) * 64;
    s16x4 l0[4], h0[4], l1[4], h1[4];
#pragma unroll
    for (int s = 0; s < 4; ++s) { l0[s] = vtr(vp + s * 1024); h0[s] = vtr(vp + s * 1024 + 512); l1[s] = vtr(vp + 4096 + s * 1024); h1[s] = vtr(vp + 4096 + s * 1024 + 512); }
    __builtin_amdgcn_sched_barrier(0);
#pragma unroll
    for (int s = 0; s < 4; ++s) {
        const bf16x8 v0 = (bf16x8){l0[s][0], l0[s][1], l0[s][2], l0[s][3], h0[s][0], h0[s][1], h0[s][2], h0[s][3]};
        const bf16x8 v1 = (bf16x8){l1[s][0], l1[s][1], l1[s][2], l1[s][3], h1[s][0], h1[s][1], h1[s][2], h1[s][3]};
        o0 = MFMA32(pa[s], v0, o0); o1 = MFMA32(pa[s], v1, o1);
    }
}
__device__ __forceinline__ void tile_online(St& st, LAS const unsigned char* kb, LAS const unsigned char* vb, const bf16x8* qr, unsigned long long allow,
                                            LAS float* wsf, int lane, int r, int h) {
    f32x16 p0, p1; qk_tile(p0, p1, kb, qr, r, h); __builtin_amdgcn_sched_barrier(0); apply_mask(p0, p1, allow, h);
    const float rm = rowmax32(p0, p1), mnew = fmaxf(st.m, rm), f = ex2(st.m - mnew); st.m = mnew;
    float ls = 0.f;
#pragma unroll
    for (int i = 0; i < 16; ++i) { p0[i] = ex2(p0[i] - mnew); p1[i] = ex2(p1[i] - mnew); ls += p0[i] + p1[i]; }
    st.l = st.l * f + ls;
    if (__any(f != 1.0f)) {
        if (h == 0) wsf[r] = f;
#pragma unroll
        for (int i = 0; i < 16; ++i) { const float fi = wsf[crow(i, h)]; st.o0[i] *= fi; st.o1[i] *= fi; }
    }
    pv_tile(st.o0, st.o1, vb, p0, p1, lane, h);
}
__device__ __forceinline__ void tile_stats(float& m, float& l, LAS const unsigned char* kb, const bf16x8* qr, unsigned long long allow, int r, int h) {
    f32x16 p0, p1; qk_tile(p0, p1, kb, qr, r, h); __builtin_amdgcn_sched_barrier(0); apply_mask(p0, p1, allow, h);
    const float rm = rowmax32(p0, p1), mnew = fmaxf(m, rm), f = ex2(m - mnew); m = mnew;
    float ls = 0.f;
#pragma unroll
    for (int i = 0; i < 16; ++i) ls += ex2(p0[i] - mnew) + ex2(p1[i] - mnew);
    l = l * f + ls;
}
__device__ __forceinline__ void tile_exact(f32x16& o0, f32x16& o1, float m, float invl, LAS const unsigned char* kb, LAS const unsigned char* vb, const bf16x8* qr,
                                           unsigned long long allow, LAS float* impw  , float& carry, int j, int lane, int r, int h) {
    f32x16 p0, p1; qk_tile(p0, p1, kb, qr, r, h); __builtin_amdgcn_sched_barrier(0); apply_mask(p0, p1, allow, h);
#pragma unroll
    for (int i = 0; i < 16; ++i) { p0[i] = ex2(p0[i] - m) * invl; p1[i] = ex2(p1[i] - m) * invl; }
#pragma unroll
    for (int pos = 0; pos < 8; ++pos) {
        const int half = pos >> 2, r4 = pos & 3;
        const float P0 = half ? p1[4 * r4] : p0[4 * r4], P1 = half ? p1[4 * r4 + 1] : p0[4 * r4 + 1], P2 = half ? p1[4 * r4 + 2] : p0[4 * r4 + 2], P3 = half ? p1[4 * r4 + 3] : p0[4 * r4 + 3];
        const float a = (P0 + P1) + (P2 + 0.5f * P3), b = 0.5f * P3;
        const float bx = __shfl_xor(b, 32);
        const float add = h ? bx : carry;
        impw[16 * j + 2 * pos + h] = a + add;
        carry = bx;
    }
    pv_tile(o0, o1, vb, p0, p1, lane, h);
}

__device__ __forceinline__ void qk_tile_c(f32x16& p0, f32x16& p1, LAS const unsigned char* kb, const bf16x8* qf, const f32x16& c, int r, int h) {
    bf16x8 k0[4], k1[4], qv[4];
#pragma unroll
    for (int d0 = 0; d0 < 4; ++d0) { k0[d0] = *(const LAS bf16x8*)(kb + (2 * d0 + h) * 1024 + r * 16); k1[d0] = *(const LAS bf16x8*)(kb + (2 * d0 + h) * 1024 + 512 + r * 16);
        qv[d0] = qf[d0]; }
    __builtin_amdgcn_sched_barrier(0);
    p0 = MFMA32(k0[0], qv[0], c); p1 = MFMA32(k1[0], qv[0], c);
#pragma unroll
    for (int d0 = 1; d0 < 4; ++d0) { p0 = MFMA32(k0[d0], qv[d0], p0); p1 = MFMA32(k1[d0], qv[d0], p1); }
}
__device__ __forceinline__ unsigned long long lowmask(int n);
__device__ __forceinline__ void soft_pv(St& st, f32x16& x0, f32x16& x1, float cx, LAS const unsigned char* vb, bool first, int kind, int tq,
                                        LAS float* wsf, int lane, int r, int h) {
    if (first) st.m = cx;
    else { const float d = st.m - cx;
        if (__any(d != 0.f)) {
#pragma unroll
            for (int i = 0; i < 16; ++i) { x0[i] -= d; x1[i] -= d; } } }
    if (kind) apply_mask(x0, x1, kind == 1 ? lowmask(tq + 1) : ~lowmask(tq + 1), h);
    const float rm = rowmax32(x0, x1);
    if (first) {
        const float dl = (rm > -INFINITY) ? rm : 0.f; st.m += dl;
#pragma unroll
        for (int i = 0; i < 16; ++i) { x0[i] -= dl; x1[i] -= dl; }
    } else if (__any(rm > 8.0f)) {
        const float dl = fmaxf(rm, 0.f), f = ex2(-dl); st.m += dl; st.l *= f;
        if (h == 0) wsf[r] = f;
#pragma unroll
        for (int i = 0; i < 16; ++i) { x0[i] -= dl; x1[i] -= dl; }
#pragma unroll
        for (int i = 0; i < 16; ++i) { const float fi = wsf[crow(i, h)]; st.o0[i] *= fi; st.o1[i] *= fi; }
    }
    float ls = 0.f;
#pragma unroll
    for (int i = 0; i < 16; ++i) { x0[i] = ex2(x0[i]); x1[i] = ex2(x1[i]); ls += x0[i] + x1[i]; }
    st.l += ls;
    pv_tile(st.o0, st.o1, vb, x0, x1, lane, h);
}
__device__ __forceinline__ unsigned long long lowmask(int n) { return n >= 64 ? ~0ull : ((1ull << n) - 1ull); }

typedef LAS const char* lds_cptr;
__device__ __forceinline__ void hs_glds16(const void* gsrc, unsigned lds_dst) { unsigned keep;
    asm volatile("s_mov_b32 %0, m0\n\ts_mov_b32 m0, %2\n\ts_nop 0\n\tglobal_load_lds_dwordx4 %1, off\n\ts_mov_b32 m0, %0" : "=&s"(keep) : "v"(gsrc), "s"(lds_dst) : "memory"); }
__device__ __forceinline__ float hs_max3f(float a, float b, float c) { float r; asm("v_max3_f32 %0, %1, %2, %3" : "=v"(r) : "v"(a), "v"(b), "v"(c)); return r; }
__device__ __forceinline__ float hs_max2f(float a, float b) { float r; asm("v_max_f32_e32 %0, %1, %2" : "=v"(r) : "v"(a), "v"(b)); return r; }
__device__ __forceinline__ float hs_fadd(float a, float b) { float r; asm("v_add_f32_e32 %0, %1, %2" : "=v"(r) : "v"(a), "v"(b)); return r; }
__device__ __forceinline__ float hs_fsub(float a, float b) { float r; asm("v_sub_f32_e32 %0, %1, %2" : "=v"(r) : "v"(a), "v"(b)); return r; }
#define HS_SBAR() __builtin_amdgcn_sched_barrier(0)
#define HS_WAIT_BAR(N) asm volatile("s_waitcnt vmcnt(" #N ") lgkmcnt(0)\n\ts_barrier" ::: "memory")
__device__ __forceinline__ void hs_qkt(f32x16& p0, f32x16& p1, const char* Kslot, const bf16x8* qr, const f32x16& negm, int r32, int hi) {
    const char* kb = Kslot + hi * 1024 + r32 * 16;
#pragma unroll
    for (int d0 = 0; d0 < 4; ++d0) {
        const bf16x8 b0 = *reinterpret_cast<const bf16x8*>(kb + d0 * 2048);
        const bf16x8 b1 = *reinterpret_cast<const bf16x8*>(kb + d0 * 2048 + 512);
        if (d0 == 0) { p0 = MFMA32(b0, qr[0], negm); p1 = MFMA32(b1, qr[0], negm); }
        else { p0 = MFMA32(b0, qr[d0], p0); p1 = MFMA32(b1, qr[d0], p1); } }
}
__device__ __forceinline__ void hs_kload8(bf16x8* kf, lds_cptr kp) {
    kf[0] = *(const LAS bf16x8*)(kp);        kf[1] = *(const LAS bf16x8*)(kp + 512);
    kf[2] = *(const LAS bf16x8*)(kp + 2048); kf[3] = *(const LAS bf16x8*)(kp + 2560);
    kf[4] = *(const LAS bf16x8*)(kp + 4096); kf[5] = *(const LAS bf16x8*)(kp + 4608);
    kf[6] = *(const LAS bf16x8*)(kp + 6144); kf[7] = *(const LAS bf16x8*)(kp + 6656);
}
__device__ __forceinline__ void hs_kload2(bf16x8* kf, lds_cptr kp, int j) { kf[2 * j] = *(const LAS bf16x8*)(kp + j * 2048); kf[2 * j + 1] = *(const LAS bf16x8*)(kp + j * 2048 + 512); }
__device__ __forceinline__ s16x4 hs_vtr(lds_cptr p) { return __builtin_bit_cast(s16x4, __builtin_amdgcn_ds_read_tr16_b64_v4i16((LAS v4i16_t*)p)); }
__device__ __forceinline__ float hs_rowmax(const f32x16& p0, const f32x16& p1) {
    float a = hs_max3f(p0[0], p0[1], p1[0]), b = hs_max3f(p0[2], p0[3], p1[1]); a = hs_max3f(a, p1[2], p1[3]);
#pragma unroll
    for (int r = 4; r < 16; r += 4) { a = hs_max3f(a, p0[r], p0[r + 1]); b = hs_max3f(b, p0[r + 2], p0[r + 3]); a = hs_max3f(a, p1[r], p1[r + 1]); b = hs_max3f(b, p1[r + 2], p1[r + 3]); }
    const float m = hs_max2f(a, b);
    auto rr = __builtin_amdgcn_permlane32_swap(__float_as_uint(m), __float_as_uint(m), false, false);
    return hs_max2f(__uint_as_float(rr[0]), __uint_as_float(rr[1]));
}
__device__ __forceinline__ void hs_pv(f32x16* o, int vb, bf16x8 pa0, bf16x8 pa1, bf16x8 pa2, bf16x8 pa3) {
#pragma unroll
    for (int d0 = 0; d0 < 2; ++d0) { s16x4 lo[4], hi[4];
#pragma unroll
        for (int ks = 0; ks < 4; ++ks) {
            asm volatile("ds_read_b64_tr_b16 %0,%1 offset:%c2" : "=&v"(lo[ks]) : "v"(vb), "i"(d0 * 4096 + ks * 1024) : "memory");
            asm volatile("ds_read_b64_tr_b16 %0,%1 offset:%c2" : "=&v"(hi[ks]) : "v"(vb), "i"(d0 * 4096 + ks * 1024 + 512) : "memory"); }
        asm volatile("s_waitcnt lgkmcnt(0)" ::: "memory"); HS_SBAR();
#define HS_PK(k) (bf16x8){lo[k][0], lo[k][1], lo[k][2], lo[k][3], hi[k][0], hi[k][1], hi[k][2], hi[k][3]}
        o[d0] = MFMA32(pa0, HS_PK(0), o[d0]); o[d0] = MFMA32(pa1, HS_PK(1), o[d0]); o[d0] = MFMA32(pa2, HS_PK(2), o[d0]); o[d0] = MFMA32(pa3, HS_PK(3), o[d0]);
#undef HS_PK
    }
}
__device__ __forceinline__ void hs_pre_dma(char* shm, const bf16_t* ksb, int c0, int c1, int c2, int wid, int lane) {
    const unsigned lds0 = (unsigned)(uintptr_t)shm;
    const size_t koff = (size_t)lane * PP + wid * 8, voff = (size_t)(16 * (wid & 3) + (lane >> 2)) * PP + (wid >> 2) * 32 + (lane & 3) * 8 + (C_VS - C_KS);
    const unsigned kdst = lds0 + KB0 + wid * 1024, vdst = lds0 + VB0 + wid * 1024;
#define HS_SRC0(c) (ksb + (size_t)(((c) & 0x80) ? (C_KW - C_KS) : 0) + (size_t)(((c) == 0x7f) ? 0 : ((c) & 0x7f)) * 64 * PP)
    hs_glds16(HS_SRC0(c0) + koff, (unsigned)__builtin_amdgcn_readfirstlane(kdst));
    hs_glds16(HS_SRC0(c0) + voff, (unsigned)__builtin_amdgcn_readfirstlane(vdst));
    hs_glds16(HS_SRC0(c1) + koff, (unsigned)__builtin_amdgcn_readfirstlane(kdst + 8192));
    hs_glds16(HS_SRC0(c2) + koff, (unsigned)__builtin_amdgcn_readfirstlane(kdst + 16384));
#undef HS_SRC0
}
template <int THRL, bool DIS, bool PRE> __device__ __forceinline__ void run_branch(char* shm, const bf16x8* qr, const bf16_t* ksb, LAS const unsigned char* steps, const int NT,
                                                               const int qb, f32x16* o, float& l_out, const int wid, const int lane) {
    constexpr int SLOTB = 8192, NSLOT = 3;
    { unsigned long long p_ = (unsigned long long)ksb; asm volatile("" : "+s"(p_)); ksb = (const bf16_t*)p_; }
    const int r32 = lane & 31, hi = lane >> 5, tq = (wid & 1) * 32 + r32;
    const unsigned lds0 = (unsigned)(uintptr_t)shm;
    const unsigned long long mysel = *((LAS const unsigned long long*)((lds_cptr)shm + SELM) + tq);
    const int vcodes = (int)steps[lane];
    float* wsf = (float*)(shm + WSF) + wid * 32;
    const size_t koff = (size_t)lane * PP + wid * 8, voff = (size_t)(16 * (wid & 3) + (lane >> 2)) * PP + (wid >> 2) * 32 + (lane & 3) * 8 + (C_VS - C_KS);
    const unsigned kdst = lds0 + KB0 + wid * 1024, vdst = lds0 + VB0 + wid * 1024;
#define HS_CODE(t) ((int)__builtin_amdgcn_readlane(vcodes, (t)))
#define HS_SRC(c) (ksb + (size_t)(((c) & 0x80) ? (C_KW - C_KS) : 0) + (size_t)(((c) == 0x7f) ? 0 : ((c) & 0x7f)) * 64 * PP)
#define DMA_K(t, slot) do { const int c_ = HS_CODE(t); hs_glds16(HS_SRC(c_) + koff, (unsigned)__builtin_amdgcn_readfirstlane(kdst + (slot))); } while (0)
#define DMA_V(t, slot) do { const int c_ = HS_CODE(t); hs_glds16(HS_SRC(c_) + voff, (unsigned)__builtin_amdgcn_readfirstlane(vdst + (slot))); } while (0)
    const int vb0 = (int)(lds0 + VB0) + ((lane >> 4) & 1) * 32 + (lane & 3) * 8 + (4 * hi + ((lane & 15) >> 2)) * 64;
    const char* Kbase = shm + KB0; bf16x8 kf[8];
    const lds_cptr shm3 = (lds_cptr)shm; const lds_cptr kp0 = shm3 + KB0 + hi * 1024 + r32 * 16; const lds_cptr vp0 = shm3 + VB0 + ((lane >> 4) & 1) * 32 + (lane & 3) * 8 + (4 * hi + ((lane & 15) >> 2)) * 64;
    if (!PRE) { DMA_K(0, 0); DMA_V(0, 0); DMA_K(1, SLOTB); }
    float mhat = 0.f, l_reg = 0.f; f32x16 negm;
    { float z = 0.f; asm volatile("" : "+v"(z));
#pragma unroll
      for (int i = 0; i < 16; ++i) { o[0][i] = z; o[1][i] = z; negm[i] = z; } }
    asm volatile("" : "+v"(negm));
#define CMASK(P0, P1, t) do { const int c_ = HS_CODE(t); const bool isw_ = (c_ & 0x80) != 0; const int jj_ = c_ & 0x7f; \
        if (!DIS && c_ == 0x7f) { _Pragma("unroll") for (int r = 0; r < 16; ++r) { P0[r] = -INFINITY; P1[r] = -INFINITY; } } \
        int kind_ = 0; if (c_ != 0x7f) { if (jj_ == qb) kind_ = 1; else if (isw_ && jj_ == qb - 8) kind_ = 2; } \
        if (kind_) apply_mask(P0, P1, kind_ == 1 ? lowmask(tq + 1) : ~lowmask(tq + 1), hi); } while (0)
    bool resc = false;
#define START(P0, P1) do { const float rm = hs_rowmax(P0, P1); resc = false; \
        { const float dl = (rm > -INFINITY) ? rm : 0.f; mhat = hs_fadd(mhat, dl); \
          _Pragma("unroll") for (int r = 0; r < 16; ++r) { P0[r] = hs_fsub(P0[r], dl); P1[r] = hs_fsub(P1[r], dl); } \
          _Pragma("unroll") for (int r = 0; r < 16; ++r) negm[r] = -mhat; asm volatile("" : "+v"(negm)); } \
        _Pragma("unroll") for (int r = 0; r < 16; ++r) P0[r] = __builtin_amdgcn_exp2f(P0[r]); } while (0)
#define RESC() do { if (resc) { asm volatile("s_waitcnt lgkmcnt(0)" ::: "memory"); \
        _Pragma("unroll") for (int d_ = 0; d_ < 2; ++d_) _Pragma("unroll") for (int r = 0; r < 16; ++r) o[d_][r] *= wsf[crow(r, hi)]; } } while (0)
    f32x16 pA0, pA1, pB0, pB1;
    int sl_prev = 0, sl_cur = 0, sl_next = SLOTB;
#define ROT() do { sl_prev = sl_cur; sl_cur = sl_next; sl_next = (sl_next == (NSLOT - 1) * SLOTB) ? 0 : sl_next + SLOTB; } while (0)
    if (!PRE) DMA_K(2, 2 * SLOTB);
    HS_WAIT_BAR(3);
    hs_qkt(pA0, pA1, Kbase, qr, negm, r32, hi); asm volatile("s_nop 15\n\ts_nop 7" : "+v"(pA0), "+v"(pA1)); CMASK(pA0, pA1, 0);
    START(pA0, pA1);
    _Pragma("unroll") for (int r = 0; r < 16; ++r) pA1[r] = __builtin_amdgcn_exp2f(pA1[r]);
    HS_WAIT_BAR(0);
    DMA_K(3, 0); DMA_V(1, SLOTB);
    ROT();
    hs_kload8(kf, kp0 + sl_cur);
    HS_WAIT_BAR(2);
    s16x4 vlo[8], vhi[8]; u32x4 pw0, pw1, pw2, pw3;
#define PKW(P, B) pk2(P[B], P[B + 1])
#define PAF(k) __builtin_bit_cast(bf16x8, pw##k)
#define VFR(i) (bf16x8){vlo[i][0], vlo[i][1], vlo[i][2], vlo[i][3], vhi[i][0], vhi[i][1], vhi[i][2], vhi[i][3]}
#define PIN(x) asm volatile("" : "+v"(x))
#define MX3(a, b, c) __builtin_fmaxf(__builtin_fmaxf((a), (b)), (c))
#define GAPA(MF, A0, A1, A2, A3, W0, W1, PW) do { MF; sacc += A0; sacc += A1; sacc += A2; sacc += A3; PIN(sacc); W0; W1; PIN(PW); HS_SBAR(); } while (0)
#define EX(v) __builtin_amdgcn_exp2f(v)
#define GAPB(MF, X, B) do { MF; X[B] = EX(X[B]); X[B + 1] = EX(X[B + 1]); X[B + 2] = EX(X[B + 2]); X[B + 3] = EX(X[B + 3]); PIN(X); HS_SBAR(); } while (0)
#define VRD(i) do { vlo[i] = hs_vtr(vp_ + (((i) >> 2) * 4096 + ((i) & 3) * 1024)); vhi[i] = hs_vtr(vp_ + (((i) >> 2) * 4096 + ((i) & 3) * 1024 + 512)); } while (0)
#define KRD(G, j) do { if (G) { hs_kload2(kf, kp0 + sl_next, j); HS_SBAR(); } } while (0)
#define STEP(C0, C1, P0, P1, t, GK, GV, GL) do { HS_SBAR(); \
        f32x16 cct; \
        if (DIS) { const int c0_ = HS_CODE(t); const bool en0_ = (c0_ != 0x7f) && (((mysel >> (c0_ & 63)) & 1ull) != 0ull);     \
            _Pragma("unroll") for (int r = 0; r < 16; ++r) cct[r] = en0_ ? negm[r] : -INFINITY; PIN(cct); HS_SBAR(); } \
        const lds_cptr vp_ = vp0 + sl_prev; \
        VRD(0); HS_SBAR(); float sacc = (P0[0] + P0[1]); \
        GAPA(C0 = MFMA32(kf[0], qr[0], (DIS ? cct : negm)), P0[2], P0[3], P0[4], P0[5],     pw0[0] = PKW(P0, 0), pw0[1] = PKW(P0, 2), pw0); \
        VRD(4); HS_SBAR(); GAPA(C1 = MFMA32(kf[1], qr[0], (DIS ? cct : negm)), P0[6], P0[7], P0[8], P0[9],     pw0[2] = PKW(P0, 4), pw0[3] = PKW(P0, 6), pw0); \
        VRD(1); HS_SBAR(); GAPA(C0 = MFMA32(kf[2], qr[1], C0),   P0[10], P0[11], P0[12], P0[13], pw1[0] = PKW(P0, 8), pw1[1] = PKW(P0, 10), pw1); \
        VRD(5); HS_SBAR(); GAPA(C1 = MFMA32(kf[3], qr[1], C1),   P0[14], P0[15], P1[0], P1[1],   pw1[2] = PKW(P0, 12), pw1[3] = PKW(P0, 14), pw1); \
        VRD(2); HS_SBAR(); GAPA(C0 = MFMA32(kf[4], qr[2], C0),   P1[2], P1[3], P1[4], P1[5],     pw2[0] = PKW(P1, 0), pw2[1] = PKW(P1, 2), pw2); \
        VRD(6); HS_SBAR(); GAPA(C1 = MFMA32(kf[5], qr[2], C1),   P1[6], P1[7], P1[8], P1[9],     pw2[2] = PKW(P1, 4), pw2[3] = PKW(P1, 6), pw2); \
        VRD(3); HS_SBAR(); GAPA(C0 = MFMA32(kf[6], qr[3], C0),   P1[10], P1[11], P1[12], P1[13], pw3[0] = PKW(P1, 8), pw3[1] = PKW(P1, 10), pw3); \
        VRD(7); HS_SBAR(); GAPA(C1 = MFMA32(kf[7], qr[3], C1),   P1[14], P1[15], 0.f, 0.f,       pw3[2] = PKW(P1, 12), pw3[3] = PKW(P1, 14), pw3); \
        l_reg += sacc; \
        if (GK) { DMA_K((t) + 3, sl_cur); } if (GV) { DMA_V((t) + 1, sl_next); } \
        CMASK(C0, C1, t); \
        { float a = MX3(C0[0], C0[1], C1[0]), b = MX3(C0[2], C0[3], C1[1]); a = MX3(a, C1[2], C1[3]); \
          _Pragma("unroll") for (int r = 4; r < 16; r += 4) { a = MX3(a, C0[r], C0[r + 1]); b = MX3(b, C0[r + 2], C0[r + 3]); a = MX3(a, C1[r], C1[r + 1]); b = MX3(b, C1[r + 2], C1[r + 3]); } \
          float rm = __builtin_fmaxf(a, b); { auto rr = __builtin_amdgcn_permlane32_swap(__float_as_uint(rm), __float_as_uint(rm), false, false); rm = __builtin_fmaxf(__uint_as_float(rr[0]), __uint_as_float(rr[1])); } \
          resc = false; \
          if (__builtin_expect(__any(rm > (float)THRL), 0)) { const float dl = __builtin_fmaxf(rm, 0.f); mhat += dl; \
            _Pragma("unroll") for (int r = 0; r < 16; ++r) { C0[r] -= dl; C1[r] -= dl; } \
            _Pragma("unroll") for (int r = 0; r < 16; ++r) negm[r] = -mhat; asm volatile("" : "+v"(negm)); \
            const float f = __builtin_amdgcn_exp2f(-dl); l_reg *= f; if (hi == 0) wsf[r32] = f; resc = true; } } \
        HS_SBAR(); \
        GAPB(o[0] = MFMA32(PAF(0), VFR(0), o[0]), C0, 0); \
        GAPB(o[1] = MFMA32(PAF(0), VFR(4), o[1]), C0, 4); \
        KRD(GL, 0); GAPB(o[0] = MFMA32(PAF(1), VFR(1), o[0]), C0, 8); \
        KRD(GL, 1); GAPB(o[1] = MFMA32(PAF(1), VFR(5), o[1]), C0, 12); \
        KRD(GL, 2); GAPB(o[0] = MFMA32(PAF(2), VFR(2), o[0]), C1, 0); \
        KRD(GL, 3); GAPB(o[1] = MFMA32(PAF(2), VFR(6), o[1]), C1, 4); \
        GAPB(o[0] = MFMA32(PAF(3), VFR(3), o[0]), C1, 8); \
        GAPB(o[1] = MFMA32(PAF(3), VFR(7), o[1]), C1, 12); \
    } while (0)
    int t = 1;
    for (; t + 5 < NT; t += 2) {
        STEP(pB0, pB1, pA0, pA1, t, true, true, true);     HS_WAIT_BAR(2); RESC(); ROT();
        STEP(pA0, pA1, pB0, pB1, t + 1, true, true, true); HS_WAIT_BAR(2); RESC(); ROT();
    }
#define ENDW(tt) do { if ((tt) + 3 < NT) { HS_WAIT_BAR(2); } else if ((tt) + 2 < NT) { HS_WAIT_BAR(1); } else { HS_WAIT_BAR(0); } } while (0)
    for (; t + 1 < NT; t += 2) {
        STEP(pB0, pB1, pA0, pA1, t, (t + 3 < NT), (t + 1 < NT), (t + 1 < NT));         ENDW(t);     RESC(); ROT();
        STEP(pA0, pA1, pB0, pB1, t + 1, (t + 4 < NT), (t + 2 < NT), (t + 2 < NT));     ENDW(t + 1); RESC(); ROT();
    }
#define DRAIN(PX0, PX1, SL) do { float sacc = PX0[0] + PX0[1]; _Pragma("unroll") for (int r = 2; r < 16; ++r) sacc += PX0[r]; _Pragma("unroll") for (int r = 0; r < 16; ++r) sacc += PX1[r]; l_reg += sacc; \
      pw0 = (u32x4){PKW(PX0, 0), PKW(PX0, 2), PKW(PX0, 4), PKW(PX0, 6)}; pw1 = (u32x4){PKW(PX0, 8), PKW(PX0, 10), PKW(PX0, 12), PKW(PX0, 14)}; \
      pw2 = (u32x4){PKW(PX1, 0), PKW(PX1, 2), PKW(PX1, 4), PKW(PX1, 6)}; pw3 = (u32x4){PKW(PX1, 8), PKW(PX1, 10), PKW(PX1, 12), PKW(PX1, 14)}; \
      HS_SBAR(); hs_pv(o, vb0 + (SL), PAF(0), PAF(1), PAF(2), PAF(3)); } while (0)
    if (NT & 1) {
        DRAIN(pA0, pA1, sl_prev);
    } else {
        STEP(pB0, pB1, pA0, pA1, NT - 1, false, false, false); RESC();
        DRAIN(pB0, pB1, sl_cur);
    }
#undef DRAIN
    { auto rr = __builtin_amdgcn_permlane32_swap(__float_as_uint(l_reg), __float_as_uint(l_reg), false, false); l_out = __uint_as_float(rr[0]) + __uint_as_float(rr[1]); }
    asm volatile("s_waitcnt lgkmcnt(0)\n\ts_barrier" ::: "memory");
#undef PKW
#undef PAF
#undef VFR
#undef PIN
#undef MX3
#undef GAPA
#undef GAPB
#undef EX
#undef VRD
#undef KRD
#undef STEP
#undef ENDW
#undef DMA_K
#undef DMA_V
#undef CMASK
#undef START
#undef RESC
#undef ROT
#undef HS_CODE
#undef HS_SRC
}
__device__ __forceinline__ void attn_unit(LAS unsigned char* lds, bf16_t* proj, const bf16_t* kcmp, const bf16_t* vcmp, int bh, int qb, int skipw) {
    int tid_ = threadIdx.x; asm volatile("" : "+v"(tid_));
    const int tid = tid_, lane = tid & 63, r = lane & 31, h = lane >> 5, wid = __builtin_amdgcn_readfirstlane(tid >> 6);
    const int b = bh >> 2, hk = bh & 3, g = wid >> 1, tq = (wid & 1) * 32 + r;
    const size_t row = (size_t)b * SEQ + (size_t)qb * 64 + tq;
    const int t = qb * 64 + tq;
    bf16_t* qp = proj + row * PP + C_Q + (hk * 4 + g) * 64;
    bf16x8 qreg[4];
#pragma unroll
    for (int d0 = 0; d0 < 4; ++d0) qreg[d0] = *(const bf16x8*)(qp + d0 * 16 + h * 8);
    const bf16x8* qr = qreg;
    float gate[3];
#pragma unroll
    for (int c = 0; c < 3; ++c) gate[c] = sigmoidf_(bf2f(proj[row * PP + C_GBR + c * 16 + hk * 4 + g]));
#ifdef GATE2X
    if (GATE2X & 1) gate[0] *= 2.f; if (GATE2X & 2) gate[1] *= 2.f; if (GATE2X & 4) gate[2] *= 2.f;
#endif
#ifdef GATEZ
    if (GATEZ & 1) gate[0] = 0.f; if (GATEZ & 2) gate[1] = 0.f; if (GATEZ & 4) gate[2] = 0.f;
#endif
    LAS float* wsf = (LAS float*)(lds + WSF) + wid * 32;
    LAS float* impw = (LAS float*)(lds + IMP) + (g * 64 + tq) * IMPW;
    const size_t krow = lane, kcol = wid * 8;
    const size_t vrow = 16 * (wid & 3) + (lane >> 2), vcol = 32 * (wid >> 2) + 8 * (lane & 3);
    LAS unsigned char* kst = lds + KB0 + wid * 1024 + lane * 16;
    LAS unsigned char* vst = lds + VB0 + wid * 1024 + lane * 16;
    u32x4 kreg, vreg;
    LAS float* osl = (LAS float*)(lds + IMP + wid * (32 * IMPW * 4)) + lane;
#define LDK(base, pitch) kreg = *(const u32x4*)((base) + krow * (size_t)(pitch) + kcol)
#define LDV(base, pitch) vreg = *(const u32x4*)((base) + vrow * (size_t)(pitch) + vcol)
#define STK(buf) *(LAS u32x4*)(kst + (buf) * 8192) = kreg
#define STV(buf) *(LAS u32x4*)(vst + (buf) * 8192) = vreg
#define KBUF(buf) (lds + KB0 + (buf) * 8192)
#define VBUF(buf) (lds + VB0 + (buf) * 8192)
#define ACCUM_OUT(scale_expr, FIRST) do { if (h == 0) wsf[r] = (scale_expr); \
        _Pragma("unroll") for (int i = 0; i < 16; ++i) { const float sc = wsf[crow(i, h)]; \
            if (FIRST) { osl[(i * 2) * 64] = st.o0[i] * sc; osl[(i * 2 + 1) * 64] = st.o1[i] * sc; } \
            else { osl[(i * 2) * 64] += st.o0[i] * sc; osl[(i * 2 + 1) * 64] += st.o1[i] * sc; } } } while (0)

    St st;
    const bf16_t* kc = kcmp + (size_t)bh * 256 * 64; const bf16_t* vc = vcmp + (size_t)bh * 256 * 64;
    const int nmax = (t >= 31) ? ((t - 31) >> 4) : -1;
#define CMP_KT(j) (lds + (j) * 8192)
#define CMP_VT(j) ((j) < 2 ? lds + 32768 + (j) * 8192 : lds + CMPX + ((j) - 2) * 8192)
    {
        u32x4 kr4[4], vr4[4];
#pragma unroll
        for (int j = 0; j < 4; ++j) { kr4[j] = *(const u32x4*)(kc + (size_t)j * 4096 + krow * 64 + kcol); vr4[j] = *(const u32x4*)(vc + (size_t)j * 4096 + vrow * 64 + vcol); }
#pragma unroll
        for (int j = 0; j < 4; ++j) { *(LAS u32x4*)(CMP_KT(j) + wid * 1024 + lane * 16) = kr4[j]; *(LAS u32x4*)(CMP_VT(j) + wid * 1024 + lane * 16) = vr4[j]; }
    }
    __syncthreads();
    float carry = 0.f;
    float m1 = -1e30f, l1 = 0.f;
#pragma unroll 1
    for (int j = 0; j < 4; ++j) {
        const int cnt = nmax - 64 * j + 1; const unsigned long long allow = cnt <= 0 ? 0ull : lowmask(cnt);
        if (__all(allow == 0ull)) continue;
        tile_stats(m1, l1, CMP_KT(j), qr, allow, r, h);
    }
    l1 += __shfl_xor(l1, 32);
    const float invl = __builtin_amdgcn_rcpf(fmaxf(l1, 1e-30f));
#pragma unroll
    for (int i = 0; i < 16; ++i) { st.o0[i] = 0.f; st.o1[i] = 0.f; }
#pragma unroll 1
    for (int j = 0; j < 4; ++j) {
        const int cnt = nmax - 64 * j + 1; const unsigned long long allow = cnt <= 0 ? 0ull : lowmask(cnt);
        if (__all(allow == 0ull)) {
#pragma unroll
            for (int pos = 0; pos < 8; ++pos) impw[16 * j + 2 * pos + h] = (pos == 0 && h == 0) ? carry : 0.f;
            carry = 0.f; continue; }
        tile_exact(st.o0, st.o1, m1, invl, CMP_KT(j), CMP_VT(j), qr, allow, impw, carry, j, lane, r, h);
    }
    __syncthreads();
    hs_pre_dma((char*)lds, proj + (size_t)b * SEQ * PP + C_KS + hk * 64, 0, qb > 0 ? qb : 0x7f, qb > 1 ? qb - 1 : 0x7f, wid, lane);
#undef CMP_KT
#undef CMP_VT
    {
        unsigned long long wor = 0ull;
        const unsigned long long valid = lowmask(qb + 1);
        LAS const float* ib = (LAS const float*)(lds + IMP);
        unsigned key[8], T[8];
#pragma unroll
        for (int i = 0; i < 8; ++i) { const int q = wid * 8 + i;
            float v = ((ib[(0 * 64 + q) * IMPW + lane] + ib[(1 * 64 + q) * IMPW + lane]) + ib[(2 * 64 + q) * IMPW + lane]) + ib[(3 * 64 + q) * IMPW + lane];
            if (lane == 0 || lane == qb || lane == qb - 1) v = INFINITY;
            key[i] = (lane <= qb) ? __float_as_uint(fmaxf(v, 0.f)) : 0u; T[i] = 0u; }
        if (qb >= 16)
#pragma unroll 1
        for (int bb = 30; bb >= 0; --bb) {
#pragma unroll
            for (int i = 0; i < 8; ++i) { const unsigned cand = T[i] | (1u << bb);
                const int c = __popcll(__ballot(key[i] >= cand) & valid); T[i] = (c >= 16) ? cand : T[i]; }
        }
#pragma unroll
        for (int i = 0; i < 8; ++i) { const int q = wid * 8 + i;
            const unsigned long long gt = __ballot(key[i] > T[i]) & valid, eq = __ballot(key[i] == T[i]) & valid;
            const int need = 16 - __popcll(gt);
            const bool pick = ((eq >> lane) & 1ull) && (__popcll(eq & lowmask(lane)) < need);
            const unsigned long long msk = gt | __ballot(pick);
            if (lane == 0) *(LAS unsigned long long*)(lds + SELM + q * 8) = msk;
            wor |= msk; }
        if (lane == 0) *(LAS unsigned long long*)(lds + WMASK + wid * 8) = wor;
    }
    __syncthreads();
    unsigned long long un = 0ull;
#pragma unroll
    for (int w = 0; w < 8; ++w) un |= *(LAS const unsigned long long*)(lds + WMASK + w * 8);
    { const unsigned ulo = __builtin_amdgcn_readfirstlane((unsigned)un), uhi = __builtin_amdgcn_readfirstlane((unsigned)(un >> 32)); un = ((unsigned long long)uhi << 32) | ulo; }
    ACCUM_OUT(gate[0], true);
    {
        LAS unsigned char* steps = lds + STEPS + wid * 128;
        const int nsel = __popcll(un), j0w = qb >= 8 ? qb - 8 : 0, nwin = qb - j0w + 1;
        const int NTs = nsel < 4 ? 4 : nsel, NTw = nwin < 4 ? 4 : nwin;
        {
            const unsigned long long F = 1ull | (1ull << qb) | (qb > 0 ? (1ull << (qb - 1)) : 0ull), rest = un & ~F; const int nF = __popcll(F);
            if (lane == 0) { steps[0] = 0; if (qb > 0) steps[1] = (unsigned char)qb; if (qb > 1) steps[2] = (unsigned char)(qb - 1); }
            if ((rest >> lane) & 1ull) steps[nF + __popcll(rest & lowmask(lane))] = (unsigned char)lane;
        }
        if (lane >= nsel && lane < NTs) steps[lane] = (unsigned char)0x7f;
        if (lane < NTw) steps[64 + lane] = (unsigned char)(lane < nwin ? (0x80 | (j0w + lane)) : 0x7f);
        const bf16_t* ksb = proj + (size_t)b * SEQ * PP + C_KS + hk * 64;
        char* shm = (char*)lds;
        f32x16 ob[2]; float lt;
        run_branch<8, true, true>(shm, qr, ksb, steps, NTs, qb, ob, lt, wid, lane);
        {
            int t2 = threadIdx.x; asm volatile("" : "+v"(t2));
            const int lane2 = t2 & 63, r2 = lane2 & 31, h2 = lane2 >> 5, wid2 = __builtin_amdgcn_readfirstlane(t2 >> 6), g2 = wid2 >> 1, tq2 = (wid2 & 1) * 32 + r2;
            LAS float* wsf2 = (LAS float*)(lds + WSF) + wid2 * 32; LAS float* osl2 = (LAS float*)(lds + IMP + wid2 * (32 * IMPW * 4)) + lane2;
            const float g1 = sigmoidf_(bf2f(proj[((size_t)b * SEQ + (size_t)qb * 64 + tq2) * PP + C_GBR + 1 * 16 + hk * 4 + g2]));
            if (h2 == 0) wsf2[r2] = g1 * __builtin_amdgcn_rcpf(fmaxf(lt, 1e-30f));
#pragma unroll
            for (int i = 0; i < 16; ++i) { const float sc = wsf2[crow(i, h2)]; osl2[(i * 2) * 64] += ob[0][i] * sc; osl2[(i * 2 + 1) * 64] += ob[1][i] * sc; }
        }
        {
            int t3 = threadIdx.x; asm volatile("" : "+v"(t3));
            run_branch<8, false, false>(shm, qr, ksb, steps + 64, NTw, qb, ob, lt, __builtin_amdgcn_readfirstlane(t3 >> 6), t3 & 63);
        }
        st.o0 = ob[0]; st.o1 = ob[1]; st.l = lt;
    }
    {
        int t2 = threadIdx.x; asm volatile("" : "+v"(t2));
        const int lane2 = t2 & 63, r2 = lane2 & 31, h2 = lane2 >> 5, wid2 = __builtin_amdgcn_readfirstlane(t2 >> 6), g2 = wid2 >> 1, tq2 = (wid2 & 1) * 32 + r2;
        LAS float* wsf2 = (LAS float*)(lds + WSF) + wid2 * 32; LAS float* osl2 = (LAS float*)(lds + IMP + wid2 * (32 * IMPW * 4)) + lane2;
        const float g3 = sigmoidf_(bf2f(proj[((size_t)b * SEQ + (size_t)qb * 64 + tq2) * PP + C_GBR + 2 * 16 + hk * 4 + g2]));
        if (h2 == 0) wsf2[r2] = g3 * __builtin_amdgcn_rcpf(fmaxf(st.l, 1e-30f));
        bf16_t* ob2 = proj + ((size_t)b * SEQ + (size_t)qb * 64 + (wid2 & 1) * 32) * PP + C_Q + (hk * 4 + g2) * 64;
        if (!skipw)
#pragma unroll
        for (int i = 0; i < 16; ++i) { const int q = crow(i, h2); const float sc = wsf2[q];
            const float f0 = osl2[(i * 2) * 64] + st.o0[i] * sc, f1 = osl2[(i * 2 + 1) * 64] + st.o1[i] * sc;
            ob2[(size_t)q * PP + r2] = (bf16_t)(pk2(f0, 0.f) & 0xffffu); ob2[(size_t)q * PP + 32 + r2] = (bf16_t)(pk2(f1, 0.f) & 0xffffu); }
    }
#undef LDK
#undef LDV
#undef STK
#undef STV
#undef KBUF
#undef VBUF
#undef ACCUM_OUT
}
}

__device__ __forceinline__ float wave_sum(float v) {
#pragma unroll
    for (int o = 1; o < 64; o <<= 1) v += __shfl_xor(v, o);
    return v;
}
__device__ __forceinline__ void transpose_item(const float* W, int K, int N, bf16_t* WT, int ldt, int k0, int n0, int drow0, const float* kscale, float cscale, LAS float* scr, int lane) {
    const int nq = (lane & 7) * 4, kr = lane >> 3;
    f32x4 v[8];
#pragma unroll
    for (int i = 0; i < 8; ++i) { const int kk = i * 8 + kr; const int n = n0 + nq;
        v[i] = (n < N) ? *(const f32x4*)(W + (size_t)(k0 + kk) * N + n) : (f32x4){0.f, 0.f, 0.f, 0.f}; }
#pragma unroll
    for (int i = 0; i < 8; ++i) { const int kk = i * 8 + kr; const float sc = (kscale ? kscale[k0 + kk] : 1.0f) * cscale;
        scr[(nq + 0) * 66 + kk] = v[i][0] * sc; scr[(nq + 1) * 66 + kk] = v[i][1] * sc; scr[(nq + 2) * 66 + kk] = v[i][2] * sc; scr[(nq + 3) * 66 + kk] = v[i][3] * sc; }
    asm volatile("s_waitcnt lgkmcnt(0)" ::: "memory");
    const int c = lane & 7;
    typedef float f32x2v __attribute__((ext_vector_type(2)));
#pragma unroll
    for (int j = 0; j < 4; ++j) { const int n = (lane >> 3) + 8 * j; const LAS f32x2v* s = (const LAS f32x2v*)(scr + n * 66 + 8 * c);
        const f32x2v a0 = s[0], a1 = s[1], a2 = s[2], a3 = s[3];
        u32x4 o; o.x = pk2(a0[0], a0[1]); o.y = pk2(a1[0], a1[1]); o.z = pk2(a2[0], a2[1]); o.w = pk2(a3[0], a3[1]);
        *(u32x4*)(WT + (size_t)(drow0 + n) * ldt + k0 + 8 * c) = o; }
    asm volatile("s_waitcnt lgkmcnt(0)" ::: "memory");
}

#define XB_TMO      128
#define XB_XCNT(j)  (256  + 64 * (j))
#define XB_XSUB(j)  (1280 + 64 * (j))
#define XB_XGEN(j)  (2304 + 64 * (j))
#define XB_TOP      3328
#define XB_TOPGEN   3392
#define XCD_BAR_WORDS 3456
#define XB_SPIN_CAP (1u << 18)
__device__ __forceinline__ unsigned xb_ld(unsigned* p)              { return __hip_atomic_load(p, __ATOMIC_RELAXED, __HIP_MEMORY_SCOPE_AGENT); }
__device__ __forceinline__ unsigned xb_add(unsigned* p, unsigned v) { return __hip_atomic_fetch_add(p, v, __ATOMIC_RELAXED, __HIP_MEMORY_SCOPE_AGENT); }
__device__ __forceinline__ unsigned xb_xcc_id() { return (unsigned)__builtin_amdgcn_s_getreg((3 << 11) | 20) & 0xFu; }
#define XB_SPIN(cond, bar) do { unsigned _sp = 0; while (cond) { __builtin_amdgcn_s_sleep(1); \
    if ((++_sp & 255u) == 0u) { if (xb_ld(&(bar)[XB_TMO])) break; if (_sp > XB_SPIN_CAP) { atomicAdd(&(bar)[XB_TMO], 1u); break; } } } } while (0)
struct XcdBarrier { unsigned* bar; unsigned x; volatile LAS unsigned* st; };
__device__ __forceinline__ XcdBarrier xcd_barrier_post(unsigned* bar, volatile LAS unsigned* st) {
    XcdBarrier b; b.bar = bar; b.x = xb_xcc_id(); b.st = st;
    if (threadIdx.x == 0) (void)xb_add(&bar[XB_XCNT(b.x)], 1u);
    return b;
}
__device__ __forceinline__ void xcd_barrier_complete(unsigned* bar, unsigned x, unsigned& nloc, unsigned& nx) {
    const unsigned G = gridDim.x * gridDim.y * gridDim.z;
    unsigned sum, cnt, mine, sp = 0u;
    for (;;) {
        sum = 0u; cnt = 0u; mine = 0u;
#pragma unroll
        for (unsigned j = 0; j < 16; ++j) { const unsigned c = xb_ld(&bar[XB_XCNT(j)]); sum += c; cnt += (c > 0u) ? 1u : 0u; mine = (j == x) ? c : mine; }
        if (sum == G) break;
        __builtin_amdgcn_s_sleep(1);
        if ((++sp & 255u) == 0u) { if (xb_ld(&bar[XB_TMO])) break; if (sp > XB_SPIN_CAP) { atomicAdd(&bar[XB_TMO], 1u); break; } }
    }
    nloc = mine > 0u ? mine : 1u; nx = cnt > 0u ? cnt : 1u;
}
__device__ __forceinline__ void xcd_barrier(const XcdBarrier& b) {
    asm volatile("s_waitcnt vmcnt(0)" ::: "memory");
    __syncthreads();
    if (threadIdx.x == 0) {
        unsigned* bar = b.bar;
        __builtin_amdgcn_s_waitcnt(0);
        unsigned nloc = b.st[0], nx = b.st[1];
        if (nloc == 0u) { xcd_barrier_complete(bar, b.x, nloc, nx); b.st[0] = nloc; b.st[1] = nx; }
        const unsigned old = xb_add(&bar[XB_XSUB(b.x)], 1u);
        const unsigned gen = old / nloc;
        if (old + 1u == (gen + 1u) * nloc) {
            __builtin_amdgcn_fence(__ATOMIC_RELEASE, "agent");
            asm volatile("s_waitcnt vmcnt(0)" ::: "memory");
            const unsigned og = xb_add(&bar[XB_TOP], 1u);
            const unsigned tg = og / nx;
            if (og + 1u == (tg + 1u) * nx) xb_add(&bar[XB_TOPGEN], 1u);
            else XB_SPIN(xb_ld(&bar[XB_TOPGEN]) == tg, bar);
            __builtin_amdgcn_fence(__ATOMIC_ACQUIRE, "agent");
            xb_add(&bar[XB_XGEN(b.x)], 1u);
            asm volatile("s_waitcnt vmcnt(0)" ::: "memory");
        } else {
            XB_SPIN(xb_ld(&bar[XB_XGEN(b.x)]) == gen, bar);
            __builtin_amdgcn_fence(__ATOMIC_ACQUIRE, "agent");
            asm volatile("s_waitcnt vmcnt(0)" ::: "memory");
        }
    }
    __syncthreads();
}

struct Args {
    const float *x, *w_in, *conv_w, *w_conv_out, *pos_k, *w1_k, *w2_k, *pos_v, *w1_v, *w2_v, *w_attn_out, *w_o, *g_mix, *g_ffn, *w_gate, *w_up, *w_down, *g_final;
    float* out; unsigned char* ws; int probe; int pad;
};

__global__ void __launch_bounds__(512, 2) nsa_fwd(Args a) {
    extern __shared__ __attribute__((aligned(16))) unsigned char lds_raw[];
    LAS unsigned char* lds = (LAS unsigned char*)lds_raw;
    cg::grid_group grid = cg::this_grid();
    const int tid = threadIdx.x, lane = tid & 63, wave = __builtin_amdgcn_readfirstlane(tid >> 6);
    const int G = gridDim.x, bx = blockIdx.x;
    const int vcu = (G % 8 == 0) ? (bx % 8) * (G / 8) + bx / 8 : bx;
    unsigned char* ws = a.ws;
    volatile LAS unsigned* bst = (volatile LAS unsigned*)(lds + 143360);
    if (tid < 2) bst[tid] = 0u;
    __syncthreads();
    const XcdBarrier gbar = xcd_barrier_post((unsigned*)(ws + WS_BAR), bst);
#define SEAM() xcd_barrier(gbar)
    float* part1 = (float*)(ws + WS_PART1); float* part2 = (float*)(ws + WS_PART2); float* cbias = (float*)(ws + WS_BIAS);
    bf16_t* Win = (bf16_t*)(ws + WS_WIN); bf16_t* Wconv = (bf16_t*)(ws + WS_WCONV); bf16_t* Wattn = (bf16_t*)(ws + WS_WATTN); bf16_t* Wo = (bf16_t*)(ws + WS_WO);
    bf16_t* Wup = (bf16_t*)(ws + WS_WUP); bf16_t* Wdown = (bf16_t*)(ws + WS_WDOWN); bf16_t* W1 = (bf16_t*)(ws + WS_W1); bf16_t* W2 = (bf16_t*)(ws + WS_W2);
    bf16_t* hid = (bf16_t*)(ws + WS_HID); bf16_t* kcmp = (bf16_t*)(ws + WS_KCMP); bf16_t* proj = (bf16_t*)(ws + WS_PROJ);
    float* h1f = (float*)(ws + WS_H1F); bf16_t* h1b = (bf16_t*)(ws + WS_H1B); bf16_t* act = (bf16_t*)(ws + WS_ACT);
    bf16_t* nb = (bf16_t*)a.out; bf16_t* mix = (bf16_t*)a.out; bf16_t* bc = (bf16_t*)((unsigned char*)a.out + OUT_BC);

    {
        LAS float* scr = (LAS float*)(lds + wave * 16384);
        const int gw = vcu * 8 + wave, NGW = G * 8;
        constexpr int I_IN = 16 * 194, I_CONV = 8 * 32, I_ATT = 16 * 32, I_O = 16 * 32, I_G = 16 * 88, I_U = 16 * 88, I_D = 44 * 32, I_1 = 32 * 8, I_2 = 4 * 2;
        constexpr int NITEMS = I_IN + I_CONV + I_ATT + I_O + 2 * I_1 + 2 * I_2;
        for (int it = gw; it < NITEMS; it += NGW) {
            int q = it;
            if (q < I_IN) { const int kb = q / 194, nbk = q % 194, n0 = 32 * nbk; const float cs = (n0 >= C_Q && n0 < C_KC) ? QSCALE : 1.0f;
                transpose_item(a.w_in, 1024, INCOLS, Win, 1024, 64 * kb, n0, n0, a.g_mix, cs, scr, lane); continue; } q -= I_IN;
            if (q < I_CONV) { const int kb = q / 32, nbk = q % 32; transpose_item(a.w_conv_out, 512, 1024, Wconv, 512, 64 * kb, 32 * nbk, 32 * nbk, nullptr, 1.f, scr, lane); continue; } q -= I_CONV;
            if (q < I_ATT) { const int kb = q / 32, nbk = q % 32; transpose_item(a.w_attn_out, 1024, 1024, Wattn, 1024, 64 * kb, 32 * nbk, 32 * nbk, nullptr, 1.f, scr, lane); continue; } q -= I_ATT;
            if (q < I_O) { const int kb = q / 32, nbk = q % 32; transpose_item(a.w_o, 1024, 1024, Wo, 1024, 64 * kb, 32 * nbk, 32 * nbk, nullptr, 1.f, scr, lane); continue; } q -= I_O;
            if (q < I_1) { const int kb = q / 8, nbk = q % 8; transpose_item(a.w1_k, 2048, 256, W1, 2048, 64 * kb, 32 * nbk, 32 * nbk, nullptr, 1.f, scr, lane); continue; } q -= I_1;
            if (q < I_1) { const int kb = q / 8, nbk = q % 8; transpose_item(a.w1_v, 2048, 256, W1, 2048, 64 * kb, 32 * nbk, 256 + 32 * nbk, nullptr, 1.f, scr, lane); continue; } q -= I_1;
            if (q < I_2) { const int kb = q / 2, nbk = q % 2; transpose_item(a.w2_k, 256, 64, W2, 256, 64 * kb, 32 * nbk, 32 * nbk, nullptr, 1.f, scr, lane); continue; } q -= I_2;
            { const int kb = q / 2, nbk = q % 2; transpose_item(a.w2_v, 256, 64, W2, 256, 64 * kb, 32 * nbk, 256 + 32 * nbk, nullptr, 1.f, scr, lane); }
        }
        const int gt = vcu * 512 + tid, NGT = G * 512;
        for (int i = gt; i < 192 * 1024 / 8; i += NGT) *(u32x4*)(Win + (size_t)6208 * 1024 + (size_t)i * 8) = (u32x4){0u, 0u, 0u, 0u};
        for (int i = gt; i < 2 * 192 * 256 / 8; i += NGT) { const int half = i / (192 * 256 / 8), o = i % (192 * 256 / 8);
            *(u32x4*)(W2 + (size_t)(half * 256 + 64) * 256 + (size_t)o * 8) = (u32x4){0u, 0u, 0u, 0u}; }
        for (int m = gw; m < MTOK; m += NGW) {
            const f32x4* xr = (const f32x4*)(a.x + (size_t)m * DM) + lane; f32x4 v[4]; float s = 0.f;
#pragma unroll
            for (int j = 0; j < 4; ++j) { v[j] = xr[64 * j]; s += (v[j][0] * v[j][0] + v[j][1] * v[j][1]) + (v[j][2] * v[j][2] + v[j][3] * v[j][3]); }
            const float rstd = __builtin_amdgcn_rsqf(wave_sum(s) * (1.0f / DM) + EPS);
            u32x2* o8 = (u32x2*)(nb + (size_t)m * DM) + lane;
#pragma unroll
            for (int j = 0; j < 4; ++j) { u32x2 w; w.x = pk2(v[j][0] * rstd, v[j][1] * rstd); w.y = pk2(v[j][2] * rstd, v[j][3] * rstd); o8[64 * j] = w; }
        }
        if (bx < 2) {
            const float* pos = bx ? a.pos_v : a.pos_k; const float* w1 = bx ? a.w1_v : a.w1_k;
            const int j = tid & 255, part = tid >> 8; float s = 0.f;
            for (int k = part * 1024; k < part * 1024 + 1024; ++k) s += pos[k] * w1[(size_t)k * 256 + j];
            LAS float* red = (LAS float*)(lds + 8 * 16384);
            if (part == 1) red[j] = s;
            __syncthreads();
            if (part == 0) cbias[bx * 256 + j] = s + red[j];
        }
    }
    if (a.probe == 0x7fffffff) grid.sync();
    SEAM();
    {
        const int ncols1 = (G > 64) ? 6144 : PP;
        pg8::Gemm g{nb, Win, MTOK, ncols1, DM, DM, 128, 0}; pg8::StaticOrder S; S.init(MTOK, ncols1, G, bx);
        pg8::EpiProj E{proj, PP};
        pg8::gemm_phase(lds, g, S, E);
    }
    SEAM();
    {
        {
            pg8::Gemm g{proj + C_KC, W1, 4096, 512, 2048, 16 * PP, PP * 2, 1}; pg8::StaticOrder S; S.init(4096, 512, G, bx);
            pg8::EpiHid E{hid, cbias};
            pg8::gemm_phase(lds, g, S, E);
        }
        int wb = bx, wn = G; if (G > 64) { wb = bx - 32; wn = G - 32; }
        if (wb >= 0) {
            for (int it = wb * 512 + tid; it < MTOK * 64; it += wn * 512) {
                const int row = it >> 6, ch = (it & 63) * 8, t = row & (SEQ - 1);
                const bf16_t* pr = proj + (size_t)row * PP;
                float accv[8];
#pragma unroll
                for (int j = 0; j < 8; ++j) accv[j] = 0.f;
#pragma unroll
                for (int k = 0; k < 3; ++k) { const int dt = 2 - k;
                    if (t - dt >= 0) { const u32x4 cv = *(const u32x4*)(pr - (size_t)dt * PP + C_C + ch), hv = *(const u32x4*)(pr - (size_t)dt * PP + C_H + ch);
                        const f32x4 w0 = *(const f32x4*)(a.conv_w + k * 512 + ch), w1 = *(const f32x4*)(a.conv_w + k * 512 + ch + 4);
                        accv[0] += w0[0] * lo_bf(cv.x) * lo_bf(hv.x); accv[1] += w0[1] * hi_bf(cv.x) * hi_bf(hv.x); accv[2] += w0[2] * lo_bf(cv.y) * lo_bf(hv.y); accv[3] += w0[3] * hi_bf(cv.y) * hi_bf(hv.y);
                        accv[4] += w1[0] * lo_bf(cv.z) * lo_bf(hv.z); accv[5] += w1[1] * hi_bf(cv.z) * hi_bf(hv.z); accv[6] += w1[2] * lo_bf(cv.w) * lo_bf(hv.w); accv[7] += w1[3] * hi_bf(cv.w) * hi_bf(hv.w); } }
                const u32x4 bv = *(const u32x4*)(pr + C_B + ch);
                u32x4 o; o.x = pk2(accv[0] * lo_bf(bv.x), accv[1] * hi_bf(bv.x)); o.y = pk2(accv[2] * lo_bf(bv.y), accv[3] * hi_bf(bv.y));
                o.z = pk2(accv[4] * lo_bf(bv.z), accv[5] * hi_bf(bv.z)); o.w = pk2(accv[6] * lo_bf(bv.w), accv[7] * hi_bf(bv.w));
                *(u32x4*)(bc + (size_t)row * 512 + ch) = o;
            }
        }
        if (G > 64 && wb >= 0) {
            { pg8::Gemm g{nb, Win + (size_t)6144 * 1024, MTOK, 256, DM, DM, 128, 0}; pg8::StaticOrder S; S.init(MTOK, 256, wn, wb);
              pg8::EpiProj E{proj + 6144, PP}; pg8::gemm_phase(lds, g, S, E); }
            __syncthreads();
            LAS float* scr = (LAS float*)(lds + wave * 16384);
            constexpr int I_G = 16 * 88, I_U = 16 * 88, I_D = 44 * 32;
            for (int it = wb * 8 + wave; it < I_G + I_U + I_D; it += wn * 8) {
                int q = it;
                if (q < I_G) { const int kb = q / 88, nbk = q % 88, n0 = 32 * nbk; transpose_item(a.w_gate, 1024, DFF, Wup, 1024, 64 * kb, n0, (n0 / 128) * 256 + (n0 % 128), a.g_ffn, 1.f, scr, lane); continue; } q -= I_G;
                if (q < I_U) { const int kb = q / 88, nbk = q % 88, n0 = 32 * nbk; transpose_item(a.w_up, 1024, DFF, Wup, 1024, 64 * kb, n0, (n0 / 128) * 256 + 128 + (n0 % 128), a.g_ffn, 1.f, scr, lane); continue; } q -= I_U;
                { const int kb = q / 32, nbk = q % 32; transpose_item(a.w_down, DFF, 1024, Wdown, DFF, 64 * kb, 32 * nbk, 32 * nbk, nullptr, 1.f, scr, lane); }
            }
        }
    }
    {
        pg8::Gemm g{hid, W2, 4096, 512, 256, 256, 128, 2}; pg8::StaticOrder S; S.init(4096, 512, G, bx);
        pg8::EpiCmp E{kcmp};
        pg8::gemm_phase(lds, g, S, E);
    }
    SEAM();
    {
        for (int v = vcu; v < 256; v += G) {
            const int bh = v >> 4, s = v & 15;
#pragma unroll 1
            for (int i = 0; i < 4; ++i) { const int qb = (i == 0) ? 63 - s : (i == 1) ? 32 + s : (i == 2) ? 31 - s : s;
#if defined(PROBE_ATT2) || defined(PROBE_NOLD)
                att::attn_unit(lds, proj, kcmp, kcmp + 4096 * 64, bh, qb, a.probe);
#endif
                att::attn_unit(lds, proj, kcmp, kcmp + 4096 * 64, bh, qb, 0);
            }
        }
    }
    SEAM();
    {
        { pg8::Gemm g{bc, Wconv, MTOK, DM, 512, 512, 128, 0}; pg8::StaticOrder S; S.init(MTOK, DM, G, bx);
          pg8::EpiMix<0> E{mix, proj, C_GCONV}; pg8::gemm_phase(lds, g, S, E); }
        { pg8::Gemm g{proj + C_Q, Wattn, MTOK, DM, DM, PP, 128, 0}; pg8::StaticOrder S; S.init(MTOK, DM, G, bx);
          pg8::EpiMix<1> E{mix, proj, C_GATTN}; pg8::gemm_phase(lds, g, S, E); }
    }
    SEAM();
    {
        pg8::Gemm g{mix, Wo, MTOK, DM, DM, DM, 128, 0}; pg8::StaticOrder S; S.init(MTOK, DM, G, bx);
        pg8::EpiRes<1> E{a.x, h1f, h1b, part1}; pg8::gemm_phase(lds, g, S, E);
    }
    SEAM();
    {
        pg8::Gemm g{h1b, Wup, MTOK, 2 * DFF, DM, DM, 128, 0}; pg8::StaticOrder S; S.init(MTOK, 2 * DFF, G, bx);
        pg8::EpiUp E{act, part1}; pg8::gemm_phase(lds, g, S, E);
    }
    SEAM();
    if (G == 256) {
        pg8::Gemm g{act, Wdown, MTOK, DM, DFF, DFF, 128, 0}; pg8::StaticOrder S; S.init(MTOK, DM, G, bx);
        pg8::EpiFinal E{h1f, a.out, a.g_final, (unsigned*)part2, (unsigned*)(ws + WS_BAR) + 4096, (unsigned*)(ws + WS_BAR) + XB_TMO};
        pg8::gemm_phase(lds, g, S, E);
        return;
    }
    {
        pg8::Gemm g{act, Wdown, MTOK, DM, DFF, DFF, 128, 0}; pg8::StaticOrder S; S.init(MTOK, DM, G, bx);
        pg8::EpiRes<0> E{h1f, a.out, nullptr, part2}; pg8::gemm_phase(lds, g, S, E);
    }
    SEAM();
    {
        for (int it = bx * 512 + tid; it < MTOK * 256; it += G * 512) {
            const int row = it >> 8, c4 = (it & 255) * 4;
            const f32x4* pp = (const f32x4*)(part2 + (size_t)row * 16); float ss = 0.f;
#pragma unroll
            for (int j = 0; j < 4; ++j) { const f32x4 p = pp[j]; ss += (p[0] + p[1]) + (p[2] + p[3]); }
            const float r = __builtin_amdgcn_rsqf(ss * (1.0f / DM) + EPS);
            f32x4 v = *(f32x4*)(a.out + (size_t)row * DM + c4); const f32x4 gf = *(const f32x4*)(a.g_final + c4);
            v = v * r * gf; *(f32x4*)(a.out + (size_t)row * DM + c4) = v;
        }
    }
}

extern "C" void kernel_launch(void* const* d_in, const int* in_sizes, int n_in, void* d_out, int out_size, void* d_ws, size_t ws_size, hipStream_t stream) {
    static int grid = 0;
    if (grid == 0) {
        if (n_in != 18 || out_size != MTOK * DM || ws_size < WS_NEED) { fprintf(stderr, "kernel_launch: unexpected shapes (n_in %d out %d ws %zu)\n", n_in, out_size, ws_size); grid = -1; return; }
        int dev = 0, cus = 0, per_cu = 0;
        (void)hipGetDevice(&dev);
        (void)hipDeviceGetAttribute(&cus, hipDeviceAttributeMultiprocessorCount, dev);
        (void)hipFuncSetAttribute((const void*)nsa_fwd, hipFuncAttributeMaxDynamicSharedMemorySize, LDS_BYTES);
        (void)hipOccupancyMaxActiveBlocksPerMultiprocessor(&per_cu, (const void*)nsa_fwd, 512, LDS_BYTES);
        if (per_cu < 1) { fprintf(stderr, "kernel_launch: occupancy query says %d blocks/CU\n", per_cu); grid = -1; return; }
        grid = cus;
    }
    if (grid < 0) return;
    (void)hipMemsetAsync((unsigned char*)d_ws + WS_BAR, 0, 32768, stream);
    Args a{};
    a.x = (const float*)d_in[0]; a.w_in = (const float*)d_in[1]; a.conv_w = (const float*)d_in[2]; a.w_conv_out = (const float*)d_in[3];
    a.pos_k = (const float*)d_in[4]; a.w1_k = (const float*)d_in[5]; a.w2_k = (const float*)d_in[6];
    a.pos_v = (const float*)d_in[7]; a.w1_v = (const float*)d_in[8]; a.w2_v = (const float*)d_in[9];
    a.w_attn_out = (const float*)d_in[10]; a.w_o = (const float*)d_in[11]; a.g_mix = (const float*)d_in[12]; a.g_ffn = (const float*)d_in[13];
    a.w_gate = (const float*)d_in[14]; a.w_up = (const float*)d_in[15]; a.w_down = (const float*)d_in[16]; a.g_final = (const float*)d_in[17];
    a.out = (float*)d_out; a.ws = (unsigned char*)d_ws; a.probe = 1; a.pad = 0;
    void* args[] = {&a};
    hipError_t e = hipLaunchCooperativeKernel((void*)nsa_fwd, dim3(grid), dim3(512), args, LDS_BYTES, stream);
    if (e != hipSuccess) fprintf(stderr, "kernel_launch: cooperative launch failed: %s (grid %d)\n", hipGetErrorString(e), grid);
}
```

```cpp
#include <hip/hip_runtime.h>
#include <hip/hip_cooperative_groups.h>
#include <cstdio>
#include <cstdint>
namespace cg = cooperative_groups;

#define LAS __attribute__((address_space(3)))
typedef unsigned short bf16_t;
typedef short bf16x8 __attribute__((ext_vector_type(8)));
typedef short s16x4 __attribute__((ext_vector_type(4)));
typedef float f32x4 __attribute__((ext_vector_type(4)));
typedef float f32x16 __attribute__((ext_vector_type(16)));
typedef unsigned u32x4 __attribute__((ext_vector_type(4)));
typedef unsigned u32x2 __attribute__((ext_vector_type(2)));
typedef float f32x2_t __attribute__((ext_vector_type(2)));
typedef __bf16 bf16x2_t __attribute__((ext_vector_type(2)));

constexpr int MTOK = 16384, DM = 1024, SEQ = 4096, NB = 4;
constexpr int PP = 6400;
constexpr int INCOLS = 6192;
constexpr int C_B = 0, C_C = 512, C_H = 1024, C_Q = 1536, C_KC = 2560, C_VC = 2816, C_KS = 3072, C_VS = 3328, C_KW = 3584, C_VW = 3840,
              C_GBR = 4096, C_GCONV = 4144, C_GATTN = 5168;
constexpr int DFF = 2816;
constexpr float EPS = 1e-6f;
constexpr float LOG2E = 1.4426950408889634f;
constexpr float QSCALE = 0.125f * LOG2E;

constexpr size_t MiB = 1u << 20;
constexpr size_t WS_PART1 = 0;
constexpr size_t WS_PART2 = 1 * MiB;
constexpr size_t WS_BIAS = 2 * MiB;
constexpr size_t WS_BAR = 2 * MiB + 65536;
constexpr size_t WS_WIN = 3 * MiB;
constexpr size_t WS_WCONV = 16 * MiB;
constexpr size_t WS_WATTN = 17 * MiB;
constexpr size_t WS_WO = 19 * MiB;
constexpr size_t WS_WUP = 21 * MiB;
constexpr size_t WS_WDOWN = 32 * MiB;
constexpr size_t WS_W1 = 38 * MiB;
constexpr size_t WS_W2 = 40 * MiB;
constexpr size_t WS_HID = 41 * MiB;
constexpr size_t WS_KCMP = 45 * MiB;
constexpr size_t WS_PROJ = 46 * MiB;
constexpr size_t WS_H1F = 46 * MiB;
constexpr size_t WS_H1B = 110 * MiB;
constexpr size_t WS_ACT = 142 * MiB;
constexpr size_t WS_NEED = 246 * MiB;
constexpr size_t OUT_BC = 32 * MiB;

constexpr int LDS_BYTES = 147456;

__device__ __forceinline__ float bf2f(unsigned short v) { return __uint_as_float(((unsigned)v) << 16); }
__device__ __forceinline__ unsigned pk2(float lo, float hi) { f32x2_t v = {lo, hi}; bf16x2_t b = __builtin_convertvector(v, bf16x2_t); return __builtin_bit_cast(unsigned, b); }
__device__ __forceinline__ float ex2(float x) { return __builtin_amdgcn_exp2f(x); }
__device__ __forceinline__ float sigmoidf_(float x) { return __builtin_amdgcn_rcpf(1.0f + ex2(-x * LOG2E)); }
__device__ __forceinline__ float lo_bf(unsigned w) { return __uint_as_float(w << 16); }
__device__ __forceinline__ float hi_bf(unsigned w) { return __uint_as_float(w & 0xffff0000u); }

namespace pg8 {
constexpr int BM = 256, BK = 64, HALF = 128, HTB = HALF * BK * 2, STAGE_BYTES = 8 * HTB, NXCD = 8, WGM = 8;
__host__ __device__ __forceinline__ int lds_byte(int r, int c) { const int st = (r >> 4) * 2 + (c >> 5), rr = r & 15, cc = c & 31, ob = rr * 64 + cc * 2; return st * 1024 + (ob ^ (((ob >> 9) & 1) << 5)); }
__host__ __device__ __forceinline__ void stage_rc(int b, int& R, int& C) { const int st = b / 1024, sb = b % 1024, swz = sb ^ (((sb >> 9) & 1) << 5); R = (st >> 1) * 16 + swz / 64; C = (st & 1) * 32 + (swz % 64) / 2; }
__host__ __device__ __forceinline__ int perm32(int rho) { const int n = rho >> 4, i = rho & 15; return 8 * (i >> 2) + 4 * n + (i & 3); }

struct Unit { int pm, pn; };
struct Gemm { const bf16_t* A; const bf16_t* Bt; int M, N, K; int lda; int a_kstep; int amode; };

struct StaticOrder {
    int nM, nN, nwg, G, c;
    __host__ __device__ void init(int M, int N, int G_, int c_) { nM = M / BM; nN = N / BM; nwg = nM * nN; G = G_; c = c_; }
    __host__ __device__ bool next(int i, Unit& u) const {
        const long L = (long)i * G + c; if (L >= nwg) return false;
        int wgid = (int)L; { const int q = nwg / NXCD, r = nwg % NXCD, xcd = wgid % NXCD, off = wgid / NXCD; wgid = (xcd < r ? xcd * (q + 1) : r * (q + 1) + (xcd - r) * q) + off; }
        const int nig = WGM * nN, gid = wgid / nig, fm = gid * WGM, gsz = (nM - fm) < WGM ? (nM - fm) : WGM;
        u.pm = fm + ((wgid % nig) % gsz); u.pn = (wgid % nig) / gsz; return true;
    }
};

__device__ __forceinline__ const char* a_tile(const Gemm& g, const Unit& u) {
    if (g.amode == 1) return (const char*)g.A + ((size_t)(u.pm >> 2) * SEQ * PP + (size_t)u.pn * 256 + (size_t)(u.pm & 3) * 64) * 2;
    if (g.amode == 2) return (const char*)g.A + ((size_t)u.pn * 4096 * 256 + (size_t)u.pm * 256 * 256) * 2;
    return (const char*)g.A + (size_t)u.pm * 256 * (size_t)g.lda * 2;
}

template <class T, class = void> struct is_fused { static constexpr bool value = false; };
template <class T> struct is_fused<T, decltype((void)T::FUSED)> { static constexpr bool value = true; };
template <class Epi>
__device__ __forceinline__ void gemm_phase(LAS unsigned char* lds, const Gemm g, const StaticOrder& S, const Epi& E) {
#ifdef NO_GEMM
    return;
#endif
    int tid_ = threadIdx.x; asm volatile("" : "+v"(tid_));
    const int tid = tid_, wid = __builtin_amdgcn_readfirstlane(tid >> 6), lane = tid & 63, wr = wid >> 2, wc = wid & 3, fr = lane & 15, fq = lane >> 4;
    const int K = g.K, nt = K / BK;
    unsigned voffA[2], voffB[2];
#pragma unroll
    for (int i = 0; i < 2; ++i) { int R, C; stage_rc(tid * 16 + i * 8192, R, C); const int Rb = (R & ~31) + perm32(R & 31);
        voffA[i] = (unsigned)(R * g.lda + C) * 2u; voffB[i] = (unsigned)(Rb * K + C) * 2u; }
    const size_t kstepA = (size_t)g.a_kstep, kstepB = (size_t)(BK * 2);
    const size_t hstepA = (size_t)HALF * g.lda * 2, hstepB = (size_t)HALF * K * 2;
    const size_t tstepB = 2 * hstepB;
    const unsigned ldsw = (unsigned)wid * 1024u;
    const int aoff = lds_byte(wr * 64 + fr, fq * 8), boff = lds_byte(wc * 32 + fr, fq * 8);
#define PG8_SA(b, h) (((b) * 2 + (h)) * HTB)
#define PG8_SB(b, h) ((4 + (b) * 2 + (h)) * HTB)
#define PG8_STAGE(bufoff, gbase, voff) do { _Pragma("unroll") for (int _i = 0; _i < 2; ++_i) \
        __builtin_amdgcn_global_load_lds((const unsigned*)((const char*)(gbase) + (voff)[_i]), (LAS unsigned*)(lds + (bufoff) + ldsw + _i * 8192), 16, 0, 0); } while (0)
#define PG8_LDA(dst, b, h) do { _Pragma("unroll") for (int m = 0; m < 4; ++m) _Pragma("unroll") for (int k = 0; k < 2; ++k) dst[m][k] = *(const LAS bf16x8*)(lds + PG8_SA(b, h) + aoff + m * 2048 + k * 1024); } while (0)
#define PG8_LDB(dst, b, h) do { _Pragma("unroll") for (int n = 0; n < 2; ++n) _Pragma("unroll") for (int k = 0; k < 2; ++k) dst[n][k] = *(const LAS bf16x8*)(lds + PG8_SB(b, h) + boff + n * 2048 + k * 1024); } while (0)
#define PG8_MMA(ai, bj, At, Bt) do { __builtin_amdgcn_s_setprio(1); _Pragma("unroll") for (int m = 0; m < 4; ++m) _Pragma("unroll") for (int n = 0; n < 2; ++n) _Pragma("unroll") for (int k = 0; k < 2; ++k) \
        acc[ai][bj][m][n] = __builtin_amdgcn_mfma_f32_16x16x32_bf16(Bt[n][k], At[m][k], acc[ai][bj][m][n], 0, 0, 0); __builtin_amdgcn_s_setprio(0); } while (0)
#define PG8_WAIT_V(n) asm volatile("s_waitcnt vmcnt(" #n ")" ::: "memory")
#define PG8_WAIT_L(n) asm volatile("s_waitcnt lgkmcnt(" #n ")" ::: "memory")
#define PG8_BAR __builtin_amdgcn_s_barrier()
#define PG8_SCHED __builtin_amdgcn_sched_barrier(0)
    Unit cur, nxt; int ui = 0;
    if (!S.next(0, cur)) return;
    f32x4 acc[2][2][4][2];
#pragma unroll
    for (int a = 0; a < 2; ++a)
#pragma unroll
        for (int b = 0; b < 2; ++b)
#pragma unroll
            for (int m = 0; m < 4; ++m)
#pragma unroll
                for (int n = 0; n < 2; ++n) acc[a][b][m][n] = (f32x4){0.f, 0.f, 0.f, 0.f};
    bf16x8 At[4][2], B0[2][2], B1[2][2];
    const char* cA = a_tile(g, cur); const char* cB = (const char*)g.Bt + (size_t)cur.pn * tstepB;
    PG8_STAGE(PG8_SB(0, 0), cB, voffB); PG8_STAGE(PG8_SB(0, 1), cB + hstepB, voffB); PG8_STAGE(PG8_SA(0, 0), cA, voffA); PG8_STAGE(PG8_SA(0, 1), cA + hstepA, voffA);
    if (wr == 1) PG8_BAR;
    PG8_WAIT_V(2); PG8_BAR;
    PG8_STAGE(PG8_SB(1, 0), cB + kstepB, voffB); PG8_STAGE(PG8_SA(1, 0), cA + kstepA, voffA); PG8_STAGE(PG8_SB(1, 1), cB + hstepB + kstepB, voffB);
    PG8_WAIT_V(6); PG8_BAR;
    for (;;) {
        const bool has_next = S.next(ui + 1, nxt);
        const char* nA = has_next ? a_tile(g, nxt) : cA; const char* nB = has_next ? (const char*)g.Bt + (size_t)nxt.pn * tstepB : cB;
        for (int t = 0; t < nt; t += 2) {
            const bool last = (t == nt - 2);
            const char* a1 = cA + (size_t)(t + 1) * kstepA;
            const char* a2 = last ? nA : cA + (size_t)(t + 2) * kstepA; const char* b2 = last ? nB : cB + (size_t)(t + 2) * kstepB;
            const char* a3 = a2 + kstepA; const char* b3 = b2 + kstepB;
            PG8_LDB(B0, 0, 0); PG8_LDB(B1, 0, 1); PG8_SCHED; PG8_LDA(At, 0, 0); PG8_STAGE(PG8_SA(1, 1), a1 + hstepA, voffA);
            PG8_WAIT_V(8); PG8_WAIT_L(0); PG8_BAR; PG8_MMA(0, 0, At, B0); PG8_MMA(0, 1, At, B1); PG8_BAR; PG8_SCHED;
            PG8_LDA(At, 0, 1); PG8_STAGE(PG8_SB(0, 0), b2, voffB); PG8_STAGE(PG8_SB(0, 1), b2 + hstepB, voffB); PG8_STAGE(PG8_SA(0, 0), a2, voffA);
            PG8_WAIT_V(8); PG8_WAIT_L(0); PG8_BAR; PG8_MMA(1, 0, At, B0); PG8_MMA(1, 1, At, B1); PG8_BAR; PG8_SCHED;
            PG8_LDB(B0, 1, 0); PG8_LDB(B1, 1, 1); PG8_SCHED; PG8_LDA(At, 1, 0); PG8_STAGE(PG8_SA(0, 1), a2 + hstepA, voffA);
            PG8_WAIT_V(8); PG8_WAIT_L(0); PG8_BAR; PG8_MMA(0, 0, At, B0); PG8_MMA(0, 1, At, B1); PG8_BAR; PG8_SCHED;
            PG8_LDA(At, 1, 1); PG8_STAGE(PG8_SB(1, 0), b3, voffB); PG8_STAGE(PG8_SB(1, 1), b3 + hstepB, voffB); PG8_STAGE(PG8_SA(1, 0), a3, voffA);
            PG8_WAIT_V(8); PG8_WAIT_L(0); PG8_BAR; PG8_MMA(1, 0, At, B0); PG8_MMA(1, 1, At, B1); PG8_BAR; PG8_SCHED;
        }
        if (wr == 0) PG8_BAR;
        if constexpr (!is_fused<Epi>::value) E(acc, cur, wr, wc, fr, fq);
        if (!has_next) break;
#pragma unroll
        for (int a = 0; a < 2; ++a)
#pragma unroll
            for (int b = 0; b < 2; ++b)
#pragma unroll
                for (int m = 0; m < 4; ++m)
#pragma unroll
                    for (int n = 0; n < 2; ++n) acc[a][b][m][n] = (f32x4){0.f, 0.f, 0.f, 0.f};
        cur = nxt; cA = nA; cB = nB; ++ui;
        if (wr == 1) PG8_BAR;
    }
    PG8_WAIT_V(0);
    PG8_BAR;
    if constexpr (is_fused<Epi>::value) E.fused(acc, cur, wr, wc, fr, fq, lds, wid, lane);
#undef PG8_SA
#undef PG8_SB
#undef PG8_STAGE
#undef PG8_LDA
#undef PG8_LDB
#undef PG8_MMA
#undef PG8_WAIT_V
#undef PG8_WAIT_L
#undef PG8_BAR
#undef PG8_SCHED
}

typedef f32x4 Acc[2][2][4][2];
#define EPI_LOOP_BEGIN \
    _Pragma("unroll") for (int ai = 0; ai < 2; ++ai) _Pragma("unroll") for (int m = 0; m < 4; ++m) { const int row = u.pm * BM + wr * 64 + fr + ai * HALF + m * 16; \
    _Pragma("unroll") for (int bj = 0; bj < 2; ++bj) { const f32x4 v0 = acc[ai][bj][m][0], v1 = acc[ai][bj][m][1]; const int col = u.pn * BM + bj * HALF + wc * 32 + 8 * fq;
#define EPI_LOOP_END } }
__device__ __forceinline__ u32x4 pack8(const f32x4 a, const f32x4 b) { u32x4 w; w.x = pk2(a[0], a[1]); w.y = pk2(a[2], a[3]); w.z = pk2(b[0], b[1]); w.w = pk2(b[2], b[3]); return w; }

struct EpiProj { bf16_t* O; int ldc;
    __device__ __forceinline__ void operator()(const Acc& acc, const Unit& u, int wr, int wc, int fr, int fq) const {
        EPI_LOOP_BEGIN
            *(u32x4*)(O + (size_t)row * ldc + col) = pack8(v0, v1);
        EPI_LOOP_END
    } };
__device__ __forceinline__ float gelu_tanh(float x) {
    const float z = x * (1.0f + 0.044715f * x * x) * (2.0f * 0.7978845608028654f * LOG2E);
    return x * __builtin_amdgcn_rcpf(1.0f + ex2(-z));
}
struct EpiHid { bf16_t* O; const float* bias;
    __device__ __forceinline__ void operator()(const Acc& acc, const Unit& u, int wr, int wc, int fr, int fq) const {
        EPI_LOOP_BEGIN
            const int c = col - u.pn * BM; const float* bp = bias + u.pn * 256 + c;
            const f32x4 b0 = *(const f32x4*)bp, b1 = *(const f32x4*)(bp + 4);
            f32x4 a = v0 + b0, b = v1 + b1;
#pragma unroll
            for (int j = 0; j < 4; ++j) { a[j] = gelu_tanh(a[j]); b[j] = gelu_tanh(b[j]); }
            *(u32x4*)(O + (size_t)u.pn * 4096 * 256 + (size_t)row * 256 + c) = pack8(a, b);
        EPI_LOOP_END
    } };
struct EpiCmp { bf16_t* O;
    __device__ __forceinline__ void operator()(const Acc& acc, const Unit& u, int wr, int wc, int fr, int fq) const {
        EPI_LOOP_BEGIN
            const int c = col - u.pn * BM;
            if (c < 64) { u32x4 w = pack8(v0, v1); if ((row & 255) == 255) w = (u32x4){0u, 0u, 0u, 0u};
                *(u32x4*)(O + (size_t)u.pn * 4096 * 64 + (size_t)row * 64 + c) = w; }
        EPI_LOOP_END
    } };
template <int ADD> struct EpiMix { bf16_t* mix; const bf16_t* proj; int gcol;
    __device__ __forceinline__ void operator()(const Acc& acc, const Unit& u, int wr, int wc, int fr, int fq) const {
        EPI_LOOP_BEGIN
            const u32x4 gv = *(const u32x4*)(proj + (size_t)row * PP + gcol + col);
            f32x4 a, b;
            a[0] = sigmoidf_(lo_bf(gv.x)) * v0[0]; a[1] = sigmoidf_(hi_bf(gv.x)) * v0[1]; a[2] = sigmoidf_(lo_bf(gv.y)) * v0[2]; a[3] = sigmoidf_(hi_bf(gv.y)) * v0[3];
            b[0] = sigmoidf_(lo_bf(gv.z)) * v1[0]; b[1] = sigmoidf_(hi_bf(gv.z)) * v1[1]; b[2] = sigmoidf_(lo_bf(gv.w)) * v1[2]; b[3] = sigmoidf_(hi_bf(gv.w)) * v1[3];
            bf16_t* mp = mix + (size_t)row * DM + col;
            if (ADD) { const u32x4 pv = *(const u32x4*)mp;
                a[0] += lo_bf(pv.x); a[1] += hi_bf(pv.x); a[2] += lo_bf(pv.y); a[3] += hi_bf(pv.y); b[0] += lo_bf(pv.z); b[1] += hi_bf(pv.z); b[2] += lo_bf(pv.w); b[3] += hi_bf(pv.w); }
            *(u32x4*)mp = pack8(a, b);
        EPI_LOOP_END
    } };
template <int WB> struct EpiRes { const float* base; float* hf; bf16_t* hb; float* part;
    __device__ __forceinline__ void operator()(const Acc& acc, const Unit& u, int wr, int wc, int fr, int fq) const {
#pragma unroll
        for (int ai = 0; ai < 2; ++ai)
#pragma unroll
            for (int m = 0; m < 4; ++m) { const int row = u.pm * BM + wr * 64 + fr + ai * HALF + m * 16; float ss = 0.f;
#pragma unroll
                for (int bj = 0; bj < 2; ++bj) { const int col = u.pn * BM + bj * HALF + wc * 32 + 8 * fq; const size_t off = (size_t)row * DM + col;
                    const f32x4 x0 = *(const f32x4*)(base + off), x1 = *(const f32x4*)(base + off + 4);
                    const f32x4 a = x0 + acc[ai][bj][m][0], b = x1 + acc[ai][bj][m][1];
                    *(f32x4*)(hf + off) = a; *(f32x4*)(hf + off + 4) = b;
                    if (WB) *(u32x4*)(hb + off) = pack8(a, b);
                    ss += (a[0] * a[0] + a[1] * a[1]) + (a[2] * a[2] + a[3] * a[3]) + (b[0] * b[0] + b[1] * b[1]) + (b[2] * b[2] + b[3] * b[3]); }
                ss += __shfl_xor(ss, 16); ss += __shfl_xor(ss, 32);
                if (fq == 0) part[(size_t)row * 16 + u.pn * 4 + wc] = ss; }
    } };
struct EpiUp { bf16_t* act; const float* part;
    __device__ __forceinline__ void operator()(const Acc& acc, const Unit& u, int wr, int wc, int fr, int fq) const {
#pragma unroll
        for (int ai = 0; ai < 2; ++ai)
#pragma unroll
            for (int m = 0; m < 4; ++m) { const int row = u.pm * BM + wr * 64 + fr + ai * HALF + m * 16;
                const f32x4 pp = *(const f32x4*)(part + (size_t)row * 16 + 4 * fq); float ss = (pp[0] + pp[1]) + (pp[2] + pp[3]);
                ss += __shfl_xor(ss, 16); ss += __shfl_xor(ss, 32);
                const float r = __builtin_amdgcn_rsqf(ss * (1.0f / DM) + EPS);
                f32x4 a, b;
#pragma unroll
                for (int j = 0; j < 4; ++j) { const float g0 = acc[ai][0][m][0][j] * r, u0 = acc[ai][1][m][0][j] * r, g1 = acc[ai][0][m][1][j] * r, u1 = acc[ai][1][m][1][j] * r;
                    a[j] = g0 * sigmoidf_(g0) * u0; b[j] = g1 * sigmoidf_(g1) * u1; }
                *(u32x4*)(act + (size_t)row * DFF + u.pn * 128 + wc * 32 + 8 * fq) = pack8(a, b); }
    } };
struct EpiFinal { static constexpr bool FUSED = true;
    const float* base; float* out; const float* gfin; unsigned* xbuf; unsigned* cnt; unsigned* tmo;
    __device__ __forceinline__ void operator()(const Acc&, const Unit&, int, int, int, int) const {}
    __device__ __forceinline__ void fused(f32x4 (&acc)[2][2][4][2], const Unit& u, int wr, int wc, int fr, int fq, LAS unsigned char* lds, int wid, int lane) const {
        LAS float* P = (LAS float*)lds;
        LAS float* S = (LAS float*)(lds + 8192);
        LAS unsigned* flag = (LAS unsigned*)(lds + 8192 + 2048);
#pragma unroll
        for (int ai = 0; ai < 2; ++ai)
#pragma unroll
            for (int m = 0; m < 4; ++m) { const int rl = ai * HALF + wr * 64 + m * 16 + fr; const int row = u.pm * BM + rl; float ss = 0.f;
#pragma unroll
                for (int bj = 0; bj < 2; ++bj) { const int col = u.pn * BM + bj * HALF + wc * 32 + 8 * fq; const size_t off = (size_t)row * DM + col;
                    const f32x4 x0 = *(const f32x4*)(base + off), x1 = *(const f32x4*)(base + off + 4);
                    const f32x4 a = x0 + acc[ai][bj][m][0], b = x1 + acc[ai][bj][m][1]; acc[ai][bj][m][0] = a; acc[ai][bj][m][1] = b;
                    ss += (a[0] * a[0] + a[1] * a[1]) + (a[2] * a[2] + a[3] * a[3]) + (b[0] * b[0] + b[1] * b[1]) + (b[2] * b[2] + b[3] * b[3]); }
                ss += __shfl_xor(ss, 16); ss += __shfl_xor(ss, 32);
                if (fq == 0) P[rl * 4 + wc] = ss; }
        asm volatile("s_waitcnt lgkmcnt(0)" ::: "memory"); __builtin_amdgcn_s_barrier(); asm volatile("" ::: "memory");
        const int rl = wid * 32 + (lane & 31);
        if (lane < 32) { const float tot = (P[rl * 4 + 0] + P[rl * 4 + 1]) + (P[rl * 4 + 2] + P[rl * 4 + 3]);
            __hip_atomic_store(xbuf + ((size_t)(u.pm * BM + rl) * 4 + u.pn), __float_as_uint(tot), __ATOMIC_RELAXED, __HIP_MEMORY_SCOPE_AGENT); }
        asm volatile("s_waitcnt vmcnt(0)" ::: "memory");
        if (lane == 0) __hip_atomic_fetch_add(cnt + 64 * u.pm, 1u, __ATOMIC_RELAXED, __HIP_MEMORY_SCOPE_AGENT);
        if (wid == 0) {
            unsigned sp = 0u;
            for (;;) {
                if ((unsigned)__builtin_amdgcn_readfirstlane(__hip_atomic_load(cnt + 64 * u.pm, __ATOMIC_RELAXED, __HIP_MEMORY_SCOPE_AGENT)) >= 32u) break;
                __builtin_amdgcn_s_sleep(2);
                if (++sp > (1u << 20)) { if (lane == 0) __hip_atomic_store(tmo, 1u, __ATOMIC_RELAXED, __HIP_MEMORY_SCOPE_AGENT); break; }
            }
            __builtin_amdgcn_fence(__ATOMIC_ACQUIRE, "agent");
            if (lane == 0) flag[0] = 1u;
        }
        asm volatile("s_waitcnt vmcnt(0) lgkmcnt(0)" ::: "memory"); __builtin_amdgcn_s_barrier(); asm volatile("" ::: "memory");
        if (lane < 32) { const unsigned* sl = xbuf + (size_t)(u.pm * BM + rl) * 4; float tot = 0.f;
#pragma unroll
            for (int t = 0; t < 4; ++t) tot += __uint_as_float(__hip_atomic_load(sl + t, __ATOMIC_RELAXED, __HIP_MEMORY_SCOPE_AGENT));
            S[rl] = __builtin_amdgcn_rsqf(tot * (1.0f / DM) + EPS); }
        asm volatile("s_waitcnt lgkmcnt(0)" ::: "memory"); __builtin_amdgcn_s_barrier(); asm volatile("" ::: "memory");
#pragma unroll
        for (int bj = 0; bj < 2; ++bj) { const int col = u.pn * BM + bj * HALF + wc * 32 + 8 * fq;
            const f32x4 g0 = *(const f32x4*)(gfin + col), g1 = *(const f32x4*)(gfin + col + 4);
#pragma unroll
            for (int ai = 0; ai < 2; ++ai)
#pragma unroll
                for (int m = 0; m < 4; ++m) { const int rl2 = ai * HALF + wr * 64 + m * 16 + fr; const float rs = S[rl2]; const size_t off = (size_t)(u.pm * BM + rl2) * DM + col;
                    *(f32x4*)(out + off) = acc[ai][bj][m][0] * rs * g0; *(f32x4*)(out + off + 4) = acc[ai][bj][m][1] * rs * g1; } }
    } };
}

namespace att {
constexpr int KB0 = 0, VB0 = 24576, IMP = 49152, IMPW = 65, SELM = IMP + 4 * 64 * IMPW * 4, WMASK = SELM + 512, WSF = WMASK + 64, STEPS = WSF + 8 * 32 * 4, CMPX = STEPS + 8 * 128, ATT_LDS = CMPX + 16384;
static_assert(ATT_LDS <= 143360, "attention LDS");
#define MFMA32(a, b, c) __builtin_amdgcn_mfma_f32_32x32x16_bf16((a), (b), (c), 0, 0, 0)
__device__ __forceinline__ int crow(int r, int hi) { return (r & 3) + 8 * (r >> 2) + 4 * hi; }
typedef short v4i16_t __attribute__((ext_vector_type(4)));
__device__ __forceinline__ s16x4 vtr(LAS const unsigned char* p) { return __builtin_bit_cast(s16x4, __builtin_amdgcn_ds_read_tr16_b64_v4i16((LAS v4i16_t*)p)); }

struct St { float m, l; f32x16 o0, o1; };

__device__ __forceinline__ void qk_tile(f32x16& p0, f32x16& p1, LAS const unsigned char* kb, const bf16x8* qf, int r, int h) {
    bf16x8 k0[4], k1[4], qv[4];
#pragma unroll
    for (int d0 = 0; d0 < 4; ++d0) { k0[d0] = *(const LAS bf16x8*)(kb + (2 * d0 + h) * 1024 + r * 16); k1[d0] = *(const LAS bf16x8*)(kb + (2 * d0 + h) * 1024 + 512 + r * 16);
        qv[d0] = qf[d0]; }
#pragma unroll
    for (int i = 0; i < 16; ++i) { p0[i] = 0.f; p1[i] = 0.f; }
    __builtin_amdgcn_sched_barrier(0);
#pragma unroll
    for (int d0 = 0; d0 < 4; ++d0) { p0 = MFMA32(k0[d0], qv[d0], p0); p1 = MFMA32(k1[d0], qv[d0], p1); }
}
__device__ __forceinline__ void apply_mask(f32x16& p0, f32x16& p1, unsigned long long allow, int h) {
    if (__all(allow == ~0ull)) return;
    const unsigned long long a = allow >> (4 * h); const unsigned lo = (unsigned)a, hi = (unsigned)(a >> 32);
#pragma unroll
    for (int i = 0; i < 16; ++i) { const int cb = (i & 3) + 8 * (i >> 2);
        p0[i] = ((lo >> cb) & 1u) ? p0[i] : -INFINITY; p1[i] = ((hi >> cb) & 1u) ? p1[i] : -INFINITY; }
}
__device__ __forceinline__ float rowmax32(const f32x16& p0, const f32x16& p1) {
    float a = fmaxf(p0[0], p1[0]);
#pragma unroll
    for (int i = 1; i < 16; ++i) a = fmaxf(a, fmaxf(p0[i], p1[i]));
    return fmaxf(a, __shfl_xor(a, 32));
}
__device__ __forceinline__ void pv_tile(f32x16& o0, f32x16& o1, LAS const unsigned char* vb, const f32x16& p0, const f32x16& p1, int lane, int h) {
    bf16x8 pa[4];
#pragma unroll
    for (int s = 0; s < 4; ++s) { u32x4 w;
#pragma unroll
        for (int j = 0; j < 4; ++j) { const int i0 = 8 * (s & 1) + 2 * j; w[j] = (s < 2) ? pk2(p0[i0], p0[i0 + 1]) : pk2(p1[i0], p1[i0 + 1]); }
        pa[s] = __builtin_bit_cast(bf16x8, w); }
    LAS const unsigned char* vp = vb + ((lane >> 4) & 1) * 32 + (lane & 3) * 8 + (4 * h + ((lane & 15) >> 2)) * 64;
    s16x4 l0[4], h0[4], l1[4], h1[4];
#pragma unroll
    for (int s = 0; s < 4; ++s) { l0[s] = vtr(vp + s * 1024); h0[s] = vtr(vp + s * 1024 + 512); l1[s] = vtr(vp + 4096 + s * 1024); h1[s] = vtr(vp + 4096 + s * 1024 + 512); }
    __builtin_amdgcn_sched_barrier(0);
#pragma unroll
    for (int s = 0; s < 4; ++s) {
        const bf16x8 v0 = (bf16x8){l0[s][0], l0[s][1], l0[s][2], l0[s][3], h0[s][0], h0[s][1], h0[s][2], h0[s][3]};
        const bf16x8 v1 = (bf16x8){l1[s][0], l1[s][1], l1[s][2], l1[s][3], h1[s][0], h1[s][1], h1[s][2], h1[s][3]};
        o0 = MFMA32(pa[s], v0, o0); o1 = MFMA32(pa[s], v1, o1);
    }
}
__device__ __forceinline__ void tile_online(St& st, LAS const unsigned char* kb, LAS const unsigned char* vb, const bf16x8* qr, unsigned long long allow,
                                            LAS float* wsf, int lane, int r, int h) {
    f32x16 p0, p1; qk_tile(p0, p1, kb, qr, r, h); __builtin_amdgcn_sched_barrier(0); apply_mask(p0, p1, allow, h);
    const float rm = rowmax32(p0, p1), mnew = fmaxf(st.m, rm), f = ex2(st.m - mnew); st.m = mnew;
    float ls = 0.f;
#pragma unroll
    for (int i = 0; i < 16; ++i) { p0[i] = ex2(p0[i] - mnew); p1[i] = ex2(p1[i] - mnew); ls += p0[i] + p1[i]; }
    st.l = st.l * f + ls;
    if (__any(f != 1.0f)) {
        if (h == 0) wsf[r] = f;
#pragma unroll
        for (int i = 0; i < 16; ++i) { const float fi = wsf[crow(i, h)]; st.o0[i] *= fi; st.o1[i] *= fi; }
    }
    pv_tile(st.o0, st.o1, vb, p0, p1, lane, h);
}
__device__ __forceinline__ void tile_stats(float& m, float& l, LAS const unsigned char* kb, const bf16x8* qr, unsigned long long allow, int r, int h) {
    f32x16 p0, p1; qk_tile(p0, p1, kb, qr, r, h); __builtin_amdgcn_sched_barrier(0); apply_mask(p0, p1, allow, h);
    const float rm = rowmax32(p0, p1), mnew = fmaxf(m, rm), f = ex2(m - mnew); m = mnew;
    float ls = 0.f;
#pragma unroll
    for (int i = 0; i < 16; ++i) ls += ex2(p0[i] - mnew) + ex2(p1[i] - mnew);
    l = l * f + ls;
}
__device__ __forceinline__ void tile_exact(f32x16& o0, f32x16& o1, float m, float invl, LAS const unsigned char* kb, LAS const unsigned char* vb, const bf16x8* qr,
                                           unsigned long long allow, LAS float* impw  , float& carry, int j, int lane, int r, int h) {
    f32x16 p0, p1; qk_tile(p0, p1, kb, qr, r, h); __builtin_amdgcn_sched_barrier(0); apply_mask(p0, p1, allow, h);
#pragma unroll
    for (int i = 0; i < 16; ++i) { p0[i] = ex2(p0[i] - m) * invl; p1[i] = ex2(p1[i] - m) * invl; }
#pragma unroll
    for (int pos = 0; pos < 8; ++pos) {
        const int half = pos >> 2, r4 = pos & 3;
        const float P0 = half ? p1[4 * r4] : p0[4 * r4], P1 = half ? p1[4 * r4 + 1] : p0[4 * r4 + 1], P2 = half ? p1[4 * r4 + 2] : p0[4 * r4 + 2], P3 = half ? p1[4 * r4 + 3] : p0[4 * r4 + 3];
        const float a = (P0 + P1) + (P2 + 0.5f * P3), b = 0.5f * P3;
        const float bx = __shfl_xor(b, 32);
        const float add = h ? bx : carry;
        impw[16 * j + 2 * pos + h] = a + add;
        carry = bx;
    }
    pv_tile(o0, o1, vb, p0, p1, lane, h);
}

__device__ __forceinline__ void qk_tile_c(f32x16& p0, f32x16& p1, LAS const unsigned char* kb, const bf16x8* qf, const f32x16& c, int r, int h) {
    bf16x8 k0[4], k1[4], qv[4];
#pragma unroll
    for (int d0 = 0; d0 < 4; ++d0) { k0[d0] = *(const LAS bf16x8*)(kb + (2 * d0 + h) * 1024 + r * 16); k1[d0] = *(const LAS bf16x8*)(kb + (2 * d0 + h) * 1024 + 512 + r * 16);
        qv[d0] = qf[d0]; }
    __builtin_amdgcn_sched_barrier(0);
    p0 = MFMA32(k0[0], qv[0], c); p1 = MFMA32(k1[0], qv[0], c);
#pragma unroll
    for (int d0 = 1; d0 < 4; ++d0) { p0 = MFMA32(k0[d0], qv[d0], p0); p1 = MFMA32(k1[d0], qv[d0], p1); }
}
__device__ __forceinline__ unsigned long long lowmask(int n);
__device__ __forceinline__ void soft_pv(St& st, f32x16& x0, f32x16& x1, float cx, LAS const unsigned char* vb, bool first, int kind, int tq,
                                        LAS float* wsf, int lane, int r, int h) {
    if (first) st.m = cx;
    else { const float d = st.m - cx;
        if (__any(d != 0.f)) {
#pragma unroll
            for (int i = 0; i < 16; ++i) { x0[i] -= d; x1[i] -= d; } } }
    if (kind) apply_mask(x0, x1, kind == 1 ? lowmask(tq + 1) : ~lowmask(tq + 1), h);
    const float rm = rowmax32(x0, x1);
    if (first) {
        const float dl = (rm > -INFINITY) ? rm : 0.f; st.m += dl;
#pragma unroll
        for (int i = 0; i < 16; ++i) { x0[i] -= dl; x1[i] -= dl; }
    } else if (__any(rm > 8.0f)) {
        const float dl = fmaxf(rm, 0.f), f = ex2(-dl); st.m += dl; st.l *= f;
        if (h == 0) wsf[r] = f;
#pragma unroll
        for (int i = 0; i < 16; ++i) { x0[i] -= dl; x1[i] -= dl; }
#pragma unroll
        for (int i = 0; i < 16; ++i) { const float fi = wsf[crow(i, h)]; st.o0[i] *= fi; st.o1[i] *= fi; }
    }
    float ls = 0.f;
#pragma unroll
    for (int i = 0; i < 16; ++i) { x0[i] = ex2(x0[i]); x1[i] = ex2(x1[i]); ls += x0[i] + x1[i]; }
    st.l += ls;
    pv_tile(st.o0, st.o1, vb, x0, x1, lane, h);
}
__device__ __forceinline__ unsigned long long lowmask(int n) { return n >= 64 ? ~0ull : ((1ull << n) - 1ull); }

typedef LAS const char* lds_cptr;
__device__ __forceinline__ void hs_glds16(const void* gsrc, unsigned lds_dst) { unsigned keep;
    asm volatile("s_mov_b32 %0, m0\n\ts_mov_b32 m0, %2\n\ts_nop 0\n\tglobal_load_lds_dwordx4 %1, off\n\ts_mov_b32 m0, %0" : "=&s"(keep) : "v"(gsrc), "s"(lds_dst) : "memory"); }
__device__ __forceinline__ float hs_max3f(float a, float b, float c) { float r; asm("v_max3_f32 %0, %1, %2, %3" : "=v"(r) : "v"(a), "v"(b), "v"(c)); return r; }
__device__ __forceinline__ float hs_max2f(float a, float b) { float r; asm("v_max_f32_e32 %0, %1, %2" : "=v"(r) : "v"(a), "v"(b)); return r; }
__device__ __forceinline__ float hs_fadd(float a, float b) { float r; asm("v_add_f32_e32 %0, %1, %2" : "=v"(r) : "v"(a), "v"(b)); return r; }
__device__ __forceinline__ float hs_fsub(float a, float b) { float r; asm("v_sub_f32_e32 %0, %1, %2" : "=v"(r) : "v"(a), "v"(b)); return r; }
#define HS_SBAR() __builtin_amdgcn_sched_barrier(0)
#define HS_WAIT_BAR(N) asm volatile("s_waitcnt vmcnt(" #N ") lgkmcnt(0)\n\ts_barrier" ::: "memory")
__device__ __forceinline__ void hs_qkt(f32x16& p0, f32x16& p1, const char* Kslot, const bf16x8* qr, const f32x16& negm, int r32, int hi) {
    const char* kb = Kslot + hi * 1024 + r32 * 16;
#pragma unroll
    for (int d0 = 0; d0 < 4; ++d0) {
        const bf16x8 b0 = *reinterpret_cast<const bf16x8*>(kb + d0 * 2048);
        const bf16x8 b1 = *reinterpret_cast<const bf16x8*>(kb + d0 * 2048 + 512);
        if (d0 == 0) { p0 = MFMA32(b0, qr[0], negm); p1 = MFMA32(b1, qr[0], negm); }
        else { p0 = MFMA32(b0, qr[d0], p0); p1 = MFMA32(b1, qr[d0], p1); } }
}
__device__ __forceinline__ void hs_kload8(bf16x8* kf, lds_cptr kp) {
    kf[0] = *(const LAS bf16x8*)(kp);        kf[1] = *(const LAS bf16x8*)(kp + 512);
    kf[2] = *(const LAS bf16x8*)(kp + 2048); kf[3] = *(const LAS bf16x8*)(kp + 2560);
    kf[4] = *(const LAS bf16x8*)(kp + 4096); kf[5] = *(const LAS bf16x8*)(kp + 4608);
    kf[6] = *(const LAS bf16x8*)(kp + 6144); kf[7] = *(const LAS bf16x8*)(kp + 6656);
}
__device__ __forceinline__ void hs_kload2(bf16x8* kf, lds_cptr kp, int j) { kf[2 * j] = *(const LAS bf16x8*)(kp + j * 2048); kf[2 * j + 1] = *(const LAS bf16x8*)(kp + j * 2048 + 512); }
__device__ __forceinline__ s16x4 hs_vtr(lds_cptr p) { return __builtin_bit_cast(s16x4, __builtin_amdgcn_ds_read_tr16_b64_v4i16((LAS v4i16_t*)p)); }
__device__ __forceinline__ float hs_rowmax(const f32x16& p0, const f32x16& p1) {
    float a = hs_max3f(p0[0], p0[1], p1[0]), b = hs_max3f(p0[2], p0[3], p1[1]); a = hs_max3f(a, p1[2], p1[3]);
#pragma unroll
    for (int r = 4; r < 16; r += 4) { a = hs_max3f(a, p0[r], p0[r + 1]); b = hs_max3f(b, p0[r + 2], p0[r + 3]); a = hs_max3f(a, p1[r], p1[r + 1]); b = hs_max3f(b, p1[r + 2], p1[r + 3]); }
    const float m = hs_max2f(a, b);
    auto rr = __builtin_amdgcn_permlane32_swap(__float_as_uint(m), __float_as_uint(m), false, false);
    return hs_max2f(__uint_as_float(rr[0]), __uint_as_float(rr[1]));
}
__device__ __forceinline__ void hs_pv(f32x16* o, int vb, bf16x8 pa0, bf16x8 pa1, bf16x8 pa2, bf16x8 pa3) {
#pragma unroll
    for (int d0 = 0; d0 < 2; ++d0) { s16x4 lo[4], hi[4];
#pragma unroll
        for (int ks = 0; ks < 4; ++ks) {
            asm volatile("ds_read_b64_tr_b16 %0,%1 offset:%c2" : "=&v"(lo[ks]) : "v"(vb), "i"(d0 * 4096 + ks * 1024) : "memory");
            asm volatile("ds_read_b64_tr_b16 %0,%1 offset:%c2" : "=&v"(hi[ks]) : "v"(vb), "i"(d0 * 4096 + ks * 1024 + 512) : "memory"); }
        asm volatile("s_waitcnt lgkmcnt(0)" ::: "memory"); HS_SBAR();
#define HS_PK(k) (bf16x8){lo[k][0], lo[k][1], lo[k][2], lo[k][3], hi[k][0], hi[k][1], hi[k][2], hi[k][3]}
        o[d0] = MFMA32(pa0, HS_PK(0), o[d0]); o[d0] = MFMA32(pa1, HS_PK(1), o[d0]); o[d0] = MFMA32(pa2, HS_PK(2), o[d0]); o[d0] = MFMA32(pa3, HS_PK(3), o[d0]);
#undef HS_PK
    }
}
__device__ __forceinline__ void hs_pre_dma(char* shm, const bf16_t* ksb, int c0, int c1, int c2, int wid, int lane) {
    const unsigned lds0 = (unsigned)(uintptr_t)shm;
    const size_t koff = (size_t)lane * PP + wid * 8, voff = (size_t)(16 * (wid & 3) + (lane >> 2)) * PP + (wid >> 2) * 32 + (lane & 3) * 8 + (C_VS - C_KS);
    const unsigned kdst = lds0 + KB0 + wid * 1024, vdst = lds0 + VB0 + wid * 1024;
#define HS_SRC0(c) (ksb + (size_t)(((c) & 0x80) ? (C_KW - C_KS) : 0) + (size_t)(((c) == 0x7f) ? 0 : ((c) & 0x7f)) * 64 * PP)
    hs_glds16(HS_SRC0(c0) + koff, (unsigned)__builtin_amdgcn_readfirstlane(kdst));
    hs_glds16(HS_SRC0(c0) + voff, (unsigned)__builtin_amdgcn_readfirstlane(vdst));
    hs_glds16(HS_SRC0(c1) + koff, (unsigned)__builtin_amdgcn_readfirstlane(kdst + 8192));
    hs_glds16(HS_SRC0(c2) + koff, (unsigned)__builtin_amdgcn_readfirstlane(kdst + 16384));
#undef HS_SRC0
}
template <int THRL, bool DIS, bool PRE> __device__ __forceinline__ void run_branch(char* shm, const bf16x8* qr, const bf16_t* ksb, LAS const unsigned char* steps, const int NT,
                                                               const int qb, f32x16* o, float& l_out, const int wid, const int lane) {
    constexpr int SLOTB = 8192, NSLOT = 3;
    { unsigned long long p_ = (unsigned long long)ksb; asm volatile("" : "+s"(p_)); ksb = (const bf16_t*)p_; }
    const int r32 = lane & 31, hi = lane >> 5, tq = (wid & 1) * 32 + r32;
    const unsigned lds0 = (unsigned)(uintptr_t)shm;
    const unsigned long long mysel = *((LAS const unsigned long long*)((lds_cptr)shm + SELM) + tq);
    const int vcodes = (int)steps[lane];
    float* wsf = (float*)(shm + WSF) + wid * 32;
    const size_t koff = (size_t)lane * PP + wid * 8, voff = (size_t)(16 * (wid & 3) + (lane >> 2)) * PP + (wid >> 2) * 32 + (lane & 3) * 8 + (C_VS - C_KS);
    const unsigned kdst = lds0 + KB0 + wid * 1024, vdst = lds0 + VB0 + wid * 1024;
#define HS_CODE(t) ((int)__builtin_amdgcn_readlane(vcodes, (t)))
#define HS_SRC(c) (ksb + (size_t)(((c) & 0x80) ? (C_KW - C_KS) : 0) + (size_t)(((c) == 0x7f) ? 0 : ((c) & 0x7f)) * 64 * PP)
#define DMA_K(t, slot) do { const int c_ = HS_CODE(t); hs_glds16(HS_SRC(c_) + koff, (unsigned)__builtin_amdgcn_readfirstlane(kdst + (slot))); } while (0)
#define DMA_V(t, slot) do { const int c_ = HS_CODE(t); hs_glds16(HS_SRC(c_) + voff, (unsigned)__builtin_amdgcn_readfirstlane(vdst + (slot))); } while (0)
    const int vb0 = (int)(lds0 + VB0) + ((lane >> 4) & 1) * 32 + (lane & 3) * 8 + (4 * hi + ((lane & 15) >> 2)) * 64;
    const char* Kbase = shm + KB0; bf16x8 kf[8];
    const lds_cptr shm3 = (lds_cptr)shm; const lds_cptr kp0 = shm3 + KB0 + hi * 1024 + r32 * 16; const lds_cptr vp0 = shm3 + VB0 + ((lane >> 4) & 1) * 32 + (lane & 3) * 8 + (4 * hi + ((lane & 15) >> 2)) * 64;
    if (!PRE) { DMA_K(0, 0); DMA_V(0, 0); DMA_K(1, SLOTB); }
    float mhat = 0.f, l_reg = 0.f; f32x16 negm;
    { float z = 0.f; asm volatile("" : "+v"(z));
#pragma unroll
      for (int i = 0; i < 16; ++i) { o[0][i] = z; o[1][i] = z; negm[i] = z; } }
    asm volatile("" : "+v"(negm));
#define CMASK(P0, P1, t) do { const int c_ = HS_CODE(t); const bool isw_ = (c_ & 0x80) != 0; const int jj_ = c_ & 0x7f; \
        if (!DIS && c_ == 0x7f) { _Pragma("unroll") for (int r = 0; r < 16; ++r) { P0[r] = -INFINITY; P1[r] = -INFINITY; } } \
        int kind_ = 0; if (c_ != 0x7f) { if (jj_ == qb) kind_ = 1; else if (isw_ && jj_ == qb - 8) kind_ = 2; } \
        if (kind_) apply_mask(P0, P1, kind_ == 1 ? lowmask(tq + 1) : ~lowmask(tq + 1), hi); } while (0)
    bool resc = false;
#define START(P0, P1) do { const float rm = hs_rowmax(P0, P1); resc = false; \
        { const float dl = (rm > -INFINITY) ? rm : 0.f; mhat = hs_fadd(mhat, dl); \
          _Pragma("unroll") for (int r = 0; r < 16; ++r) { P0[r] = hs_fsub(P0[r], dl); P1[r] = hs_fsub(P1[r], dl); } \
          _Pragma("unroll") for (int r = 0; r < 16; ++r) negm[r] = -mhat; asm volatile("" : "+v"(negm)); } \
        _Pragma("unroll") for (int r = 0; r < 16; ++r) P0[r] = __builtin_amdgcn_exp2f(P0[r]); } while (0)
#define RESC() do { if (resc) { asm volatile("s_waitcnt lgkmcnt(0)" ::: "memory"); \
        _Pragma("unroll") for (int d_ = 0; d_ < 2; ++d_) _Pragma("unroll") for (int r = 0; r < 16; ++r) o[d_][r] *= wsf[crow(r, hi)]; } } while (0)
    f32x16 pA0, pA1, pB0, pB1;
    int sl_prev = 0, sl_cur = 0, sl_next = SLOTB;
#define ROT() do { sl_prev = sl_cur; sl_cur = sl_next; sl_next = (sl_next == (NSLOT - 1) * SLOTB) ? 0 : sl_next + SLOTB; } while (0)
    if (!PRE) DMA_K(2, 2 * SLOTB);
    HS_WAIT_BAR(3);
    hs_qkt(pA0, pA1, Kbase, qr, negm, r32, hi); asm volatile("s_nop 15\n\ts_nop 7" : "+v"(pA0), "+v"(pA1)); CMASK(pA0, pA1, 0);
    START(pA0, pA1);
    _Pragma("unroll") for (int r = 0; r < 16; ++r) pA1[r] = __builtin_amdgcn_exp2f(pA1[r]);
    HS_WAIT_BAR(0);
    DMA_K(3, 0); DMA_V(1, SLOTB);
    ROT();
    hs_kload8(kf, kp0 + sl_cur);
    HS_WAIT_BAR(2);
    s16x4 vlo[8], vhi[8]; u32x4 pw0, pw1, pw2, pw3;
#define PKW(P, B) pk2(P[B], P[B + 1])
#define PAF(k) __builtin_bit_cast(bf16x8, pw##k)
#define VFR(i) (bf16x8){vlo[i][0], vlo[i][1], vlo[i][2], vlo[i][3], vhi[i][0], vhi[i][1], vhi[i][2], vhi[i][3]}
#define PIN(x) asm volatile("" : "+v"(x))
#define MX3(a, b, c) __builtin_fmaxf(__builtin_fmaxf((a), (b)), (c))
#define GAPA(MF, A0, A1, A2, A3, W0, W1, PW) do { MF; sacc += A0; sacc += A1; sacc += A2; sacc += A3; PIN(sacc); W0; W1; PIN(PW); HS_SBAR(); } while (0)
#define EX(v) __builtin_amdgcn_exp2f(v)
#define GAPB(MF, X, B) do { MF; X[B] = EX(X[B]); X[B + 1] = EX(X[B + 1]); X[B + 2] = EX(X[B + 2]); X[B + 3] = EX(X[B + 3]); PIN(X); HS_SBAR(); } while (0)
#define VRD(i) do { vlo[i] = hs_vtr(vp_ + (((i) >> 2) * 4096 + ((i) & 3) * 1024)); vhi[i] = hs_vtr(vp_ + (((i) >> 2) * 4096 + ((i) & 3) * 1024 + 512)); } while (0)
#define KRD(G, j) do { if (G) { hs_kload2(kf, kp0 + sl_next, j); HS_SBAR(); } } while (0)
#define STEP(C0, C1, P0, P1, t, GK, GV, GL) do { HS_SBAR(); \
        f32x16 cct; \
        if (DIS) { const int c0_ = HS_CODE(t); const bool en0_ = (c0_ != 0x7f) && (((mysel >> (c0_ & 63)) & 1ull) != 0ull);     \
            _Pragma("unroll") for (int r = 0; r < 16; ++r) cct[r] = en0_ ? negm[r] : -INFINITY; PIN(cct); HS_SBAR(); } \
        const lds_cptr vp_ = vp0 + sl_prev; \
        VRD(0); HS_SBAR(); float sacc = (P0[0] + P0[1]); \
        GAPA(C0 = MFMA32(kf[0], qr[0], (DIS ? cct : negm)), P0[2], P0[3], P0[4], P0[5],     pw0[0] = PKW(P0, 0), pw0[1] = PKW(P0, 2), pw0); \
        VRD(4); HS_SBAR(); GAPA(C1 = MFMA32(kf[1], qr[0], (DIS ? cct : negm)), P0[6], P0[7], P0[8], P0[9],     pw0[2] = PKW(P0, 4), pw0[3] = PKW(P0, 6), pw0); \
        VRD(1); HS_SBAR(); GAPA(C0 = MFMA32(kf[2], qr[1], C0),   P0[10], P0[11], P0[12], P0[13], pw1[0] = PKW(P0, 8), pw1[1] = PKW(P0, 10), pw1); \
        VRD(5); HS_SBAR(); GAPA(C1 = MFMA32(kf[3], qr[1], C1),   P0[14], P0[15], P1[0], P1[1],   pw1[2] = PKW(P0, 12), pw1[3] = PKW(P0, 14), pw1); \
        VRD(2); HS_SBAR(); GAPA(C0 = MFMA32(kf[4], qr[2], C0),   P1[2], P1[3], P1[4], P1[5],     pw2[0] = PKW(P1, 0), pw2[1] = PKW(P1, 2), pw2); \
        VRD(6); HS_SBAR(); GAPA(C1 = MFMA32(kf[5], qr[2], C1),   P1[6], P1[7], P1[8], P1[9],     pw2[2] = PKW(P1, 4), pw2[3] = PKW(P1, 6), pw2); \
        VRD(3); HS_SBAR(); GAPA(C0 = MFMA32(kf[6], qr[3], C0),   P1[10], P1[11], P1[12], P1[13], pw3[0] = PKW(P1, 8), pw3[1] = PKW(P1, 10), pw3); \
        VRD(7); HS_SBAR(); GAPA(C1 = MFMA32(kf[7], qr[3], C1),   P1[14], P1[15], 0.f, 0.f,       pw3[2] = PKW(P1, 12), pw3[3] = PKW(P1, 14), pw3); \
        l_reg += sacc; \
        if (GK) { DMA_K((t) + 3, sl_cur); } if (GV) { DMA_V((t) + 1, sl_next); } \
        CMASK(C0, C1, t); \
        { float a = MX3(C0[0], C0[1], C1[0]), b = MX3(C0[2], C0[3], C1[1]); a = MX3(a, C1[2], C1[3]); \
          _Pragma("unroll") for (int r = 4; r < 16; r += 4) { a = MX3(a, C0[r], C0[r + 1]); b = MX3(b, C0[r + 2], C0[r + 3]); a = MX3(a, C1[r], C1[r + 1]); b = MX3(b, C1[r + 2], C1[r + 3]); } \
          float rm = __builtin_fmaxf(a, b); { auto rr = __builtin_amdgcn_permlane32_swap(__float_as_uint(rm), __float_as_uint(rm), false, false); rm = __builtin_fmaxf(__uint_as_float(rr[0]), __uint_as_float(rr[1])); } \
          resc = false; \
          if (__builtin_expect(__any(rm > (float)THRL), 0)) { const float dl = __builtin_fmaxf(rm, 0.f); mhat += dl; \
            _Pragma("unroll") for (int r = 0; r < 16; ++r) { C0[r] -= dl; C1[r] -= dl; } \
            _Pragma("unroll") for (int r = 0; r < 16; ++r) negm[r] = -mhat; asm volatile("" : "+v"(negm)); \
            const float f = __builtin_amdgcn_exp2f(-dl); l_reg *= f; if (hi == 0) wsf[r32] = f; resc = true; } } \
        HS_SBAR(); \
        GAPB(o[0] = MFMA32(PAF(0), VFR(0), o[0]), C0, 0); \
        GAPB(o[1] = MFMA32(PAF(0), VFR(4), o[1]), C0, 4); \
        KRD(GL, 0); GAPB(o[0] = MFMA32(PAF(1), VFR(1), o[0]), C0, 8); \
        KRD(GL, 1); GAPB(o[1] = MFMA32(PAF(1), VFR(5), o[1]), C0, 12); \
        KRD(GL, 2); GAPB(o[0] = MFMA32(PAF(2), VFR(2), o[0]), C1, 0); \
        KRD(GL, 3); GAPB(o[1] = MFMA32(PAF(2), VFR(6), o[1]), C1, 4); \
        GAPB(o[0] = MFMA32(PAF(3), VFR(3), o[0]), C1, 8); \
        GAPB(o[1] = MFMA32(PAF(3), VFR(7), o[1]), C1, 12); \
    } while (0)
    int t = 1;
    for (; t + 5 < NT; t += 2) {
        STEP(pB0, pB1, pA0, pA1, t, true, true, true);     HS_WAIT_BAR(2); RESC(); ROT();
        STEP(pA0, pA1, pB0, pB1, t + 1, true, true, true); HS_WAIT_BAR(2); RESC(); ROT();
    }
#define ENDW(tt) do { if ((tt) + 3 < NT) { HS_WAIT_BAR(2); } else if ((tt) + 2 < NT) { HS_WAIT_BAR(1); } else { HS_WAIT_BAR(0); } } while (0)
    for (; t + 1 < NT; t += 2) {
        STEP(pB0, pB1, pA0, pA1, t, (t + 3 < NT), (t + 1 < NT), (t + 1 < NT));         ENDW(t);     RESC(); ROT();
        STEP(pA0, pA1, pB0, pB1, t + 1, (t + 4 < NT), (t + 2 < NT), (t + 2 < NT));     ENDW(t + 1); RESC(); ROT();
    }
#define DRAIN(PX0, PX1, SL) do { float sacc = PX0[0] + PX0[1]; _Pragma("unroll") for (int r = 2; r < 16; ++r) sacc += PX0[r]; _Pragma("unroll") for (int r = 0; r < 16; ++r) sacc += PX1[r]; l_reg += sacc; \
      pw0 = (u32x4){PKW(PX0, 0), PKW(PX0, 2), PKW(PX0, 4), PKW(PX0, 6)}; pw1 = (u32x4){PKW(PX0, 8), PKW(PX0, 10), PKW(PX0, 12), PKW(PX0, 14)}; \
      pw2 = (u32x4){PKW(PX1, 0), PKW(PX1, 2), PKW(PX1, 4), PKW(PX1, 6)}; pw3 = (u32x4){PKW(PX1, 8), PKW(PX1, 10), PKW(PX1, 12), PKW(PX1, 14)}; \
      HS_SBAR(); hs_pv(o, vb0 + (SL), PAF(0), PAF(1), PAF(2), PAF(3)); } while (0)
    if (NT & 1) {
        DRAIN(pA0, pA1, sl_prev);
    } else {
        STEP(pB0, pB1, pA0, pA1, NT - 1, false, false, false); RESC();
        DRAIN(pB0, pB1, sl_cur);
    }
#undef DRAIN
    { auto rr = __builtin_amdgcn_permlane32_swap(__float_as_uint(l_reg), __float_as_uint(l_reg), false, false); l_out = __uint_as_float(rr[0]) + __uint_as_float(rr[1]); }
    asm volatile("s_waitcnt lgkmcnt(0)\n\ts_barrier" ::: "memory");
#undef PKW
#undef PAF
#undef VFR
#undef PIN
#undef MX3
#undef GAPA
#undef GAPB
#undef EX
#undef VRD
#undef KRD
#undef STEP
#undef ENDW
#undef DMA_K
#undef DMA_V
#undef CMASK
#undef START
#undef RESC
#undef ROT
#undef HS_CODE
#undef HS_SRC
}
__device__ __forceinline__ void attn_unit(LAS unsigned char* lds, bf16_t* proj, const bf16_t* kcmp, const bf16_t* vcmp, int bh, int qb, int skipw) {
    int tid_ = threadIdx.x; asm volatile("" : "+v"(tid_));
    const int tid = tid_, lane = tid & 63, r = lane & 31, h = lane >> 5, wid = __builtin_amdgcn_readfirstlane(tid >> 6);
    const int b = bh >> 2, hk = bh & 3, g = wid >> 1, tq = (wid & 1) * 32 + r;
    const size_t row = (size_t)b * SEQ + (size_t)qb * 64 + tq;
    const int t = qb * 64 + tq;
    bf16_t* qp = proj + row * PP + C_Q + (hk * 4 + g) * 64;
    bf16x8 qreg[4];
#pragma unroll
    for (int d0 = 0; d0 < 4; ++d0) qreg[d0] = *(const bf16x8*)(qp + d0 * 16 + h * 8);
    const bf16x8* qr = qreg;
    float gate[3];
#pragma unroll
    for (int c = 0; c < 3; ++c) gate[c] = sigmoidf_(bf2f(proj[row * PP + C_GBR + c * 16 + hk * 4 + g]));
#ifdef GATE2X
    if (GATE2X & 1) gate[0] *= 2.f; if (GATE2X & 2) gate[1] *= 2.f; if (GATE2X & 4) gate[2] *= 2.f;
#endif
#ifdef GATEZ
    if (GATEZ & 1) gate[0] = 0.f; if (GATEZ & 2) gate[1] = 0.f; if (GATEZ & 4) gate[2] = 0.f;
#endif
    LAS float* wsf = (LAS float*)(lds + WSF) + wid * 32;
    LAS float* impw = (LAS float*)(lds + IMP) + (g * 64 + tq) * IMPW;
    const size_t krow = lane, kcol = wid * 8;
    const size_t vrow = 16 * (wid & 3) + (lane >> 2), vcol = 32 * (wid >> 2) + 8 * (lane & 3);
    LAS unsigned char* kst = lds + KB0 + wid * 1024 + lane * 16;
    LAS unsigned char* vst = lds + VB0 + wid * 1024 + lane * 16;
    u32x4 kreg, vreg;
    LAS float* osl = (LAS float*)(lds + IMP + wid * (32 * IMPW * 4)) + lane;
#define LDK(base, pitch) kreg = *(const u32x4*)((base) + krow * (size_t)(pitch) + kcol)
#define LDV(base, pitch) vreg = *(const u32x4*)((base) + vrow * (size_t)(pitch) + vcol)
#define STK(buf) *(LAS u32x4*)(kst + (buf) * 8192) = kreg
#define STV(buf) *(LAS u32x4*)(vst + (buf) * 8192) = vreg
#define KBUF(buf) (lds + KB0 + (buf) * 8192)
#define VBUF(buf) (lds + VB0 + (buf) * 8192)
#define ACCUM_OUT(scale_expr, FIRST) do { if (h == 0) wsf[r] = (scale_expr); \
        _Pragma("unroll") for (int i = 0; i < 16; ++i) { const float sc = wsf[crow(i, h)]; \
            if (FIRST) { osl[(i * 2) * 64] = st.o0[i] * sc; osl[(i * 2 + 1) * 64] = st.o1[i] * sc; } \
            else { osl[(i * 2) * 64] += st.o0[i] * sc; osl[(i * 2 + 1) * 64] += st.o1[i] * sc; } } } while (0)

    St st;
    const bf16_t* kc = kcmp + (size_t)bh * 256 * 64; const bf16_t* vc = vcmp + (size_t)bh * 256 * 64;
    const int nmax = (t >= 31) ? ((t - 31) >> 4) : -1;
#define CMP_KT(j) (lds + (j) * 8192)
#define CMP_VT(j) ((j) < 2 ? lds + 32768 + (j) * 8192 : lds + CMPX + ((j) - 2) * 8192)
    {
        u32x4 kr4[4], vr4[4];
#pragma unroll
        for (int j = 0; j < 4; ++j) { kr4[j] = *(const u32x4*)(kc + (size_t)j * 4096 + krow * 64 + kcol); vr4[j] = *(const u32x4*)(vc + (size_t)j * 4096 + vrow * 64 + vcol); }
#pragma unroll
        for (int j = 0; j < 4; ++j) { *(LAS u32x4*)(CMP_KT(j) + wid * 1024 + lane * 16) = kr4[j]; *(LAS u32x4*)(CMP_VT(j) + wid * 1024 + lane * 16) = vr4[j]; }
    }
    __syncthreads();
    float carry = 0.f;
    float m1 = -1e30f, l1 = 0.f;
#pragma unroll 1
    for (int j = 0; j < 4; ++j) {
        const int cnt = nmax - 64 * j + 1; const unsigned long long allow = cnt <= 0 ? 0ull : lowmask(cnt);
        if (__all(allow == 0ull)) continue;
        tile_stats(m1, l1, CMP_KT(j), qr, allow, r, h);
    }
    l1 += __shfl_xor(l1, 32);
    const float invl = __builtin_amdgcn_rcpf(fmaxf(l1, 1e-30f));
#pragma unroll
    for (int i = 0; i < 16; ++i) { st.o0[i] = 0.f; st.o1[i] = 0.f; }
#pragma unroll 1
    for (int j = 0; j < 4; ++j) {
        const int cnt = nmax - 64 * j + 1; const unsigned long long allow = cnt <= 0 ? 0ull : lowmask(cnt);
        if (__all(allow == 0ull)) {
#pragma unroll
            for (int pos = 0; pos < 8; ++pos) impw[16 * j + 2 * pos + h] = (pos == 0 && h == 0) ? carry : 0.f;
            carry = 0.f; continue; }
        tile_exact(st.o0, st.o1, m1, invl, CMP_KT(j), CMP_VT(j), qr, allow, impw, carry, j, lane, r, h);
    }
    __syncthreads();
    hs_pre_dma((char*)lds, proj + (size_t)b * SEQ * PP + C_KS + hk * 64, 0, qb > 0 ? qb : 0x7f, qb > 1 ? qb - 1 : 0x7f, wid, lane);
#undef CMP_KT
#undef CMP_VT
    {
        unsigned long long wor = 0ull;
        const unsigned long long valid = lowmask(qb + 1);
        LAS const float* ib = (LAS const float*)(lds + IMP);
        unsigned key[8], T[8];
#pragma unroll
        for (int i = 0; i < 8; ++i) { const int q = wid * 8 + i;
            float v = ((ib[(0 * 64 + q) * IMPW + lane] + ib[(1 * 64 + q) * IMPW + lane]) + ib[(2 * 64 + q) * IMPW + lane]) + ib[(3 * 64 + q) * IMPW + lane];
            if (lane == 0 || lane == qb || lane == qb - 1) v = INFINITY;
            key[i] = (lane <= qb) ? __float_as_uint(fmaxf(v, 0.f)) : 0u; T[i] = 0u; }
        if (qb >= 16)
#pragma unroll 1
        for (int bb = 30; bb >= 0; --bb) {
#pragma unroll
            for (int i = 0; i < 8; ++i) { const unsigned cand = T[i] | (1u << bb);
                const int c = __popcll(__ballot(key[i] >= cand) & valid); T[i] = (c >= 16) ? cand : T[i]; }
        }
#pragma unroll
        for (int i = 0; i < 8; ++i) { const int q = wid * 8 + i;
            const unsigned long long gt = __ballot(key[i] > T[i]) & valid, eq = __ballot(key[i] == T[i]) & valid;
            const int need = 16 - __popcll(gt);
            const bool pick = ((eq >> lane) & 1ull) && (__popcll(eq & lowmask(lane)) < need);
            const unsigned long long msk = gt | __ballot(pick);
            if (lane == 0) *(LAS unsigned long long*)(lds + SELM + q * 8) = msk;
            wor |= msk; }
        if (lane == 0) *(LAS unsigned long long*)(lds + WMASK + wid * 8) = wor;
    }
    __syncthreads();
    unsigned long long un = 0ull;
#pragma unroll
    for (int w = 0; w < 8; ++w) un |= *(LAS const unsigned long long*)(lds + WMASK + w * 8);
    { const unsigned ulo = __builtin_amdgcn_readfirstlane((unsigned)un), uhi = __builtin_amdgcn_readfirstlane((unsigned)(un >> 32)); un = ((unsigned long long)uhi << 32) | ulo; }
    ACCUM_OUT(gate[0], true);
    {
        LAS unsigned char* steps = lds + STEPS + wid * 128;
        const int nsel = __popcll(un), j0w = qb >= 8 ? qb - 8 : 0, nwin = qb - j0w + 1;
        const int NTs = nsel < 4 ? 4 : nsel, NTw = nwin < 4 ? 4 : nwin;
        {
            const unsigned long long F = 1ull | (1ull << qb) | (qb > 0 ? (1ull << (qb - 1)) : 0ull), rest = un & ~F; const int nF = __popcll(F);
            if (lane == 0) { steps[0] = 0; if (qb > 0) steps[1] = (unsigned char)qb; if (qb > 1) steps[2] = (unsigned char)(qb - 1); }
            if ((rest >> lane) & 1ull) steps[nF + __popcll(rest & lowmask(lane))] = (unsigned char)lane;
        }
        if (lane >= nsel && lane < NTs) steps[lane] = (unsigned char)0x7f;
        if (lane < NTw) steps[64 + lane] = (unsigned char)(lane < nwin ? (0x80 | (j0w + lane)) : 0x7f);
        const bf16_t* ksb = proj + (size_t)b * SEQ * PP + C_KS + hk * 64;
        char* shm = (char*)lds;
        f32x16 ob[2]; float lt;
        run_branch<8, true, true>(shm, qr, ksb, steps, NTs, qb, ob, lt, wid, lane);
        {
            int t2 = threadIdx.x; asm volatile("" : "+v"(t2));
            const int lane2 = t2 & 63, r2 = lane2 & 31, h2 = lane2 >> 5, wid2 = __builtin_amdgcn_readfirstlane(t2 >> 6), g2 = wid2 >> 1, tq2 = (wid2 & 1) * 32 + r2;
            LAS float* wsf2 = (LAS float*)(lds + WSF) + wid2 * 32; LAS float* osl2 = (LAS float*)(lds + IMP + wid2 * (32 * IMPW * 4)) + lane2;
            const float g1 = sigmoidf_(bf2f(proj[((size_t)b * SEQ + (size_t)qb * 64 + tq2) * PP + C_GBR + 1 * 16 + hk * 4 + g2]));
            if (h2 == 0) wsf2[r2] = g1 * __builtin_amdgcn_rcpf(fmaxf(lt, 1e-30f));
#pragma unroll
            for (int i = 0; i < 16; ++i) { const float sc = wsf2[crow(i, h2)]; osl2[(i * 2) * 64] += ob[0][i] * sc; osl2[(i * 2 + 1) * 64] += ob[1][i] * sc; }
        }
        {
            int t3 = threadIdx.x; asm volatile("" : "+v"(t3));
            run_branch<8, false, false>(shm, qr, ksb, steps + 64, NTw, qb, ob, lt, __builtin_amdgcn_readfirstlane(t3 >> 6), t3 & 63);
        }
        st.o0 = ob[0]; st.o1 = ob[1]; st.l = lt;
    }
    {
        int t2 = threadIdx.x; asm volatile("" : "+v"(t2));
        const int lane2 = t2 & 63, r2 = lane2 & 31, h2 = lane2 >> 5, wid2 = __builtin_amdgcn_readfirstlane(t2 >> 6), g2 = wid2 >> 1, tq2 = (wid2 & 1) * 32 + r2;
        LAS float* wsf2 = (LAS float*)(lds + WSF) + wid2 * 32; LAS float* osl2 = (LAS float*)(lds + IMP + wid2 * (32 * IMPW * 4)) + lane2;
        const float g3 = sigmoidf_(bf2f(proj[((size_t)b * SEQ + (size_t)qb * 64 + tq2) * PP + C_GBR + 2 * 16 + hk * 4 + g2]));
        if (h2 == 0) wsf2[r2] = g3 * __builtin_amdgcn_rcpf(fmaxf(st.l, 1e-30f));
        bf16_t* ob2 = proj + ((size_t)b * SEQ + (size_t)qb * 64 + (wid2 & 1) * 32) * PP + C_Q + (hk * 4 + g2) * 64;
        if (!skipw)
#pragma unroll
        for (int i = 0; i < 16; ++i) { const int q = crow(i, h2); const float sc = wsf2[q];
            const float f0 = osl2[(i * 2) * 64] + st.o0[i] * sc, f1 = osl2[(i * 2 + 1) * 64] + st.o1[i] * sc;
            ob2[(size_t)q * PP + r2] = (bf16_t)(pk2(f0, 0.f) & 0xffffu); ob2[(size_t)q * PP + 32 + r2] = (bf16_t)(pk2(f1, 0.f) & 0xffffu); }
    }
#undef LDK
#undef LDV
#undef STK
#undef STV
#undef KBUF
#undef VBUF
#undef ACCUM_OUT
}
}

__device__ __forceinline__ float wave_sum(float v) {
#pragma unroll
    for (int o = 1; o < 64; o <<= 1) v += __shfl_xor(v, o);
    return v;
}
__device__ __forceinline__ void transpose_item(const float* W, int K, int N, bf16_t* WT, int ldt, int k0, int n0, int drow0, const float* kscale, float cscale, LAS float* scr, int lane) {
    const int nq = (lane & 7) * 4, kr = lane >> 3;
    f32x4 v[8];
#pragma unroll
    for (int i = 0; i < 8; ++i) { const int kk = i * 8 + kr; const int n = n0 + nq;
        v[i] = (n < N) ? *(const f32x4*)(W + (size_t)(k0 + kk) * N + n) : (f32x4){0.f, 0.f, 0.f, 0.f}; }
#pragma unroll
    for (int i = 0; i < 8; ++i) { const int kk = i * 8 + kr; const float sc = (kscale ? kscale[k0 + kk] : 1.0f) * cscale;
        scr[(nq + 0) * 66 + kk] = v[i][0] * sc; scr[(nq + 1) * 66 + kk] = v[i][1] * sc; scr[(nq + 2) * 66 + kk] = v[i][2] * sc; scr[(nq + 3) * 66 + kk] = v[i][3] * sc; }
    asm volatile("s_waitcnt lgkmcnt(0)" ::: "memory");
    const int c = lane & 7;
    typedef float f32x2v __attribute__((ext_vector_type(2)));
#pragma unroll
    for (int j = 0; j < 4; ++j) { const int n = (lane >> 3) + 8 * j; const LAS f32x2v* s = (const LAS f32x2v*)(scr + n * 66 + 8 * c);
        const f32x2v a0 = s[0], a1 = s[1], a2 = s[2], a3 = s[3];
        u32x4 o; o.x = pk2(a0[0], a0[1]); o.y = pk2(a1[0], a1[1]); o.z = pk2(a2[0], a2[1]); o.w = pk2(a3[0], a3[1]);
        *(u32x4*)(WT + (size_t)(drow0 + n) * ldt + k0 + 8 * c) = o; }
    asm volatile("s_waitcnt lgkmcnt(0)" ::: "memory");
}

#define XB_TMO      128
#define XB_XCNT(j)  (256  + 64 * (j))
#define XB_XSUB(j)  (1280 + 64 * (j))
#define XB_XGEN(j)  (2304 + 64 * (j))
#define XB_TOP      3328
#define XB_TOPGEN   3392
#define XCD_BAR_WORDS 3456
#define XB_SPIN_CAP (1u << 18)
__device__ __forceinline__ unsigned xb_ld(unsigned* p)              { return __hip_atomic_load(p, __ATOMIC_RELAXED, __HIP_MEMORY_SCOPE_AGENT); }
__device__ __forceinline__ unsigned xb_add(unsigned* p, unsigned v) { return __hip_atomic_fetch_add(p, v, __ATOMIC_RELAXED, __HIP_MEMORY_SCOPE_AGENT); }
__device__ __forceinline__ unsigned xb_xcc_id() { return (unsigned)__builtin_amdgcn_s_getreg((3 << 11) | 20) & 0xFu; }
#define XB_SPIN(cond, bar) do { unsigned _sp = 0; while (cond) { __builtin_amdgcn_s_sleep(1); \
    if ((++_sp & 255u) == 0u) { if (xb_ld(&(bar)[XB_TMO])) break; if (_sp > XB_SPIN_CAP) { atomicAdd(&(bar)[XB_TMO], 1u); break; } } } } while (0)
struct XcdBarrier { unsigned* bar; unsigned x; volatile LAS unsigned* st; };
__device__ __forceinline__ XcdBarrier xcd_barrier_post(unsigned* bar, volatile LAS unsigned* st) {
    XcdBarrier b; b.bar = bar; b.x = xb_xcc_id(); b.st = st;
    if (threadIdx.x == 0) (void)xb_add(&bar[XB_XCNT(b.x)], 1u);
    return b;
}
__device__ __forceinline__ void xcd_barrier_complete(unsigned* bar, unsigned x, unsigned& nloc, unsigned& nx) {
    const unsigned G = gridDim.x * gridDim.y * gridDim.z;
    unsigned sum, cnt, mine, sp = 0u;
    for (;;) {
        sum = 0u; cnt = 0u; mine = 0u;
#pragma unroll
        for (unsigned j = 0; j < 16; ++j) { const unsigned c = xb_ld(&bar[XB_XCNT(j)]); sum += c; cnt += (c > 0u) ? 1u : 0u; mine = (j == x) ? c : mine; }
        if (sum == G) break;
        __builtin_amdgcn_s_sleep(1);
        if ((++sp & 255u) == 0u) { if (xb_ld(&bar[XB_TMO])) break; if (sp > XB_SPIN_CAP) { atomicAdd(&bar[XB_TMO], 1u); break; } }
    }
    nloc = mine > 0u ? mine : 1u; nx = cnt > 0u ? cnt : 1u;
}
__device__ __forceinline__ void xcd_barrier(const XcdBarrier& b) {
    asm volatile("s_waitcnt vmcnt(0)" ::: "memory");
    __syncthreads();
    if (threadIdx.x == 0) {
        unsigned* bar = b.bar;
        __builtin_amdgcn_s_waitcnt(0);
        unsigned nloc = b.st[0], nx = b.st[1];
        if (nloc == 0u) { xcd_barrier_complete(bar, b.x, nloc, nx); b.st[0] = nloc; b.st[1] = nx; }
        const unsigned old = xb_add(&bar[XB_XSUB(b.x)], 1u);
        const unsigned gen = old / nloc;
        if (old + 1u == (gen + 1u) * nloc) {
            __builtin_amdgcn_fence(__ATOMIC_RELEASE, "agent");
            asm volatile("s_waitcnt vmcnt(0)" ::: "memory");
            const unsigned og = xb_add(&bar[XB_TOP], 1u);
            const unsigned tg = og / nx;
            if (og + 1u == (tg + 1u) * nx) xb_add(&bar[XB_TOPGEN], 1u);
            else XB_SPIN(xb_ld(&bar[XB_TOPGEN]) == tg, bar);
            __builtin_amdgcn_fence(__ATOMIC_ACQUIRE, "agent");
            xb_add(&bar[XB_XGEN(b.x)], 1u);
            asm volatile("s_waitcnt vmcnt(0)" ::: "memory");
        } else {
            XB_SPIN(xb_ld(&bar[XB_XGEN(b.x)]) == gen, bar);
            __builtin_amdgcn_fence(__ATOMIC_ACQUIRE, "agent");
            asm volatile("s_waitcnt vmcnt(0)" ::: "memory");
        }
    }
    __syncthreads();
}

struct Args {
    const float *x, *w_in, *conv_w, *w_conv_out, *pos_k, *w1_k, *w2_k, *pos_v, *w1_v, *w2_v, *w_attn_out, *w_o, *g_mix, *g_ffn, *w_gate, *w_up, *w_down, *g_final;
    float* out; unsigned char* ws; int probe; int pad;
};

__global__ void __launch_bounds__(512, 2) nsa_fwd(Args a) {
    extern __shared__ __attribute__((aligned(16))) unsigned char lds_raw[];
    LAS unsigned char* lds = (LAS unsigned char*)lds_raw;
    cg::grid_group grid = cg::this_grid();
    const int tid = threadIdx.x, lane = tid & 63, wave = __builtin_amdgcn_readfirstlane(tid >> 6);
    const int G = gridDim.x, bx = blockIdx.x;
    const int vcu = (G % 8 == 0) ? (bx % 8) * (G / 8) + bx / 8 : bx;
    unsigned char* ws = a.ws;
    volatile LAS unsigned* bst = (volatile LAS unsigned*)(lds + 143360);
    if (tid < 2) bst[tid] = 0u;
    __syncthreads();
    const XcdBarrier gbar = xcd_barrier_post((unsigned*)(ws + WS_BAR), bst);
#define SEAM() xcd_barrier(gbar)
    float* part1 = (float*)(ws + WS_PART1); float* part2 = (float*)(ws + WS_PART2); float* cbias = (float*)(ws + WS_BIAS);
    bf16_t* Win = (bf16_t*)(ws + WS_WIN); bf16_t* Wconv = (bf16_t*)(ws + WS_WCONV); bf16_t* Wattn = (bf16_t*)(ws + WS_WATTN); bf16_t* Wo = (bf16_t*)(ws + WS_WO);
    bf16_t* Wup = (bf16_t*)(ws + WS_WUP); bf16_t* Wdown = (bf16_t*)(ws + WS_WDOWN); bf16_t* W1 = (bf16_t*)(ws + WS_W1); bf16_t* W2 = (bf16_t*)(ws + WS_W2);
    bf16_t* hid = (bf16_t*)(ws + WS_HID); bf16_t* kcmp = (bf16_t*)(ws + WS_KCMP); bf16_t* proj = (bf16_t*)(ws + WS_PROJ);
    float* h1f = (float*)(ws + WS_H1F); bf16_t* h1b = (bf16_t*)(ws + WS_H1B); bf16_t* act = (bf16_t*)(ws + WS_ACT);
    bf16_t* nb = (bf16_t*)a.out; bf16_t* mix = (bf16_t*)a.out; bf16_t* bc = (bf16_t*)((unsigned char*)a.out + OUT_BC);

    {
        LAS float* scr = (LAS float*)(lds + wave * 16384);
        const int gw = vcu * 8 + wave, NGW = G * 8;
        constexpr int I_IN = 16 * 194, I_CONV = 8 * 32, I_ATT = 16 * 32, I_O = 16 * 32, I_G = 16 * 88, I_U = 16 * 88, I_D = 44 * 32, I_1 = 32 * 8, I_2 = 4 * 2;
        constexpr int NITEMS = I_IN + I_CONV + I_ATT + I_O + 2 * I_1 + 2 * I_2;
        for (int it = gw; it < NITEMS; it += NGW) {
            int q = it;
            if (q < I_IN) { const int kb = q / 194, nbk = q % 194, n0 = 32 * nbk; const float cs = (n0 >= C_Q && n0 < C_KC) ? QSCALE : 1.0f;
                transpose_item(a.w_in, 1024, INCOLS, Win, 1024, 64 * kb, n0, n0, a.g_mix, cs, scr, lane); continue; } q -= I_IN;
            if (q < I_CONV) { const int kb = q / 32, nbk = q % 32; transpose_item(a.w_conv_out, 512, 1024, Wconv, 512, 64 * kb, 32 * nbk, 32 * nbk, nullptr, 1.f, scr, lane); continue; } q -= I_CONV;
            if (q < I_ATT) { const int kb = q / 32, nbk = q % 32; transpose_item(a.w_attn_out, 1024, 1024, Wattn, 1024, 64 * kb, 32 * nbk, 32 * nbk, nullptr, 1.f, scr, lane); continue; } q -= I_ATT;
            if (q < I_O) { const int kb = q / 32, nbk = q % 32; transpose_item(a.w_o, 1024, 1024, Wo, 1024, 64 * kb, 32 * nbk, 32 * nbk, nullptr, 1.f, scr, lane); continue; } q -= I_O;
            if (q < I_1) { const int kb = q / 8, nbk = q % 8; transpose_item(a.w1_k, 2048, 256, W1, 2048, 64 * kb, 32 * nbk, 32 * nbk, nullptr, 1.f, scr, lane); continue; } q -= I_1;
            if (q < I_1) { const int kb = q / 8, nbk = q % 8; transpose_item(a.w1_v, 2048, 256, W1, 2048, 64 * kb, 32 * nbk, 256 + 32 * nbk, nullptr, 1.f, scr, lane); continue; } q -= I_1;
            if (q < I_2) { const int kb = q / 2, nbk = q % 2; transpose_item(a.w2_k, 256, 64, W2, 256, 64 * kb, 32 * nbk, 32 * nbk, nullptr, 1.f, scr, lane); continue; } q -= I_2;
            { const int kb = q / 2, nbk = q % 2; transpose_item(a.w2_v, 256, 64, W2, 256, 64 * kb, 32 * nbk, 256 + 32 * nbk, nullptr, 1.f, scr, lane); }
        }
        const int gt = vcu * 512 + tid, NGT = G * 512;
        for (int i = gt; i < 192 * 1024 / 8; i += NGT) *(u32x4*)(Win + (size_t)6208 * 1024 + (size_t)i * 8) = (u32x4){0u, 0u, 0u, 0u};
        for (int i = gt; i < 2 * 192 * 256 / 8; i += NGT) { const int half = i / (192 * 256 / 8), o = i % (192 * 256 / 8);
            *(u32x4*)(W2 + (size_t)(half * 256 + 64) * 256 + (size_t)o * 8) = (u32x4){0u, 0u, 0u, 0u}; }
        for (int m = gw; m < MTOK; m += NGW) {
            const f32x4* xr = (const f32x4*)(a.x + (size_t)m * DM) + lane; f32x4 v[4]; float s = 0.f;
#pragma unroll
            for (int j = 0; j < 4; ++j) { v[j] = xr[64 * j]; s += (v[j][0] * v[j][0] + v[j][1] * v[j][1]) + (v[j][2] * v[j][2] + v[j][3] * v[j][3]); }
            const float rstd = __builtin_amdgcn_rsqf(wave_sum(s) * (1.0f / DM) + EPS);
            u32x2* o8 = (u32x2*)(nb + (size_t)m * DM) + lane;
#pragma unroll
            for (int j = 0; j < 4; ++j) { u32x2 w; w.x = pk2(v[j][0] * rstd, v[j][1] * rstd); w.y = pk2(v[j][2] * rstd, v[j][3] * rstd); o8[64 * j] = w; }
        }
        if (bx < 32) {
            const int which = bx >> 4, chunk = bx & 15;
            const float* pos = which ? a.pos_v : a.pos_k; const float* w1 = which ? a.w1_v : a.w1_k;
            const int j = tid & 255, part = tid >> 8, kbeg = chunk * 128 + part * 64; float s = 0.f;
#pragma unroll 16
            for (int k = kbeg; k < kbeg + 64; ++k) s += pos[k] * w1[(size_t)k * 256 + j];
            LAS float* red = (LAS float*)(lds + 8 * 16384);
            if (part == 1) red[j] = s;
            __syncthreads();
            if (part == 0) cbias[1024 + (which * 16 + chunk) * 256 + j] = s + red[j];
        }
    }
    if (a.probe == 0x7fffffff) grid.sync();
    SEAM();
    {
        const int ncols1 = (G > 64) ? 6144 : PP;
        pg8::Gemm g{nb, Win, MTOK, ncols1, DM, DM, 128, 0}; pg8::StaticOrder S; S.init(MTOK, ncols1, G, bx);
        pg8::EpiProj E{proj, PP};
        pg8::gemm_phase(lds, g, S, E);
    }
    SEAM();
    {
        {
            pg8::Gemm g{proj + C_KC, W1, 4096, 512, 2048, 16 * PP, PP * 2, 1}; pg8::StaticOrder S; S.init(4096, 512, G, bx);
            float* cb = (float*)(ws + WS_PART2 + 512 * 1024) + (size_t)bx * 512;
            if (bx < 32) { const int which = tid >> 8, j = tid & 255; float sb = 0.f;
#pragma unroll
                for (int c = 0; c < 16; ++c) sb += cbias[1024 + (which * 16 + c) * 256 + j];
                cb[tid] = sb;
                asm volatile("s_waitcnt vmcnt(0)" ::: "memory"); __syncthreads(); }
            pg8::EpiHid E{hid, cb};
            pg8::gemm_phase(lds, g, S, E);
        }
        int wb = bx, wn = G; if (G > 64) { wb = bx - 32; wn = G - 32; }
        if (wb >= 0) {
            for (int it = wb * 512 + tid; it < MTOK * 64; it += wn * 512) {
                const int row = it >> 6, ch = (it & 63) * 8, t = row & (SEQ - 1);
                const bf16_t* pr = proj + (size_t)row * PP;
                float accv[8];
#pragma unroll
                for (int j = 0; j < 8; ++j) accv[j] = 0.f;
#pragma unroll
                for (int k = 0; k < 3; ++k) { const int dt = 2 - k;
                    if (t - dt >= 0) { const u32x4 cv = *(const u32x4*)(pr - (size_t)dt * PP + C_C + ch), hv = *(const u32x4*)(pr - (size_t)dt * PP + C_H + ch);
                        const f32x4 w0 = *(const f32x4*)(a.conv_w + k * 512 + ch), w1 = *(const f32x4*)(a.conv_w + k * 512 + ch + 4);
                        accv[0] += w0[0] * lo_bf(cv.x) * lo_bf(hv.x); accv[1] += w0[1] * hi_bf(cv.x) * hi_bf(hv.x); accv[2] += w0[2] * lo_bf(cv.y) * lo_bf(hv.y); accv[3] += w0[3] * hi_bf(cv.y) * hi_bf(hv.y);
                        accv[4] += w1[0] * lo_bf(cv.z) * lo_bf(hv.z); accv[5] += w1[1] * hi_bf(cv.z) * hi_bf(hv.z); accv[6] += w1[2] * lo_bf(cv.w) * lo_bf(hv.w); accv[7] += w1[3] * hi_bf(cv.w) * hi_bf(hv.w); } }
                const u32x4 bv = *(const u32x4*)(pr + C_B + ch);
                u32x4 o; o.x = pk2(accv[0] * lo_bf(bv.x), accv[1] * hi_bf(bv.x)); o.y = pk2(accv[2] * lo_bf(bv.y), accv[3] * hi_bf(bv.y));
                o.z = pk2(accv[4] * lo_bf(bv.z), accv[5] * hi_bf(bv.z)); o.w = pk2(accv[6] * lo_bf(bv.w), accv[7] * hi_bf(bv.w));
                *(u32x4*)(bc + (size_t)row * 512 + ch) = o;
            }
        }
        if (G > 64 && wb >= 0) {
            { pg8::Gemm g{nb, Win + (size_t)6144 * 1024, MTOK, 256, DM, DM, 128, 0}; pg8::StaticOrder S; S.init(MTOK, 256, wn, wb);
              pg8::EpiProj E{proj + 6144, PP}; pg8::gemm_phase(lds, g, S, E); }
            __syncthreads();
            LAS float* scr = (LAS float*)(lds + wave * 16384);
            constexpr int I_G = 16 * 88, I_U = 16 * 88, I_D = 44 * 32;
            for (int it = wb * 8 + wave; it < I_G + I_U + I_D; it += wn * 8) {
                int q = it;
                if (q < I_G) { const int kb = q / 88, nbk = q % 88, n0 = 32 * nbk; transpose_item(a.w_gate, 1024, DFF, Wup, 1024, 64 * kb, n0, (n0 / 128) * 256 + (n0 % 128), a.g_ffn, 1.f, scr, lane); continue; } q -= I_G;
                if (q < I_U) { const int kb = q / 88, nbk = q % 88, n0 = 32 * nbk; transpose_item(a.w_up, 1024, DFF, Wup, 1024, 64 * kb, n0, (n0 / 128) * 256 + 128 + (n0 % 128), a.g_ffn, 1.f, scr, lane); continue; } q -= I_U;
                { const int kb = q / 32, nbk = q % 32; transpose_item(a.w_down, DFF, 1024, Wdown, DFF, 64 * kb, 32 * nbk, 32 * nbk, nullptr, 1.f, scr, lane); }
            }
        }
    }
    {
        pg8::Gemm g{hid, W2, 4096, 512, 256, 256, 128, 2}; pg8::StaticOrder S; S.init(4096, 512, G, bx);
        pg8::EpiCmp E{kcmp};
        pg8::gemm_phase(lds, g, S, E);
    }
    SEAM();
    {
        for (int v = vcu; v < 256; v += G) {
            const int bh = v >> 4, s = v & 15;
#pragma unroll 1
            for (int i = 0; i < 4; ++i) { const int qb = (i == 0) ? 63 - s : (i == 1) ? 32 + s : (i == 2) ? 31 - s : s;
#if defined(PROBE_ATT2) || defined(PROBE_NOLD)
                att::attn_unit(lds, proj, kcmp, kcmp + 4096 * 64, bh, qb, a.probe);
#endif
                att::attn_unit(lds, proj, kcmp, kcmp + 4096 * 64, bh, qb, 0);
            }
        }
    }
    SEAM();
    {
        { pg8::Gemm g{bc, Wconv, MTOK, DM, 512, 512, 128, 0}; pg8::StaticOrder S; S.init(MTOK, DM, G, bx);
          pg8::EpiMix<0> E{mix, proj, C_GCONV}; pg8::gemm_phase(lds, g, S, E); }
        { pg8::Gemm g{proj + C_Q, Wattn, MTOK, DM, DM, PP, 128, 0}; pg8::StaticOrder S; S.init(MTOK, DM, G, bx);
          pg8::EpiMix<1> E{mix, proj, C_GATTN}; pg8::gemm_phase(lds, g, S, E); }
    }
    SEAM();
    {
        pg8::Gemm g{mix, Wo, MTOK, DM, DM, DM, 128, 0}; pg8::StaticOrder S; S.init(MTOK, DM, G, bx);
        pg8::EpiRes<1> E{a.x, h1f, h1b, part1}; pg8::gemm_phase(lds, g, S, E);
    }
    SEAM();
    {
        pg8::Gemm g{h1b, Wup, MTOK, 2 * DFF, DM, DM, 128, 0}; pg8::StaticOrder S; S.init(MTOK, 2 * DFF, G, bx);
        pg8::EpiUp E{act, part1}; pg8::gemm_phase(lds, g, S, E);
    }
    SEAM();
    if (G == 256) {
        pg8::Gemm g{act, Wdown, MTOK, DM, DFF, DFF, 128, 0}; pg8::StaticOrder S; S.init(MTOK, DM, G, bx);
        pg8::EpiFinal E{h1f, a.out, a.g_final, (unsigned*)part2, (unsigned*)(ws + WS_BAR) + 4096, (unsigned*)(ws + WS_BAR) + XB_TMO};
        pg8::gemm_phase(lds, g, S, E);
        return;
    }
    {
        pg8::Gemm g{act, Wdown, MTOK, DM, DFF, DFF, 128, 0}; pg8::StaticOrder S; S.init(MTOK, DM, G, bx);
        pg8::EpiRes<0> E{h1f, a.out, nullptr, part2}; pg8::gemm_phase(lds, g, S, E);
    }
    SEAM();
    {
        for (int it = bx * 512 + tid; it < MTOK * 256; it += G * 512) {
            const int row = it >> 8, c4 = (it & 255) * 4;
            const f32x4* pp = (const f32x4*)(part2 + (size_t)row * 16); float ss = 0.f;
#pragma unroll
            for (int j = 0; j < 4; ++j) { const f32x4 p = pp[j]; ss += (p[0] + p[1]) + (p[2] + p[3]); }
            const float r = __builtin_amdgcn_rsqf(ss * (1.0f / DM) + EPS);
            f32x4 v = *(f32x4*)(a.out + (size_t)row * DM + c4); const f32x4 gf = *(const f32x4*)(a.g_final + c4);
            v = v * r * gf; *(f32x4*)(a.out + (size_t)row * DM + c4) = v;
        }
    }
}

extern "C" void kernel_launch(void* const* d_in, const int* in_sizes, int n_in, void* d_out, int out_size, void* d_ws, size_t ws_size, hipStream_t stream) {
    static int grid = 0;
    if (grid == 0) {
        if (n_in != 18 || out_size != MTOK * DM || ws_size < WS_NEED) { fprintf(stderr, "kernel_launch: unexpected shapes (n_in %d out %d ws %zu)\n", n_in, out_size, ws_size); grid = -1; return; }
        int dev = 0, cus = 0, per_cu = 0;
        (void)hipGetDevice(&dev);
        (void)hipDeviceGetAttribute(&cus, hipDeviceAttributeMultiprocessorCount, dev);
        (void)hipFuncSetAttribute((const void*)nsa_fwd, hipFuncAttributeMaxDynamicSharedMemorySize, LDS_BYTES);
        (void)hipOccupancyMaxActiveBlocksPerMultiprocessor(&per_cu, (const void*)nsa_fwd, 512, LDS_BYTES);
        if (per_cu < 1) { fprintf(stderr, "kernel_launch: occupancy query says %d blocks/CU\n", per_cu); grid = -1; return; }
        grid = cus;
    }
    if (grid < 0) return;
    (void)hipMemsetAsync((unsigned char*)d_ws + WS_BAR, 0, 32768, stream);
    Args a{};
    a.x = (const float*)d_in[0]; a.w_in = (const float*)d_in[1]; a.conv_w = (const float*)d_in[2]; a.w_conv_out = (const float*)d_in[3];
    a.pos_k = (const float*)d_in[4]; a.w1_k = (const float*)d_in[5]; a.w2_k = (const float*)d_in[6];
    a.pos_v = (const float*)d_in[7]; a.w1_v = (const float*)d_in[8]; a.w2_v = (const float*)d_in[9];
    a.w_attn_out = (const float*)d_in[10]; a.w_o = (const float*)d_in[11]; a.g_mix = (const float*)d_in[12]; a.g_ffn = (const float*)d_in[13];
    a.w_gate = (const float*)d_in[14]; a.w_up = (const float*)d_in[15]; a.w_down = (const float*)d_in[16]; a.g_final = (const float*)d_in[17];
    a.out = (float*)d_out; a.ws = (unsigned char*)d_ws; a.probe = 1; a.pad = 0;
    void* args[] = {&a};
    hipError_t e = hipLaunchCooperativeKernel((void*)nsa_fwd, dim3(grid), dim3(512), args, LDS_BYTES, stream);
    if (e != hipSuccess) fprintf(stderr, "kernel_launch: cooperative launch failed: %s (grid %d)\n", hipGetErrorString(e), grid);
}
```
